# Optimizing an MI355X kernel written in HIP

```python
import jax, jax.numpy as jnp
from jax import lax
import numpy as np

D_MODEL = 2048
BATCH = 2
SEQ = 4096
DEPTH = 1

RW_HEADS = 16
RW_HEAD = 64
RW_DIM = RW_HEADS * RW_HEAD
DECAY_LORA = 96
ICLR_LORA = 96
GATE_LORA = 256
GN_EPS = 64e-5
ATT_HEADS = 16
ATT_KV_HEADS = 4
ATT_GROUP = ATT_HEADS // ATT_KV_HEADS
ATT_HEAD = 64
ATT_Q_DIM = ATT_HEADS * ATT_HEAD
ATT_KV_DIM = ATT_KV_HEADS * ATT_HEAD
WINDOW = 128
BLOCK = 128
D_FF = 5632
CONV_W = 3
RMS_EPS = 1e-6
NEG_BIG = -1e30

RW_SHIFT_COLS = 3 * RW_DIM + DECAY_LORA + ICLR_LORA + GATE_LORA
ATT_COLS = ATT_Q_DIM + 2 * ATT_KV_DIM
GATE_COLS = 2 * D_MODEL
IN_COLS = RW_SHIFT_COLS + ATT_COLS + GATE_COLS

kernel_name = "hybrid_rwkv7_swa_gated_convffn"


def rms_norm(x, g, eps=RMS_EPS):
    xf = x.astype(jnp.float32)
    y = xf * lax.rsqrt(jnp.mean(xf * xf, axis=-1, keepdims=True) + eps)
    return (y * g.astype(jnp.float32)).astype(x.dtype)


def token_shift(z, mu):
    z_prev = jnp.pad(z, ((0, 0), (1, 0), (0, 0)))[:, :-1]
    return z + (z_prev - z) * mu


def rwkv7_mix(zs, w0, w2, a0, a2, g2, k_k, k_a, r_k, gn_w, gn_b):
    B, S, _ = zs.shape
    f32 = jnp.float32
    o1 = RW_DIM
    o2 = 2 * RW_DIM
    o3 = 3 * RW_DIM
    o4 = o3 + DECAY_LORA
    o5 = o4 + ICLR_LORA
    r, k, v, wd, ad, gd = jnp.split(zs, [o1, o2, o3, o4, o5], axis=-1)
    w = -jax.nn.softplus(-(w0 + jnp.tanh(wd) @ w2)) - 0.5
    decay = jnp.exp(-jnp.exp(w.astype(f32)))
    a = jax.nn.sigmoid(a0 + ad @ a2)
    g = jax.nn.sigmoid(gd) @ g2
    hd = (B, S, RW_HEADS, RW_HEAD)
    kk = (k * k_k).reshape(hd).astype(f32)
    kk = kk / jnp.maximum(jnp.sqrt(jnp.sum(kk * kk, axis=-1, keepdims=True)), 1e-12)
    k = k * (1.0 + (a - 1.0) * k_a)
    rh = r.reshape(hd).astype(f32)
    kh = k.reshape(hd).astype(f32)
    vh = v.reshape(hd).astype(f32)
    wh = decay.reshape(hd)
    ah = a.reshape(hd).astype(f32)
    tm = lambda t: jnp.moveaxis(t, 1, 0)
    xs = (tm(rh), tm(kh), tm(vh), tm(wh), tm(-kk), tm(kk * ah))

    def step(state, inp):
        r_t, k_t, v_t, w_t, ka_t, kb_t = inp
        sa = jnp.einsum('bhvk,bhk->bhv', state, ka_t)
        state = (state * w_t[:, :, None, :] + sa[..., None] * kb_t[:, :, None, :]
                 + v_t[..., None] * k_t[:, :, None, :])
        y = jnp.einsum('bhvk,bhk->bhv', state, r_t)
        return state, y

    state0 = jnp.zeros((B, RW_HEADS, RW_HEAD, RW_HEAD), f32)
    _, y = lax.scan(step, state0, xs)
    y = jnp.moveaxis(y, 0, 1)
    mu = jnp.mean(y, axis=-1, keepdims=True)
    var = jnp.mean(jnp.square(y - mu), axis=-1, keepdims=True)
    y = ((y - mu) * lax.rsqrt(var + GN_EPS)).reshape(B, S, RW_DIM)
    y = y * gn_w.astype(f32) + gn_b.astype(f32)
    bonus = jnp.sum(rh * kh * r_k.astype(f32), axis=-1, keepdims=True) * vh
    out = (y + bonus.reshape(B, S, RW_DIM)) * g.astype(f32)
    return out.astype(zs.dtype)


def swa_attention(q, k, v, q_gain, k_gain, sinks):
    B, S, _ = q.shape
    nb = S // BLOCK
    q = rms_norm(q.reshape(B, S, ATT_HEADS, ATT_HEAD), q_gain)
    k = rms_norm(k.reshape(B, S, ATT_KV_HEADS, ATT_HEAD), k_gain)
    v = v.reshape(B, S, ATT_KV_HEADS, ATT_HEAD)
    qb = q.reshape(B, nb, BLOCK, ATT_KV_HEADS, ATT_GROUP, ATT_HEAD)

    def band(t):
        tp = jnp.pad(t, ((0, 0), (BLOCK, 0), (0, 0), (0, 0)))[:, :S]
        prev = tp.reshape(B, nb, BLOCK, ATT_KV_HEADS, ATT_HEAD)
        cur = t.reshape(B, nb, BLOCK, ATT_KV_HEADS, ATT_HEAD)
        return jnp.concatenate([prev, cur], axis=2)

    kb, vb = band(k), band(v)
    scores = jnp.einsum('bnqhgd,bnkhd->bnhgqk', qb, kb).astype(jnp.float32) * (ATT_HEAD ** -0.5)
    qi = jnp.arange(BLOCK)[:, None]
    kj = jnp.arange(2 * BLOCK)[None, :]
    dist = (BLOCK + qi - kj).astype(jnp.float32)
    key_pos = jnp.arange(nb)[:, None] * BLOCK - BLOCK + jnp.arange(2 * BLOCK)[None, :]
    valid = ((dist >= 0) & (dist < WINDOW))[None] & (key_pos[:, None, :] >= 0)
    slopes = jnp.exp2(-8.0 * jnp.arange(1, ATT_HEADS + 1, dtype=jnp.float32) / ATT_HEADS)
    alibi = -slopes.reshape(ATT_KV_HEADS, ATT_GROUP)[:, :, None, None] * dist
    scores = jnp.where(valid[None, :, None, None], scores + alibi[None, None], NEG_BIG)
    sink = jnp.broadcast_to(sinks.astype(jnp.float32).reshape(1, 1, ATT_KV_HEADS, ATT_GROUP, 1, 1),
                            scores.shape[:-1] + (1,))
    p = jax.nn.softmax(jnp.concatenate([scores, sink], axis=-1), axis=-1)[..., :-1]
    o = jnp.einsum('bnhgqk,bnkhd->bnqhgd', p.astype(vb.dtype), vb)
    return o.reshape(B, S, ATT_Q_DIM)


def conv_ffn(h, w_up, conv_w, conv_b, w_down):
    u = h @ w_up
    S = u.shape[1]
    up = jnp.pad(u, ((0, 0), (CONV_W - 1, 0), (0, 0)))
    c = up[:, 0:S] * conv_w[0] + up[:, 1:S + 1] * conv_w[1] + up[:, 2:S + 2] * conv_w[2] + conv_b
    val, gate = jnp.split(c, 2, axis=-1)
    return (jax.nn.silu(gate) * val) @ w_down


def setup_inputs(seed: int = 0) -> dict:
    key = jax.random.key(seed)
    ks = jax.random.split(key, 26)
    f32 = jnp.float32
    L = DEPTH
    nrm = lambda k, shape, s: jax.random.normal(k, shape, f32) * s
    return {
        "x": nrm(ks[0], (BATCH, SEQ, D_MODEL), 1.0),
        "norm1_g": 1.0 + nrm(ks[1], (L, D_MODEL), 0.02),
        "w_in": nrm(ks[2], (L, D_MODEL, IN_COLS), D_MODEL ** -0.5),
        "rw_mu": jax.random.uniform(ks[3], (L, RW_SHIFT_COLS), f32),
        "rw_w0": jax.random.uniform(ks[4], (L, RW_DIM), f32, -6.0, -1.0),
        "rw_w2": nrm(ks[5], (L, DECAY_LORA, RW_DIM), 0.1 * DECAY_LORA ** -0.5),
        "rw_a0": nrm(ks[6], (L, RW_DIM), 0.5),
        "rw_a2": nrm(ks[7], (L, ICLR_LORA, RW_DIM), ICLR_LORA ** -0.5),
        "rw_g2": nrm(ks[8], (L, GATE_LORA, RW_DIM), GATE_LORA ** -0.5),
        "rw_k_k": 0.85 + nrm(ks[9], (L, RW_DIM), 0.02),
        "rw_k_a": 1.0 + nrm(ks[10], (L, RW_DIM), 0.02),
        "rw_r_k": nrm(ks[11], (L, RW_HEADS, RW_HEAD), 0.1),
        "rw_gn_w": 1.0 + nrm(ks[12], (L, RW_DIM), 0.02),
        "rw_gn_b": nrm(ks[13], (L, RW_DIM), 0.02),
        "q_norm_g": 1.0 + nrm(ks[14], (L, ATT_HEAD), 0.02),
        "k_norm_g": 1.0 + nrm(ks[15], (L, ATT_HEAD), 0.02),
        "attn_sinks": nrm(ks[16], (L, ATT_HEADS), 0.5),
        "w_branch": nrm(ks[17], (L, RW_DIM + ATT_Q_DIM, D_MODEL), RW_DIM ** -0.5),
        "w_out": nrm(ks[18], (L, D_MODEL, D_MODEL), D_MODEL ** -0.5),
        "norm2_g": 1.0 + nrm(ks[19], (L, D_MODEL), 0.02),
        "w_up": nrm(ks[20], (L, D_MODEL, 2 * D_FF), D_MODEL ** -0.5),
        "conv_w": nrm(ks[21], (L, CONV_W, 2 * D_FF), CONV_W ** -0.5),
        "conv_b": nrm(ks[22], (L, 2 * D_FF), 0.02),
        "w_down": nrm(ks[23], (L, D_FF, D_MODEL), D_FF ** -0.5),
    }


def reference(x, norm1_g, w_in, rw_mu, rw_w0, rw_w2, rw_a0, rw_a2, rw_g2, rw_k_k, rw_k_a,
              rw_r_k, rw_gn_w, rw_gn_b, q_norm_g, k_norm_g, attn_sinks, w_branch, w_out,
              norm2_g, w_up, conv_w, conv_b, w_down):
    for l in range(DEPTH):
        h = rms_norm(x, norm1_g[l])
        z = h @ w_in[l]
        zs = token_shift(z[..., :RW_SHIFT_COLS], rw_mu[l])
        za = z[..., RW_SHIFT_COLS:RW_SHIFT_COLS + ATT_COLS]
        zg = z[..., RW_SHIFT_COLS + ATT_COLS:]
        o_rw = rwkv7_mix(zs, rw_w0[l], rw_w2[l], rw_a0[l], rw_a2[l], rw_g2[l], rw_k_k[l],
                         rw_k_a[l], rw_r_k[l], rw_gn_w[l], rw_gn_b[l])
        q = za[..., :ATT_Q_DIM]
        k = za[..., ATT_Q_DIM:ATT_Q_DIM + ATT_KV_DIM]
        v = za[..., ATT_Q_DIM + ATT_KV_DIM:]
        o_att = swa_attention(q, k, v, q_norm_g[l], k_norm_g[l], attn_sinks[l])
        p_rw = o_rw @ w_branch[l, :RW_DIM]
        p_att = o_att @ w_branch[l, RW_DIM:]
        g_rw = jax.nn.sigmoid(zg[..., :D_MODEL])
        g_att = jax.nn.sigmoid(zg[..., D_MODEL:])
        x = x + (g_rw * p_rw + g_att * p_att) @ w_out[l]
        x = x + conv_ffn(rms_norm(x, norm2_g[l]), w_up[l], conv_w[l], conv_b[l], w_down[l])
    return x
```

```cpp
#include <hip/hip_runtime.h>
#include <hip/hip_cooperative_groups.h>
#include <cstdio>
#include <cstdint>
namespace cg = cooperative_groups;
namespace pg8 {
#define PG8_LAS __attribute__((address_space(3)))
typedef unsigned short bf16_t;
typedef short bf16x8 __attribute__((ext_vector_type(8)));
typedef float f32x4 __attribute__((ext_vector_type(4)));
typedef unsigned u32x4 __attribute__((ext_vector_type(4)));
constexpr int BM = 256, BK = 64, HALF = 128, HTB = HALF * BK * 2  , STAGE_BYTES = 8 * HTB, NXCD = 8, WGM = 8;

__host__ __device__ __forceinline__ int lds_byte(int r, int c) { const int st = (r >> 4) * 2 + (c >> 5), rr = r & 15, cc = c & 31, ob = rr * 64 + cc * 2; return st * 1024 + (ob ^ (((ob >> 9) & 1) << 5)); }
__host__ __device__ __forceinline__ void stage_rc(int b, int& R, int& C) { const int st = b / 1024, sb = b % 1024, swz = sb ^ (((sb >> 9) & 1) << 5); R = (st >> 1) * 16 + swz / 64; C = (st & 1) * 32 + (swz % 64) / 2; }
__host__ __device__ __forceinline__ int perm32(int rho) { const int n = rho >> 4, i = rho & 15; return 8 * (i >> 2) + 4 * n + (i & 3); }

struct Unit { int pm, pn; };
struct Gemm { const bf16_t* A; const bf16_t* Bt; int M, N, K; };

struct StaticOrder {
    int nM, nN, nwg, G, c;
    __host__ __device__ void init(int M, int N, int G_, int c_) { nM = M / BM; nN = N / BM; nwg = nM * nN; G = G_; c = c_; }
    __host__ __device__ bool next(int i, Unit& u) const {
        const long L = (long)i * G + c; if (L >= nwg) return false;
        int wgid = (int)L; { const int q = nwg / NXCD, r = nwg % NXCD, xcd = wgid % NXCD, off = wgid / NXCD; wgid = (xcd < r ? xcd * (q + 1) : r * (q + 1) + (xcd - r) * q) + off; }
        const int nig = WGM * nN, gid = wgid / nig, fm = gid * WGM, gsz = (nM - fm) < WGM ? (nM - fm) : WGM;
        u.pm = fm + ((wgid % nig) % gsz); u.pn = (wgid % nig) / gsz; return true;
    }
    __device__ __forceinline__ void a_ready(const Unit&) const {}
    __device__ __forceinline__ void done(const Unit&) const {}
};
typedef __bf16 bf16v2_t __attribute__((ext_vector_type(2))); typedef float f32v2_t __attribute__((ext_vector_type(2)));
__device__ __forceinline__ unsigned cvt_pk_bf16(float lo, float hi) { const f32v2_t x = {lo, hi}; const bf16v2_t r = __builtin_convertvector(x, bf16v2_t); return __builtin_bit_cast(unsigned, r); }
template <class Epi, class Sched>
__device__ __forceinline__ void gemm_phase(PG8_LAS unsigned char* lds, const Gemm g, const Sched& S, const Epi& E) {
    const int tid = threadIdx.x, wid = __builtin_amdgcn_readfirstlane(tid >> 6), lane = tid & 63, wr = wid >> 2, wc = wid & 3, fr = lane & 15, fq = lane >> 4;
    const int K = g.K, nt = K / BK;
    unsigned voffA[2], voffB[2];
#pragma unroll
    for (int i = 0; i < 2; ++i) { int R, C; stage_rc(tid * 16 + i * 8192, R, C); const int Rb = Epi::PERM ? ((R & ~31) + perm32(R & 31)) : R;
        voffA[i] = (unsigned)(R * K + C) * 2u; voffB[i] = (unsigned)(Rb * K + C) * 2u; }
    const size_t kstep = (size_t)(BK * 2);
    const size_t hstep = (size_t)HALF * K * 2;
    const size_t tstep = 2 * hstep;
    const unsigned ldsw = (unsigned)wid * 1024u;
    const int aoff = lds_byte(wr * 64 + fr, fq * 8), boff = lds_byte(wc * 32 + fr, fq * 8);
#define PG8_SA(b, h) (((b) * 2 + (h)) * HTB)
#define PG8_SB(b, h) ((4 + (b) * 2 + (h)) * HTB)
#define PG8_STAGE(bufoff, gbase, voff) do { _Pragma("unroll") for (int _i = 0; _i < 2; ++_i) \
        __builtin_amdgcn_global_load_lds((const unsigned*)((const char*)(gbase) + (voff)[_i]), (PG8_LAS unsigned*)(lds + (bufoff) + ldsw + _i * 8192), 16, 0, 0); } while (0)
#define PG8_LDA(dst, b, h) do { _Pragma("unroll") for (int m = 0; m < 4; ++m) _Pragma("unroll") for (int k = 0; k < 2; ++k) dst[m][k] = *(const PG8_LAS bf16x8*)(lds + PG8_SA(b, h) + aoff + m * 2048 + k * 1024); } while (0)
#define PG8_LDB(dst, b, h) do { _Pragma("unroll") for (int n = 0; n < 2; ++n) _Pragma("unroll") for (int k = 0; k < 2; ++k) dst[n][k] = *(const PG8_LAS bf16x8*)(lds + PG8_SB(b, h) + boff + n * 2048 + k * 1024); } while (0)
#define PG8_MMA(ai, bj, At, Bt) do { __builtin_amdgcn_s_setprio(1); _Pragma("unroll") for (int m = 0; m < 4; ++m) _Pragma("unroll") for (int n = 0; n < 2; ++n) _Pragma("unroll") for (int k = 0; k < 2; ++k) \
        acc[ai][bj][m][n] = __builtin_amdgcn_mfma_f32_16x16x32_bf16(Bt[n][k], At[m][k], acc[ai][bj][m][n], 0, 0, 0); __builtin_amdgcn_s_setprio(0); } while (0)
#define PG8_WAIT_V(n) asm volatile("s_waitcnt vmcnt(" #n ")" ::: "memory")
#define PG8_WAIT_L(n) asm volatile("s_waitcnt lgkmcnt(" #n ")" ::: "memory")
#define PG8_BAR __builtin_amdgcn_s_barrier()
#define PG8_SCHED __builtin_amdgcn_sched_barrier(0)
    Unit cur, nxt; int ui = 0;
    if (!S.next(0, cur)) return;
    f32x4 acc[2][2][4][2];
#pragma unroll
    for (int a = 0; a < 2; ++a)
#pragma unroll
        for (int b = 0; b < 2; ++b)
#pragma unroll
            for (int m = 0; m < 4; ++m)
#pragma unroll
                for (int n = 0; n < 2; ++n) acc[a][b][m][n] = (f32x4){0.f, 0.f, 0.f, 0.f};
    bf16x8 At[4][2], B0[2][2], B1[2][2];
    const char* cA = (const char*)g.A + (size_t)cur.pm * tstep; const char* cB = (const char*)g.Bt + (size_t)cur.pn * tstep;
    S.a_ready(cur);
    PG8_STAGE(PG8_SB(0, 0), cB, voffB); PG8_STAGE(PG8_SA(0, 0), cA, voffA); PG8_STAGE(PG8_SB(0, 1), cB + hstep, voffB); PG8_STAGE(PG8_SA(0, 1), cA + hstep, voffA);
    if (wr == 1) PG8_BAR;
    PG8_WAIT_V(4); PG8_BAR;
    PG8_STAGE(PG8_SB(1, 0), cB + kstep, voffB); PG8_STAGE(PG8_SA(1, 0), cA + kstep, voffA); PG8_STAGE(PG8_SB(1, 1), cB + hstep + kstep, voffB);
    PG8_WAIT_V(6); PG8_BAR;
    for (;;) {
        const bool has_next = S.next(ui + 1, nxt);
        const char* nA = has_next ? (const char*)g.A + (size_t)nxt.pm * tstep : cA; const char* nB = has_next ? (const char*)g.Bt + (size_t)nxt.pn * tstep : cB;
        for (int t = 0; t < nt; t += 2) {
            const bool last = (t == nt - 2);
            const char* a1 = cA + (size_t)(t + 1) * kstep;
            const char* a2 = last ? nA : cA + (size_t)(t + 2) * kstep; const char* b2 = last ? nB : cB + (size_t)(t + 2) * kstep;
            const char* a3 = a2 + kstep; const char* b3 = b2 + kstep;
            if (last && has_next) S.a_ready(nxt);
            PG8_LDB(B0, 0, 0); PG8_SCHED; PG8_LDA(At, 0, 0); PG8_STAGE(PG8_SA(1, 1), a1 + hstep, voffA);
            PG8_WAIT_L(8); PG8_BAR; PG8_WAIT_L(0); PG8_MMA(0, 0, At, B0); PG8_BAR; PG8_SCHED;
            PG8_LDB(B1, 0, 1); PG8_STAGE(PG8_SB(0, 0), b2, voffB);
            PG8_BAR; PG8_WAIT_L(0); PG8_MMA(0, 1, At, B1); PG8_BAR;
            PG8_LDA(At, 0, 1); PG8_STAGE(PG8_SA(0, 0), a2, voffA);
            PG8_BAR; PG8_WAIT_L(0); PG8_MMA(1, 0, At, B0); PG8_BAR; PG8_SCHED;
            PG8_STAGE(PG8_SB(0, 1), b2 + hstep, voffB);
            PG8_WAIT_V(6); PG8_BAR; PG8_MMA(1, 1, At, B1); PG8_BAR;
            PG8_LDB(B0, 1, 0); PG8_SCHED; PG8_LDA(At, 1, 0); PG8_STAGE(PG8_SA(0, 1), a2 + hstep, voffA);
            PG8_WAIT_L(8); PG8_BAR; PG8_WAIT_L(0); PG8_MMA(0, 0, At, B0); PG8_BAR; PG8_SCHED;
            PG8_LDB(B1, 1, 1); PG8_STAGE(PG8_SB(1, 0), b3, voffB);
            PG8_BAR; PG8_WAIT_L(0); PG8_MMA(0, 1, At, B1); PG8_BAR;
            PG8_LDA(At, 1, 1); PG8_STAGE(PG8_SA(1, 0), a3, voffA);
            PG8_BAR; PG8_WAIT_L(0); PG8_MMA(1, 0, At, B0); PG8_BAR; PG8_SCHED;
            PG8_STAGE(PG8_SB(1, 1), b3 + hstep, voffB);
            PG8_WAIT_V(6); PG8_BAR; PG8_MMA(1, 1, At, B1); PG8_BAR;
        }
        if constexpr (!Epi::AFTER_DRAIN) { E(acc, cur, wr, wc, fr, fq); S.done(cur); }
        if (!has_next) break;
#pragma unroll
        for (int a = 0; a < 2; ++a)
#pragma unroll
            for (int b = 0; b < 2; ++b)
#pragma unroll
                for (int m = 0; m < 4; ++m)
#pragma unroll
                    for (int n = 0; n < 2; ++n) acc[a][b][m][n] = (f32x4){0.f, 0.f, 0.f, 0.f};
        cur = nxt; cA = nA; cB = nB; ++ui;
    }
    PG8_WAIT_V(0);
    if (wr == 0) PG8_BAR;
    PG8_BAR;
    if constexpr (Epi::AFTER_DRAIN) { E.fused(acc, cur, wr, wc, fr, fq, lds, wid, lane); S.done(cur); }
#undef PG8_SA
#undef PG8_SB
#undef PG8_STAGE
#undef PG8_LDA
#undef PG8_LDB
#undef PG8_MMA
#undef PG8_WAIT_V
#undef PG8_WAIT_L
#undef PG8_BAR
#undef PG8_SCHED
}
}

using pg8::f32x4; using pg8::bf16x8; using pg8::Unit; using pg8::cvt_pk_bf16;
typedef unsigned short u16;
#define LAS __attribute__((address_space(3)))

constexpr int MT = 8192, DM = 2048, SEQ = 4096;
constexpr int NZ = 9216, ZM = 5120, ZG = 4096, DFF = 5632, NUP = 11264, RWD = 1024;
constexpr size_t WS_WDOWN = 0;
constexpr size_t WS_WIN   = WS_WDOWN + (size_t)2048 * 5632 * 2;
constexpr size_t WS_WUP   = WS_WIN + (size_t)9216 * 2048 * 2;
constexpr size_t WS_WBR1  = WS_WUP + (size_t)11264 * 2048 * 2;
constexpr size_t WS_WBR2  = WS_WBR1 + (size_t)2048 * 1024 * 2;
constexpr size_t WS_WOUT  = WS_WBR2 + (size_t)2048 * 1024 * 2;
constexpr size_t WS_WLORA = WS_WOUT + (size_t)2048 * 2048 * 2;
constexpr size_t WS_Z     = WS_WLORA + (size_t)3072 * 512 * 2;
constexpr size_t Z_BYTES  = (size_t)MT * NUP * 2;
constexpr size_t WS_X     = WS_Z + Z_BYTES;
constexpr size_t WS_SMALL = WS_X + (size_t)MT * DM * 2;
constexpr size_t WS_END   = WS_SMALL + 32768 + (size_t)MT * 32 * 4;
constexpr size_t WS_ACT   = WS_WIN;
static_assert(WS_Z - WS_WIN >= (size_t)MT * DFF * 2, "act overlay");
constexpr size_t Z_MAIN = 0, Z_GATE = (size_t)MT * ZM * 2, Z_TAIL = (size_t)MT * (ZM + ZG) * 2;
constexpr size_t Z_LW = 0, Z_A = (size_t)MT * RWD * 4, Z_G = 2 * (size_t)MT * RWD * 4;
constexpr size_t X_AP = 0, X_KN = (size_t)MT * 512 * 2, X_VT = X_KN + (size_t)MT * 256 * 2, X_OATT = X_VT + (size_t)MT * 256 * 2;
constexpr size_t O_RKV = 0, O_QN = (size_t)MT * 3072 * 2;

struct Params { const float* in[24]; float* out; unsigned char* ws; int ph_lo, ph_hi; };

__device__ __forceinline__ float bf2f(unsigned short b) { return __uint_as_float(((unsigned)b) << 16); }
__device__ __forceinline__ float bflo(unsigned u) { return __uint_as_float(u << 16); }
__device__ __forceinline__ float bfhi(unsigned u) { return __uint_as_float(u & 0xffff0000u); }
__device__ __forceinline__ u16 f2bf(float f) { return (u16)(cvt_pk_bf16(f, f) & 0xffffu); }
__device__ __forceinline__ float wave_sum(float v) {
#pragma unroll
    for (int o = 32; o; o >>= 1) v += __shfl_xor(v, o);
    return v; }
__device__ __forceinline__ float sigmoidf_(float x) { return 1.0f / (1.0f + __expf(-x)); }
template <int CTRL> __device__ __forceinline__ float dppf(float x) { return __int_as_float(__builtin_amdgcn_update_dpp(0, __float_as_int(x), CTRL, 0xF, 0xF, true)); }
__device__ __forceinline__ float row16_sum(float x) { x += dppf<0xB1>(x); x += dppf<0x4E>(x); x += dppf<0x141>(x); x += dppf<0x140>(x); return x; }

#define EPI_ROWS _Pragma("unroll") for (int ai = 0; ai < 2; ++ai) _Pragma("unroll") for (int m = 0; m < 4; ++m)
#define EPI_COLS _Pragma("unroll") for (int bj = 0; bj < 2; ++bj) _Pragma("unroll") for (int n = 0; n < 2; ++n)
struct EpiZ {
    static constexpr bool PERM = false, AFTER_DRAIN = false;
    u16* zmain; u16* zgate; const float* rstd;
    __device__ __forceinline__ void operator()(const f32x4 (&acc)[2][2][4][2], const Unit& u, int wr, int wc, int fr, int fq) const {
        u16* base; int ld, c0;
        if (u.pn < 20) { base = zmain; ld = ZM; c0 = u.pn * 256; } else { base = zgate; ld = ZG; c0 = (u.pn - 20) * 256; }
        const int row0 = u.pm * 256 + wr * 64 + fr; c0 += wc * 32 + 4 * fq;
        EPI_ROWS { const int row = row0 + ai * 128 + m * 16; const float rs = rstd[row]; u16* rp = base + (size_t)row * ld + c0;
            EPI_COLS { const f32x4 v = acc[ai][bj][m][n] * rs; uint2 w; w.x = cvt_pk_bf16(v[0], v[1]); w.y = cvt_pk_bf16(v[2], v[3]); *(uint2*)(rp + bj * 128 + n * 16) = w; } }
    }
};
struct EpiLora {
    static constexpr bool PERM = false, AFTER_DRAIN = false;
    float* lw; float* av; u16* g; const float* w0; const float* a0;
    __device__ __forceinline__ void operator()(const f32x4 (&acc)[2][2][4][2], const Unit& u, int wr, int wc, int fr, int fq) const {
        const int row0 = u.pm * 256 + wr * 64 + fr; const int kind = u.pn >> 2; const int c0 = (u.pn & 3) * 256 + wc * 32 + 4 * fq;
        if (kind == 0) {
            EPI_ROWS { const int row = row0 + ai * 128 + m * 16;
                EPI_COLS { const int col = c0 + bj * 128 + n * 16; const f32x4 v = acc[ai][bj][m][n]; const f32x4 b = *(const f32x4*)(w0 + col); f32x4 o;
#pragma unroll
                    for (int j = 0; j < 4; ++j) { const float y = -(b[j] + v[j]); const float sp = fmaxf(y, 0.f) + __logf(1.0f + __expf(-fabsf(y))); o[j] = -__expf(-sp - 0.5f); }
                    *(f32x4*)(lw + (size_t)row * RWD + col) = o; } }
        } else if (kind == 1) {
            EPI_ROWS { const int row = row0 + ai * 128 + m * 16;
                EPI_COLS { const int col = c0 + bj * 128 + n * 16; const f32x4 v = acc[ai][bj][m][n]; const f32x4 b = *(const f32x4*)(a0 + col); f32x4 o;
#pragma unroll
                    for (int j = 0; j < 4; ++j) o[j] = sigmoidf_(b[j] + v[j]);
                    *(f32x4*)(av + (size_t)row * RWD + col) = o; } }
        } else {
            EPI_ROWS { const int row = row0 + ai * 128 + m * 16;
                EPI_COLS { const int col = c0 + bj * 128 + n * 16; const f32x4 v = acc[ai][bj][m][n];
                    uint2 w; w.x = cvt_pk_bf16(v[0], v[1]); w.y = cvt_pk_bf16(v[2], v[3]); *(uint2*)(g + (size_t)row * RWD + col) = w; } }
        }
    }
};
template <int PASS> struct EpiBranch {
    static constexpr bool PERM = false, AFTER_DRAIN = false;
    u16* mixed; const u16* zgate;
    __device__ __forceinline__ void operator()(const f32x4 (&acc)[2][2][4][2], const Unit& u, int wr, int wc, int fr, int fq) const {
        const int row0 = u.pm * 256 + wr * 64 + fr; const int c0 = u.pn * 256 + wc * 32 + 4 * fq;
        EPI_ROWS { const int row = row0 + ai * 128 + m * 16;
            EPI_COLS { const int col = c0 + bj * 128 + n * 16; const f32x4 v = acc[ai][bj][m][n];
                const uint2 gz = *(const uint2*)(zgate + (size_t)row * ZG + PASS * 2048 + col);
                f32x4 o; o[0] = sigmoidf_(bflo(gz.x)) * v[0]; o[1] = sigmoidf_(bfhi(gz.x)) * v[1]; o[2] = sigmoidf_(bflo(gz.y)) * v[2]; o[3] = sigmoidf_(bfhi(gz.y)) * v[3];
                uint2* mp = (uint2*)(mixed + (size_t)row * DM + col);
                if (PASS == 1) { const uint2 pm = *mp; o[0] += bflo(pm.x); o[1] += bfhi(pm.x); o[2] += bflo(pm.y); o[3] += bfhi(pm.y); }
                uint2 w; w.x = cvt_pk_bf16(o[0], o[1]); w.y = cvt_pk_bf16(o[2], o[3]); *mp = w; } }
    }
};
struct EpiOut1 {
    static constexpr bool PERM = false, AFTER_DRAIN = false;
    const float* x; float* x1; u16* x1b; float* rowss;
    __device__ __forceinline__ void operator()(const f32x4 (&acc)[2][2][4][2], const Unit& u, int wr, int wc, int fr, int fq) const {
        const int row0 = u.pm * 256 + wr * 64 + fr; const int c0 = u.pn * 256 + wc * 32 + 4 * fq;
        EPI_ROWS { const int row = row0 + ai * 128 + m * 16; float ss = 0.f;
            EPI_COLS { const int col = c0 + bj * 128 + n * 16; const size_t o = (size_t)row * DM + col;
                const f32x4 v = acc[ai][bj][m][n] + *(const f32x4*)(x + o);
                *(f32x4*)(x1 + o) = v; ss += v[0] * v[0] + v[1] * v[1] + v[2] * v[2] + v[3] * v[3];
                uint2 w; w.x = cvt_pk_bf16(v[0], v[1]); w.y = cvt_pk_bf16(v[2], v[3]); *(uint2*)(x1b + o) = w; }
            ss += __shfl_xor(ss, 16); ss += __shfl_xor(ss, 32);
            if (fq == 0) rowss[(size_t)row * 32 + u.pn * 4 + wc] = ss; }
    }
};
struct EpiUp {
    static constexpr bool PERM = false, AFTER_DRAIN = false;
    u16* uo; const float* rowss;
    __device__ __forceinline__ void operator()(const f32x4 (&acc)[2][2][4][2], const Unit& u, int wr, int wc, int fr, int fq) const {
        const int row0 = u.pm * 256 + wr * 64 + fr; const int c0 = u.pn * 256 + wc * 32 + 4 * fq;
        EPI_ROWS { const int row = row0 + ai * 128 + m * 16;
            const f32x4 p0 = *(const f32x4*)(rowss + (size_t)row * 32 + fq * 8), p1 = *(const f32x4*)(rowss + (size_t)row * 32 + fq * 8 + 4);
            float ss = ((p0[0] + p0[1]) + (p0[2] + p0[3])) + ((p1[0] + p1[1]) + (p1[2] + p1[3]));
            ss += __shfl_xor(ss, 16); ss += __shfl_xor(ss, 32);
            const float rs = rsqrtf(ss * (1.0f / 2048.0f) + 1e-6f); u16* rp = uo + (size_t)row * NUP + c0;
            EPI_COLS { const f32x4 v = acc[ai][bj][m][n] * rs; uint2 w; w.x = cvt_pk_bf16(v[0], v[1]); w.y = cvt_pk_bf16(v[2], v[3]); *(uint2*)(rp + bj * 128 + n * 16) = w; } }
    }
};
struct EpiFinal {
    static constexpr bool PERM = false, AFTER_DRAIN = false;
    float* out;
    __device__ __forceinline__ void operator()(const f32x4 (&acc)[2][2][4][2], const Unit& u, int wr, int wc, int fr, int fq) const {
        const int row0 = u.pm * 256 + wr * 64 + fr; const int c0 = u.pn * 256 + wc * 32 + 4 * fq;
        EPI_ROWS { const int row = row0 + ai * 128 + m * 16;
            EPI_COLS { float* op = out + (size_t)row * DM + c0 + bj * 128 + n * 16; *(f32x4*)op = *(const f32x4*)op + acc[ai][bj][m][n]; } }
    }
};

template <class Epi> __device__ __forceinline__ void run_gemm(LAS unsigned char* lds, const u16* A, const u16* Bt, int N, int K, const Epi& E) {
    pg8::Gemm g; g.A = A; g.Bt = Bt; g.M = MT; g.N = N; g.K = K;
    pg8::StaticOrder S; S.init(MT, N, (int)gridDim.x, (int)blockIdx.x);
    pg8::gemm_phase<Epi, pg8::StaticOrder>(lds, g, S, E);
}

__device__ __forceinline__ void tr_tile(const float* __restrict__ src, int ldn, int nsrc0, u16* __restrict__ dst, int K, int k0, int ndst0, const float* __restrict__ scale, float* tile) {
    const int tid = threadIdx.x, nc = tid & 63, kr0 = tid >> 6;
#pragma unroll
    for (int i = 0; i < 8; ++i) { const int kr = kr0 + 8 * i; float v = 0.f;
        if (nsrc0 >= 0) { v = src[(size_t)(k0 + kr) * ldn + nsrc0 + nc]; if (scale) v *= scale[k0 + kr]; }
        tile[kr * 65 + nc] = v; }
    __syncthreads();
    const int nr = tid >> 3, kc = (tid & 7) * 8;
    uint4 w;
    w.x = cvt_pk_bf16(tile[(kc + 0) * 65 + nr], tile[(kc + 1) * 65 + nr]); w.y = cvt_pk_bf16(tile[(kc + 2) * 65 + nr], tile[(kc + 3) * 65 + nr]);
    w.z = cvt_pk_bf16(tile[(kc + 4) * 65 + nr], tile[(kc + 5) * 65 + nr]); w.w = cvt_pk_bf16(tile[(kc + 6) * 65 + nr], tile[(kc + 7) * 65 + nr]);
    *(uint4*)(dst + (size_t)(ndst0 + nr) * K + k0 + kc) = w;
    __syncthreads();
}
__device__ void phase0(const Params& P, float* tile) {
    unsigned char* ws = P.ws; const int G = gridDim.x, bid = blockIdx.x, tid = threadIdx.x;
    for (int id = bid; id < 15104; id += G) {
        if (id < 4608) { const int nt = id % 144, kt = id / 144; const int ns = nt < 55 ? nt * 64 : (nt == 55 ? -1 : nt * 64 - 64);
            tr_tile(P.in[2], 9152, ns, (u16*)(ws + WS_WIN), 2048, kt * 64, nt * 64, P.in[1], tile); }
        else if (id < 4608 + 5632) { const int j = id - 4608, nt = j % 176, kt = j / 176;
            tr_tile(P.in[20], NUP, nt * 64, (u16*)(ws + WS_WUP), 2048, kt * 64, nt * 64, P.in[19], tile); }
        else if (id < 4608 + 5632 + 2816) { const int j = id - 10240, nt = j % 32, kt = j / 32;
            tr_tile(P.in[23], 2048, nt * 64, (u16*)(ws + WS_WDOWN), 5632, kt * 64, nt * 64, nullptr, tile); }
        else if (id < 13056 + 512) { const int j = id - 13056, nt = j % 32, kt = j / 32;
            tr_tile(P.in[17], 2048, nt * 64, (u16*)(ws + WS_WBR1), 1024, kt * 64, nt * 64, nullptr, tile); }
        else if (id < 13568 + 512) { const int j = id - 13568, nt = j % 32, kt = j / 32;
            tr_tile(P.in[17] + (size_t)1024 * 2048, 2048, nt * 64, (u16*)(ws + WS_WBR2), 1024, kt * 64, nt * 64, nullptr, tile); }
        else { const int j = id - 14080, nt = j % 32, kt = j / 32;
            tr_tile(P.in[18], 2048, nt * 64, (u16*)(ws + WS_WOUT), 2048, kt * 64, nt * 64, nullptr, tile); }
    }
    { u16* wl = (u16*)(ws + WS_WLORA);
      for (int idx = bid * 512 + tid; idx < 3072 * 512; idx += G * 512) { const int n = idx >> 9, k = idx & 511; float v = 0.f;
          if (n < 1024) { if (k < 96) v = P.in[5][(size_t)k * 1024 + n]; }
          else if (n < 2048) { if (k >= 96 && k < 192) v = P.in[7][(size_t)(k - 96) * 1024 + (n - 1024)]; }
          else { if (k >= 256) v = P.in[8][(size_t)(k - 256) * 1024 + (n - 2048)]; }
          wl[idx] = f2bf(v); } }
    { const int lane = tid & 63, gw = bid * 8 + (tid >> 6), nw = G * 8; u16* xb = (u16*)(ws + WS_X); float* rstd1 = (float*)(ws + WS_SMALL);
      for (int t = gw; t < MT; t += nw) { const float4* xr = (const float4*)(P.in[0] + (size_t)t * DM); float ss = 0.f;
#pragma unroll
          for (int i = 0; i < 8; ++i) { const float4 v = xr[lane + 64 * i]; ss += v.x * v.x + v.y * v.y + v.z * v.z + v.w * v.w;
              uint2 w; w.x = cvt_pk_bf16(v.x, v.y); w.y = cvt_pk_bf16(v.z, v.w); *(uint2*)(xb + (size_t)t * DM + (lane + 64 * i) * 4) = w; }
          ss = wave_sum(ss); if (lane == 0) rstd1[t] = rsqrtf(ss * (1.0f / 2048.0f) + 1e-6f); } }
}

__device__ void phase2(const Params& P, u16* tile) {
    unsigned char* ws = P.ws; const int G = gridDim.x, bid = blockIdx.x, tid = threadIdx.x, lane = tid & 63;
    const u16* zmain = (const u16*)(ws + WS_Z + Z_MAIN);
    u16* rkv = (u16*)((unsigned char*)P.out + O_RKV); u16* Qn = (u16*)((unsigned char*)P.out + O_QN);
    u16* Ap = (u16*)(ws + WS_X + X_AP); u16* Kn = (u16*)(ws + WS_X + X_KN); u16* Vt = (u16*)(ws + WS_X + X_VT);
    const float* mu = P.in[3]; const float qg = P.in[14][lane], kg = P.in[15][lane];
    for (int t = bid * 8 + (tid >> 6); t < MT; t += G * 8) {
        const u16* zr = zmain + (size_t)t * ZM; const bool hp = (t & (SEQ - 1)) != 0;
        for (int i = 0; i < 28; ++i) { const int c = i * 128 + lane * 2;
            if (c < 3520) { const unsigned zz = *(const unsigned*)(zr + c); const unsigned pp = hp ? *(const unsigned*)(zr - ZM + c) : 0u; const float2 m2 = *(const float2*)(mu + c);
                const float z0 = bflo(zz), z1 = bfhi(zz); const float a0 = z0 + (bflo(pp) - z0) * m2.x, a1 = z1 + (bfhi(pp) - z1) * m2.y;
                if (c < 3072) *(unsigned*)(rkv + (size_t)t * 3072 + c) = cvt_pk_bf16(a0, a1);
                else if (c < 3168) *(unsigned*)(Ap + (size_t)t * 512 + (c - 3072)) = cvt_pk_bf16(tanhf(a0), tanhf(a1));
                else if (c < 3264) *(unsigned*)(Ap + (size_t)t * 512 + 96 + (c - 3168)) = cvt_pk_bf16(a0, a1);
                else *(unsigned*)(Ap + (size_t)t * 512 + 256 + (c - 3264)) = cvt_pk_bf16(sigmoidf_(a0), sigmoidf_(a1)); } }
        if (lane < 32) *(unsigned*)(Ap + (size_t)t * 512 + 192 + lane * 2) = 0u;
        for (int h = 0; h < 16; ++h) { const float v = bf2f(zr[3584 + h * 64 + lane]); const float ss = wave_sum(v * v); const float rs = rsqrtf(ss * (1.0f / 64.0f) + 1e-6f);
            Qn[(size_t)t * 1024 + h * 64 + lane] = f2bf(v * rs * qg * 0.125f); }
        for (int h = 0; h < 4; ++h) { const float v = bf2f(zr[4608 + h * 64 + lane]); const float ss = wave_sum(v * v); const float rs = rsqrtf(ss * (1.0f / 64.0f) + 1e-6f);
            Kn[(size_t)t * 256 + h * 64 + lane] = f2bf(v * rs * kg); }
    }
    for (int tl = bid; tl < MT / 64; tl += G) { const int t0 = tl * 64;
        __syncthreads();
        for (int i = 0; i < 16; ++i) { const int idx = tid + 512 * i, r = idx >> 7, cp = idx & 127; const unsigned vv = *(const unsigned*)(zmain + (size_t)(t0 + r) * ZM + 4864 + 2 * cp);
            tile[(2 * cp) * 66 + r] = (u16)(vv & 0xffffu); tile[(2 * cp + 1) * 66 + r] = (u16)(vv >> 16); }
        __syncthreads();
        const int b = t0 >> 12, s0 = t0 & (SEQ - 1);
        for (int i = 0; i < 16; ++i) { const int idx = tid + 512 * i, c = idx >> 5, sp = idx & 31;
            const unsigned w = (unsigned)tile[c * 66 + 2 * sp] | ((unsigned)tile[c * 66 + 2 * sp + 1] << 16);
            *(unsigned*)(Vt + ((size_t)(b * 4 + (c >> 6)) * 64 + (c & 63)) * SEQ + s0 + 2 * sp) = w; }
    }
}

constexpr int NS = 2, NSCAN = 32 * NS, TCH = 64;
__device__ void scan_phase(const Params& P, float* L) {
    unsigned char* ws = P.ws; const int bid = blockIdx.x, tid = threadIdx.x, lane = tid & 63, w = tid >> 6;
    const int hb = bid / NS, vs = bid % NS, b = hb >> 4, h = hb & 15;
    const u16* rkv = (const u16*)((unsigned char*)P.out + O_RKV);
    const float* lwp = (const float*)(ws + WS_Z + Z_LW); const float* ap = (const float*)(ws + WS_Z + Z_A);
    float* yraw = (float*)(ws + WS_Z + Z_TAIL);
    float* R = L; float* Kp = L + 4096; float* Wd = L + 8192; float* KK = L + 12288; float* Bv = L + 16384; float* Vv = L + 20480; float* Yb = L + 22528;
    const int tl = tid >> 3, c8 = (tid & 7) * 8, v4 = (tid & 7) * 4;
    float kkw[8], kaw[8];
#pragma unroll
    for (int j = 0; j < 8; ++j) { kkw[j] = P.in[9][h * 64 + c8 + j]; kaw[j] = P.in[10][h * 64 + c8 + j]; }
    const int vl = lane >> 4, kg = lane & 15;
    float s0 = 0.f, s1 = 0.f, s2 = 0.f, s3 = 0.f;
    uint4 r8, k8; float4 lw0, lw1, a0, a1; uint2 vv4;
    auto prefetch = [&](int ci) { const size_t t = (size_t)b * SEQ + ci * TCH + tl;
        r8 = *(const uint4*)(rkv + t * 3072 + h * 64 + c8); k8 = *(const uint4*)(rkv + t * 3072 + 1024 + h * 64 + c8);
        vv4 = *(const uint2*)(rkv + t * 3072 + 2048 + h * 64 + vs * 32 + v4);
        lw0 = *(const float4*)(lwp + t * RWD + h * 64 + c8); lw1 = *(const float4*)(lwp + t * RWD + h * 64 + c8 + 4);
        a0 = *(const float4*)(ap + t * RWD + h * 64 + c8); a1 = *(const float4*)(ap + t * RWD + h * 64 + c8 + 4); };
    prefetch(0);
    for (int ci = 0; ci < SEQ / TCH; ++ci) {
        __syncthreads();
        if (ci > 0) { const size_t t = (size_t)b * SEQ + (ci - 1) * TCH + tl; *(float4*)(yraw + t * RWD + h * 64 + vs * 32 + v4) = *(const float4*)(Yb + tl * 32 + v4); }
        { float rr[8], kk_[8], aa[8], ll[8];
          rr[0] = bflo(r8.x); rr[1] = bfhi(r8.x); rr[2] = bflo(r8.y); rr[3] = bfhi(r8.y); rr[4] = bflo(r8.z); rr[5] = bfhi(r8.z); rr[6] = bflo(r8.w); rr[7] = bfhi(r8.w);
          kk_[0] = bflo(k8.x); kk_[1] = bfhi(k8.x); kk_[2] = bflo(k8.y); kk_[3] = bfhi(k8.y); kk_[4] = bflo(k8.z); kk_[5] = bfhi(k8.z); kk_[6] = bflo(k8.w); kk_[7] = bfhi(k8.w);
          aa[0] = a0.x; aa[1] = a0.y; aa[2] = a0.z; aa[3] = a0.w; aa[4] = a1.x; aa[5] = a1.y; aa[6] = a1.z; aa[7] = a1.w;
          ll[0] = lw0.x; ll[1] = lw0.y; ll[2] = lw0.z; ll[3] = lw0.w; ll[4] = lw1.x; ll[5] = lw1.y; ll[6] = lw1.z; ll[7] = lw1.w;
          float q[8]; float ss = 0.f;
#pragma unroll
          for (int j = 0; j < 8; ++j) { q[j] = kk_[j] * kkw[j]; ss += q[j] * q[j]; }
          ss += __shfl_xor(ss, 1); ss += __shfl_xor(ss, 2); ss += __shfl_xor(ss, 4);
          const float inv = 1.0f / fmaxf(sqrtf(ss), 1e-12f);
#pragma unroll
          for (int j = 0; j < 8; ++j) { const float kkn = q[j] * inv; const int o = tl * 64 + c8 + j;
              R[o] = rr[j]; Kp[o] = kk_[j] * (1.0f + (aa[j] - 1.0f) * kaw[j]); Wd[o] = __expf(ll[j]); KK[o] = kkn; Bv[o] = kkn * aa[j]; }
          float* vp = Vv + tl * 32 + v4; vp[0] = bflo(vv4.x); vp[1] = bfhi(vv4.x); vp[2] = bflo(vv4.y); vp[3] = bfhi(vv4.y); }
        __syncthreads();
        if (ci + 1 < SEQ / TCH) prefetch(ci + 1);
#pragma unroll 4
        for (int t = 0; t < TCH; ++t) {
            const float4 kk4 = *(const float4*)(KK + t * 64 + 4 * kg), w4 = *(const float4*)(Wd + t * 64 + 4 * kg), b4 = *(const float4*)(Bv + t * 64 + 4 * kg);
            const float4 k4 = *(const float4*)(Kp + t * 64 + 4 * kg), r4 = *(const float4*)(R + t * 64 + 4 * kg);
            const float vv = Vv[t * 32 + w * 4 + vl];
            float sa = s0 * kk4.x + s1 * kk4.y + s2 * kk4.z + s3 * kk4.w; sa = -row16_sum(sa);
            s0 = s0 * w4.x + sa * b4.x + vv * k4.x; s1 = s1 * w4.y + sa * b4.y + vv * k4.y; s2 = s2 * w4.z + sa * b4.z + vv * k4.z; s3 = s3 * w4.w + sa * b4.w + vv * k4.w;
            float y = s0 * r4.x + s1 * r4.y + s2 * r4.z + s3 * r4.w; y = row16_sum(y);
            if (kg == 0) Yb[t * 32 + w * 4 + vl] = y;
        }
    }
    __syncthreads();
    { const size_t t = (size_t)b * SEQ + (SEQ / TCH - 1) * TCH + tl; *(float4*)(yraw + t * RWD + h * 64 + vs * 32 + v4) = *(const float4*)(Yb + tl * 32 + v4); }
}

__device__ void attn_phase(const Params& P) {
    unsigned char* ws = P.ws; const int tid = threadIdx.x, lane = tid & 63, fr = lane & 15, fq = lane >> 4;
    const u16* Qn = (const u16*)((unsigned char*)P.out + O_QN); const u16* Kn = (const u16*)(ws + WS_X + X_KN); const u16* Vt = (const u16*)(ws + WS_X + X_VT);
    u16* oatt = (u16*)(ws + WS_X + X_OATT);
    const int NA = (int)gridDim.x - NSCAN; const int gw = ((int)blockIdx.x - NSCAN) * 8 + (tid >> 6);
    for (int unit = gw; unit < 8192; unit += NA * 8) {
        const int h = unit & 15, st = (unit >> 4) & 255, b = unit >> 12, kh = h >> 2;
        const int s0 = st * 16; const size_t t0 = (size_t)b * SEQ + s0;
        const float slope = exp2f(-0.5f * (float)(h + 1)), sink = P.in[16][h];
        bf16x8 qf[2];
        qf[0] = *(const bf16x8*)(Qn + (t0 + fr) * 1024 + h * 64 + 8 * fq); qf[1] = *(const bf16x8*)(Qn + (t0 + fr) * 1024 + h * 64 + 32 + 8 * fq);
        f32x4 sc[10]; float mx = sink;
#pragma unroll
        for (int kt = 0; kt < 10; ++kt) { const int ks0 = s0 - 144 + 16 * kt; int kp = ks0 + fr; kp = kp < 0 ? 0 : kp;
            const u16* kr = Kn + ((size_t)b * SEQ + kp) * 256 + kh * 64 + 8 * fq;
            const bf16x8 k0 = *(const bf16x8*)kr, k1 = *(const bf16x8*)(kr + 32);
            f32x4 a = {0.f, 0.f, 0.f, 0.f};
            a = __builtin_amdgcn_mfma_f32_16x16x32_bf16(k0, qf[0], a, 0, 0, 0); a = __builtin_amdgcn_mfma_f32_16x16x32_bf16(k1, qf[1], a, 0, 0, 0);
#pragma unroll
            for (int j = 0; j < 4; ++j) { const int kpos = ks0 + 4 * fq + j; const int dist = s0 + fr - kpos; const bool valid = (dist >= 0) && (dist < 128) && (kpos >= 0);
                const float v = valid ? a[j] - slope * (float)dist : -1e30f; a[j] = v; mx = fmaxf(mx, v); }
            sc[kt] = a; }
        mx = fmaxf(mx, __shfl_xor(mx, 16)); mx = fmaxf(mx, __shfl_xor(mx, 32));
        float sum = 0.f;
#pragma unroll
        for (int kt = 0; kt < 10; ++kt)
#pragma unroll
            for (int j = 0; j < 4; ++j) { const float e = __expf(sc[kt][j] - mx); sc[kt][j] = e; sum += e; }
        sum += __shfl_xor(sum, 16); sum += __shfl_xor(sum, 32);
        const float inv = 1.0f / (sum + __expf(sink - mx));
        f32x4 o[4];
#pragma unroll
        for (int dt = 0; dt < 4; ++dt) o[dt] = (f32x4){0.f, 0.f, 0.f, 0.f};
#pragma unroll
        for (int u = 0; u < 5; ++u) {
            union { bf16x8 v; unsigned w[4]; } pf;
            pf.w[0] = cvt_pk_bf16(sc[2 * u][0] * inv, sc[2 * u][1] * inv); pf.w[1] = cvt_pk_bf16(sc[2 * u][2] * inv, sc[2 * u][3] * inv);
            pf.w[2] = cvt_pk_bf16(sc[2 * u + 1][0] * inv, sc[2 * u + 1][1] * inv); pf.w[3] = cvt_pk_bf16(sc[2 * u + 1][2] * inv, sc[2 * u + 1][3] * inv);
            int ka = s0 - 144 + 32 * u + 4 * fq, kb = ka + 16; ka = ka < 0 ? 0 : ka; kb = kb < 0 ? 0 : kb;
#pragma unroll
            for (int dt = 0; dt < 4; ++dt) { const u16* vr = Vt + ((size_t)(b * 4 + kh) * 64 + dt * 16 + fr) * SEQ;
                union { bf16x8 v; uint2 w[2]; } vf; vf.w[0] = *(const uint2*)(vr + ka); vf.w[1] = *(const uint2*)(vr + kb);
                o[dt] = __builtin_amdgcn_mfma_f32_16x16x32_bf16(pf.v, vf.v, o[dt], 0, 0, 0); } }
#pragma unroll
        for (int dt = 0; dt < 4; ++dt)
#pragma unroll
            for (int j = 0; j < 4; ++j) oatt[(t0 + 4 * fq + j) * 1024 + h * 64 + dt * 16 + fr] = f2bf(o[dt][j]);
    }
}

__device__ void phase5(const Params& P) {
    unsigned char* ws = P.ws; const int G = gridDim.x, bid = blockIdx.x, tid = threadIdx.x, lane = tid & 63;
    const u16* rkv = (const u16*)((unsigned char*)P.out + O_RKV); u16* orw = (u16*)((unsigned char*)P.out + O_QN);
    const float* yraw = (const float*)(ws + WS_Z + Z_TAIL); const float* ap = (const float*)(ws + WS_Z + Z_A); const u16* gp = (const u16*)(ws + WS_Z + Z_G);
    for (int t = bid * 8 + (tid >> 6); t < MT; t += G * 8) {
        for (int h = 0; h < 16; ++h) { const int hc = h * 64 + lane; const size_t o = (size_t)t * RWD + hc;
            const float y = yraw[o]; const float mu = wave_sum(y) * (1.0f / 64.0f); const float d = y - mu; const float var = wave_sum(d * d) * (1.0f / 64.0f);
            const float yn = d * rsqrtf(var + 64e-5f) * P.in[12][hc] + P.in[13][hc];
            const float r = bf2f(rkv[(size_t)t * 3072 + hc]), k = bf2f(rkv[(size_t)t * 3072 + 1024 + hc]), v = bf2f(rkv[(size_t)t * 3072 + 2048 + hc]);
            const float a = ap[o]; const float kp = k * (1.0f + (a - 1.0f) * P.in[10][hc]);
            const float rk = wave_sum(r * kp * P.in[11][hc]);
            orw[o] = f2bf((yn + rk * v) * bf2f(gp[o])); }
    }
}

__device__ void phase9(const Params& P) {
    unsigned char* ws = P.ws; const u16* uu = (const u16*)(ws + WS_Z); u16* act = (u16*)(ws + WS_ACT);
    const float* cw = P.in[21]; const float* cb = P.in[22];
    const int nth = gridDim.x * 512;
    for (int task = blockIdx.x * 512 + threadIdx.x; task < 512 * 704; task += nth) {
        const int j0 = (task % 704) * 8, t0 = (task / 704) * 16;
        float w0[16], w1[16], w2[16], bb[16], p2[16], p1[16];
#pragma unroll
        for (int j = 0; j < 8; ++j) { w0[j] = cw[j0 + j]; w1[j] = cw[NUP + j0 + j]; w2[j] = cw[2 * NUP + j0 + j]; bb[j] = cb[j0 + j];
            w0[8 + j] = cw[DFF + j0 + j]; w1[8 + j] = cw[NUP + DFF + j0 + j]; w2[8 + j] = cw[2 * NUP + DFF + j0 + j]; bb[8 + j] = cb[DFF + j0 + j]; }
        auto ld16 = [&](int t, float* d) { const uint4 a = *(const uint4*)(uu + (size_t)t * NUP + j0), g = *(const uint4*)(uu + (size_t)t * NUP + DFF + j0);
            d[0] = bflo(a.x); d[1] = bfhi(a.x); d[2] = bflo(a.y); d[3] = bfhi(a.y); d[4] = bflo(a.z); d[5] = bfhi(a.z); d[6] = bflo(a.w); d[7] = bfhi(a.w);
            d[8] = bflo(g.x); d[9] = bfhi(g.x); d[10] = bflo(g.y); d[11] = bfhi(g.y); d[12] = bflo(g.z); d[13] = bfhi(g.z); d[14] = bflo(g.w); d[15] = bfhi(g.w); };
        if ((t0 & (SEQ - 1)) == 0) {
#pragma unroll
            for (int j = 0; j < 16; ++j) { p2[j] = 0.f; p1[j] = 0.f; } }
        else { ld16(t0 - 2, p2); ld16(t0 - 1, p1); }
        for (int i = 0; i < 16; ++i) { float c[16]; ld16(t0 + i, c); float o[8];
#pragma unroll
            for (int j = 0; j < 8; ++j) { const float cv = p2[j] * w0[j] + p1[j] * w1[j] + c[j] * w2[j] + bb[j]; const float cg_ = p2[8 + j] * w0[8 + j] + p1[8 + j] * w1[8 + j] + c[8 + j] * w2[8 + j] + bb[8 + j];
                o[j] = cg_ * sigmoidf_(cg_) * cv; }
            uint4 w; w.x = cvt_pk_bf16(o[0], o[1]); w.y = cvt_pk_bf16(o[2], o[3]); w.z = cvt_pk_bf16(o[4], o[5]); w.w = cvt_pk_bf16(o[6], o[7]);
            *(uint4*)(act + (size_t)(t0 + i) * DFF + j0) = w;
#pragma unroll
            for (int j = 0; j < 16; ++j) { p2[j] = p1[j]; p1[j] = c[j]; } }
    }
}


__device__ void dump_phase(const Params& P, int which) {
    unsigned char* ws = P.ws; const size_t n = (size_t)MT * DM; const size_t nth = (size_t)gridDim.x * 512;
    if (which == 2) { const u16* kv = (const u16*)(ws + WS_X + X_KN); const u16* qn = (const u16*)((unsigned char*)P.out + O_QN);
        for (size_t i = (size_t)blockIdx.x * 512 + threadIdx.x; i < (size_t)12582912; i += nth) P.out[i] = i < 4194304 ? bf2f(kv[i]) : bf2f(qn[i - 4194304]);
        return; }
    for (size_t i = (size_t)blockIdx.x * 512 + threadIdx.x; i < n; i += nth) { const size_t t = i / DM, c = i % DM; float v = 0.f;
        if (which == 1) v = bf2f(((const u16*)(ws + WS_Z + Z_MAIN))[t * ZM + c]);
        else if (which == 3) v = c < 1024 ? ((const float*)(ws + WS_Z + Z_LW))[t * RWD + c] : ((const float*)(ws + WS_Z + Z_A))[t * RWD + c - 1024];
        else if (which == 4) v = c < 1024 ? ((const float*)(ws + WS_Z + Z_TAIL))[t * RWD + c] : 0.f;
        else if (which == 6) v = bf2f(((const u16*)(ws + WS_Z))[t * DM + c]);
        else if (which == 9) v = bf2f(((const u16*)(ws + WS_ACT))[t * DFF + c]);
        if (!(fabsf(v) < 1e30f)) v = 12345.0f;
        P.out[i] = v; }
}
constexpr int NPH = 11;
#ifndef STOP_AFTER
#define STOP_AFTER 10
#endif
__global__ void __launch_bounds__(512, 2) mega(Params P) {
    extern __shared__ __attribute__((aligned(16))) unsigned char lds_raw[];
    cg::grid_group grid = cg::this_grid();
    LAS unsigned char* lds = (LAS unsigned char*)lds_raw;
    unsigned char* ws = P.ws;
#define RUN(i) ((i) >= P.ph_lo && (i) < P.ph_hi)
#define SEAM(i) do { if ((i) >= P.ph_lo && (i) + 1 < P.ph_hi) grid.sync(); } while (0)
    if (RUN(0)) phase0(P, (float*)lds_raw);
    SEAM(0);
    if (RUN(1)) { EpiZ E; E.zmain = (u16*)(ws + WS_Z + Z_MAIN); E.zgate = (u16*)(ws + WS_Z + Z_GATE); E.rstd = (const float*)(ws + WS_SMALL);
        run_gemm(lds, (const u16*)(ws + WS_X), (const u16*)(ws + WS_WIN), NZ, 2048, E); }
    SEAM(1);
    if (RUN(2)) phase2(P, (u16*)lds_raw);
    SEAM(2);
    if (RUN(3)) { EpiLora E; E.lw = (float*)(ws + WS_Z + Z_LW); E.av = (float*)(ws + WS_Z + Z_A); E.g = (u16*)(ws + WS_Z + Z_G); E.w0 = P.in[4]; E.a0 = P.in[6];
        run_gemm(lds, (const u16*)(ws + WS_X + X_AP), (const u16*)(ws + WS_WLORA), 3072, 512, E); }
    SEAM(3);
    if (RUN(4)) { if ((int)blockIdx.x < NSCAN) scan_phase(P, (float*)lds_raw); else attn_phase(P); }
    SEAM(4);
    if (RUN(5)) phase5(P);
    SEAM(5);
    if (RUN(6)) {
        { EpiBranch<0> E; E.mixed = (u16*)(ws + WS_Z); E.zgate = (const u16*)(ws + WS_Z + Z_GATE);
          run_gemm(lds, (const u16*)((unsigned char*)P.out + O_QN), (const u16*)(ws + WS_WBR1), 2048, 1024, E); }
        { EpiBranch<1> E; E.mixed = (u16*)(ws + WS_Z); E.zgate = (const u16*)(ws + WS_Z + Z_GATE);
          run_gemm(lds, (const u16*)(ws + WS_X + X_OATT), (const u16*)(ws + WS_WBR2), 2048, 1024, E); } }
    SEAM(6);
    if (RUN(7)) { EpiOut1 E; E.x = P.in[0]; E.x1 = P.out; E.x1b = (u16*)(ws + WS_X); E.rowss = (float*)(ws + WS_SMALL + 32768);
        run_gemm(lds, (const u16*)(ws + WS_Z), (const u16*)(ws + WS_WOUT), 2048, 2048, E); }
    SEAM(7);
    if (RUN(8)) { EpiUp E; E.uo = (u16*)(ws + WS_Z); E.rowss = (const float*)(ws + WS_SMALL + 32768);
        run_gemm(lds, (const u16*)(ws + WS_X), (const u16*)(ws + WS_WUP), NUP, 2048, E); }
    SEAM(8);
    if (RUN(9)) phase9(P);
    SEAM(9);
    if (RUN(10)) { EpiFinal E; E.out = P.out;
        run_gemm(lds, (const u16*)(ws + WS_ACT), (const u16*)(ws + WS_WDOWN), 2048, DFF, E); }
    if (RUN(11)) dump_phase(P, STOP_AFTER);
}

constexpr int LDS_BYTES = 131072;
extern "C" void kernel_launch(void* const* d_in, const int* in_sizes, int n_in, void* d_out, int out_size, void* d_ws, size_t ws_size, hipStream_t stream) {
    static int grid = 0;
    if (grid == 0) {
        if (n_in != 24 || out_size != MT * DM || ws_size < WS_END) { fprintf(stderr, "kernel_launch: unexpected shapes (n_in %d out %d ws %zu need %zu)\n", n_in, out_size, ws_size, (size_t)WS_END); grid = -1; return; }
        int dev = 0, cus = 0, per_cu = 0;
        hipGetDevice(&dev); hipDeviceGetAttribute(&cus, hipDeviceAttributeMultiprocessorCount, dev);
        if (hipFuncSetAttribute((const void*)mega, hipFuncAttributeMaxDynamicSharedMemorySize, LDS_BYTES) != hipSuccess) { fprintf(stderr, "kernel_launch: hipFuncSetAttribute failed\n"); grid = -1; return; }
        if (hipOccupancyMaxActiveBlocksPerMultiprocessor(&per_cu, (const void*)mega, 512, LDS_BYTES) != hipSuccess || per_cu < 1) { fprintf(stderr, "kernel_launch: occupancy query failed (%d)\n", per_cu); grid = -1; return; }
        grid = cus * per_cu; if (grid > 256) grid = 256;
        if (grid < 2 * NSCAN) { fprintf(stderr, "kernel_launch: grid %d too small\n", grid); grid = -1; return; }
    }
    if (grid < 0) return;
    Params p{};
    for (int i = 0; i < 24; ++i) p.in[i] = (const float*)d_in[i];
    p.out = (float*)d_out; p.ws = (unsigned char*)d_ws;
#ifndef SPLIT_LAUNCH
    p.ph_lo = 0; p.ph_hi = NPH;
    { void* args[] = {&p}; hipError_t e = hipLaunchCooperativeKernel((const void*)mega, dim3(grid), dim3(512), args, LDS_BYTES, stream);
      if (e != hipSuccess) fprintf(stderr, "cooperative launch failed: %s (grid %d)\n", hipGetErrorString(e), grid); }
#else
    for (int ph = 0; ph < 12; ++ph) { if (ph > STOP_AFTER && !(ph == 11 && STOP_AFTER < 10 && STOP_AFTER != 7)) continue; p.ph_lo = ph; p.ph_hi = ph + 1; void* args[] = {&p};
        hipError_t e = hipLaunchCooperativeKernel((const void*)mega, dim3(grid), dim3(512), args, LDS_BYTES, stream);
        if (e != hipSuccess) fprintf(stderr, "cooperative launch failed: %s (grid %d)\n", hipGetErrorString(e), grid); }
#endif
}
```

```cpp
#include <hip/hip_runtime.h>
#include <hip/hip_cooperative_groups.h>
#include <cstdio>
#include <cstdint>
namespace cg = cooperative_groups;
namespace pg8 {
#define PG8_LAS __attribute__((address_space(3)))
typedef unsigned short bf16_t;
typedef short bf16x8 __attribute__((ext_vector_type(8)));
typedef float f32x4 __attribute__((ext_vector_type(4)));
typedef unsigned u32x4 __attribute__((ext_vector_type(4)));
constexpr int BM = 256, BK = 64, HALF = 128, HTB = HALF * BK * 2  , STAGE_BYTES = 8 * HTB, NXCD = 8, WGM = 8;

__host__ __device__ __forceinline__ int lds_byte(int r, int c) { const int st = (r >> 4) * 2 + (c >> 5), rr = r & 15, cc = c & 31, ob = rr * 64 + cc * 2; return st * 1024 + (ob ^ (((ob >> 9) & 1) << 5)); }
__host__ __device__ __forceinline__ void stage_rc(int b, int& R, int& C) { const int st = b / 1024, sb = b % 1024, swz = sb ^ (((sb >> 9) & 1) << 5); R = (st >> 1) * 16 + swz / 64; C = (st & 1) * 32 + (swz % 64) / 2; }
__host__ __device__ __forceinline__ int perm32(int rho) { const int n = rho >> 4, i = rho & 15; return 8 * (i >> 2) + 4 * n + (i & 3); }

struct Unit { int pm, pn; };
struct Gemm { const bf16_t* A; const bf16_t* Bt; int M, N, K; };

struct StaticOrder {
    int nM, nN, nwg, G, c;
    __host__ __device__ void init(int M, int N, int G_, int c_) { nM = M / BM; nN = N / BM; nwg = nM * nN; G = G_; c = c_; }
    __host__ __device__ bool next(int i, Unit& u) const {
        const long L = (long)i * G + c; if (L >= nwg) return false;
        int wgid = (int)L; { const int q = nwg / NXCD, r = nwg % NXCD, xcd = wgid % NXCD, off = wgid / NXCD; wgid = (xcd < r ? xcd * (q + 1) : r * (q + 1) + (xcd - r) * q) + off; }
        const int nig = WGM * nN, gid = wgid / nig, fm = gid * WGM, gsz = (nM - fm) < WGM ? (nM - fm) : WGM;
        u.pm = fm + ((wgid % nig) % gsz); u.pn = (wgid % nig) / gsz; return true;
    }
    __device__ __forceinline__ void a_ready(const Unit&) const {}
    __device__ __forceinline__ void done(const Unit&) const {}
};
typedef __bf16 bf16v2_t __attribute__((ext_vector_type(2))); typedef float f32v2_t __attribute__((ext_vector_type(2)));
__device__ __forceinline__ unsigned cvt_pk_bf16(float lo, float hi) { const f32v2_t x = {lo, hi}; const bf16v2_t r = __builtin_convertvector(x, bf16v2_t); return __builtin_bit_cast(unsigned, r); }
template <class Epi, class Sched>
__device__ __forceinline__ void gemm_phase(PG8_LAS unsigned char* lds, const Gemm g, const Sched& S, const Epi& E) {
    const int tid = threadIdx.x, wid = __builtin_amdgcn_readfirstlane(tid >> 6), lane = tid & 63, wr = wid >> 2, wc = wid & 3, fr = lane & 15, fq = lane >> 4;
    const int K = g.K, nt = K / BK;
    unsigned voffA[2], voffB[2];
#pragma unroll
    for (int i = 0; i < 2; ++i) { int R, C; stage_rc(tid * 16 + i * 8192, R, C); const int Rb = Epi::PERM ? ((R & ~31) + perm32(R & 31)) : R;
        voffA[i] = (unsigned)(R * K + C) * 2u; voffB[i] = (unsigned)(Rb * K + C) * 2u; }
    const size_t kstep = (size_t)(BK * 2);
    const size_t hstep = (size_t)HALF * K * 2;
    const size_t tstep = 2 * hstep;
    const unsigned ldsw = (unsigned)wid * 1024u;
    const int aoff = lds_byte(wr * 64 + fr, fq * 8), boff = lds_byte(wc * 32 + fr, fq * 8);
#define PG8_SA(b, h) (((b) * 2 + (h)) * HTB)
#define PG8_SB(b, h) ((4 + (b) * 2 + (h)) * HTB)
#define PG8_STAGE(bufoff, gbase, voff) do { _Pragma("unroll") for (int _i = 0; _i < 2; ++_i) \
        __builtin_amdgcn_global_load_lds((const unsigned*)((const char*)(gbase) + (voff)[_i]), (PG8_LAS unsigned*)(lds + (bufoff) + ldsw + _i * 8192), 16, 0, 0); } while (0)
#define PG8_LDA(dst, b, h) do { _Pragma("unroll") for (int m = 0; m < 4; ++m) _Pragma("unroll") for (int k = 0; k < 2; ++k) dst[m][k] = *(const PG8_LAS bf16x8*)(lds + PG8_SA(b, h) + aoff + m * 2048 + k * 1024); } while (0)
#define PG8_LDB(dst, b, h) do { _Pragma("unroll") for (int n = 0; n < 2; ++n) _Pragma("unroll") for (int k = 0; k < 2; ++k) dst[n][k] = *(const PG8_LAS bf16x8*)(lds + PG8_SB(b, h) + boff + n * 2048 + k * 1024); } while (0)
#define PG8_MMA(ai, bj, At, Bt) do { __builtin_amdgcn_s_setprio(1); _Pragma("unroll") for (int m = 0; m < 4; ++m) _Pragma("unroll") for (int n = 0; n < 2; ++n) _Pragma("unroll") for (int k = 0; k < 2; ++k) \
        acc[ai][bj][m][n] = __builtin_amdgcn_mfma_f32_16x16x32_bf16(Bt[n][k], At[m][k], acc[ai][bj][m][n], 0, 0, 0); __builtin_amdgcn_s_setprio(0); } while (0)
#define PG8_WAIT_V(n) asm volatile("s_waitcnt vmcnt(" #n ")" ::: "memory")
#define PG8_WAIT_L(n) asm volatile("s_waitcnt lgkmcnt(" #n ")" ::: "memory")
#define PG8_BAR __builtin_amdgcn_s_barrier()
#define PG8_SCHED __builtin_amdgcn_sched_barrier(0)
    Unit cur, nxt; int ui = 0;
    if (!S.next(0, cur)) return;
    f32x4 acc[2][2][4][2];
#pragma unroll
    for (int a = 0; a < 2; ++a)
#pragma unroll
        for (int b = 0; b < 2; ++b)
#pragma unroll
            for (int m = 0; m < 4; ++m)
#pragma unroll
                for (int n = 0; n < 2; ++n) acc[a][b][m][n] = (f32x4){0.f, 0.f, 0.f, 0.f};
    bf16x8 At[4][2], B0[2][2], B1[2][2];
    const char* cA = (const char*)g.A + (size_t)cur.pm * tstep; const char* cB = (const char*)g.Bt + (size_t)cur.pn * tstep;
    S.a_ready(cur);
    PG8_STAGE(PG8_SB(0, 0), cB, voffB); PG8_STAGE(PG8_SA(0, 0), cA, voffA); PG8_STAGE(PG8_SB(0, 1), cB + hstep, voffB); PG8_STAGE(PG8_SA(0, 1), cA + hstep, voffA);
    if (wr == 1) PG8_BAR;
    PG8_WAIT_V(4); PG8_BAR;
    PG8_STAGE(PG8_SB(1, 0), cB + kstep, voffB); PG8_STAGE(PG8_SA(1, 0), cA + kstep, voffA); PG8_STAGE(PG8_SB(1, 1), cB + hstep + kstep, voffB);
    PG8_WAIT_V(6); PG8_BAR;
    for (;;) {
        const bool has_next = S.next(ui + 1, nxt);
        const char* nA = has_next ? (const char*)g.A + (size_t)nxt.pm * tstep : cA; const char* nB = has_next ? (const char*)g.Bt + (size_t)nxt.pn * tstep : cB;
        for (int t = 0; t < nt; t += 2) {
            const bool last = (t == nt - 2);
            const char* a1 = cA + (size_t)(t + 1) * kstep;
            const char* a2 = last ? nA : cA + (size_t)(t + 2) * kstep; const char* b2 = last ? nB : cB + (size_t)(t + 2) * kstep;
            const char* a3 = a2 + kstep; const char* b3 = b2 + kstep;
            if (last && has_next) S.a_ready(nxt);
            PG8_LDB(B0, 0, 0); PG8_SCHED; PG8_LDA(At, 0, 0); PG8_STAGE(PG8_SA(1, 1), a1 + hstep, voffA);
            PG8_WAIT_L(8); PG8_BAR; PG8_WAIT_L(0); PG8_MMA(0, 0, At, B0); PG8_BAR; PG8_SCHED;
            PG8_LDB(B1, 0, 1); PG8_STAGE(PG8_SB(0, 0), b2, voffB);
            PG8_BAR; PG8_WAIT_L(0); PG8_MMA(0, 1, At, B1); PG8_BAR;
            PG8_LDA(At, 0, 1); PG8_STAGE(PG8_SA(0, 0), a2, voffA);
            PG8_BAR; PG8_WAIT_L(0); PG8_MMA(1, 0, At, B0); PG8_BAR; PG8_SCHED;
            PG8_STAGE(PG8_SB(0, 1), b2 + hstep, voffB);
            PG8_WAIT_V(6); PG8_BAR; PG8_MMA(1, 1, At, B1); PG8_BAR;
            PG8_LDB(B0, 1, 0); PG8_SCHED; PG8_LDA(At, 1, 0); PG8_STAGE(PG8_SA(0, 1), a2 + hstep, voffA);
            PG8_WAIT_L(8); PG8_BAR; PG8_WAIT_L(0); PG8_MMA(0, 0, At, B0); PG8_BAR; PG8_SCHED;
            PG8_LDB(B1, 1, 1); PG8_STAGE(PG8_SB(1, 0), b3, voffB);
            PG8_BAR; PG8_WAIT_L(0); PG8_MMA(0, 1, At, B1); PG8_BAR;
            PG8_LDA(At, 1, 1); PG8_STAGE(PG8_SA(1, 0), a3, voffA);
            PG8_BAR; PG8_WAIT_L(0); PG8_MMA(1, 0, At, B0); PG8_BAR; PG8_SCHED;
            PG8_STAGE(PG8_SB(1, 1), b3 + hstep, voffB);
            PG8_WAIT_V(6); PG8_BAR; PG8_MMA(1, 1, At, B1); PG8_BAR;
        }
        if constexpr (!Epi::AFTER_DRAIN) { E(acc, cur, wr, wc, fr, fq); S.done(cur); }
        if (!has_next) break;
#pragma unroll
        for (int a = 0; a < 2; ++a)
#pragma unroll
            for (int b = 0; b < 2; ++b)
#pragma unroll
                for (int m = 0; m < 4; ++m)
#pragma unroll
                    for (int n = 0; n < 2; ++n) acc[a][b][m][n] = (f32x4){0.f, 0.f, 0.f, 0.f};
        cur = nxt; cA = nA; cB = nB; ++ui;
    }
    PG8_WAIT_V(0);
    if (wr == 0) PG8_BAR;
    PG8_BAR;
    if constexpr (Epi::AFTER_DRAIN) { E.fused(acc, cur, wr, wc, fr, fq, lds, wid, lane); S.done(cur); }
#undef PG8_SA
#undef PG8_SB
#undef PG8_STAGE
#undef PG8_LDA
#undef PG8_LDB
#undef PG8_MMA
#undef PG8_WAIT_V
#undef PG8_WAIT_L
#undef PG8_BAR
#undef PG8_SCHED
}
}

using pg8::f32x4; using pg8::bf16x8; using pg8::Unit; using pg8::cvt_pk_bf16;
typedef unsigned short u16;
#define LAS __attribute__((address_space(3)))

constexpr int MT = 8192, DM = 2048, SEQ = 4096;
constexpr int NZ = 9216, ZM = 5120, ZG = 4096, DFF = 5632, NUP = 11264, RWD = 1024;
constexpr size_t WS_WDOWN = 0;
constexpr size_t WS_WIN   = WS_WDOWN + (size_t)2048 * 5632 * 2;
constexpr size_t WS_WUP   = WS_WIN + (size_t)9216 * 2048 * 2;
constexpr size_t WS_WBR1  = WS_WUP + (size_t)11264 * 2048 * 2;
constexpr size_t WS_WBR2  = WS_WBR1 + (size_t)2048 * 1024 * 2;
constexpr size_t WS_WOUT  = WS_WBR2 + (size_t)2048 * 1024 * 2;
constexpr size_t WS_WLORA = WS_WOUT + (size_t)2048 * 2048 * 2;
constexpr size_t WS_Z     = WS_WLORA + (size_t)3072 * 512 * 2;
constexpr size_t Z_BYTES  = (size_t)MT * NUP * 2;
constexpr size_t WS_X     = WS_Z + Z_BYTES;
constexpr size_t WS_SMALL = WS_X + (size_t)MT * DM * 2;
constexpr size_t WS_END   = WS_SMALL + 32768 + (size_t)MT * 32 * 4;
constexpr size_t WS_ACT   = WS_WIN;
static_assert(WS_Z - WS_WIN >= (size_t)MT * DFF * 2, "act overlay");
constexpr size_t Z_MAIN = 0, Z_GATE = (size_t)MT * ZM * 2, Z_TAIL = (size_t)MT * (ZM + ZG) * 2;
constexpr size_t Z_LW = 0, Z_A = (size_t)MT * RWD * 4, Z_G = 2 * (size_t)MT * RWD * 4;
constexpr size_t X_AP = 0, X_KN = (size_t)MT * 512 * 2, X_VT = X_KN + (size_t)MT * 256 * 2, X_OATT = X_VT + (size_t)MT * 256 * 2;
constexpr size_t O_RKV = 0, O_QN = (size_t)MT * 3072 * 2;

struct Params { const float* in[24]; float* out; unsigned char* ws; int ph_lo, ph_hi; };

__device__ __forceinline__ float bf2f(unsigned short b) { return __uint_as_float(((unsigned)b) << 16); }
__device__ __forceinline__ float bflo(unsigned u) { return __uint_as_float(u << 16); }
__device__ __forceinline__ float bfhi(unsigned u) { return __uint_as_float(u & 0xffff0000u); }
__device__ __forceinline__ u16 f2bf(float f) { return (u16)(cvt_pk_bf16(f, f) & 0xffffu); }
__device__ __forceinline__ float wave_sum(float v) {
#pragma unroll
    for (int o = 32; o; o >>= 1) v += __shfl_xor(v, o);
    return v; }
__device__ __forceinline__ float sigmoidf_(float x) { return 1.0f / (1.0f + __expf(-x)); }
template <int CTRL> __device__ __forceinline__ float dppf(float x) { return __int_as_float(__builtin_amdgcn_update_dpp(0, __float_as_int(x), CTRL, 0xF, 0xF, true)); }
__device__ __forceinline__ float row16_sum(float x) { x += dppf<0xB1>(x); x += dppf<0x4E>(x); x += dppf<0x141>(x); x += dppf<0x140>(x); return x; }

#define EPI_ROWS _Pragma("unroll") for (int ai = 0; ai < 2; ++ai) _Pragma("unroll") for (int m = 0; m < 4; ++m)
#define EPI_COLS _Pragma("unroll") for (int bj = 0; bj < 2; ++bj) _Pragma("unroll") for (int n = 0; n < 2; ++n)
struct EpiZ {
    static constexpr bool PERM = false, AFTER_DRAIN = false;
    u16* zmain; u16* zgate; const float* rstd;
    __device__ __forceinline__ void operator()(const f32x4 (&acc)[2][2][4][2], const Unit& u, int wr, int wc, int fr, int fq) const {
        u16* base; int ld, c0;
        if (u.pn < 20) { base = zmain; ld = ZM; c0 = u.pn * 256; } else { base = zgate; ld = ZG; c0 = (u.pn - 20) * 256; }
        const int row0 = u.pm * 256 + wr * 64 + fr; c0 += wc * 32 + 4 * fq;
        EPI_ROWS { const int row = row0 + ai * 128 + m * 16; const float rs = rstd[row]; u16* rp = base + (size_t)row * ld + c0;
            EPI_COLS { const f32x4 v = acc[ai][bj][m][n] * rs; uint2 w; w.x = cvt_pk_bf16(v[0], v[1]); w.y = cvt_pk_bf16(v[2], v[3]); *(uint2*)(rp + bj * 128 + n * 16) = w; } }
    }
};
struct EpiLora {
    static constexpr bool PERM = false, AFTER_DRAIN = false;
    float* lw; float* av; u16* g; const float* w0; const float* a0;
    __device__ __forceinline__ void operator()(const f32x4 (&acc)[2][2][4][2], const Unit& u, int wr, int wc, int fr, int fq) const {
        const int row0 = u.pm * 256 + wr * 64 + fr; const int kind = u.pn >> 2; const int c0 = (u.pn & 3) * 256 + wc * 32 + 4 * fq;
        if (kind == 0) {
            EPI_ROWS { const int row = row0 + ai * 128 + m * 16;
                EPI_COLS { const int col = c0 + bj * 128 + n * 16; const f32x4 v = acc[ai][bj][m][n]; const f32x4 b = *(const f32x4*)(w0 + col); f32x4 o;
#pragma unroll
                    for (int j = 0; j < 4; ++j) { const float y = -(b[j] + v[j]); const float sp = fmaxf(y, 0.f) + __logf(1.0f + __expf(-fabsf(y))); o[j] = -__expf(-sp - 0.5f); }
                    *(f32x4*)(lw + (size_t)row * RWD + col) = o; } }
        } else if (kind == 1) {
            EPI_ROWS { const int row = row0 + ai * 128 + m * 16;
                EPI_COLS { const int col = c0 + bj * 128 + n * 16; const f32x4 v = acc[ai][bj][m][n]; const f32x4 b = *(const f32x4*)(a0 + col); f32x4 o;
#pragma unroll
                    for (int j = 0; j < 4; ++j) o[j] = sigmoidf_(b[j] + v[j]);
                    *(f32x4*)(av + (size_t)row * RWD + col) = o; } }
        } else {
            EPI_ROWS { const int row = row0 + ai * 128 + m * 16;
                EPI_COLS { const int col = c0 + bj * 128 + n * 16; const f32x4 v = acc[ai][bj][m][n];
                    uint2 w; w.x = cvt_pk_bf16(v[0], v[1]); w.y = cvt_pk_bf16(v[2], v[3]); *(uint2*)(g + (size_t)row * RWD + col) = w; } }
        }
    }
};
template <int PASS> struct EpiBranch {
    static constexpr bool PERM = false, AFTER_DRAIN = false;
    u16* mixed; const u16* zgate;
    __device__ __forceinline__ void operator()(const f32x4 (&acc)[2][2][4][2], const Unit& u, int wr, int wc, int fr, int fq) const {
        const int row0 = u.pm * 256 + wr * 64 + fr; const int c0 = u.pn * 256 + wc * 32 + 4 * fq;
        EPI_ROWS { const int row = row0 + ai * 128 + m * 16;
            EPI_COLS { const int col = c0 + bj * 128 + n * 16; const f32x4 v = acc[ai][bj][m][n];
                const uint2 gz = *(const uint2*)(zgate + (size_t)row * ZG + PASS * 2048 + col);
                f32x4 o; o[0] = sigmoidf_(bflo(gz.x)) * v[0]; o[1] = sigmoidf_(bfhi(gz.x)) * v[1]; o[2] = sigmoidf_(bflo(gz.y)) * v[2]; o[3] = sigmoidf_(bfhi(gz.y)) * v[3];
                uint2* mp = (uint2*)(mixed + (size_t)row * DM + col);
                if (PASS == 1) { const uint2 pm = *mp; o[0] += bflo(pm.x); o[1] += bfhi(pm.x); o[2] += bflo(pm.y); o[3] += bfhi(pm.y); }
                uint2 w; w.x = cvt_pk_bf16(o[0], o[1]); w.y = cvt_pk_bf16(o[2], o[3]); *mp = w; } }
    }
};
struct EpiOut1 {
    static constexpr bool PERM = false, AFTER_DRAIN = false;
    const float* x; float* x1; u16* x1b; float* rowss;
    __device__ __forceinline__ void operator()(const f32x4 (&acc)[2][2][4][2], const Unit& u, int wr, int wc, int fr, int fq) const {
        const int row0 = u.pm * 256 + wr * 64 + fr; const int c0 = u.pn * 256 + wc * 32 + 4 * fq;
        EPI_ROWS { const int row = row0 + ai * 128 + m * 16; float ss = 0.f;
            EPI_COLS { const int col = c0 + bj * 128 + n * 16; const size_t o = (size_t)row * DM + col;
                const f32x4 v = acc[ai][bj][m][n] + *(const f32x4*)(x + o);
                *(f32x4*)(x1 + o) = v; ss += v[0] * v[0] + v[1] * v[1] + v[2] * v[2] + v[3] * v[3];
                uint2 w; w.x = cvt_pk_bf16(v[0], v[1]); w.y = cvt_pk_bf16(v[2], v[3]); *(uint2*)(x1b + o) = w; }
            ss += __shfl_xor(ss, 16); ss += __shfl_xor(ss, 32);
            if (fq == 0) rowss[(size_t)row * 32 + u.pn * 4 + wc] = ss; }
    }
};
struct EpiUp {
    static constexpr bool PERM = false, AFTER_DRAIN = false;
    u16* uo; const float* rowss;
    __device__ __forceinline__ void operator()(const f32x4 (&acc)[2][2][4][2], const Unit& u, int wr, int wc, int fr, int fq) const {
        const int row0 = u.pm * 256 + wr * 64 + fr; const int c0 = u.pn * 256 + wc * 32 + 4 * fq;
        EPI_ROWS { const int row = row0 + ai * 128 + m * 16;
            const f32x4 p0 = *(const f32x4*)(rowss + (size_t)row * 32 + fq * 8), p1 = *(const f32x4*)(rowss + (size_t)row * 32 + fq * 8 + 4);
            float ss = ((p0[0] + p0[1]) + (p0[2] + p0[3])) + ((p1[0] + p1[1]) + (p1[2] + p1[3]));
            ss += __shfl_xor(ss, 16); ss += __shfl_xor(ss, 32);
            const float rs = rsqrtf(ss * (1.0f / 2048.0f) + 1e-6f); u16* rp = uo + (size_t)row * NUP + c0;
            EPI_COLS { const f32x4 v = acc[ai][bj][m][n] * rs; uint2 w; w.x = cvt_pk_bf16(v[0], v[1]); w.y = cvt_pk_bf16(v[2], v[3]); *(uint2*)(rp + bj * 128 + n * 16) = w; } }
    }
};
struct EpiFinal {
    static constexpr bool PERM = false, AFTER_DRAIN = false;
    float* out;
    __device__ __forceinline__ void operator()(const f32x4 (&acc)[2][2][4][2], const Unit& u, int wr, int wc, int fr, int fq) const {
        const int row0 = u.pm * 256 + wr * 64 + fr; const int c0 = u.pn * 256 + wc * 32 + 4 * fq;
        EPI_ROWS { const int row = row0 + ai * 128 + m * 16;
            EPI_COLS { float* op = out + (size_t)row * DM + c0 + bj * 128 + n * 16; *(f32x4*)op = *(const f32x4*)op + acc[ai][bj][m][n]; } }
    }
};

template <class Epi> __device__ __forceinline__ void run_gemm(LAS unsigned char* lds, const u16* A, const u16* Bt, int N, int K, const Epi& E) {
    pg8::Gemm g; g.A = A; g.Bt = Bt; g.M = MT; g.N = N; g.K = K;
    pg8::StaticOrder S; S.init(MT, N, (int)gridDim.x, (int)blockIdx.x);
    pg8::gemm_phase<Epi, pg8::StaticOrder>(lds, g, S, E);
}

__device__ __forceinline__ void tr_tile(const float* __restrict__ src, int ldn, int nsrc0, u16* __restrict__ dst, int K, int k0, int ndst0, const float* __restrict__ scale, float* tile) {
    const int tid = threadIdx.x, nc4 = (tid & 15) * 4, kr0 = tid >> 4;
    float4 v[8];
#pragma unroll
    for (int i = 0; i < 8; ++i) { const int kr = kr0 + 32 * i; v[i] = make_float4(0.f, 0.f, 0.f, 0.f);
        if (nsrc0 >= 0) v[i] = *(const float4*)(src + (size_t)(k0 + kr) * ldn + nsrc0 + nc4); }
#pragma unroll
    for (int i = 0; i < 8; ++i) { const int kr = kr0 + 32 * i; const float sc = scale ? scale[k0 + kr] : 1.0f; float* tp = tile + kr * 65 + nc4;
        tp[0] = v[i].x * sc; tp[1] = v[i].y * sc; tp[2] = v[i].z * sc; tp[3] = v[i].w * sc; }
    __syncthreads();
    const int nr = tid >> 3, kb = (tid & 7) * 8;
#pragma unroll
    for (int q = 0; q < 4; ++q) { const int kc = kb + 64 * q; uint4 w;
        w.x = cvt_pk_bf16(tile[(kc + 0) * 65 + nr], tile[(kc + 1) * 65 + nr]); w.y = cvt_pk_bf16(tile[(kc + 2) * 65 + nr], tile[(kc + 3) * 65 + nr]);
        w.z = cvt_pk_bf16(tile[(kc + 4) * 65 + nr], tile[(kc + 5) * 65 + nr]); w.w = cvt_pk_bf16(tile[(kc + 6) * 65 + nr], tile[(kc + 7) * 65 + nr]);
        *(uint4*)(dst + (size_t)(ndst0 + nr) * K + k0 + kc) = w; }
    __syncthreads();
}
constexpr int WT_IN = 1152, WT_ALL = 3776;
__device__ __forceinline__ void weight_tile(const Params& P, int id, float* tile) {
    unsigned char* ws = P.ws;
    if (id < 1152) { const int nt = id % 144, kt = id / 144; const int ns = nt < 55 ? nt * 64 : (nt == 55 ? -1 : nt * 64 - 64);
        tr_tile(P.in[2], 9152, ns, (u16*)(ws + WS_WIN), 2048, kt * 256, nt * 64, P.in[1], tile); }
    else if (id < 1152 + 1408) { const int j = id - 1152, nt = j % 176, kt = j / 176;
        tr_tile(P.in[20], NUP, nt * 64, (u16*)(ws + WS_WUP), 2048, kt * 256, nt * 64, P.in[19], tile); }
    else if (id < 2560 + 704) { const int j = id - 2560, nt = j % 32, kt = j / 32;
        tr_tile(P.in[23], 2048, nt * 64, (u16*)(ws + WS_WDOWN), 5632, kt * 256, nt * 64, nullptr, tile); }
    else if (id < 3264 + 128) { const int j = id - 3264, nt = j % 32, kt = j / 32;
        tr_tile(P.in[17], 2048, nt * 64, (u16*)(ws + WS_WBR1), 1024, kt * 256, nt * 64, nullptr, tile); }
    else if (id < 3392 + 128) { const int j = id - 3392, nt = j % 32, kt = j / 32;
        tr_tile(P.in[17] + (size_t)1024 * 2048, 2048, nt * 64, (u16*)(ws + WS_WBR2), 1024, kt * 256, nt * 64, nullptr, tile); }
    else { const int j = id - 3520, nt = j % 32, kt = j / 32;
        tr_tile(P.in[18], 2048, nt * 64, (u16*)(ws + WS_WOUT), 2048, kt * 256, nt * 64, nullptr, tile); }
}
__device__ void phase0(const Params& P, float* tile) {
    unsigned char* ws = P.ws; const int G = gridDim.x, bid = blockIdx.x, tid = threadIdx.x;
    for (int id = bid; id < WT_IN; id += G) weight_tile(P, id, tile);
    { u16* wl = (u16*)(ws + WS_WLORA);
      for (int idx = bid * 512 + tid; idx < 3072 * 512; idx += G * 512) { const int n = idx >> 9, k = idx & 511; float v = 0.f;
          if (n < 1024) { if (k < 96) v = P.in[5][(size_t)k * 1024 + n]; }
          else if (n < 2048) { if (k >= 96 && k < 192) v = P.in[7][(size_t)(k - 96) * 1024 + (n - 1024)]; }
          else { if (k >= 256) v = P.in[8][(size_t)(k - 256) * 1024 + (n - 2048)]; }
          wl[idx] = f2bf(v); } }
    { const int lane = tid & 63, gw = bid * 8 + (tid >> 6), nw = G * 8; u16* xb = (u16*)(ws + WS_X); float* rstd1 = (float*)(ws + WS_SMALL);
      for (int t = gw; t < MT; t += nw) { const float4* xr = (const float4*)(P.in[0] + (size_t)t * DM); float ss = 0.f;
#pragma unroll
          for (int i = 0; i < 8; ++i) { const float4 v = xr[lane + 64 * i]; ss += v.x * v.x + v.y * v.y + v.z * v.z + v.w * v.w;
              uint2 w; w.x = cvt_pk_bf16(v.x, v.y); w.y = cvt_pk_bf16(v.z, v.w); *(uint2*)(xb + (size_t)t * DM + (lane + 64 * i) * 4) = w; }
          ss = wave_sum(ss); if (lane == 0) rstd1[t] = rsqrtf(ss * (1.0f / 2048.0f) + 1e-6f); } }
}

__device__ void phase2(const Params& P, u16* tile) {
    unsigned char* ws = P.ws; const int G = gridDim.x, bid = blockIdx.x, tid = threadIdx.x, lane = tid & 63;
    const u16* zmain = (const u16*)(ws + WS_Z + Z_MAIN);
    u16* rkv = (u16*)((unsigned char*)P.out + O_RKV); u16* Qn = (u16*)((unsigned char*)P.out + O_QN);
    u16* Ap = (u16*)(ws + WS_X + X_AP); u16* Kn = (u16*)(ws + WS_X + X_KN); u16* Vt = (u16*)(ws + WS_X + X_VT);
    const float* mu = P.in[3]; const float qg = P.in[14][lane], kg = P.in[15][lane];
    for (int t = bid * 8 + (tid >> 6); t < MT; t += G * 8) {
        const u16* zr = zmain + (size_t)t * ZM; const bool hp = (t & (SEQ - 1)) != 0;
        for (int i = 0; i < 28; ++i) { const int c = i * 128 + lane * 2;
            if (c < 3520) { const unsigned zz = *(const unsigned*)(zr + c); const unsigned pp = hp ? *(const unsigned*)(zr - ZM + c) : 0u; const float2 m2 = *(const float2*)(mu + c);
                const float z0 = bflo(zz), z1 = bfhi(zz); const float a0 = z0 + (bflo(pp) - z0) * m2.x, a1 = z1 + (bfhi(pp) - z1) * m2.y;
                if (c < 3072) *(unsigned*)(rkv + (size_t)t * 3072 + c) = cvt_pk_bf16(a0, a1);
                else if (c < 3168) *(unsigned*)(Ap + (size_t)t * 512 + (c - 3072)) = cvt_pk_bf16(tanhf(a0), tanhf(a1));
                else if (c < 3264) *(unsigned*)(Ap + (size_t)t * 512 + 96 + (c - 3168)) = cvt_pk_bf16(a0, a1);
                else *(unsigned*)(Ap + (size_t)t * 512 + 256 + (c - 3264)) = cvt_pk_bf16(sigmoidf_(a0), sigmoidf_(a1)); } }
        if (lane < 32) *(unsigned*)(Ap + (size_t)t * 512 + 192 + lane * 2) = 0u;
        for (int h = 0; h < 16; ++h) { const float v = bf2f(zr[3584 + h * 64 + lane]); const float ss = wave_sum(v * v); const float rs = rsqrtf(ss * (1.0f / 64.0f) + 1e-6f);
            Qn[(size_t)t * 1024 + h * 64 + lane] = f2bf(v * rs * qg * 0.125f); }
        for (int h = 0; h < 4; ++h) { const float v = bf2f(zr[4608 + h * 64 + lane]); const float ss = wave_sum(v * v); const float rs = rsqrtf(ss * (1.0f / 64.0f) + 1e-6f);
            Kn[(size_t)t * 256 + h * 64 + lane] = f2bf(v * rs * kg); }
    }
    for (int tl = bid; tl < MT / 64; tl += G) { const int t0 = tl * 64;
        __syncthreads();
        for (int i = 0; i < 16; ++i) { const int idx = tid + 512 * i, r = idx >> 7, cp = idx & 127; const unsigned vv = *(const unsigned*)(zmain + (size_t)(t0 + r) * ZM + 4864 + 2 * cp);
            tile[(2 * cp) * 66 + r] = (u16)(vv & 0xffffu); tile[(2 * cp + 1) * 66 + r] = (u16)(vv >> 16); }
        __syncthreads();
        const int b = t0 >> 12, s0 = t0 & (SEQ - 1);
        for (int i = 0; i < 16; ++i) { const int idx = tid + 512 * i, c = idx >> 5, sp = idx & 31;
            const unsigned w = (unsigned)tile[c * 66 + 2 * sp] | ((unsigned)tile[c * 66 + 2 * sp + 1] << 16);
            *(unsigned*)(Vt + ((size_t)(b * 4 + (c >> 6)) * 64 + (c & 63)) * SEQ + s0 + 2 * sp) = w; }
    }
}

constexpr int NS = 4, NSCAN = 32 * NS, TCH = 64, VR = 64 / NS;
__device__ void scan_phase(const Params& P, float* L) {
    unsigned char* ws = P.ws; const int bid = blockIdx.x, tid = threadIdx.x, lane = tid & 63, w = tid >> 6;
    const int hb = bid / NS, vs = bid % NS, b = hb >> 4, h = hb & 15;
    const u16* rkv = (const u16*)((unsigned char*)P.out + O_RKV);
    const float* lwp = (const float*)(ws + WS_Z + Z_LW); const float* ap = (const float*)(ws + WS_Z + Z_A);
    float* yraw = (float*)(ws + WS_Z + Z_TAIL);
    float* R = L; float* Kp = L + 4096; float* Wd = L + 8192; float* KK = L + 12288; float* Bv = L + 16384; float* Vv = L + 20480; float* Yb = L + 21504; float* DUM = L + 22528;
    const int tl = tid >> 3, c8 = (tid & 7) * 8, v2 = (tid & 7) * 2;
    float kkw[8], kaw[8];
#pragma unroll
    for (int j = 0; j < 8; ++j) { kkw[j] = P.in[9][h * 64 + c8 + j]; kaw[j] = P.in[10][h * 64 + c8 + j]; }
    const int vl = lane >> 4, kg = lane & 15, row = (w & 3) * 4 + vl;
    float s0 = 0.f, s1 = 0.f, s2 = 0.f, s3 = 0.f;
    uint4 r8, k8; float4 lw0, lw1, a0, a1; unsigned vv2;
    auto prefetch = [&](int ci) { const size_t t = (size_t)b * SEQ + ci * TCH + tl;
        r8 = *(const uint4*)(rkv + t * 3072 + h * 64 + c8); k8 = *(const uint4*)(rkv + t * 3072 + 1024 + h * 64 + c8);
        vv2 = *(const unsigned*)(rkv + t * 3072 + 2048 + h * 64 + vs * VR + v2);
        lw0 = *(const float4*)(lwp + t * RWD + h * 64 + c8); lw1 = *(const float4*)(lwp + t * RWD + h * 64 + c8 + 4);
        a0 = *(const float4*)(ap + t * RWD + h * 64 + c8); a1 = *(const float4*)(ap + t * RWD + h * 64 + c8 + 4); };
    prefetch(0);
    for (int ci = 0; ci < SEQ / TCH; ++ci) {
        __syncthreads();
        if (ci > 0) { const size_t t = (size_t)b * SEQ + (ci - 1) * TCH + tl; *(float2*)(yraw + t * RWD + h * 64 + vs * VR + v2) = *(const float2*)(Yb + tl * VR + v2); }
        { float rr[8], kk_[8], aa[8], ll[8];
          rr[0] = bflo(r8.x); rr[1] = bfhi(r8.x); rr[2] = bflo(r8.y); rr[3] = bfhi(r8.y); rr[4] = bflo(r8.z); rr[5] = bfhi(r8.z); rr[6] = bflo(r8.w); rr[7] = bfhi(r8.w);
          kk_[0] = bflo(k8.x); kk_[1] = bfhi(k8.x); kk_[2] = bflo(k8.y); kk_[3] = bfhi(k8.y); kk_[4] = bflo(k8.z); kk_[5] = bfhi(k8.z); kk_[6] = bflo(k8.w); kk_[7] = bfhi(k8.w);
          aa[0] = a0.x; aa[1] = a0.y; aa[2] = a0.z; aa[3] = a0.w; aa[4] = a1.x; aa[5] = a1.y; aa[6] = a1.z; aa[7] = a1.w;
          ll[0] = lw0.x; ll[1] = lw0.y; ll[2] = lw0.z; ll[3] = lw0.w; ll[4] = lw1.x; ll[5] = lw1.y; ll[6] = lw1.z; ll[7] = lw1.w;
          float q[8]; float ss = 0.f;
#pragma unroll
          for (int j = 0; j < 8; ++j) { q[j] = kk_[j] * kkw[j]; ss += q[j] * q[j]; }
          ss += __shfl_xor(ss, 1); ss += __shfl_xor(ss, 2); ss += __shfl_xor(ss, 4);
          const float inv = 1.0f / fmaxf(sqrtf(ss), 1e-12f);
#pragma unroll
          for (int j = 0; j < 8; ++j) { const float kkn = q[j] * inv; const int o = tl * 64 + c8 + j;
              R[o] = rr[j]; Kp[o] = kk_[j] * (1.0f + (aa[j] - 1.0f) * kaw[j]); Wd[o] = __expf(ll[j]); KK[o] = kkn; Bv[o] = kkn * aa[j]; }
          float* vp = Vv + tl * VR + v2; vp[0] = bflo(vv2); vp[1] = bfhi(vv2); }
        __syncthreads();
        if (ci + 1 < SEQ / TCH) prefetch(ci + 1);
        if (w < 4) {
            float4 ckk = *(const float4*)(KK + 4 * kg), cw = *(const float4*)(Wd + 4 * kg), cb = *(const float4*)(Bv + 4 * kg), ck = *(const float4*)(Kp + 4 * kg), cr = *(const float4*)(R + 4 * kg);
            float cv = Vv[row];
#pragma unroll 4
            for (int t = 0; t < TCH; ++t) {
                const int tn = (t + 1) & (TCH - 1);
                const float4 nkk = *(const float4*)(KK + tn * 64 + 4 * kg), nw = *(const float4*)(Wd + tn * 64 + 4 * kg), nb = *(const float4*)(Bv + tn * 64 + 4 * kg);
                const float4 nk = *(const float4*)(Kp + tn * 64 + 4 * kg), nr = *(const float4*)(R + tn * 64 + 4 * kg);
                const float nv = Vv[tn * VR + row];
                float sa = s0 * ckk.x + s1 * ckk.y + s2 * ckk.z + s3 * ckk.w; sa = -row16_sum(sa);
                s0 = s0 * cw.x + sa * cb.x + cv * ck.x; s1 = s1 * cw.y + sa * cb.y + cv * ck.y; s2 = s2 * cw.z + sa * cb.z + cv * ck.z; s3 = s3 * cw.w + sa * cb.w + cv * ck.w;
                float y = s0 * cr.x + s1 * cr.y + s2 * cr.z + s3 * cr.w; y = row16_sum(y);
                float* yp = (kg == 0) ? (Yb + t * VR + row) : (DUM + lane); *yp = y;
                ckk = nkk; cw = nw; cb = nb; ck = nk; cr = nr; cv = nv;
            }
        }
    }
    __syncthreads();
    { const size_t t = (size_t)b * SEQ + (SEQ / TCH - 1) * TCH + tl; *(float2*)(yraw + t * RWD + h * 64 + vs * VR + v2) = *(const float2*)(Yb + tl * VR + v2); }
}

__device__ void attn_phase(const Params& P) {
    unsigned char* ws = P.ws; const int tid = threadIdx.x, lane = tid & 63, fr = lane & 15, fq = lane >> 4;
    const u16* Qn = (const u16*)((unsigned char*)P.out + O_QN); const u16* Kn = (const u16*)(ws + WS_X + X_KN); const u16* Vt = (const u16*)(ws + WS_X + X_VT);
    u16* oatt = (u16*)(ws + WS_X + X_OATT);
    const int NA = (int)gridDim.x - NSCAN; const int gw = ((int)blockIdx.x - NSCAN) * 8 + (tid >> 6);
    for (int unit = gw; unit < 8192; unit += NA * 8) {
        const int h = unit & 15, st = (unit >> 4) & 255, b = unit >> 12, kh = h >> 2;
        const int s0 = st * 16; const size_t t0 = (size_t)b * SEQ + s0;
        const float slope = exp2f(-0.5f * (float)(h + 1)), sink = P.in[16][h];
        bf16x8 qf[2];
        qf[0] = *(const bf16x8*)(Qn + (t0 + fr) * 1024 + h * 64 + 8 * fq); qf[1] = *(const bf16x8*)(Qn + (t0 + fr) * 1024 + h * 64 + 32 + 8 * fq);
        f32x4 sc[10]; float mx = sink;
#pragma unroll
        for (int kt = 0; kt < 10; ++kt) { const int ks0 = s0 - 144 + 16 * kt; int kp = ks0 + fr; kp = kp < 0 ? 0 : kp;
            const u16* kr = Kn + ((size_t)b * SEQ + kp) * 256 + kh * 64 + 8 * fq;
            const bf16x8 k0 = *(const bf16x8*)kr, k1 = *(const bf16x8*)(kr + 32);
            f32x4 a = {0.f, 0.f, 0.f, 0.f};
            a = __builtin_amdgcn_mfma_f32_16x16x32_bf16(k0, qf[0], a, 0, 0, 0); a = __builtin_amdgcn_mfma_f32_16x16x32_bf16(k1, qf[1], a, 0, 0, 0);
#pragma unroll
            for (int j = 0; j < 4; ++j) { const int kpos = ks0 + 4 * fq + j; const int dist = s0 + fr - kpos; const bool valid = (dist >= 0) && (dist < 128) && (kpos >= 0);
                const float v = valid ? a[j] - slope * (float)dist : -1e30f; a[j] = v; mx = fmaxf(mx, v); }
            sc[kt] = a; }
        mx = fmaxf(mx, __shfl_xor(mx, 16)); mx = fmaxf(mx, __shfl_xor(mx, 32));
        float sum = 0.f;
#pragma unroll
        for (int kt = 0; kt < 10; ++kt)
#pragma unroll
            for (int j = 0; j < 4; ++j) { const float e = __expf(sc[kt][j] - mx); sc[kt][j] = e; sum += e; }
        sum += __shfl_xor(sum, 16); sum += __shfl_xor(sum, 32);
        const float inv = 1.0f / (sum + __expf(sink - mx));
        f32x4 o[4];
#pragma unroll
        for (int dt = 0; dt < 4; ++dt) o[dt] = (f32x4){0.f, 0.f, 0.f, 0.f};
#pragma unroll
        for (int u = 0; u < 5; ++u) {
            union { bf16x8 v; unsigned w[4]; } pf;
            pf.w[0] = cvt_pk_bf16(sc[2 * u][0] * inv, sc[2 * u][1] * inv); pf.w[1] = cvt_pk_bf16(sc[2 * u][2] * inv, sc[2 * u][3] * inv);
            pf.w[2] = cvt_pk_bf16(sc[2 * u + 1][0] * inv, sc[2 * u + 1][1] * inv); pf.w[3] = cvt_pk_bf16(sc[2 * u + 1][2] * inv, sc[2 * u + 1][3] * inv);
            int ka = s0 - 144 + 32 * u + 4 * fq, kb = ka + 16; ka = ka < 0 ? 0 : ka; kb = kb < 0 ? 0 : kb;
#pragma unroll
            for (int dt = 0; dt < 4; ++dt) { const u16* vr = Vt + ((size_t)(b * 4 + kh) * 64 + dt * 16 + fr) * SEQ;
                union { bf16x8 v; uint2 w[2]; } vf; vf.w[0] = *(const uint2*)(vr + ka); vf.w[1] = *(const uint2*)(vr + kb);
                o[dt] = __builtin_amdgcn_mfma_f32_16x16x32_bf16(pf.v, vf.v, o[dt], 0, 0, 0); } }
#pragma unroll
        for (int dt = 0; dt < 4; ++dt)
#pragma unroll
            for (int j = 0; j < 4; ++j) oatt[(t0 + 4 * fq + j) * 1024 + h * 64 + dt * 16 + fr] = f2bf(o[dt][j]);
    }
}

__device__ void phase5(const Params& P) {
    unsigned char* ws = P.ws; const int G = gridDim.x, bid = blockIdx.x, tid = threadIdx.x, lane = tid & 63;
    const u16* rkv = (const u16*)((unsigned char*)P.out + O_RKV); u16* orw = (u16*)((unsigned char*)P.out + O_QN);
    const float* yraw = (const float*)(ws + WS_Z + Z_TAIL); const float* ap = (const float*)(ws + WS_Z + Z_A); const u16* gp = (const u16*)(ws + WS_Z + Z_G);
    for (int t = bid * 8 + (tid >> 6); t < MT; t += G * 8) {
        for (int h = 0; h < 16; ++h) { const int hc = h * 64 + lane; const size_t o = (size_t)t * RWD + hc;
            const float y = yraw[o]; const float mu = wave_sum(y) * (1.0f / 64.0f); const float d = y - mu; const float var = wave_sum(d * d) * (1.0f / 64.0f);
            const float yn = d * rsqrtf(var + 64e-5f) * P.in[12][hc] + P.in[13][hc];
            const float r = bf2f(rkv[(size_t)t * 3072 + hc]), k = bf2f(rkv[(size_t)t * 3072 + 1024 + hc]), v = bf2f(rkv[(size_t)t * 3072 + 2048 + hc]);
            const float a = ap[o]; const float kp = k * (1.0f + (a - 1.0f) * P.in[10][hc]);
            const float rk = wave_sum(r * kp * P.in[11][hc]);
            orw[o] = f2bf((yn + rk * v) * bf2f(gp[o])); }
    }
}

__device__ void phase9(const Params& P) {
    unsigned char* ws = P.ws; const u16* uu = (const u16*)(ws + WS_Z); u16* act = (u16*)(ws + WS_ACT);
    const float* cw = P.in[21]; const float* cb = P.in[22];
    const int nth = gridDim.x * 512;
    for (int task = blockIdx.x * 512 + threadIdx.x; task < 512 * 704; task += nth) {
        const int j0 = (task % 704) * 8, t0 = (task / 704) * 16;
        float w0[16], w1[16], w2[16], bb[16], p2[16], p1[16];
#pragma unroll
        for (int j = 0; j < 8; ++j) { w0[j] = cw[j0 + j]; w1[j] = cw[NUP + j0 + j]; w2[j] = cw[2 * NUP + j0 + j]; bb[j] = cb[j0 + j];
            w0[8 + j] = cw[DFF + j0 + j]; w1[8 + j] = cw[NUP + DFF + j0 + j]; w2[8 + j] = cw[2 * NUP + DFF + j0 + j]; bb[8 + j] = cb[DFF + j0 + j]; }
        auto ld16 = [&](int t, float* d) { const uint4 a = *(const uint4*)(uu + (size_t)t * NUP + j0), g = *(const uint4*)(uu + (size_t)t * NUP + DFF + j0);
            d[0] = bflo(a.x); d[1] = bfhi(a.x); d[2] = bflo(a.y); d[3] = bfhi(a.y); d[4] = bflo(a.z); d[5] = bfhi(a.z); d[6] = bflo(a.w); d[7] = bfhi(a.w);
            d[8] = bflo(g.x); d[9] = bfhi(g.x); d[10] = bflo(g.y); d[11] = bfhi(g.y); d[12] = bflo(g.z); d[13] = bfhi(g.z); d[14] = bflo(g.w); d[15] = bfhi(g.w); };
        if ((t0 & (SEQ - 1)) == 0) {
#pragma unroll
            for (int j = 0; j < 16; ++j) { p2[j] = 0.f; p1[j] = 0.f; } }
        else { ld16(t0 - 2, p2); ld16(t0 - 1, p1); }
        for (int i = 0; i < 16; ++i) { float c[16]; ld16(t0 + i, c); float o[8];
#pragma unroll
            for (int j = 0; j < 8; ++j) { const float cv = p2[j] * w0[j] + p1[j] * w1[j] + c[j] * w2[j] + bb[j]; const float cg_ = p2[8 + j] * w0[8 + j] + p1[8 + j] * w1[8 + j] + c[8 + j] * w2[8 + j] + bb[8 + j];
                o[j] = cg_ * sigmoidf_(cg_) * cv; }
            uint4 w; w.x = cvt_pk_bf16(o[0], o[1]); w.y = cvt_pk_bf16(o[2], o[3]); w.z = cvt_pk_bf16(o[4], o[5]); w.w = cvt_pk_bf16(o[6], o[7]);
            *(uint4*)(act + (size_t)(t0 + i) * DFF + j0) = w;
#pragma unroll
            for (int j = 0; j < 16; ++j) { p2[j] = p1[j]; p1[j] = c[j]; } }
    }
}


constexpr int NPH = 11;
__global__ void __launch_bounds__(512, 2) mega(Params P) {
    extern __shared__ __attribute__((aligned(16))) unsigned char lds_raw[];
    cg::grid_group grid = cg::this_grid();
    LAS unsigned char* lds = (LAS unsigned char*)lds_raw;
    unsigned char* ws = P.ws;
#define RUN(i) ((i) >= P.ph_lo && (i) < P.ph_hi)
#define SEAM(i) do { if ((i) >= P.ph_lo && (i) + 1 < P.ph_hi) grid.sync(); } while (0)
    if (RUN(0)) phase0(P, (float*)lds_raw);
    SEAM(0);
    if (RUN(1)) { EpiZ E; E.zmain = (u16*)(ws + WS_Z + Z_MAIN); E.zgate = (u16*)(ws + WS_Z + Z_GATE); E.rstd = (const float*)(ws + WS_SMALL);
        run_gemm(lds, (const u16*)(ws + WS_X), (const u16*)(ws + WS_WIN), NZ, 2048, E); }
    SEAM(1);
    if (RUN(2)) phase2(P, (u16*)lds_raw);
    SEAM(2);
    if (RUN(3)) { EpiLora E; E.lw = (float*)(ws + WS_Z + Z_LW); E.av = (float*)(ws + WS_Z + Z_A); E.g = (u16*)(ws + WS_Z + Z_G); E.w0 = P.in[4]; E.a0 = P.in[6];
        run_gemm(lds, (const u16*)(ws + WS_X + X_AP), (const u16*)(ws + WS_WLORA), 3072, 512, E); }
    SEAM(3);
    if (RUN(4)) { if ((int)blockIdx.x < NSCAN) scan_phase(P, (float*)lds_raw);
        else { attn_phase(P); __syncthreads(); for (int id = WT_IN + ((int)blockIdx.x - NSCAN); id < WT_ALL; id += (int)gridDim.x - NSCAN) weight_tile(P, id, (float*)lds_raw); } }
    SEAM(4);
    if (RUN(5)) phase5(P);
    SEAM(5);
    if (RUN(6)) {
        { EpiBranch<0> E; E.mixed = (u16*)(ws + WS_Z); E.zgate = (const u16*)(ws + WS_Z + Z_GATE);
          run_gemm(lds, (const u16*)((unsigned char*)P.out + O_QN), (const u16*)(ws + WS_WBR1), 2048, 1024, E); }
        { EpiBranch<1> E; E.mixed = (u16*)(ws + WS_Z); E.zgate = (const u16*)(ws + WS_Z + Z_GATE);
          run_gemm(lds, (const u16*)(ws + WS_X + X_OATT), (const u16*)(ws + WS_WBR2), 2048, 1024, E); } }
    SEAM(6);
    if (RUN(7)) { EpiOut1 E; E.x = P.in[0]; E.x1 = P.out; E.x1b = (u16*)(ws + WS_X); E.rowss = (float*)(ws + WS_SMALL + 32768);
        run_gemm(lds, (const u16*)(ws + WS_Z), (const u16*)(ws + WS_WOUT), 2048, 2048, E); }
    SEAM(7);
    if (RUN(8)) { EpiUp E; E.uo = (u16*)(ws + WS_Z); E.rowss = (const float*)(ws + WS_SMALL + 32768);
        run_gemm(lds, (const u16*)(ws + WS_X), (const u16*)(ws + WS_WUP), NUP, 2048, E); }
    SEAM(8);
    if (RUN(9)) phase9(P);
    SEAM(9);
    if (RUN(10)) { EpiFinal E; E.out = P.out;
        run_gemm(lds, (const u16*)(ws + WS_ACT), (const u16*)(ws + WS_WDOWN), 2048, DFF, E); }
}

constexpr int LDS_BYTES = 131072;
extern "C" void kernel_launch(void* const* d_in, const int* in_sizes, int n_in, void* d_out, int out_size, void* d_ws, size_t ws_size, hipStream_t stream) {
    static int grid = 0;
    if (grid == 0) {
        if (n_in != 24 || out_size != MT * DM || ws_size < WS_END) { fprintf(stderr, "kernel_launch: unexpected shapes (n_in %d out %d ws %zu need %zu)\n", n_in, out_size, ws_size, (size_t)WS_END); grid = -1; return; }
        int dev = 0, cus = 0, per_cu = 0;
        hipGetDevice(&dev); hipDeviceGetAttribute(&cus, hipDeviceAttributeMultiprocessorCount, dev);
        if (hipFuncSetAttribute((const void*)mega, hipFuncAttributeMaxDynamicSharedMemorySize, LDS_BYTES) != hipSuccess) { fprintf(stderr, "kernel_launch: hipFuncSetAttribute failed\n"); grid = -1; return; }
        if (hipOccupancyMaxActiveBlocksPerMultiprocessor(&per_cu, (const void*)mega, 512, LDS_BYTES) != hipSuccess || per_cu < 1) { fprintf(stderr, "kernel_launch: occupancy query failed (%d)\n", per_cu); grid = -1; return; }
        grid = cus * per_cu; if (grid > 256) grid = 256;
        if (grid < 2 * NSCAN) { fprintf(stderr, "kernel_launch: grid %d too small\n", grid); grid = -1; return; }
    }
    if (grid < 0) return;
    Params p{};
    for (int i = 0; i < 24; ++i) p.in[i] = (const float*)d_in[i];
    p.out = (float*)d_out; p.ws = (unsigned char*)d_ws;
#ifndef SPLIT_LAUNCH
    p.ph_lo = 0; p.ph_hi = NPH;
    { void* args[] = {&p}; hipError_t e = hipLaunchCooperativeKernel((const void*)mega, dim3(grid), dim3(512), args, LDS_BYTES, stream);
      if (e != hipSuccess) fprintf(stderr, "cooperative launch failed: %s (grid %d)\n", hipGetErrorString(e), grid); }
#else
    for (int ph = 0; ph < NPH; ++ph) { p.ph_lo = ph; p.ph_hi = ph + 1; void* args[] = {&p};
        hipError_t e = hipLaunchCooperativeKernel((const void*)mega, dim3(grid), dim3(512), args, LDS_BYTES, stream);
        if (e != hipSuccess) fprintf(stderr, "cooperative launch failed: %s (grid %d)\n", hipGetErrorString(e), grid); }
#endif
}
```

```cpp
#include <hip/hip_runtime.h>
#include <hip/hip_cooperative_groups.h>
#include <cstdio>
#include <cstdint>
namespace cg = cooperative_groups;
namespace pg8 {
#define PG8_LAS __attribute__((address_space(3)))
typedef unsigned short bf16_t;
typedef short bf16x8 __attribute__((ext_vector_type(8)));
typedef float f32x4 __attribute__((ext_vector_type(4)));
typedef unsigned u32x4 __attribute__((ext_vector_type(4)));
constexpr int BM = 256, BK = 64, HALF = 128, HTB = HALF * BK * 2  , STAGE_BYTES = 8 * HTB, NXCD = 8, WGM = 8;

__host__ __device__ __forceinline__ int lds_byte(int r, int c) { const int st = (r >> 4) * 2 + (c >> 5), rr = r & 15, cc = c & 31, ob = rr * 64 + cc * 2; return st * 1024 + (ob ^ (((ob >> 9) & 1) << 5)); }
__host__ __device__ __forceinline__ void stage_rc(int b, int& R, int& C) { const int st = b / 1024, sb = b % 1024, swz = sb ^ (((sb >> 9) & 1) << 5); R = (st >> 1) * 16 + swz / 64; C = (st & 1) * 32 + (swz % 64) / 2; }
__host__ __device__ __forceinline__ int perm32(int rho) { const int n = rho >> 4, i = rho & 15; return 8 * (i >> 2) + 4 * n + (i & 3); }

struct Unit { int pm, pn; };
struct Gemm { const bf16_t* A; const bf16_t* Bt; int M, N, K; };

struct StaticOrder {
    int nM, nN, nwg, G, c;
    __host__ __device__ void init(int M, int N, int G_, int c_) { nM = M / BM; nN = N / BM; nwg = nM * nN; G = G_; c = c_; }
    __host__ __device__ bool next(int i, Unit& u) const {
        const long L = (long)i * G + c; if (L >= nwg) return false;
        int wgid = (int)L; { const int q = nwg / NXCD, r = nwg % NXCD, xcd = wgid % NXCD, off = wgid / NXCD; wgid = (xcd < r ? xcd * (q + 1) : r * (q + 1) + (xcd - r) * q) + off; }
        const int nig = WGM * nN, gid = wgid / nig, fm = gid * WGM, gsz = (nM - fm) < WGM ? (nM - fm) : WGM;
        u.pm = fm + ((wgid % nig) % gsz); u.pn = (wgid % nig) / gsz; return true;
    }
    __device__ __forceinline__ void a_ready(const Unit&) const {}
    __device__ __forceinline__ void done(const Unit&) const {}
};
typedef __bf16 bf16v2_t __attribute__((ext_vector_type(2))); typedef float f32v2_t __attribute__((ext_vector_type(2)));
__device__ __forceinline__ unsigned cvt_pk_bf16(float lo, float hi) { const f32v2_t x = {lo, hi}; const bf16v2_t r = __builtin_convertvector(x, bf16v2_t); return __builtin_bit_cast(unsigned, r); }
template <class Epi, class Sched>
__device__ __forceinline__ void gemm_phase(PG8_LAS unsigned char* lds, const Gemm g, const Sched& S, const Epi& E) {
    const int tid = threadIdx.x, wid = __builtin_amdgcn_readfirstlane(tid >> 6), lane = tid & 63, wr = wid >> 2, wc = wid & 3, fr = lane & 15, fq = lane >> 4;
    const int K = g.K, nt = K / BK;
    unsigned voffA[2], voffB[2];
#pragma unroll
    for (int i = 0; i < 2; ++i) { int R, C; stage_rc(tid * 16 + i * 8192, R, C); const int Rb = Epi::PERM ? ((R & ~31) + perm32(R & 31)) : R;
        voffA[i] = (unsigned)(R * K + C) * 2u; voffB[i] = (unsigned)(Rb * K + C) * 2u; }
    const size_t kstep = (size_t)(BK * 2);
    const size_t hstep = (size_t)HALF * K * 2;
    const size_t tstep = 2 * hstep;
    const unsigned ldsw = (unsigned)wid * 1024u;
    const int aoff = lds_byte(wr * 64 + fr, fq * 8), boff = lds_byte(wc * 32 + fr, fq * 8);
#define PG8_SA(b, h) (((b) * 2 + (h)) * HTB)
#define PG8_SB(b, h) ((4 + (b) * 2 + (h)) * HTB)
#define PG8_STAGE(bufoff, gbase, voff) do { _Pragma("unroll") for (int _i = 0; _i < 2; ++_i) \
        __builtin_amdgcn_global_load_lds((const unsigned*)((const char*)(gbase) + (voff)[_i]), (PG8_LAS unsigned*)(lds + (bufoff) + ldsw + _i * 8192), 16, 0, 0); } while (0)
#define PG8_LDA(dst, b, h) do { _Pragma("unroll") for (int m = 0; m < 4; ++m) _Pragma("unroll") for (int k = 0; k < 2; ++k) dst[m][k] = *(const PG8_LAS bf16x8*)(lds + PG8_SA(b, h) + aoff + m * 2048 + k * 1024); } while (0)
#define PG8_LDB(dst, b, h) do { _Pragma("unroll") for (int n = 0; n < 2; ++n) _Pragma("unroll") for (int k = 0; k < 2; ++k) dst[n][k] = *(const PG8_LAS bf16x8*)(lds + PG8_SB(b, h) + boff + n * 2048 + k * 1024); } while (0)
#define PG8_MMA(ai, bj, At, Bt) do { __builtin_amdgcn_s_setprio(1); _Pragma("unroll") for (int m = 0; m < 4; ++m) _Pragma("unroll") for (int n = 0; n < 2; ++n) _Pragma("unroll") for (int k = 0; k < 2; ++k) \
        acc[ai][bj][m][n] = __builtin_amdgcn_mfma_f32_16x16x32_bf16(Bt[n][k], At[m][k], acc[ai][bj][m][n], 0, 0, 0); __builtin_amdgcn_s_setprio(0); } while (0)
#define PG8_WAIT_V(n) asm volatile("s_waitcnt vmcnt(" #n ")" ::: "memory")
#define PG8_WAIT_L(n) asm volatile("s_waitcnt lgkmcnt(" #n ")" ::: "memory")
#define PG8_BAR __builtin_amdgcn_s_barrier()
#define PG8_SCHED __builtin_amdgcn_sched_barrier(0)
    Unit cur, nxt; int ui = 0;
    if (!S.next(0, cur)) return;
    f32x4 acc[2][2][4][2];
#pragma unroll
    for (int a = 0; a < 2; ++a)
#pragma unroll
        for (int b = 0; b < 2; ++b)
#pragma unroll
            for (int m = 0; m < 4; ++m)
#pragma unroll
                for (int n = 0; n < 2; ++n) acc[a][b][m][n] = (f32x4){0.f, 0.f, 0.f, 0.f};
    bf16x8 At[4][2], B0[2][2], B1[2][2];
    const char* cA = (const char*)g.A + (size_t)cur.pm * tstep; const char* cB = (const char*)g.Bt + (size_t)cur.pn * tstep;
    S.a_ready(cur);
    PG8_STAGE(PG8_SB(0, 0), cB, voffB); PG8_STAGE(PG8_SA(0, 0), cA, voffA); PG8_STAGE(PG8_SB(0, 1), cB + hstep, voffB); PG8_STAGE(PG8_SA(0, 1), cA + hstep, voffA);
    if (wr == 1) PG8_BAR;
    PG8_WAIT_V(4); PG8_BAR;
    PG8_STAGE(PG8_SB(1, 0), cB + kstep, voffB); PG8_STAGE(PG8_SA(1, 0), cA + kstep, voffA); PG8_STAGE(PG8_SB(1, 1), cB + hstep + kstep, voffB);
    PG8_WAIT_V(6); PG8_BAR;
    for (;;) {
        const bool has_next = S.next(ui + 1, nxt);
        const char* nA = has_next ? (const char*)g.A + (size_t)nxt.pm * tstep : cA; const char* nB = has_next ? (const char*)g.Bt + (size_t)nxt.pn * tstep : cB;
        for (int t = 0; t < nt; t += 2) {
            const bool last = (t == nt - 2);
            const char* a1 = cA + (size_t)(t + 1) * kstep;
            const char* a2 = last ? nA : cA + (size_t)(t + 2) * kstep; const char* b2 = last ? nB : cB + (size_t)(t + 2) * kstep;
            const char* a3 = a2 + kstep; const char* b3 = b2 + kstep;
            if (last && has_next) S.a_ready(nxt);
            PG8_LDB(B0, 0, 0); PG8_SCHED; PG8_LDA(At, 0, 0); PG8_STAGE(PG8_SA(1, 1), a1 + hstep, voffA);
            PG8_WAIT_L(8); PG8_BAR; PG8_WAIT_L(0); PG8_MMA(0, 0, At, B0); PG8_BAR; PG8_SCHED;
            PG8_LDB(B1, 0, 1); PG8_STAGE(PG8_SB(0, 0), b2, voffB);
            PG8_BAR; PG8_WAIT_L(0); PG8_MMA(0, 1, At, B1); PG8_BAR;
            PG8_LDA(At, 0, 1); PG8_STAGE(PG8_SA(0, 0), a2, voffA);
            PG8_BAR; PG8_WAIT_L(0); PG8_MMA(1, 0, At, B0); PG8_BAR; PG8_SCHED;
            PG8_STAGE(PG8_SB(0, 1), b2 + hstep, voffB);
            PG8_WAIT_V(6); PG8_BAR; PG8_MMA(1, 1, At, B1); PG8_BAR;
            PG8_LDB(B0, 1, 0); PG8_SCHED; PG8_LDA(At, 1, 0); PG8_STAGE(PG8_SA(0, 1), a2 + hstep, voffA);
            PG8_WAIT_L(8); PG8_BAR; PG8_WAIT_L(0); PG8_MMA(0, 0, At, B0); PG8_BAR; PG8_SCHED;
            PG8_LDB(B1, 1, 1); PG8_STAGE(PG8_SB(1, 0), b3, voffB);
            PG8_BAR; PG8_WAIT_L(0); PG8_MMA(0, 1, At, B1); PG8_BAR;
            PG8_LDA(At, 1, 1); PG8_STAGE(PG8_SA(1, 0), a3, voffA);
            PG8_BAR; PG8_WAIT_L(0); PG8_MMA(1, 0, At, B0); PG8_BAR; PG8_SCHED;
            PG8_STAGE(PG8_SB(1, 1), b3 + hstep, voffB);
            PG8_WAIT_V(6); PG8_BAR; PG8_MMA(1, 1, At, B1); PG8_BAR;
        }
        if constexpr (!Epi::AFTER_DRAIN) { E(acc, cur, wr, wc, fr, fq); S.done(cur); }
        if (!has_next) break;
#pragma unroll
        for (int a = 0; a < 2; ++a)
#pragma unroll
            for (int b = 0; b < 2; ++b)
#pragma unroll
                for (int m = 0; m < 4; ++m)
#pragma unroll
                    for (int n = 0; n < 2; ++n) acc[a][b][m][n] = (f32x4){0.f, 0.f, 0.f, 0.f};
        cur = nxt; cA = nA; cB = nB; ++ui;
    }
    PG8_WAIT_V(0);
    if (wr == 0) PG8_BAR;
    PG8_BAR;
    if constexpr (Epi::AFTER_DRAIN) { E.fused(acc, cur, wr, wc, fr, fq, lds, wid, lane); S.done(cur); }
#undef PG8_SA
#undef PG8_SB
#undef PG8_STAGE
#undef PG8_LDA
#undef PG8_LDB
#undef PG8_MMA
#undef PG8_WAIT_V
#undef PG8_WAIT_L
#undef PG8_BAR
#undef PG8_SCHED
}
}

using pg8::f32x4; using pg8::bf16x8; using pg8::Unit; using pg8::cvt_pk_bf16;
typedef unsigned short u16;
#define LAS __attribute__((address_space(3)))

constexpr int MT = 8192, DM = 2048, SEQ = 4096;
constexpr int NZ = 9216, ZM = 5120, ZG = 4096, DFF = 5632, NUP = 11264, RWD = 1024;
constexpr size_t WS_WDOWN = 0;
constexpr size_t WS_WIN   = WS_WDOWN + (size_t)2048 * 5632 * 2;
constexpr size_t WS_WUP   = WS_WIN + (size_t)9216 * 2048 * 2;
constexpr size_t WS_WBR1  = WS_WUP + (size_t)11264 * 2048 * 2;
constexpr size_t WS_WBR2  = WS_WBR1 + (size_t)2048 * 1024 * 2;
constexpr size_t WS_WOUT  = WS_WBR2 + (size_t)2048 * 1024 * 2;
constexpr size_t WS_WLORA = WS_WOUT + (size_t)2048 * 2048 * 2;
constexpr size_t WS_Z     = WS_WLORA + (size_t)3072 * 512 * 2;
constexpr size_t Z_BYTES  = (size_t)MT * NUP * 2;
constexpr size_t WS_X     = WS_Z + Z_BYTES;
constexpr size_t WS_SMALL = WS_X + (size_t)MT * DM * 2;
constexpr size_t WS_END   = WS_SMALL + 32768 + (size_t)MT * 32 * 4;
constexpr size_t WS_ACT   = WS_WIN;
static_assert(WS_Z - WS_WIN >= (size_t)MT * DFF * 2, "act overlay");
constexpr size_t Z_MAIN = 0, Z_GATE = (size_t)MT * ZM * 2, Z_TAIL = (size_t)MT * (ZM + ZG) * 2;
constexpr size_t Z_LW = 0, Z_A = (size_t)MT * RWD * 4, Z_G = 2 * (size_t)MT * RWD * 4;
constexpr size_t X_AP = 0, X_KN = (size_t)MT * 512 * 2, X_VT = X_KN + (size_t)MT * 256 * 2, X_OATT = X_VT + (size_t)MT * 256 * 2;
constexpr size_t O_RKV = 0, O_QN = (size_t)MT * 3072 * 2;

struct Params { const float* in[24]; float* out; unsigned char* ws; int ph_lo, ph_hi; };

__device__ __forceinline__ float bf2f(unsigned short b) { return __uint_as_float(((unsigned)b) << 16); }
__device__ __forceinline__ float bflo(unsigned u) { return __uint_as_float(u << 16); }
__device__ __forceinline__ float bfhi(unsigned u) { return __uint_as_float(u & 0xffff0000u); }
__device__ __forceinline__ u16 f2bf(float f) { return (u16)(cvt_pk_bf16(f, f) & 0xffffu); }
__device__ __forceinline__ float wave_sum(float v) {
#pragma unroll
    for (int o = 32; o; o >>= 1) v += __shfl_xor(v, o);
    return v; }
__device__ __forceinline__ float sigmoidf_(float x) { return 1.0f / (1.0f + __expf(-x)); }
template <int CTRL> __device__ __forceinline__ float dppf(float x) { return __int_as_float(__builtin_amdgcn_update_dpp(0, __float_as_int(x), CTRL, 0xF, 0xF, true)); }
__device__ __forceinline__ float row16_sum(float x) { x += dppf<0xB1>(x); x += dppf<0x4E>(x); x += dppf<0x141>(x); x += dppf<0x140>(x); return x; }

#define EPI_ROWS _Pragma("unroll") for (int ai = 0; ai < 2; ++ai) _Pragma("unroll") for (int m = 0; m < 4; ++m)
#define EPI_COLS _Pragma("unroll") for (int bj = 0; bj < 2; ++bj) _Pragma("unroll") for (int n = 0; n < 2; ++n)
struct EpiZ {
    static constexpr bool PERM = false, AFTER_DRAIN = false;
    u16* zmain; u16* zgate; const float* rstd;
    __device__ __forceinline__ void operator()(const f32x4 (&acc)[2][2][4][2], const Unit& u, int wr, int wc, int fr, int fq) const {
        u16* base; int ld, c0;
        if (u.pn < 20) { base = zmain; ld = ZM; c0 = u.pn * 256; } else { base = zgate; ld = ZG; c0 = (u.pn - 20) * 256; }
        const int row0 = u.pm * 256 + wr * 64 + fr; c0 += wc * 32 + 4 * fq;
        EPI_ROWS { const int row = row0 + ai * 128 + m * 16; const float rs = rstd[row]; u16* rp = base + (size_t)row * ld + c0;
            EPI_COLS { const f32x4 v = acc[ai][bj][m][n] * rs; uint2 w; w.x = cvt_pk_bf16(v[0], v[1]); w.y = cvt_pk_bf16(v[2], v[3]); *(uint2*)(rp + bj * 128 + n * 16) = w; } }
    }
};
struct EpiLora {
    static constexpr bool PERM = false, AFTER_DRAIN = false;
    float* lw; float* av; u16* g; const float* w0; const float* a0;
    __device__ __forceinline__ void operator()(const f32x4 (&acc)[2][2][4][2], const Unit& u, int wr, int wc, int fr, int fq) const {
        const int row0 = u.pm * 256 + wr * 64 + fr; const int kind = u.pn >> 2; const int c0 = (u.pn & 3) * 256 + wc * 32 + 4 * fq;
        if (kind == 0) {
            EPI_ROWS { const int row = row0 + ai * 128 + m * 16;
                EPI_COLS { const int col = c0 + bj * 128 + n * 16; const f32x4 v = acc[ai][bj][m][n]; const f32x4 b = *(const f32x4*)(w0 + col); f32x4 o;
#pragma unroll
                    for (int j = 0; j < 4; ++j) { const float y = -(b[j] + v[j]); const float sp = fmaxf(y, 0.f) + __logf(1.0f + __expf(-fabsf(y))); o[j] = -__expf(-sp - 0.5f); }
                    *(f32x4*)(lw + (size_t)row * RWD + col) = o; } }
        } else if (kind == 1) {
            EPI_ROWS { const int row = row0 + ai * 128 + m * 16;
                EPI_COLS { const int col = c0 + bj * 128 + n * 16; const f32x4 v = acc[ai][bj][m][n]; const f32x4 b = *(const f32x4*)(a0 + col); f32x4 o;
#pragma unroll
                    for (int j = 0; j < 4; ++j) o[j] = sigmoidf_(b[j] + v[j]);
                    *(f32x4*)(av + (size_t)row * RWD + col) = o; } }
        } else {
            EPI_ROWS { const int row = row0 + ai * 128 + m * 16;
                EPI_COLS { const int col = c0 + bj * 128 + n * 16; const f32x4 v = acc[ai][bj][m][n];
                    uint2 w; w.x = cvt_pk_bf16(v[0], v[1]); w.y = cvt_pk_bf16(v[2], v[3]); *(uint2*)(g + (size_t)row * RWD + col) = w; } }
        }
    }
};
template <int PASS> struct EpiBranch {
    static constexpr bool PERM = false, AFTER_DRAIN = false;
    u16* mixed; const u16* zgate;
    __device__ __forceinline__ void operator()(const f32x4 (&acc)[2][2][4][2], const Unit& u, int wr, int wc, int fr, int fq) const {
        const int row0 = u.pm * 256 + wr * 64 + fr; const int c0 = u.pn * 256 + wc * 32 + 4 * fq;
        EPI_ROWS { const int row = row0 + ai * 128 + m * 16;
            EPI_COLS { const int col = c0 + bj * 128 + n * 16; const f32x4 v = acc[ai][bj][m][n];
                const uint2 gz = *(const uint2*)(zgate + (size_t)row * ZG + PASS * 2048 + col);
                f32x4 o; o[0] = sigmoidf_(bflo(gz.x)) * v[0]; o[1] = sigmoidf_(bfhi(gz.x)) * v[1]; o[2] = sigmoidf_(bflo(gz.y)) * v[2]; o[3] = sigmoidf_(bfhi(gz.y)) * v[3];
                uint2* mp = (uint2*)(mixed + (size_t)row * DM + col);
                if (PASS == 1) { const uint2 pm = *mp; o[0] += bflo(pm.x); o[1] += bfhi(pm.x); o[2] += bflo(pm.y); o[3] += bfhi(pm.y); }
                uint2 w; w.x = cvt_pk_bf16(o[0], o[1]); w.y = cvt_pk_bf16(o[2], o[3]); *mp = w; } }
    }
};
struct EpiOut1 {
    static constexpr bool PERM = false, AFTER_DRAIN = false;
    const float* x; float* x1; u16* x1b; float* rowss;
    __device__ __forceinline__ void operator()(const f32x4 (&acc)[2][2][4][2], const Unit& u, int wr, int wc, int fr, int fq) const {
        const int row0 = u.pm * 256 + wr * 64 + fr; const int c0 = u.pn * 256 + wc * 32 + 4 * fq;
        EPI_ROWS { const int row = row0 + ai * 128 + m * 16; float ss = 0.f;
            EPI_COLS { const int col = c0 + bj * 128 + n * 16; const size_t o = (size_t)row * DM + col;
                const f32x4 v = acc[ai][bj][m][n] + *(const f32x4*)(x + o);
                *(f32x4*)(x1 + o) = v; ss += v[0] * v[0] + v[1] * v[1] + v[2] * v[2] + v[3] * v[3];
                uint2 w; w.x = cvt_pk_bf16(v[0], v[1]); w.y = cvt_pk_bf16(v[2], v[3]); *(uint2*)(x1b + o) = w; }
            ss += __shfl_xor(ss, 16); ss += __shfl_xor(ss, 32);
            if (fq == 0) rowss[(size_t)row * 32 + u.pn * 4 + wc] = ss; }
    }
};
struct EpiUp {
    static constexpr bool PERM = false, AFTER_DRAIN = false;
    u16* uo; const float* rowss;
    __device__ __forceinline__ void operator()(const f32x4 (&acc)[2][2][4][2], const Unit& u, int wr, int wc, int fr, int fq) const {
        const int row0 = u.pm * 256 + wr * 64 + fr; const int c0 = u.pn * 256 + wc * 32 + 4 * fq;
        EPI_ROWS { const int row = row0 + ai * 128 + m * 16;
            const f32x4 p0 = *(const f32x4*)(rowss + (size_t)row * 32 + fq * 8), p1 = *(const f32x4*)(rowss + (size_t)row * 32 + fq * 8 + 4);
            float ss = ((p0[0] + p0[1]) + (p0[2] + p0[3])) + ((p1[0] + p1[1]) + (p1[2] + p1[3]));
            ss += __shfl_xor(ss, 16); ss += __shfl_xor(ss, 32);
            const float rs = rsqrtf(ss * (1.0f / 2048.0f) + 1e-6f); u16* rp = uo + (size_t)row * NUP + c0;
            EPI_COLS { const f32x4 v = acc[ai][bj][m][n] * rs; uint2 w; w.x = cvt_pk_bf16(v[0], v[1]); w.y = cvt_pk_bf16(v[2], v[3]); *(uint2*)(rp + bj * 128 + n * 16) = w; } }
    }
};
struct EpiFinal {
    static constexpr bool PERM = false, AFTER_DRAIN = false;
    float* out;
    __device__ __forceinline__ void operator()(const f32x4 (&acc)[2][2][4][2], const Unit& u, int wr, int wc, int fr, int fq) const {
        const int row0 = u.pm * 256 + wr * 64 + fr; const int c0 = u.pn * 256 + wc * 32 + 4 * fq;
        EPI_ROWS { const int row = row0 + ai * 128 + m * 16;
            EPI_COLS { float* op = out + (size_t)row * DM + c0 + bj * 128 + n * 16; *(f32x4*)op = *(const f32x4*)op + acc[ai][bj][m][n]; } }
    }
};

template <class Epi> __device__ __forceinline__ void run_gemm(LAS unsigned char* lds, const u16* A, const u16* Bt, int N, int K, const Epi& E) {
    pg8::Gemm g; g.A = A; g.Bt = Bt; g.M = MT; g.N = N; g.K = K;
    pg8::StaticOrder S; S.init(MT, N, (int)gridDim.x, (int)blockIdx.x);
    pg8::gemm_phase<Epi, pg8::StaticOrder>(lds, g, S, E);
}

__device__ __forceinline__ void tr_tile(const float* __restrict__ src, int ldn, int nsrc0, u16* __restrict__ dst, int K, int k0, int ndst0, const float* __restrict__ scale, float* tile) {
    const int tid = threadIdx.x, nc4 = (tid & 15) * 4, kr0 = tid >> 4;
    float4 v[8];
#pragma unroll
    for (int i = 0; i < 8; ++i) { const int kr = kr0 + 32 * i; v[i] = make_float4(0.f, 0.f, 0.f, 0.f);
        if (nsrc0 >= 0) v[i] = *(const float4*)(src + (size_t)(k0 + kr) * ldn + nsrc0 + nc4); }
#pragma unroll
    for (int i = 0; i < 8; ++i) { const int kr = kr0 + 32 * i; const float sc = scale ? scale[k0 + kr] : 1.0f; float* tp = tile + kr * 65 + nc4;
        tp[0] = v[i].x * sc; tp[1] = v[i].y * sc; tp[2] = v[i].z * sc; tp[3] = v[i].w * sc; }
    __syncthreads();
    const int nr = tid >> 3, kb = (tid & 7) * 8;
#pragma unroll
    for (int q = 0; q < 4; ++q) { const int kc = kb + 64 * q; uint4 w;
        w.x = cvt_pk_bf16(tile[(kc + 0) * 65 + nr], tile[(kc + 1) * 65 + nr]); w.y = cvt_pk_bf16(tile[(kc + 2) * 65 + nr], tile[(kc + 3) * 65 + nr]);
        w.z = cvt_pk_bf16(tile[(kc + 4) * 65 + nr], tile[(kc + 5) * 65 + nr]); w.w = cvt_pk_bf16(tile[(kc + 6) * 65 + nr], tile[(kc + 7) * 65 + nr]);
        *(uint4*)(dst + (size_t)(ndst0 + nr) * K + k0 + kc) = w; }
    __syncthreads();
}
constexpr int WT_IN = 1152, WT_ALL = 3776;
__device__ __forceinline__ void weight_tile(const Params& P, int id, float* tile) {
    unsigned char* ws = P.ws;
    if (id < 1152) { const int nt = id % 144, kt = id / 144; const int ns = nt < 55 ? nt * 64 : (nt == 55 ? -1 : nt * 64 - 64);
        tr_tile(P.in[2], 9152, ns, (u16*)(ws + WS_WIN), 2048, kt * 256, nt * 64, P.in[1], tile); }
    else if (id < 1152 + 1408) { const int j = id - 1152, nt = j % 176, kt = j / 176;
        tr_tile(P.in[20], NUP, nt * 64, (u16*)(ws + WS_WUP), 2048, kt * 256, nt * 64, P.in[19], tile); }
    else if (id < 2560 + 704) { const int j = id - 2560, nt = j % 32, kt = j / 32;
        tr_tile(P.in[23], 2048, nt * 64, (u16*)(ws + WS_WDOWN), 5632, kt * 256, nt * 64, nullptr, tile); }
    else if (id < 3264 + 128) { const int j = id - 3264, nt = j % 32, kt = j / 32;
        tr_tile(P.in[17], 2048, nt * 64, (u16*)(ws + WS_WBR1), 1024, kt * 256, nt * 64, nullptr, tile); }
    else if (id < 3392 + 128) { const int j = id - 3392, nt = j % 32, kt = j / 32;
        tr_tile(P.in[17] + (size_t)1024 * 2048, 2048, nt * 64, (u16*)(ws + WS_WBR2), 1024, kt * 256, nt * 64, nullptr, tile); }
    else { const int j = id - 3520, nt = j % 32, kt = j / 32;
        tr_tile(P.in[18], 2048, nt * 64, (u16*)(ws + WS_WOUT), 2048, kt * 256, nt * 64, nullptr, tile); }
}
__device__ void phase0(const Params& P, float* tile) {
    unsigned char* ws = P.ws; const int G = gridDim.x, bid = blockIdx.x, tid = threadIdx.x;
    for (int id = bid; id < WT_IN; id += G) weight_tile(P, id, tile);
    { u16* wl = (u16*)(ws + WS_WLORA);
      for (int idx = bid * 512 + tid; idx < 3072 * 512; idx += G * 512) { const int n = idx >> 9, k = idx & 511; float v = 0.f;
          if (n < 1024) { if (k < 96) v = P.in[5][(size_t)k * 1024 + n]; }
          else if (n < 2048) { if (k >= 96 && k < 192) v = P.in[7][(size_t)(k - 96) * 1024 + (n - 1024)]; }
          else { if (k >= 256) v = P.in[8][(size_t)(k - 256) * 1024 + (n - 2048)]; }
          wl[idx] = f2bf(v); } }
    { const int lane = tid & 63, gw = bid * 8 + (tid >> 6), nw = G * 8; u16* xb = (u16*)(ws + WS_X); float* rstd1 = (float*)(ws + WS_SMALL);
      for (int t = gw; t < MT; t += nw) { const float4* xr = (const float4*)(P.in[0] + (size_t)t * DM); float ss = 0.f;
#pragma unroll
          for (int i = 0; i < 8; ++i) { const float4 v = xr[lane + 64 * i]; ss += v.x * v.x + v.y * v.y + v.z * v.z + v.w * v.w;
              uint2 w; w.x = cvt_pk_bf16(v.x, v.y); w.y = cvt_pk_bf16(v.z, v.w); *(uint2*)(xb + (size_t)t * DM + (lane + 64 * i) * 4) = w; }
          ss = wave_sum(ss); if (lane == 0) rstd1[t] = rsqrtf(ss * (1.0f / 2048.0f) + 1e-6f); } }
}

__device__ void phase2(const Params& P, u16* tile) {
    unsigned char* ws = P.ws; const int G = gridDim.x, bid = blockIdx.x, tid = threadIdx.x, lane = tid & 63;
    const u16* zmain = (const u16*)(ws + WS_Z + Z_MAIN);
    u16* rkv = (u16*)((unsigned char*)P.out + O_RKV); u16* Qn = (u16*)((unsigned char*)P.out + O_QN);
    u16* Ap = (u16*)(ws + WS_X + X_AP); u16* Kn = (u16*)(ws + WS_X + X_KN); u16* Vt = (u16*)(ws + WS_X + X_VT);
    const float* mu = P.in[3];
    const int d0 = (lane * 2) & 63; const float qg0 = P.in[14][d0] * 0.125f, qg1 = P.in[14][d0 + 1] * 0.125f, kg0 = P.in[15][d0], kg1 = P.in[15][d0 + 1];
    for (int t = bid * 8 + (tid >> 6); t < MT; t += G * 8) {
        const u16* zr = zmain + (size_t)t * ZM; const bool hp = (t & (SEQ - 1)) != 0; const u16* zp = hp ? zr - ZM : zr;
        unsigned zz[28], pp[28], qk[10]; float2 m2[28];
#pragma unroll
        for (int i = 0; i < 28; ++i) { const int c = i * 128 + lane * 2; zz[i] = 0u; pp[i] = 0u; m2[i] = make_float2(0.f, 0.f);
            if (i < 27 || lane < 32) { zz[i] = *(const unsigned*)(zr + c); pp[i] = *(const unsigned*)(zp + c); m2[i] = *(const float2*)(mu + c); } }
#pragma unroll
        for (int i = 0; i < 10; ++i) qk[i] = *(const unsigned*)(zr + 3584 + i * 128 + lane * 2);
#pragma unroll
        for (int i = 0; i < 28; ++i) { const int c = i * 128 + lane * 2;
            if (i < 27 || lane < 32) { const unsigned pv = hp ? pp[i] : 0u;
                const float z0 = bflo(zz[i]), z1 = bfhi(zz[i]); const float a0 = z0 + (bflo(pv) - z0) * m2[i].x, a1 = z1 + (bfhi(pv) - z1) * m2[i].y;
                if (i < 24) *(unsigned*)(rkv + (size_t)t * 3072 + c) = cvt_pk_bf16(a0, a1);
                else if (c < 3168) *(unsigned*)(Ap + (size_t)t * 512 + (c - 3072)) = cvt_pk_bf16(tanhf(a0), tanhf(a1));
                else if (c < 3264) *(unsigned*)(Ap + (size_t)t * 512 + 96 + (c - 3168)) = cvt_pk_bf16(a0, a1);
                else *(unsigned*)(Ap + (size_t)t * 512 + 256 + (c - 3264)) = cvt_pk_bf16(sigmoidf_(a0), sigmoidf_(a1)); } }
        if (lane < 32) *(unsigned*)(Ap + (size_t)t * 512 + 192 + lane * 2) = 0u;
#pragma unroll
        for (int i = 0; i < 10; ++i) { const float v0 = bflo(qk[i]), v1 = bfhi(qk[i]); float ss = row16_sum(v0 * v0 + v1 * v1); ss += __shfl_xor(ss, 16);
            const float rs = rsqrtf(ss * (1.0f / 64.0f) + 1e-6f);
            if (i < 8) *(unsigned*)(Qn + (size_t)t * 1024 + i * 128 + lane * 2) = cvt_pk_bf16(v0 * rs * qg0, v1 * rs * qg1);
            else *(unsigned*)(Kn + (size_t)t * 256 + (i - 8) * 128 + lane * 2) = cvt_pk_bf16(v0 * rs * kg0, v1 * rs * kg1); }
    }
    for (int tl = bid; tl < MT / 64; tl += G) { const int t0 = tl * 64;
        __syncthreads();
        for (int i = 0; i < 16; ++i) { const int idx = tid + 512 * i, r = idx >> 7, cp = idx & 127; const unsigned vv = *(const unsigned*)(zmain + (size_t)(t0 + r) * ZM + 4864 + 2 * cp);
            tile[(2 * cp) * 66 + r] = (u16)(vv & 0xffffu); tile[(2 * cp + 1) * 66 + r] = (u16)(vv >> 16); }
        __syncthreads();
        const int b = t0 >> 12, s0 = t0 & (SEQ - 1);
        for (int i = 0; i < 16; ++i) { const int idx = tid + 512 * i, c = idx >> 5, sp = idx & 31;
            const unsigned w = (unsigned)tile[c * 66 + 2 * sp] | ((unsigned)tile[c * 66 + 2 * sp + 1] << 16);
            *(unsigned*)(Vt + ((size_t)(b * 4 + (c >> 6)) * 64 + (c & 63)) * SEQ + s0 + 2 * sp) = w; }
    }
}

constexpr int NS = 4, NSCAN = 32 * NS, TCH = 64, VR = 64 / NS;
__device__ void scan_phase(const Params& P, float* L) {
    unsigned char* ws = P.ws; const int bid = blockIdx.x, tid = threadIdx.x, lane = tid & 63, w = tid >> 6;
    const int hb = bid / NS, vs = bid % NS, b = hb >> 4, h = hb & 15;
    const u16* rkv = (const u16*)((unsigned char*)P.out + O_RKV);
    const float* lwp = (const float*)(ws + WS_Z + Z_LW); const float* ap = (const float*)(ws + WS_Z + Z_A);
    float* yraw = (float*)(ws + WS_Z + Z_TAIL);
    float* R = L; float* Kp = L + 4096; float* Wd = L + 8192; float* KK = L + 12288; float* Bv = L + 16384; float* Vv = L + 20480; float* Yb = L + 21504; float* DUM = L + 22528;
    const int tl = tid >> 3, c8 = (tid & 7) * 8, v2 = (tid & 7) * 2;
    float kkw[8], kaw[8];
#pragma unroll
    for (int j = 0; j < 8; ++j) { kkw[j] = P.in[9][h * 64 + c8 + j]; kaw[j] = P.in[10][h * 64 + c8 + j]; }
    const int vl = lane >> 4, kg = lane & 15, row = (w & 3) * 4 + vl;
    float s0 = 0.f, s1 = 0.f, s2 = 0.f, s3 = 0.f;
    uint4 r8, k8; float4 lw0, lw1, a0, a1; unsigned vv2;
    auto prefetch = [&](int ci) { const size_t t = (size_t)b * SEQ + ci * TCH + tl;
        r8 = *(const uint4*)(rkv + t * 3072 + h * 64 + c8); k8 = *(const uint4*)(rkv + t * 3072 + 1024 + h * 64 + c8);
        vv2 = *(const unsigned*)(rkv + t * 3072 + 2048 + h * 64 + vs * VR + v2);
        lw0 = *(const float4*)(lwp + t * RWD + h * 64 + c8); lw1 = *(const float4*)(lwp + t * RWD + h * 64 + c8 + 4);
        a0 = *(const float4*)(ap + t * RWD + h * 64 + c8); a1 = *(const float4*)(ap + t * RWD + h * 64 + c8 + 4); };
    prefetch(0);
    for (int ci = 0; ci < SEQ / TCH; ++ci) {
        __syncthreads();
        if (ci > 0) { const size_t t = (size_t)b * SEQ + (ci - 1) * TCH + tl; *(float2*)(yraw + t * RWD + h * 64 + vs * VR + v2) = *(const float2*)(Yb + tl * VR + v2); }
        { float rr[8], kk_[8], aa[8], ll[8];
          rr[0] = bflo(r8.x); rr[1] = bfhi(r8.x); rr[2] = bflo(r8.y); rr[3] = bfhi(r8.y); rr[4] = bflo(r8.z); rr[5] = bfhi(r8.z); rr[6] = bflo(r8.w); rr[7] = bfhi(r8.w);
          kk_[0] = bflo(k8.x); kk_[1] = bfhi(k8.x); kk_[2] = bflo(k8.y); kk_[3] = bfhi(k8.y); kk_[4] = bflo(k8.z); kk_[5] = bfhi(k8.z); kk_[6] = bflo(k8.w); kk_[7] = bfhi(k8.w);
          aa[0] = a0.x; aa[1] = a0.y; aa[2] = a0.z; aa[3] = a0.w; aa[4] = a1.x; aa[5] = a1.y; aa[6] = a1.z; aa[7] = a1.w;
          ll[0] = lw0.x; ll[1] = lw0.y; ll[2] = lw0.z; ll[3] = lw0.w; ll[4] = lw1.x; ll[5] = lw1.y; ll[6] = lw1.z; ll[7] = lw1.w;
          float q[8]; float ss = 0.f;
#pragma unroll
          for (int j = 0; j < 8; ++j) { q[j] = kk_[j] * kkw[j]; ss += q[j] * q[j]; }
          ss += __shfl_xor(ss, 1); ss += __shfl_xor(ss, 2); ss += __shfl_xor(ss, 4);
          const float inv = 1.0f / fmaxf(sqrtf(ss), 1e-12f);
#pragma unroll
          for (int j = 0; j < 8; ++j) { const float kkn = q[j] * inv; const int o = tl * 64 + c8 + j;
              R[o] = rr[j]; Kp[o] = kk_[j] * (1.0f + (aa[j] - 1.0f) * kaw[j]); Wd[o] = __expf(ll[j]); KK[o] = kkn; Bv[o] = kkn * aa[j]; }
          float* vp = Vv + tl * VR + v2; vp[0] = bflo(vv2); vp[1] = bfhi(vv2); }
        __syncthreads();
        if (ci + 1 < SEQ / TCH) prefetch(ci + 1);
        if (w < 4) {
            float4 ckk = *(const float4*)(KK + 4 * kg), cw = *(const float4*)(Wd + 4 * kg), cb = *(const float4*)(Bv + 4 * kg), ck = *(const float4*)(Kp + 4 * kg), cr = *(const float4*)(R + 4 * kg);
            float cv = Vv[row];
#pragma unroll 4
            for (int t = 0; t < TCH; ++t) {
                const int tn = (t + 1) & (TCH - 1);
                const float4 nkk = *(const float4*)(KK + tn * 64 + 4 * kg), nw = *(const float4*)(Wd + tn * 64 + 4 * kg), nb = *(const float4*)(Bv + tn * 64 + 4 * kg);
                const float4 nk = *(const float4*)(Kp + tn * 64 + 4 * kg), nr = *(const float4*)(R + tn * 64 + 4 * kg);
                const float nv = Vv[tn * VR + row];
                float sa = s0 * ckk.x + s1 * ckk.y + s2 * ckk.z + s3 * ckk.w; sa = -row16_sum(sa);
                s0 = s0 * cw.x + sa * cb.x + cv * ck.x; s1 = s1 * cw.y + sa * cb.y + cv * ck.y; s2 = s2 * cw.z + sa * cb.z + cv * ck.z; s3 = s3 * cw.w + sa * cb.w + cv * ck.w;
                float y = s0 * cr.x + s1 * cr.y + s2 * cr.z + s3 * cr.w; y = row16_sum(y);
                float* yp = (kg == 0) ? (Yb + t * VR + row) : (DUM + lane); *yp = y;
                ckk = nkk; cw = nw; cb = nb; ck = nk; cr = nr; cv = nv;
            }
        }
    }
    __syncthreads();
    { const size_t t = (size_t)b * SEQ + (SEQ / TCH - 1) * TCH + tl; *(float2*)(yraw + t * RWD + h * 64 + vs * VR + v2) = *(const float2*)(Yb + tl * VR + v2); }
}

__device__ void attn_phase(const Params& P) {
    unsigned char* ws = P.ws; const int tid = threadIdx.x, lane = tid & 63, fr = lane & 15, fq = lane >> 4;
    const u16* Qn = (const u16*)((unsigned char*)P.out + O_QN); const u16* Kn = (const u16*)(ws + WS_X + X_KN); const u16* Vt = (const u16*)(ws + WS_X + X_VT);
    u16* oatt = (u16*)(ws + WS_X + X_OATT);
    const int NA = (int)gridDim.x - NSCAN; const int gw = ((int)blockIdx.x - NSCAN) * 8 + (tid >> 6);
    for (int unit = gw; unit < 8192; unit += NA * 8) {
        const int h = unit & 15, st = (unit >> 4) & 255, b = unit >> 12, kh = h >> 2;
        const int s0 = st * 16; const size_t t0 = (size_t)b * SEQ + s0;
        const float slope = exp2f(-0.5f * (float)(h + 1)), sink = P.in[16][h];
        bf16x8 qf[2];
        qf[0] = *(const bf16x8*)(Qn + (t0 + fr) * 1024 + h * 64 + 8 * fq); qf[1] = *(const bf16x8*)(Qn + (t0 + fr) * 1024 + h * 64 + 32 + 8 * fq);
        f32x4 sc[10]; float mx = sink;
#pragma unroll
        for (int kt = 0; kt < 10; ++kt) { const int ks0 = s0 - 144 + 16 * kt; int kp = ks0 + fr; kp = kp < 0 ? 0 : kp;
            const u16* kr = Kn + ((size_t)b * SEQ + kp) * 256 + kh * 64 + 8 * fq;
            const bf16x8 k0 = *(const bf16x8*)kr, k1 = *(const bf16x8*)(kr + 32);
            f32x4 a = {0.f, 0.f, 0.f, 0.f};
            a = __builtin_amdgcn_mfma_f32_16x16x32_bf16(k0, qf[0], a, 0, 0, 0); a = __builtin_amdgcn_mfma_f32_16x16x32_bf16(k1, qf[1], a, 0, 0, 0);
#pragma unroll
            for (int j = 0; j < 4; ++j) { const int kpos = ks0 + 4 * fq + j; const int dist = s0 + fr - kpos; const bool valid = (dist >= 0) && (dist < 128) && (kpos >= 0);
                const float v = valid ? a[j] - slope * (float)dist : -1e30f; a[j] = v; mx = fmaxf(mx, v); }
            sc[kt] = a; }
        mx = fmaxf(mx, __shfl_xor(mx, 16)); mx = fmaxf(mx, __shfl_xor(mx, 32));
        float sum = 0.f;
#pragma unroll
        for (int kt = 0; kt < 10; ++kt)
#pragma unroll
            for (int j = 0; j < 4; ++j) { const float e = __expf(sc[kt][j] - mx); sc[kt][j] = e; sum += e; }
        sum += __shfl_xor(sum, 16); sum += __shfl_xor(sum, 32);
        const float inv = 1.0f / (sum + __expf(sink - mx));
        f32x4 o[4];
#pragma unroll
        for (int dt = 0; dt < 4; ++dt) o[dt] = (f32x4){0.f, 0.f, 0.f, 0.f};
#pragma unroll
        for (int u = 0; u < 5; ++u) {
            union { bf16x8 v; unsigned w[4]; } pf;
            pf.w[0] = cvt_pk_bf16(sc[2 * u][0] * inv, sc[2 * u][1] * inv); pf.w[1] = cvt_pk_bf16(sc[2 * u][2] * inv, sc[2 * u][3] * inv);
            pf.w[2] = cvt_pk_bf16(sc[2 * u + 1][0] * inv, sc[2 * u + 1][1] * inv); pf.w[3] = cvt_pk_bf16(sc[2 * u + 1][2] * inv, sc[2 * u + 1][3] * inv);
            int ka = s0 - 144 + 32 * u + 4 * fq, kb = ka + 16; ka = ka < 0 ? 0 : ka; kb = kb < 0 ? 0 : kb;
#pragma unroll
            for (int dt = 0; dt < 4; ++dt) { const u16* vr = Vt + ((size_t)(b * 4 + kh) * 64 + dt * 16 + fr) * SEQ;
                union { bf16x8 v; uint2 w[2]; } vf; vf.w[0] = *(const uint2*)(vr + ka); vf.w[1] = *(const uint2*)(vr + kb);
                o[dt] = __builtin_amdgcn_mfma_f32_16x16x32_bf16(pf.v, vf.v, o[dt], 0, 0, 0); } }
#pragma unroll
        for (int dt = 0; dt < 4; ++dt)
#pragma unroll
            for (int j = 0; j < 4; ++j) oatt[(t0 + 4 * fq + j) * 1024 + h * 64 + dt * 16 + fr] = f2bf(o[dt][j]);
    }
}

__device__ void phase5(const Params& P) {
    unsigned char* ws = P.ws; const int G = gridDim.x, bid = blockIdx.x, tid = threadIdx.x, lane = tid & 63;
    const u16* rkv = (const u16*)((unsigned char*)P.out + O_RKV); u16* orw = (u16*)((unsigned char*)P.out + O_QN);
    const float* yraw = (const float*)(ws + WS_Z + Z_TAIL); const float* ap = (const float*)(ws + WS_Z + Z_A); const u16* gp = (const u16*)(ws + WS_Z + Z_G);
    for (int t = bid * 8 + (tid >> 6); t < MT; t += G * 8) {
        float4 y4[4], a4[4]; uint2 r2[4], k2[4], v2[4], g2[4];
#pragma unroll
        for (int it = 0; it < 4; ++it) { const int hc = (it * 4 + (lane >> 4)) * 64 + (lane & 15) * 4; const size_t o = (size_t)t * RWD + hc;
            y4[it] = *(const float4*)(yraw + o); a4[it] = *(const float4*)(ap + o); g2[it] = *(const uint2*)(gp + o);
            r2[it] = *(const uint2*)(rkv + (size_t)t * 3072 + hc); k2[it] = *(const uint2*)(rkv + (size_t)t * 3072 + 1024 + hc); v2[it] = *(const uint2*)(rkv + (size_t)t * 3072 + 2048 + hc); }
#pragma unroll
        for (int it = 0; it < 4; ++it) { const int hc = (it * 4 + (lane >> 4)) * 64 + (lane & 15) * 4; const size_t o = (size_t)t * RWD + hc;
            const float4 gw = *(const float4*)(P.in[12] + hc), gb = *(const float4*)(P.in[13] + hc), ka = *(const float4*)(P.in[10] + hc), rkw = *(const float4*)(P.in[11] + hc);
            const float4 y = y4[it], a = a4[it];
            const float mu = row16_sum((y.x + y.y) + (y.z + y.w)) * (1.0f / 64.0f);
            const float dx = y.x - mu, dy = y.y - mu, dz = y.z - mu, dw = y.w - mu;
            const float var = row16_sum((dx * dx + dy * dy) + (dz * dz + dw * dw)) * (1.0f / 64.0f); const float rs = rsqrtf(var + 64e-5f);
            const float r0 = bflo(r2[it].x), r1 = bfhi(r2[it].x), r2_ = bflo(r2[it].y), r3 = bfhi(r2[it].y);
            const float k0 = bflo(k2[it].x) * (1.0f + (a.x - 1.0f) * ka.x), k1 = bfhi(k2[it].x) * (1.0f + (a.y - 1.0f) * ka.y), k2_ = bflo(k2[it].y) * (1.0f + (a.z - 1.0f) * ka.z), k3 = bfhi(k2[it].y) * (1.0f + (a.w - 1.0f) * ka.w);
            const float rk = row16_sum((r0 * k0 * rkw.x + r1 * k1 * rkw.y) + (r2_ * k2_ * rkw.z + r3 * k3 * rkw.w));
            const float o0 = (dx * rs * gw.x + gb.x + rk * bflo(v2[it].x)) * bflo(g2[it].x), o1 = (dy * rs * gw.y + gb.y + rk * bfhi(v2[it].x)) * bfhi(g2[it].x);
            const float o2 = (dz * rs * gw.z + gb.z + rk * bflo(v2[it].y)) * bflo(g2[it].y), o3 = (dw * rs * gw.w + gb.w + rk * bfhi(v2[it].y)) * bfhi(g2[it].y);
            uint2 w; w.x = cvt_pk_bf16(o0, o1); w.y = cvt_pk_bf16(o2, o3); *(uint2*)(orw + o) = w; }
    }
}

__device__ void phase9(const Params& P) {
    unsigned char* ws = P.ws; const u16* uu = (const u16*)(ws + WS_Z); u16* act = (u16*)(ws + WS_ACT);
    const float* cw = P.in[21]; const float* cb = P.in[22];
    const int nth = gridDim.x * 512;
    for (int task = blockIdx.x * 512 + threadIdx.x; task < 1024 * 1408; task += nth) {
        const int j0 = (task % 1408) * 4, t0 = (task / 1408) * 8; const bool first = (t0 & (SEQ - 1)) == 0;
        uint2 ra[10], rg[10];
#pragma unroll
        for (int r = 0; r < 10; ++r) { const int t = (first && r < 2) ? t0 : t0 - 2 + r; ra[r] = *(const uint2*)(uu + (size_t)t * NUP + j0); rg[r] = *(const uint2*)(uu + (size_t)t * NUP + DFF + j0); }
        if (first) { ra[0] = make_uint2(0u, 0u); ra[1] = ra[0]; rg[0] = ra[0]; rg[1] = ra[0]; }
        const float4 wa0 = *(const float4*)(cw + j0), wa1 = *(const float4*)(cw + NUP + j0), wa2 = *(const float4*)(cw + 2 * NUP + j0), ba = *(const float4*)(cb + j0);
        const float4 wg0 = *(const float4*)(cw + DFF + j0), wg1 = *(const float4*)(cw + NUP + DFF + j0), wg2 = *(const float4*)(cw + 2 * NUP + DFF + j0), bg = *(const float4*)(cb + DFF + j0);
#pragma unroll
        for (int i = 0; i < 8; ++i) {
            const float cv0 = bflo(ra[i].x) * wa0.x + bflo(ra[i + 1].x) * wa1.x + bflo(ra[i + 2].x) * wa2.x + ba.x, cv1 = bfhi(ra[i].x) * wa0.y + bfhi(ra[i + 1].x) * wa1.y + bfhi(ra[i + 2].x) * wa2.y + ba.y;
            const float cv2 = bflo(ra[i].y) * wa0.z + bflo(ra[i + 1].y) * wa1.z + bflo(ra[i + 2].y) * wa2.z + ba.z, cv3 = bfhi(ra[i].y) * wa0.w + bfhi(ra[i + 1].y) * wa1.w + bfhi(ra[i + 2].y) * wa2.w + ba.w;
            const float cg0 = bflo(rg[i].x) * wg0.x + bflo(rg[i + 1].x) * wg1.x + bflo(rg[i + 2].x) * wg2.x + bg.x, cg1 = bfhi(rg[i].x) * wg0.y + bfhi(rg[i + 1].x) * wg1.y + bfhi(rg[i + 2].x) * wg2.y + bg.y;
            const float cg2 = bflo(rg[i].y) * wg0.z + bflo(rg[i + 1].y) * wg1.z + bflo(rg[i + 2].y) * wg2.z + bg.z, cg3 = bfhi(rg[i].y) * wg0.w + bfhi(rg[i + 1].y) * wg1.w + bfhi(rg[i + 2].y) * wg2.w + bg.w;
            uint2 w; w.x = cvt_pk_bf16(cg0 * sigmoidf_(cg0) * cv0, cg1 * sigmoidf_(cg1) * cv1); w.y = cvt_pk_bf16(cg2 * sigmoidf_(cg2) * cv2, cg3 * sigmoidf_(cg3) * cv3);
            *(uint2*)(act + (size_t)(t0 + i) * DFF + j0) = w; }
    }
}

constexpr int NPH = 11;
__global__ void __launch_bounds__(512, 2) mega(Params P) {
    extern __shared__ __attribute__((aligned(16))) unsigned char lds_raw[];
    cg::grid_group grid = cg::this_grid();
    LAS unsigned char* lds = (LAS unsigned char*)lds_raw;
    unsigned char* ws = P.ws;
#define RUN(i) ((i) >= P.ph_lo && (i) < P.ph_hi)
#define SEAM(i) do { if ((i) >= P.ph_lo && (i) + 1 < P.ph_hi) grid.sync(); } while (0)
    if (RUN(0)) phase0(P, (float*)lds_raw);
    SEAM(0);
    if (RUN(1)) { EpiZ E; E.zmain = (u16*)(ws + WS_Z + Z_MAIN); E.zgate = (u16*)(ws + WS_Z + Z_GATE); E.rstd = (const float*)(ws + WS_SMALL);
        run_gemm(lds, (const u16*)(ws + WS_X), (const u16*)(ws + WS_WIN), NZ, 2048, E); }
    SEAM(1);
    if (RUN(2)) phase2(P, (u16*)lds_raw);
    SEAM(2);
    if (RUN(3)) { EpiLora E; E.lw = (float*)(ws + WS_Z + Z_LW); E.av = (float*)(ws + WS_Z + Z_A); E.g = (u16*)(ws + WS_Z + Z_G); E.w0 = P.in[4]; E.a0 = P.in[6];
        run_gemm(lds, (const u16*)(ws + WS_X + X_AP), (const u16*)(ws + WS_WLORA), 3072, 512, E); }
    SEAM(3);
    if (RUN(4)) { if ((int)blockIdx.x < NSCAN) scan_phase(P, (float*)lds_raw);
        else { attn_phase(P); __syncthreads(); for (int id = WT_IN + ((int)blockIdx.x - NSCAN); id < WT_ALL; id += (int)gridDim.x - NSCAN) weight_tile(P, id, (float*)lds_raw); } }
    SEAM(4);
    if (RUN(5)) phase5(P);
    SEAM(5);
    if (RUN(6)) {
        { EpiBranch<0> E; E.mixed = (u16*)(ws + WS_Z); E.zgate = (const u16*)(ws + WS_Z + Z_GATE);
          run_gemm(lds, (const u16*)((unsigned char*)P.out + O_QN), (const u16*)(ws + WS_WBR1), 2048, 1024, E); }
        { EpiBranch<1> E; E.mixed = (u16*)(ws + WS_Z); E.zgate = (const u16*)(ws + WS_Z + Z_GATE);
          run_gemm(lds, (const u16*)(ws + WS_X + X_OATT), (const u16*)(ws + WS_WBR2), 2048, 1024, E); } }
    SEAM(6);
    if (RUN(7)) { EpiOut1 E; E.x = P.in[0]; E.x1 = P.out; E.x1b = (u16*)(ws + WS_X); E.rowss = (float*)(ws + WS_SMALL + 32768);
        run_gemm(lds, (const u16*)(ws + WS_Z), (const u16*)(ws + WS_WOUT), 2048, 2048, E); }
    SEAM(7);
    if (RUN(8)) { EpiUp E; E.uo = (u16*)(ws + WS_Z); E.rowss = (const float*)(ws + WS_SMALL + 32768);
        run_gemm(lds, (const u16*)(ws + WS_X), (const u16*)(ws + WS_WUP), NUP, 2048, E); }
    SEAM(8);
    if (RUN(9)) phase9(P);
    SEAM(9);
    if (RUN(10)) { EpiFinal E; E.out = P.out;
        run_gemm(lds, (const u16*)(ws + WS_ACT), (const u16*)(ws + WS_WDOWN), 2048, DFF, E); }
}

constexpr int LDS_BYTES = 131072;
extern "C" void kernel_launch(void* const* d_in, const int* in_sizes, int n_in, void* d_out, int out_size, void* d_ws, size_t ws_size, hipStream_t stream) {
    static int grid = 0;
    if (grid == 0) {
        if (n_in != 24 || out_size != MT * DM || ws_size < WS_END) { fprintf(stderr, "kernel_launch: unexpected shapes (n_in %d out %d ws %zu need %zu)\n", n_in, out_size, ws_size, (size_t)WS_END); grid = -1; return; }
        int dev = 0, cus = 0, per_cu = 0;
        hipGetDevice(&dev); hipDeviceGetAttribute(&cus, hipDeviceAttributeMultiprocessorCount, dev);
        if (hipFuncSetAttribute((const void*)mega, hipFuncAttributeMaxDynamicSharedMemorySize, LDS_BYTES) != hipSuccess) { fprintf(stderr, "kernel_launch: hipFuncSetAttribute failed\n"); grid = -1; return; }
        if (hipOccupancyMaxActiveBlocksPerMultiprocessor(&per_cu, (const void*)mega, 512, LDS_BYTES) != hipSuccess || per_cu < 1) { fprintf(stderr, "kernel_launch: occupancy query failed (%d)\n", per_cu); grid = -1; return; }
        grid = cus * per_cu; if (grid > 256) grid = 256;
        if (grid < 2 * NSCAN) { fprintf(stderr, "kernel_launch: grid %d too small\n", grid); grid = -1; return; }
    }
    if (grid < 0) return;
    Params p{};
    for (int i = 0; i < 24; ++i) p.in[i] = (const float*)d_in[i];
    p.out = (float*)d_out; p.ws = (unsigned char*)d_ws;
#ifndef SPLIT_LAUNCH
    p.ph_lo = 0; p.ph_hi = NPH;
    { void* args[] = {&p}; hipError_t e = hipLaunchCooperativeKernel((const void*)mega, dim3(grid), dim3(512), args, LDS_BYTES, stream);
      if (e != hipSuccess) fprintf(stderr, "cooperative launch failed: %s (grid %d)\n", hipGetErrorString(e), grid); }
#else
    for (int ph = 0; ph < NPH; ++ph) { p.ph_lo = ph; p.ph_hi = ph + 1; void* args[] = {&p};
        hipError_t e = hipLaunchCooperativeKernel((const void*)mega, dim3(grid), dim3(512), args, LDS_BYTES, stream);
        if (e != hipSuccess) fprintf(stderr, "cooperative launch failed: %s (grid %d)\n", hipGetErrorString(e), grid); }
#endif
}
```

```cpp
#include <hip/hip_runtime.h>
#include <hip/hip_cooperative_groups.h>
#include <cstdio>
#include <cstdint>
namespace cg = cooperative_groups;
namespace pg8 {
#define PG8_LAS __attribute__((address_space(3)))
typedef unsigned short bf16_t;
typedef short bf16x8 __attribute__((ext_vector_type(8)));
typedef float f32x4 __attribute__((ext_vector_type(4)));
typedef unsigned u32x4 __attribute__((ext_vector_type(4)));
constexpr int BM = 256, BK = 64, HALF = 128, HTB = HALF * BK * 2  , STAGE_BYTES = 8 * HTB, NXCD = 8, WGM = 8;

__host__ __device__ __forceinline__ int lds_byte(int r, int c) { const int st = (r >> 4) * 2 + (c >> 5), rr = r & 15, cc = c & 31, ob = rr * 64 + cc * 2; return st * 1024 + (ob ^ (((ob >> 9) & 1) << 5)); }
__host__ __device__ __forceinline__ void stage_rc(int b, int& R, int& C) { const int st = b / 1024, sb = b % 1024, swz = sb ^ (((sb >> 9) & 1) << 5); R = (st >> 1) * 16 + swz / 64; C = (st & 1) * 32 + (swz % 64) / 2; }
__host__ __device__ __forceinline__ int perm32(int rho) { const int n = rho >> 4, i = rho & 15; return 8 * (i >> 2) + 4 * n + (i & 3); }

struct Unit { int pm, pn; };
struct Gemm { const bf16_t* A; const bf16_t* Bt; int M, N, K; };

struct StaticOrder {
    int nM, nN, nwg, G, c;
    __host__ __device__ void init(int M, int N, int G_, int c_) { nM = M / BM; nN = N / BM; nwg = nM * nN; G = G_; c = c_; }
    __host__ __device__ bool next(int i, Unit& u) const {
        const long L = (long)i * G + c; if (L >= nwg) return false;
        int wgid = (int)L; { const int q = nwg / NXCD, r = nwg % NXCD, xcd = wgid % NXCD, off = wgid / NXCD; wgid = (xcd < r ? xcd * (q + 1) : r * (q + 1) + (xcd - r) * q) + off; }
        const int nig = WGM * nN, gid = wgid / nig, fm = gid * WGM, gsz = (nM - fm) < WGM ? (nM - fm) : WGM;
        u.pm = fm + ((wgid % nig) % gsz); u.pn = (wgid % nig) / gsz; return true;
    }
    __device__ __forceinline__ void a_ready(const Unit&) const {}
    __device__ __forceinline__ void done(const Unit&) const {}
};
typedef __bf16 bf16v2_t __attribute__((ext_vector_type(2))); typedef float f32v2_t __attribute__((ext_vector_type(2)));
__device__ __forceinline__ unsigned cvt_pk_bf16(float lo, float hi) { const f32v2_t x = {lo, hi}; const bf16v2_t r = __builtin_convertvector(x, bf16v2_t); return __builtin_bit_cast(unsigned, r); }
template <class Epi, class Sched>
__device__ __forceinline__ void gemm_phase(PG8_LAS unsigned char* lds, const Gemm g, const Sched& S, const Epi& E) {
    const int tid = threadIdx.x, wid = __builtin_amdgcn_readfirstlane(tid >> 6), lane = tid & 63, wr = wid >> 2, wc = wid & 3, fr = lane & 15, fq = lane >> 4;
    const int K = g.K, nt = K / BK;
    unsigned voffA[2], voffB[2];
#pragma unroll
    for (int i = 0; i < 2; ++i) { int R, C; stage_rc(tid * 16 + i * 8192, R, C); const int Rb = Epi::PERM ? ((R & ~31) + perm32(R & 31)) : R;
        voffA[i] = (unsigned)(R * K + C) * 2u; voffB[i] = (unsigned)(Rb * K + C) * 2u; }
    const size_t kstep = (size_t)(BK * 2);
    const size_t hstep = (size_t)HALF * K * 2;
    const size_t tstep = 2 * hstep;
    const unsigned ldsw = (unsigned)wid * 1024u;
    const int aoff = lds_byte(wr * 64 + fr, fq * 8), boff = lds_byte(wc * 32 + fr, fq * 8);
#define PG8_SA(b, h) (((b) * 2 + (h)) * HTB)
#define PG8_SB(b, h) ((4 + (b) * 2 + (h)) * HTB)
#define PG8_STAGE(bufoff, gbase, voff) do { _Pragma("unroll") for (int _i = 0; _i < 2; ++_i) \
        __builtin_amdgcn_global_load_lds((const unsigned*)((const char*)(gbase) + (voff)[_i]), (PG8_LAS unsigned*)(lds + (bufoff) + ldsw + _i * 8192), 16, 0, 0); } while (0)
#define PG8_LDA(dst, b, h) do { _Pragma("unroll") for (int m = 0; m < 4; ++m) _Pragma("unroll") for (int k = 0; k < 2; ++k) dst[m][k] = *(const PG8_LAS bf16x8*)(lds + PG8_SA(b, h) + aoff + m * 2048 + k * 1024); } while (0)
#define PG8_LDB(dst, b, h) do { _Pragma("unroll") for (int n = 0; n < 2; ++n) _Pragma("unroll") for (int k = 0; k < 2; ++k) dst[n][k] = *(const PG8_LAS bf16x8*)(lds + PG8_SB(b, h) + boff + n * 2048 + k * 1024); } while (0)
#define PG8_MMA(ai, bj, At, Bt) do { __builtin_amdgcn_s_setprio(1); _Pragma("unroll") for (int m = 0; m < 4; ++m) _Pragma("unroll") for (int n = 0; n < 2; ++n) _Pragma("unroll") for (int k = 0; k < 2; ++k) \
        acc[ai][bj][m][n] = __builtin_amdgcn_mfma_f32_16x16x32_bf16(Bt[n][k], At[m][k], acc[ai][bj][m][n], 0, 0, 0); __builtin_amdgcn_s_setprio(0); } while (0)
#define PG8_WAIT_V(n) asm volatile("s_waitcnt vmcnt(" #n ")" ::: "memory")
#define PG8_WAIT_L(n) asm volatile("s_waitcnt lgkmcnt(" #n ")" ::: "memory")
#define PG8_BAR __builtin_amdgcn_s_barrier()
#define PG8_SCHED __builtin_amdgcn_sched_barrier(0)
    Unit cur, nxt; int ui = 0;
    if (!S.next(0, cur)) return;
    f32x4 acc[2][2][4][2];
#pragma unroll
    for (int a = 0; a < 2; ++a)
#pragma unroll
        for (int b = 0; b < 2; ++b)
#pragma unroll
            for (int m = 0; m < 4; ++m)
#pragma unroll
                for (int n = 0; n < 2; ++n) acc[a][b][m][n] = (f32x4){0.f, 0.f, 0.f, 0.f};
    bf16x8 At[4][2], B0[2][2], B1[2][2];
    const char* cA = (const char*)g.A + (size_t)cur.pm * tstep; const char* cB = (const char*)g.Bt + (size_t)cur.pn * tstep;
    S.a_ready(cur);
    PG8_STAGE(PG8_SB(0, 0), cB, voffB); PG8_STAGE(PG8_SA(0, 0), cA, voffA); PG8_STAGE(PG8_SB(0, 1), cB + hstep, voffB); PG8_STAGE(PG8_SA(0, 1), cA + hstep, voffA);
    if (wr == 1) PG8_BAR;
    PG8_WAIT_V(4); PG8_BAR;
    PG8_STAGE(PG8_SB(1, 0), cB + kstep, voffB); PG8_STAGE(PG8_SA(1, 0), cA + kstep, voffA); PG8_STAGE(PG8_SB(1, 1), cB + hstep + kstep, voffB);
    PG8_WAIT_V(6); PG8_BAR;
    for (;;) {
        const bool has_next = S.next(ui + 1, nxt);
        const char* nA = has_next ? (const char*)g.A + (size_t)nxt.pm * tstep : cA; const char* nB = has_next ? (const char*)g.Bt + (size_t)nxt.pn * tstep : cB;
        for (int t = 0; t < nt; t += 2) {
            const bool last = (t == nt - 2);
            const char* a1 = cA + (size_t)(t + 1) * kstep;
            const char* a2 = last ? nA : cA + (size_t)(t + 2) * kstep; const char* b2 = last ? nB : cB + (size_t)(t + 2) * kstep;
            const char* a3 = a2 + kstep; const char* b3 = b2 + kstep;
            if (last && has_next) S.a_ready(nxt);
            PG8_LDB(B0, 0, 0); PG8_SCHED; PG8_LDA(At, 0, 0); PG8_STAGE(PG8_SA(1, 1), a1 + hstep, voffA);
            PG8_WAIT_L(8); PG8_BAR; PG8_WAIT_L(0); PG8_MMA(0, 0, At, B0); PG8_BAR; PG8_SCHED;
            PG8_LDB(B1, 0, 1); PG8_STAGE(PG8_SB(0, 0), b2, voffB);
            PG8_BAR; PG8_WAIT_L(0); PG8_MMA(0, 1, At, B1); PG8_BAR;
            PG8_LDA(At, 0, 1); PG8_STAGE(PG8_SA(0, 0), a2, voffA);
            PG8_BAR; PG8_WAIT_L(0); PG8_MMA(1, 0, At, B0); PG8_BAR; PG8_SCHED;
            PG8_STAGE(PG8_SB(0, 1), b2 + hstep, voffB);
            PG8_WAIT_V(6); PG8_BAR; PG8_MMA(1, 1, At, B1); PG8_BAR;
            PG8_LDB(B0, 1, 0); PG8_SCHED; PG8_LDA(At, 1, 0); PG8_STAGE(PG8_SA(0, 1), a2 + hstep, voffA);
            PG8_WAIT_L(8); PG8_BAR; PG8_WAIT_L(0); PG8_MMA(0, 0, At, B0); PG8_BAR; PG8_SCHED;
            PG8_LDB(B1, 1, 1); PG8_STAGE(PG8_SB(1, 0), b3, voffB);
            PG8_BAR; PG8_WAIT_L(0); PG8_MMA(0, 1, At, B1); PG8_BAR;
            PG8_LDA(At, 1, 1); PG8_STAGE(PG8_SA(1, 0), a3, voffA);
            PG8_BAR; PG8_WAIT_L(0); PG8_MMA(1, 0, At, B0); PG8_BAR; PG8_SCHED;
            PG8_STAGE(PG8_SB(1, 1), b3 + hstep, voffB);
            PG8_WAIT_V(6); PG8_BAR; PG8_MMA(1, 1, At, B1); PG8_BAR;
        }
        if constexpr (!Epi::AFTER_DRAIN) { E(acc, cur, wr, wc, fr, fq); S.done(cur); }
        if (!has_next) break;
#pragma unroll
        for (int a = 0; a < 2; ++a)
#pragma unroll
            for (int b = 0; b < 2; ++b)
#pragma unroll
                for (int m = 0; m < 4; ++m)
#pragma unroll
                    for (int n = 0; n < 2; ++n) acc[a][b][m][n] = (f32x4){0.f, 0.f, 0.f, 0.f};
        cur = nxt; cA = nA; cB = nB; ++ui;
    }
    PG8_WAIT_V(0);
    if (wr == 0) PG8_BAR;
    PG8_BAR;
    if constexpr (Epi::AFTER_DRAIN) { E.fused(acc, cur, wr, wc, fr, fq, lds, wid, lane); S.done(cur); }
#undef PG8_SA
#undef PG8_SB
#undef PG8_STAGE
#undef PG8_LDA
#undef PG8_LDB
#undef PG8_MMA
#undef PG8_WAIT_V
#undef PG8_WAIT_L
#undef PG8_BAR
#undef PG8_SCHED
}
}

using pg8::f32x4; using pg8::bf16x8; using pg8::Unit; using pg8::cvt_pk_bf16;
typedef unsigned short u16;
#define LAS __attribute__((address_space(3)))

constexpr int MT = 8192, DM = 2048, SEQ = 4096;
constexpr int NZ = 9216, ZM = 5120, ZG = 4096, DFF = 5632, NUP = 11264, RWD = 1024;
constexpr size_t WS_WDOWN = 0;
constexpr size_t WS_WIN   = WS_WDOWN + (size_t)2048 * 5632 * 2;
constexpr size_t WS_WUP   = WS_WIN + (size_t)9216 * 2048 * 2;
constexpr size_t WS_WBR1  = WS_WUP + (size_t)11264 * 2048 * 2;
constexpr size_t WS_WBR2  = WS_WBR1 + (size_t)2048 * 1024 * 2;
constexpr size_t WS_WOUT  = WS_WBR2 + (size_t)2048 * 1024 * 2;
constexpr size_t WS_WLORA = WS_WOUT + (size_t)2048 * 2048 * 2;
constexpr size_t WS_Z     = WS_WLORA + (size_t)3072 * 512 * 2;
constexpr size_t Z_BYTES  = (size_t)MT * NUP * 2;
constexpr size_t WS_X     = WS_Z + Z_BYTES;
constexpr size_t WS_SMALL = WS_X + (size_t)MT * DM * 2;
constexpr size_t WS_Y     = WS_SMALL + 32768 + (size_t)MT * 32 * 4;
constexpr size_t WS_END   = WS_Y + (size_t)MT * 1024 * 2;
constexpr size_t WS_ACT   = WS_WIN;
static_assert(WS_Z - WS_WIN >= (size_t)MT * DFF * 2, "act overlay");
constexpr size_t Z_MAIN = 0, Z_GATE = (size_t)MT * ZM * 2, Z_TAIL = (size_t)MT * (ZM + ZG) * 2;
constexpr size_t Z_LW = 0, Z_A = (size_t)MT * RWD * 4, Z_G = 2 * (size_t)MT * RWD * 4;
constexpr size_t X_AP = 0, X_KN = (size_t)MT * 512 * 2, X_VT = X_KN + (size_t)MT * 256 * 2, X_OATT = X_VT + (size_t)MT * 256 * 2;
constexpr size_t O_RKV = 0, O_QN = (size_t)MT * 3072 * 2;

struct Params { const float* in[24]; float* out; unsigned char* ws; int ph_lo, ph_hi; };

__device__ __forceinline__ float bf2f(unsigned short b) { return __uint_as_float(((unsigned)b) << 16); }
__device__ __forceinline__ float bflo(unsigned u) { return __uint_as_float(u << 16); }
__device__ __forceinline__ float bfhi(unsigned u) { return __uint_as_float(u & 0xffff0000u); }
__device__ __forceinline__ u16 f2bf(float f) { return (u16)(cvt_pk_bf16(f, f) & 0xffffu); }
__device__ __forceinline__ float wave_sum(float v) {
#pragma unroll
    for (int o = 32; o; o >>= 1) v += __shfl_xor(v, o);
    return v; }
__device__ __forceinline__ float sigmoidf_(float x) { return 1.0f / (1.0f + __expf(-x)); }
template <int CTRL> __device__ __forceinline__ float dppf(float x) { return __int_as_float(__builtin_amdgcn_update_dpp(0, __float_as_int(x), CTRL, 0xF, 0xF, true)); }
__device__ __forceinline__ float row16_sum(float x) { x += dppf<0xB1>(x); x += dppf<0x4E>(x); x += dppf<0x141>(x); x += dppf<0x140>(x); return x; }

#define EPI_ROWS _Pragma("unroll") for (int ai = 0; ai < 2; ++ai) _Pragma("unroll") for (int m = 0; m < 4; ++m)
#define EPI_COLS _Pragma("unroll") for (int bj = 0; bj < 2; ++bj) _Pragma("unroll") for (int n = 0; n < 2; ++n)
struct EpiZ {
    static constexpr bool PERM = false, AFTER_DRAIN = false;
    u16* zmain; u16* zgate; const float* rstd;
    __device__ __forceinline__ void operator()(const f32x4 (&acc)[2][2][4][2], const Unit& u, int wr, int wc, int fr, int fq) const {
        u16* base; int ld, c0;
        if (u.pn < 20) { base = zmain; ld = ZM; c0 = u.pn * 256; } else { base = zgate; ld = ZG; c0 = (u.pn - 20) * 256; }
        const int row0 = u.pm * 256 + wr * 64 + fr; c0 += wc * 32 + 4 * fq;
        EPI_ROWS { const int row = row0 + ai * 128 + m * 16; const float rs = rstd[row]; u16* rp = base + (size_t)row * ld + c0;
            EPI_COLS { const f32x4 v = acc[ai][bj][m][n] * rs; uint2 w; w.x = cvt_pk_bf16(v[0], v[1]); w.y = cvt_pk_bf16(v[2], v[3]); *(uint2*)(rp + bj * 128 + n * 16) = w; } }
    }
};
struct EpiLora {
    static constexpr bool PERM = false, AFTER_DRAIN = false;
    float* lw; float* av; u16* g; const float* w0; const float* a0;
    __device__ __forceinline__ void operator()(const f32x4 (&acc)[2][2][4][2], const Unit& u, int wr, int wc, int fr, int fq) const {
        const int row0 = u.pm * 256 + wr * 64 + fr; const int kind = u.pn >> 2; const int c0 = (u.pn & 3) * 256 + wc * 32 + 4 * fq;
        if (kind == 0) {
            EPI_ROWS { const int row = row0 + ai * 128 + m * 16;
                EPI_COLS { const int col = c0 + bj * 128 + n * 16; const f32x4 v = acc[ai][bj][m][n]; const f32x4 b = *(const f32x4*)(w0 + col); f32x4 o;
#pragma unroll
                    for (int j = 0; j < 4; ++j) { const float y = -(b[j] + v[j]); const float sp = fmaxf(y, 0.f) + __logf(1.0f + __expf(-fabsf(y))); o[j] = -__expf(-sp - 0.5f); }
                    *(f32x4*)(lw + (size_t)row * RWD + col) = o; } }
        } else if (kind == 1) {
            EPI_ROWS { const int row = row0 + ai * 128 + m * 16;
                EPI_COLS { const int col = c0 + bj * 128 + n * 16; const f32x4 v = acc[ai][bj][m][n]; const f32x4 b = *(const f32x4*)(a0 + col); f32x4 o;
#pragma unroll
                    for (int j = 0; j < 4; ++j) o[j] = sigmoidf_(b[j] + v[j]);
                    *(f32x4*)(av + (size_t)row * RWD + col) = o; } }
        } else {
            EPI_ROWS { const int row = row0 + ai * 128 + m * 16;
                EPI_COLS { const int col = c0 + bj * 128 + n * 16; const f32x4 v = acc[ai][bj][m][n];
                    uint2 w; w.x = cvt_pk_bf16(v[0], v[1]); w.y = cvt_pk_bf16(v[2], v[3]); *(uint2*)(g + (size_t)row * RWD + col) = w; } }
        }
    }
};
template <int PASS> struct EpiBranch {
    static constexpr bool PERM = false, AFTER_DRAIN = false;
    u16* mixed; const u16* zgate;
    __device__ __forceinline__ void operator()(const f32x4 (&acc)[2][2][4][2], const Unit& u, int wr, int wc, int fr, int fq) const {
        const int row0 = u.pm * 256 + wr * 64 + fr; const int c0 = u.pn * 256 + wc * 32 + 4 * fq;
        EPI_ROWS { const int row = row0 + ai * 128 + m * 16;
            EPI_COLS { const int col = c0 + bj * 128 + n * 16; const f32x4 v = acc[ai][bj][m][n];
                const uint2 gz = *(const uint2*)(zgate + (size_t)row * ZG + PASS * 2048 + col);
                f32x4 o; o[0] = sigmoidf_(bflo(gz.x)) * v[0]; o[1] = sigmoidf_(bfhi(gz.x)) * v[1]; o[2] = sigmoidf_(bflo(gz.y)) * v[2]; o[3] = sigmoidf_(bfhi(gz.y)) * v[3];
                uint2* mp = (uint2*)(mixed + (size_t)row * DM + col);
                if (PASS == 1) { const uint2 pm = *mp; o[0] += bflo(pm.x); o[1] += bfhi(pm.x); o[2] += bflo(pm.y); o[3] += bfhi(pm.y); }
                uint2 w; w.x = cvt_pk_bf16(o[0], o[1]); w.y = cvt_pk_bf16(o[2], o[3]); *mp = w; } }
    }
};
struct EpiOut1 {
    static constexpr bool PERM = false, AFTER_DRAIN = false;
    const float* x; float* x1; u16* x1b; float* rowss;
    __device__ __forceinline__ void operator()(const f32x4 (&acc)[2][2][4][2], const Unit& u, int wr, int wc, int fr, int fq) const {
        const int row0 = u.pm * 256 + wr * 64 + fr; const int c0 = u.pn * 256 + wc * 32 + 4 * fq;
        EPI_ROWS { const int row = row0 + ai * 128 + m * 16; float ss = 0.f;
            EPI_COLS { const int col = c0 + bj * 128 + n * 16; const size_t o = (size_t)row * DM + col;
                const f32x4 v = acc[ai][bj][m][n] + *(const f32x4*)(x + o);
                *(f32x4*)(x1 + o) = v; ss += v[0] * v[0] + v[1] * v[1] + v[2] * v[2] + v[3] * v[3];
                uint2 w; w.x = cvt_pk_bf16(v[0], v[1]); w.y = cvt_pk_bf16(v[2], v[3]); *(uint2*)(x1b + o) = w; }
            ss += __shfl_xor(ss, 16); ss += __shfl_xor(ss, 32);
            if (fq == 0) rowss[(size_t)row * 32 + u.pn * 4 + wc] = ss; }
    }
};
struct EpiUp {
    static constexpr bool PERM = false, AFTER_DRAIN = false;
    u16* uo; const float* rowss;
    __device__ __forceinline__ void operator()(const f32x4 (&acc)[2][2][4][2], const Unit& u, int wr, int wc, int fr, int fq) const {
        const int row0 = u.pm * 256 + wr * 64 + fr; const int c0 = u.pn * 256 + wc * 32 + 4 * fq;
        EPI_ROWS { const int row = row0 + ai * 128 + m * 16;
            const f32x4 p0 = *(const f32x4*)(rowss + (size_t)row * 32 + fq * 8), p1 = *(const f32x4*)(rowss + (size_t)row * 32 + fq * 8 + 4);
            float ss = ((p0[0] + p0[1]) + (p0[2] + p0[3])) + ((p1[0] + p1[1]) + (p1[2] + p1[3]));
            ss += __shfl_xor(ss, 16); ss += __shfl_xor(ss, 32);
            const float rs = rsqrtf(ss * (1.0f / 2048.0f) + 1e-6f); u16* rp = uo + (size_t)row * NUP + c0;
            EPI_COLS { const f32x4 v = acc[ai][bj][m][n] * rs; uint2 w; w.x = cvt_pk_bf16(v[0], v[1]); w.y = cvt_pk_bf16(v[2], v[3]); *(uint2*)(rp + bj * 128 + n * 16) = w; } }
    }
};
struct EpiFinal {
    static constexpr bool PERM = false, AFTER_DRAIN = false;
    float* out;
    __device__ __forceinline__ void operator()(const f32x4 (&acc)[2][2][4][2], const Unit& u, int wr, int wc, int fr, int fq) const {
        const int row0 = u.pm * 256 + wr * 64 + fr; const int c0 = u.pn * 256 + wc * 32 + 4 * fq;
        EPI_ROWS { const int row = row0 + ai * 128 + m * 16;
            EPI_COLS { float* op = out + (size_t)row * DM + c0 + bj * 128 + n * 16; *(f32x4*)op = *(const f32x4*)op + acc[ai][bj][m][n]; } }
    }
};

template <class Epi> __device__ __forceinline__ void run_gemm(LAS unsigned char* lds, const u16* A, const u16* Bt, int N, int K, const Epi& E) {
    pg8::Gemm g; g.A = A; g.Bt = Bt; g.M = MT; g.N = N; g.K = K;
    pg8::StaticOrder S; S.init(MT, N, (int)gridDim.x, (int)blockIdx.x);
    pg8::gemm_phase<Epi, pg8::StaticOrder>(lds, g, S, E);
}

template <class Epi> __device__ __forceinline__ void run_gemm_sub(LAS unsigned char* lds, const u16* A, const u16* Bt, int N, int K, const Epi& E, int G, int c) {
    pg8::Gemm g; g.A = A; g.Bt = Bt; g.M = MT; g.N = N; g.K = K;
    pg8::StaticOrder S; S.init(MT, N, G, c);
    pg8::gemm_phase<Epi, pg8::StaticOrder>(lds, g, S, E);
}
struct EpiZG {
    static constexpr bool PERM = false, AFTER_DRAIN = false;
    u16* zgate; const float* rstd;
    __device__ __forceinline__ void operator()(const f32x4 (&acc)[2][2][4][2], const Unit& u, int wr, int wc, int fr, int fq) const {
        const int row0 = u.pm * 256 + wr * 64 + fr; const int c0 = 1024 + u.pn * 256 + wc * 32 + 4 * fq;
        EPI_ROWS { const int row = row0 + ai * 128 + m * 16; const float rs = rstd[row]; u16* rp = zgate + (size_t)row * ZG + c0;
            EPI_COLS { const f32x4 v = acc[ai][bj][m][n] * rs; uint2 w; w.x = cvt_pk_bf16(v[0], v[1]); w.y = cvt_pk_bf16(v[2], v[3]); *(uint2*)(rp + bj * 128 + n * 16) = w; } }
    }
};

__device__ __forceinline__ void tr_tile(const float* __restrict__ src, int ldn, int nsrc0, u16* __restrict__ dst, int K, int k0, int ndst0, const float* __restrict__ scale, float* tile) {
    const int tid = threadIdx.x, nc4 = (tid & 15) * 4, kr0 = tid >> 4;
    float4 v[8];
#pragma unroll
    for (int i = 0; i < 8; ++i) { const int kr = kr0 + 32 * i; v[i] = make_float4(0.f, 0.f, 0.f, 0.f);
        if (nsrc0 >= 0) v[i] = *(const float4*)(src + (size_t)(k0 + kr) * ldn + nsrc0 + nc4); }
#pragma unroll
    for (int i = 0; i < 8; ++i) { const int kr = kr0 + 32 * i; const float sc = scale ? scale[k0 + kr] : 1.0f; float* tp = tile + kr * 65 + nc4;
        tp[0] = v[i].x * sc; tp[1] = v[i].y * sc; tp[2] = v[i].z * sc; tp[3] = v[i].w * sc; }
    __syncthreads();
    const int nr = tid >> 3, kb = (tid & 7) * 8;
#pragma unroll
    for (int q = 0; q < 4; ++q) { const int kc = kb + 64 * q; uint4 w;
        w.x = cvt_pk_bf16(tile[(kc + 0) * 65 + nr], tile[(kc + 1) * 65 + nr]); w.y = cvt_pk_bf16(tile[(kc + 2) * 65 + nr], tile[(kc + 3) * 65 + nr]);
        w.z = cvt_pk_bf16(tile[(kc + 4) * 65 + nr], tile[(kc + 5) * 65 + nr]); w.w = cvt_pk_bf16(tile[(kc + 6) * 65 + nr], tile[(kc + 7) * 65 + nr]);
        *(uint4*)(dst + (size_t)(ndst0 + nr) * K + k0 + kc) = w; }
    __syncthreads();
}
constexpr int WT_IN = 1152, WT_ALL = 3776;
__device__ __forceinline__ void weight_tile(const Params& P, int id, float* tile) {
    unsigned char* ws = P.ws;
    if (id < 1152) { const int nt = id % 144, kt = id / 144; const int ns = nt < 55 ? nt * 64 : (nt == 55 ? -1 : nt * 64 - 64);
        tr_tile(P.in[2], 9152, ns, (u16*)(ws + WS_WIN), 2048, kt * 256, nt * 64, P.in[1], tile); }
    else if (id < 1152 + 1408) { const int j = id - 1152, nt = j % 176, kt = j / 176;
        tr_tile(P.in[20], NUP, nt * 64, (u16*)(ws + WS_WUP), 2048, kt * 256, nt * 64, P.in[19], tile); }
    else if (id < 2560 + 704) { const int j = id - 2560, nt = j % 32, kt = j / 32;
        tr_tile(P.in[23], 2048, nt * 64, (u16*)(ws + WS_WDOWN), 5632, kt * 256, nt * 64, nullptr, tile); }
    else if (id < 3264 + 128) { const int j = id - 3264, nt = j % 32, kt = j / 32;
        tr_tile(P.in[17], 2048, nt * 64, (u16*)(ws + WS_WBR1), 1024, kt * 256, nt * 64, nullptr, tile); }
    else if (id < 3392 + 128) { const int j = id - 3392, nt = j % 32, kt = j / 32;
        tr_tile(P.in[17] + (size_t)1024 * 2048, 2048, nt * 64, (u16*)(ws + WS_WBR2), 1024, kt * 256, nt * 64, nullptr, tile); }
    else { const int j = id - 3520, nt = j % 32, kt = j / 32;
        tr_tile(P.in[18], 2048, nt * 64, (u16*)(ws + WS_WOUT), 2048, kt * 256, nt * 64, nullptr, tile); }
}
__device__ void phase0(const Params& P, float* tile) {
    unsigned char* ws = P.ws; const int G = gridDim.x, bid = blockIdx.x, tid = threadIdx.x;
    for (int id = bid; id < WT_IN; id += G) weight_tile(P, id, tile);
    { u16* wl = (u16*)(ws + WS_WLORA);
      for (int idx = bid * 512 + tid; idx < 3072 * 512; idx += G * 512) { const int n = idx >> 9, k = idx & 511; float v = 0.f;
          if (n < 1024) { if (k < 96) v = P.in[5][(size_t)k * 1024 + n]; }
          else if (n < 2048) { if (k >= 96 && k < 192) v = P.in[7][(size_t)(k - 96) * 1024 + (n - 1024)]; }
          else { if (k >= 256) v = P.in[8][(size_t)(k - 256) * 1024 + (n - 2048)]; }
          wl[idx] = f2bf(v); } }
    { const int lane = tid & 63, gw = bid * 8 + (tid >> 6), nw = G * 8; u16* xb = (u16*)(ws + WS_Z + Z_TAIL); float* rstd1 = (float*)(ws + WS_SMALL);
      for (int t = gw; t < MT; t += nw) { const float4* xr = (const float4*)(P.in[0] + (size_t)t * DM); float ss = 0.f;
#pragma unroll
          for (int i = 0; i < 8; ++i) { const float4 v = xr[lane + 64 * i]; ss += v.x * v.x + v.y * v.y + v.z * v.z + v.w * v.w;
              uint2 w; w.x = cvt_pk_bf16(v.x, v.y); w.y = cvt_pk_bf16(v.z, v.w); *(uint2*)(xb + (size_t)t * DM + (lane + 64 * i) * 4) = w; }
          ss = wave_sum(ss); if (lane == 0) rstd1[t] = rsqrtf(ss * (1.0f / 2048.0f) + 1e-6f); } }
}

__device__ void phase2(const Params& P, u16* tile) {
    unsigned char* ws = P.ws; const int G = gridDim.x, bid = blockIdx.x, tid = threadIdx.x, lane = tid & 63;
    const u16* zmain = (const u16*)(ws + WS_Z + Z_MAIN);
    u16* rkv = (u16*)((unsigned char*)P.out + O_RKV); u16* Qn = (u16*)((unsigned char*)P.out + O_QN);
    u16* Ap = (u16*)(ws + WS_X + X_AP); u16* Kn = (u16*)(ws + WS_X + X_KN); u16* Vt = (u16*)(ws + WS_X + X_VT);
    const float* mu = P.in[3];
    const int d0 = (lane * 2) & 63; const float qg0 = P.in[14][d0] * 0.125f, qg1 = P.in[14][d0 + 1] * 0.125f, kg0 = P.in[15][d0], kg1 = P.in[15][d0 + 1];
    for (int t = bid * 8 + (tid >> 6); t < MT; t += G * 8) {
        const u16* zr = zmain + (size_t)t * ZM; const bool hp = (t & (SEQ - 1)) != 0; const u16* zp = hp ? zr - ZM : zr;
        unsigned zz[28], pp[28], qk[10]; float2 m2[28];
#pragma unroll
        for (int i = 0; i < 28; ++i) { const int c = i * 128 + lane * 2; zz[i] = 0u; pp[i] = 0u; m2[i] = make_float2(0.f, 0.f);
            if (i < 27 || lane < 32) { zz[i] = *(const unsigned*)(zr + c); pp[i] = *(const unsigned*)(zp + c); m2[i] = *(const float2*)(mu + c); } }
#pragma unroll
        for (int i = 0; i < 10; ++i) qk[i] = *(const unsigned*)(zr + 3584 + i * 128 + lane * 2);
#pragma unroll
        for (int i = 0; i < 28; ++i) { const int c = i * 128 + lane * 2;
            if (i < 27 || lane < 32) { const unsigned pv = hp ? pp[i] : 0u;
                const float z0 = bflo(zz[i]), z1 = bfhi(zz[i]); const float a0 = z0 + (bflo(pv) - z0) * m2[i].x, a1 = z1 + (bfhi(pv) - z1) * m2[i].y;
                if (i < 24) *(unsigned*)(rkv + (size_t)t * 3072 + c) = cvt_pk_bf16(a0, a1);
                else if (c < 3168) *(unsigned*)(Ap + (size_t)t * 512 + (c - 3072)) = cvt_pk_bf16(tanhf(a0), tanhf(a1));
                else if (c < 3264) *(unsigned*)(Ap + (size_t)t * 512 + 96 + (c - 3168)) = cvt_pk_bf16(a0, a1);
                else *(unsigned*)(Ap + (size_t)t * 512 + 256 + (c - 3264)) = cvt_pk_bf16(sigmoidf_(a0), sigmoidf_(a1)); } }
        if (lane < 32) *(unsigned*)(Ap + (size_t)t * 512 + 192 + lane * 2) = 0u;
#pragma unroll
        for (int i = 0; i < 10; ++i) { const float v0 = bflo(qk[i]), v1 = bfhi(qk[i]); float ss = row16_sum(v0 * v0 + v1 * v1); ss += __shfl_xor(ss, 16);
            const float rs = rsqrtf(ss * (1.0f / 64.0f) + 1e-6f);
            if (i < 8) *(unsigned*)(Qn + (size_t)t * 1024 + i * 128 + lane * 2) = cvt_pk_bf16(v0 * rs * qg0, v1 * rs * qg1);
            else *(unsigned*)(Kn + (size_t)t * 256 + (i - 8) * 128 + lane * 2) = cvt_pk_bf16(v0 * rs * kg0, v1 * rs * kg1); }
    }
    for (int tl = bid; tl < MT / 64; tl += G) { const int t0 = tl * 64;
        __syncthreads();
        for (int i = 0; i < 16; ++i) { const int idx = tid + 512 * i, r = idx >> 7, cp = idx & 127; const unsigned vv = *(const unsigned*)(zmain + (size_t)(t0 + r) * ZM + 4864 + 2 * cp);
            tile[(2 * cp) * 66 + r] = (u16)(vv & 0xffffu); tile[(2 * cp + 1) * 66 + r] = (u16)(vv >> 16); }
        __syncthreads();
        const int b = t0 >> 12, s0 = t0 & (SEQ - 1);
        for (int i = 0; i < 16; ++i) { const int idx = tid + 512 * i, c = idx >> 5, sp = idx & 31;
            const unsigned w = (unsigned)tile[c * 66 + 2 * sp] | ((unsigned)tile[c * 66 + 2 * sp + 1] << 16);
            *(unsigned*)(Vt + ((size_t)(b * 4 + (c >> 6)) * 64 + (c & 63)) * SEQ + s0 + 2 * sp) = w; }
    }
}

constexpr int NS = 4, NSCAN = 32 * NS, TCH = 64, VR = 64 / NS;
__device__ void scan_phase(const Params& P, float* L) {
    unsigned char* ws = P.ws; const int bid = blockIdx.x, tid = threadIdx.x, lane = tid & 63, w = tid >> 6;
    const int hb = bid / NS, vs = bid % NS, b = hb >> 4, h = hb & 15;
    const u16* rkv = (const u16*)((unsigned char*)P.out + O_RKV);
    const float* lwp = (const float*)(ws + WS_Z + Z_LW); const float* ap = (const float*)(ws + WS_Z + Z_A);
    u16* yraw = (u16*)(ws + WS_Y);
    float* R = L; float* Kp = L + 4224; float* Wd = L + 8448; float* KK = L + 12672; float* Bv = L + 16896; float* Vv = L + 21120; float* Yb = L + 22176; float* DUM = L + 23200;
    const int tl = tid >> 3, c8 = (tid & 7) * 8, v2 = (tid & 7) * 2;
    float kkw[8], kaw[8];
#pragma unroll
    for (int j = 0; j < 8; ++j) { kkw[j] = P.in[9][h * 64 + c8 + j]; kaw[j] = P.in[10][h * 64 + c8 + j]; }
    const int vl = lane >> 4, kg = lane & 15, row = (w & 3) * 4 + vl;
    float s0 = 0.f, s1 = 0.f, s2 = 0.f, s3 = 0.f;
    uint4 r8, k8; float4 lw0, lw1, a0, a1; unsigned vv2;
    auto prefetch = [&](int ci) { const size_t t = (size_t)b * SEQ + ci * TCH + tl;
        r8 = *(const uint4*)(rkv + t * 3072 + h * 64 + c8); k8 = *(const uint4*)(rkv + t * 3072 + 1024 + h * 64 + c8);
        vv2 = *(const unsigned*)(rkv + t * 3072 + 2048 + h * 64 + vs * VR + v2);
        lw0 = *(const float4*)(lwp + t * RWD + h * 64 + c8); lw1 = *(const float4*)(lwp + t * RWD + h * 64 + c8 + 4);
        a0 = *(const float4*)(ap + t * RWD + h * 64 + c8); a1 = *(const float4*)(ap + t * RWD + h * 64 + c8 + 4); };
    prefetch(0);
    for (int ci = 0; ci < SEQ / TCH; ++ci) {
        __syncthreads();
        if (ci > 0) { const size_t t = (size_t)b * SEQ + (ci - 1) * TCH + tl; *(unsigned*)(yraw + t * RWD + h * 64 + vs * VR + v2) = cvt_pk_bf16(Yb[v2 * TCH + tl], Yb[(v2 + 1) * TCH + tl]); }
        { float rr[8], kk_[8], aa[8], ll[8];
          rr[0] = bflo(r8.x); rr[1] = bfhi(r8.x); rr[2] = bflo(r8.y); rr[3] = bfhi(r8.y); rr[4] = bflo(r8.z); rr[5] = bfhi(r8.z); rr[6] = bflo(r8.w); rr[7] = bfhi(r8.w);
          kk_[0] = bflo(k8.x); kk_[1] = bfhi(k8.x); kk_[2] = bflo(k8.y); kk_[3] = bfhi(k8.y); kk_[4] = bflo(k8.z); kk_[5] = bfhi(k8.z); kk_[6] = bflo(k8.w); kk_[7] = bfhi(k8.w);
          aa[0] = a0.x; aa[1] = a0.y; aa[2] = a0.z; aa[3] = a0.w; aa[4] = a1.x; aa[5] = a1.y; aa[6] = a1.z; aa[7] = a1.w;
          ll[0] = lw0.x; ll[1] = lw0.y; ll[2] = lw0.z; ll[3] = lw0.w; ll[4] = lw1.x; ll[5] = lw1.y; ll[6] = lw1.z; ll[7] = lw1.w;
          float q[8]; float ss = 0.f;
#pragma unroll
          for (int j = 0; j < 8; ++j) { q[j] = kk_[j] * kkw[j]; ss += q[j] * q[j]; }
          ss += __shfl_xor(ss, 1); ss += __shfl_xor(ss, 2); ss += __shfl_xor(ss, 4);
          const float inv = 1.0f / fmaxf(sqrtf(ss), 1e-12f);
#pragma unroll
          for (int j = 0; j < 8; ++j) { const float kkn = q[j] * inv; const int o = tl * 64 + c8 + j;
              R[o] = rr[j]; Kp[o] = kk_[j] * (1.0f + (aa[j] - 1.0f) * kaw[j]); Wd[o] = __expf(ll[j]); KK[o] = kkn; Bv[o] = kkn * aa[j]; }
          float* vp = Vv + tl * VR + v2; vp[0] = bflo(vv2); vp[1] = bfhi(vv2); }
        __syncthreads();
        if (ci + 1 < SEQ / TCH) prefetch(ci + 1);
        if (w < 4) {
            typedef float f2 __attribute__((ext_vector_type(2)));
            struct Ops { float4 kk, w, b, k, r; float v; };
            const float* pk_ = KK + 4 * kg; const float* pw_ = Wd + 4 * kg; const float* pb_ = Bv + 4 * kg; const float* pp_ = Kp + 4 * kg; const float* pr_ = R + 4 * kg; const float* pv_ = Vv + row;
            float* ys = (kg == 0) ? (Yb + row * TCH) : (DUM + lane * 4);
#define SCAN_LOAD(D, T) do { const int _o = (T) * 64; D.kk = *(const float4*)(pk_ + _o); D.w = *(const float4*)(pw_ + _o); D.b = *(const float4*)(pb_ + _o); \
                D.k = *(const float4*)(pp_ + _o); D.r = *(const float4*)(pr_ + _o); D.v = pv_[(T) * VR]; } while (0)
            Ops c, n1, n2; SCAN_LOAD(c, 0); SCAN_LOAD(n1, 1);
            f2 sA = {s0, s1}, sB = {s2, s3}; float yq[4];
#pragma unroll 8
            for (int t = 0; t < TCH; ++t) {
                SCAN_LOAD(n2, t + 2);
                const f2 kkA = {c.kk.x, c.kk.y}, kkB = {c.kk.z, c.kk.w}, wA = {c.w.x, c.w.y}, wB = {c.w.z, c.w.w}, bA = {c.b.x, c.b.y}, bB = {c.b.z, c.b.w};
                const f2 kA = {c.k.x, c.k.y}, kB = {c.k.z, c.k.w}, rA = {c.r.x, c.r.y}, rB = {c.r.z, c.r.w};
                f2 p = sA * kkA; p = sB * kkB + p;
                const f2 cvv = {c.v, c.v};
                const f2 preA = sA * wA + cvv * kA, preB = sB * wB + cvv * kB;
                const float sa = -row16_sum(p.x + p.y); const f2 saa = {sa, sa};
                sA = saa * bA + preA; sB = saa * bB + preB;
                f2 q = sA * rA; q = sB * rB + q;
                yq[t & 3] = row16_sum(q.x + q.y);
                if ((t & 3) == 3) *(float4*)(ys + (t - 3)) = make_float4(yq[0], yq[1], yq[2], yq[3]);
                c = n1; n1 = n2;
            }
#undef SCAN_LOAD
            s0 = sA.x; s1 = sA.y; s2 = sB.x; s3 = sB.y;
        }
    }
    __syncthreads();
    { const size_t t = (size_t)b * SEQ + (SEQ / TCH - 1) * TCH + tl; *(unsigned*)(yraw + t * RWD + h * 64 + vs * VR + v2) = cvt_pk_bf16(Yb[v2 * TCH + tl], Yb[(v2 + 1) * TCH + tl]); }
}

__device__ void attn_phase(const Params& P) {
    unsigned char* ws = P.ws; const int tid = threadIdx.x, lane = tid & 63, fr = lane & 15, fq = lane >> 4;
    const u16* Qn = (const u16*)((unsigned char*)P.out + O_QN); const u16* Kn = (const u16*)(ws + WS_X + X_KN); const u16* Vt = (const u16*)(ws + WS_X + X_VT);
    u16* oatt = (u16*)(ws + WS_X + X_OATT);
    const int NA = (int)gridDim.x - NSCAN; const int gw = ((int)blockIdx.x - NSCAN) * 8 + (tid >> 6);
    for (int unit = gw; unit < 8192; unit += NA * 8) {
        const int h = unit & 15, st = (unit >> 4) & 255, b = unit >> 12, kh = h >> 2;
        const int s0 = st * 16; const size_t t0 = (size_t)b * SEQ + s0;
        const float slope = exp2f(-0.5f * (float)(h + 1)), sink = P.in[16][h];
        bf16x8 qf[2];
        qf[0] = *(const bf16x8*)(Qn + (t0 + fr) * 1024 + h * 64 + 8 * fq); qf[1] = *(const bf16x8*)(Qn + (t0 + fr) * 1024 + h * 64 + 32 + 8 * fq);
        f32x4 sc[10]; float mx = sink;
#pragma unroll
        for (int kt = 0; kt < 10; ++kt) { const int ks0 = s0 - 144 + 16 * kt; int kp = ks0 + fr; kp = kp < 0 ? 0 : kp;
            const u16* kr = Kn + ((size_t)b * SEQ + kp) * 256 + kh * 64 + 8 * fq;
            const bf16x8 k0 = *(const bf16x8*)kr, k1 = *(const bf16x8*)(kr + 32);
            f32x4 a = {0.f, 0.f, 0.f, 0.f};
            a = __builtin_amdgcn_mfma_f32_16x16x32_bf16(k0, qf[0], a, 0, 0, 0); a = __builtin_amdgcn_mfma_f32_16x16x32_bf16(k1, qf[1], a, 0, 0, 0);
#pragma unroll
            for (int j = 0; j < 4; ++j) { const int kpos = ks0 + 4 * fq + j; const int dist = s0 + fr - kpos; const bool valid = (dist >= 0) && (dist < 128) && (kpos >= 0);
                const float v = valid ? a[j] - slope * (float)dist : -1e30f; a[j] = v; mx = fmaxf(mx, v); }
            sc[kt] = a; }
        mx = fmaxf(mx, __shfl_xor(mx, 16)); mx = fmaxf(mx, __shfl_xor(mx, 32));
        float sum = 0.f;
#pragma unroll
        for (int kt = 0; kt < 10; ++kt)
#pragma unroll
            for (int j = 0; j < 4; ++j) { const float e = __expf(sc[kt][j] - mx); sc[kt][j] = e; sum += e; }
        sum += __shfl_xor(sum, 16); sum += __shfl_xor(sum, 32);
        const float inv = 1.0f / (sum + __expf(sink - mx));
        f32x4 o[4];
#pragma unroll
        for (int dt = 0; dt < 4; ++dt) o[dt] = (f32x4){0.f, 0.f, 0.f, 0.f};
#pragma unroll
        for (int u = 0; u < 5; ++u) {
            union { bf16x8 v; unsigned w[4]; } pf;
            pf.w[0] = cvt_pk_bf16(sc[2 * u][0] * inv, sc[2 * u][1] * inv); pf.w[1] = cvt_pk_bf16(sc[2 * u][2] * inv, sc[2 * u][3] * inv);
            pf.w[2] = cvt_pk_bf16(sc[2 * u + 1][0] * inv, sc[2 * u + 1][1] * inv); pf.w[3] = cvt_pk_bf16(sc[2 * u + 1][2] * inv, sc[2 * u + 1][3] * inv);
            int ka = s0 - 144 + 32 * u + 4 * fq, kb = ka + 16; ka = ka < 0 ? 0 : ka; kb = kb < 0 ? 0 : kb;
#pragma unroll
            for (int dt = 0; dt < 4; ++dt) { const u16* vr = Vt + ((size_t)(b * 4 + kh) * 64 + dt * 16 + fr) * SEQ;
                union { bf16x8 v; uint2 w[2]; } vf; vf.w[0] = *(const uint2*)(vr + ka); vf.w[1] = *(const uint2*)(vr + kb);
                o[dt] = __builtin_amdgcn_mfma_f32_16x16x32_bf16(pf.v, vf.v, o[dt], 0, 0, 0); } }
#pragma unroll
        for (int dt = 0; dt < 4; ++dt)
#pragma unroll
            for (int j = 0; j < 4; ++j) oatt[(t0 + 4 * fq + j) * 1024 + h * 64 + dt * 16 + fr] = f2bf(o[dt][j]);
    }
}

__device__ void phase5(const Params& P) {
    unsigned char* ws = P.ws; const int G = gridDim.x, bid = blockIdx.x, tid = threadIdx.x, lane = tid & 63;
    const u16* rkv = (const u16*)((unsigned char*)P.out + O_RKV); u16* orw = (u16*)((unsigned char*)P.out + O_QN);
    const u16* yraw = (const u16*)(ws + WS_Y); const float* ap = (const float*)(ws + WS_Z + Z_A); const u16* gp = (const u16*)(ws + WS_Z + Z_G);
    for (int t = bid * 8 + (tid >> 6); t < MT; t += G * 8) {
        float4 y4[4], a4[4]; uint2 r2[4], k2[4], v2[4], g2[4];
#pragma unroll
        for (int it = 0; it < 4; ++it) { const int hc = (it * 4 + (lane >> 4)) * 64 + (lane & 15) * 4; const size_t o = (size_t)t * RWD + hc;
            { const uint2 yb = *(const uint2*)(yraw + o); y4[it] = make_float4(bflo(yb.x), bfhi(yb.x), bflo(yb.y), bfhi(yb.y)); } a4[it] = *(const float4*)(ap + o); g2[it] = *(const uint2*)(gp + o);
            r2[it] = *(const uint2*)(rkv + (size_t)t * 3072 + hc); k2[it] = *(const uint2*)(rkv + (size_t)t * 3072 + 1024 + hc); v2[it] = *(const uint2*)(rkv + (size_t)t * 3072 + 2048 + hc); }
#pragma unroll
        for (int it = 0; it < 4; ++it) { const int hc = (it * 4 + (lane >> 4)) * 64 + (lane & 15) * 4; const size_t o = (size_t)t * RWD + hc;
            const float4 gw = *(const float4*)(P.in[12] + hc), gb = *(const float4*)(P.in[13] + hc), ka = *(const float4*)(P.in[10] + hc), rkw = *(const float4*)(P.in[11] + hc);
            const float4 y = y4[it], a = a4[it];
            const float mu = row16_sum((y.x + y.y) + (y.z + y.w)) * (1.0f / 64.0f);
            const float dx = y.x - mu, dy = y.y - mu, dz = y.z - mu, dw = y.w - mu;
            const float var = row16_sum((dx * dx + dy * dy) + (dz * dz + dw * dw)) * (1.0f / 64.0f); const float rs = rsqrtf(var + 64e-5f);
            const float r0 = bflo(r2[it].x), r1 = bfhi(r2[it].x), r2_ = bflo(r2[it].y), r3 = bfhi(r2[it].y);
            const float k0 = bflo(k2[it].x) * (1.0f + (a.x - 1.0f) * ka.x), k1 = bfhi(k2[it].x) * (1.0f + (a.y - 1.0f) * ka.y), k2_ = bflo(k2[it].y) * (1.0f + (a.z - 1.0f) * ka.z), k3 = bfhi(k2[it].y) * (1.0f + (a.w - 1.0f) * ka.w);
            const float rk = row16_sum((r0 * k0 * rkw.x + r1 * k1 * rkw.y) + (r2_ * k2_ * rkw.z + r3 * k3 * rkw.w));
            const float o0 = (dx * rs * gw.x + gb.x + rk * bflo(v2[it].x)) * bflo(g2[it].x), o1 = (dy * rs * gw.y + gb.y + rk * bfhi(v2[it].x)) * bfhi(g2[it].x);
            const float o2 = (dz * rs * gw.z + gb.z + rk * bflo(v2[it].y)) * bflo(g2[it].y), o3 = (dw * rs * gw.w + gb.w + rk * bfhi(v2[it].y)) * bfhi(g2[it].y);
            uint2 w; w.x = cvt_pk_bf16(o0, o1); w.y = cvt_pk_bf16(o2, o3); *(uint2*)(orw + o) = w; }
    }
}

__device__ void phase9(const Params& P) {
    unsigned char* ws = P.ws; const u16* uu = (const u16*)(ws + WS_Z); u16* act = (u16*)(ws + WS_ACT);
    const float* cw = P.in[21]; const float* cb = P.in[22];
    const int nth = gridDim.x * 512;
    for (int task = blockIdx.x * 512 + threadIdx.x; task < 1024 * 1408; task += nth) {
        const int j0 = (task % 1408) * 4, t0 = (task / 1408) * 8; const bool first = (t0 & (SEQ - 1)) == 0;
        uint2 ra[10], rg[10];
#pragma unroll
        for (int r = 0; r < 10; ++r) { const int t = (first && r < 2) ? t0 : t0 - 2 + r; ra[r] = *(const uint2*)(uu + (size_t)t * NUP + j0); rg[r] = *(const uint2*)(uu + (size_t)t * NUP + DFF + j0); }
        if (first) { ra[0] = make_uint2(0u, 0u); ra[1] = ra[0]; rg[0] = ra[0]; rg[1] = ra[0]; }
        const float4 wa0 = *(const float4*)(cw + j0), wa1 = *(const float4*)(cw + NUP + j0), wa2 = *(const float4*)(cw + 2 * NUP + j0), ba = *(const float4*)(cb + j0);
        const float4 wg0 = *(const float4*)(cw + DFF + j0), wg1 = *(const float4*)(cw + NUP + DFF + j0), wg2 = *(const float4*)(cw + 2 * NUP + DFF + j0), bg = *(const float4*)(cb + DFF + j0);
#pragma unroll
        for (int i = 0; i < 8; ++i) {
            const float cv0 = bflo(ra[i].x) * wa0.x + bflo(ra[i + 1].x) * wa1.x + bflo(ra[i + 2].x) * wa2.x + ba.x, cv1 = bfhi(ra[i].x) * wa0.y + bfhi(ra[i + 1].x) * wa1.y + bfhi(ra[i + 2].x) * wa2.y + ba.y;
            const float cv2 = bflo(ra[i].y) * wa0.z + bflo(ra[i + 1].y) * wa1.z + bflo(ra[i + 2].y) * wa2.z + ba.z, cv3 = bfhi(ra[i].y) * wa0.w + bfhi(ra[i + 1].y) * wa1.w + bfhi(ra[i + 2].y) * wa2.w + ba.w;
            const float cg0 = bflo(rg[i].x) * wg0.x + bflo(rg[i + 1].x) * wg1.x + bflo(rg[i + 2].x) * wg2.x + bg.x, cg1 = bfhi(rg[i].x) * wg0.y + bfhi(rg[i + 1].x) * wg1.y + bfhi(rg[i + 2].x) * wg2.y + bg.y;
            const float cg2 = bflo(rg[i].y) * wg0.z + bflo(rg[i + 1].y) * wg1.z + bflo(rg[i + 2].y) * wg2.z + bg.z, cg3 = bfhi(rg[i].y) * wg0.w + bfhi(rg[i + 1].y) * wg1.w + bfhi(rg[i + 2].y) * wg2.w + bg.w;
            uint2 w; w.x = cvt_pk_bf16(cg0 * sigmoidf_(cg0) * cv0, cg1 * sigmoidf_(cg1) * cv1); w.y = cvt_pk_bf16(cg2 * sigmoidf_(cg2) * cv2, cg3 * sigmoidf_(cg3) * cv3);
            *(uint2*)(act + (size_t)(t0 + i) * DFF + j0) = w; }
    }
}

constexpr int NPH = 11;
__global__ void __launch_bounds__(512, 2) mega(Params P) {
    extern __shared__ __attribute__((aligned(16))) unsigned char lds_raw[];
    cg::grid_group grid = cg::this_grid();
    LAS unsigned char* lds = (LAS unsigned char*)lds_raw;
    unsigned char* ws = P.ws;
#define RUN(i) ((i) >= P.ph_lo && (i) < P.ph_hi)
#define SEAM(i) do { if ((i) >= P.ph_lo && (i) + 1 < P.ph_hi) grid.sync(); } while (0)
    if (RUN(0)) phase0(P, (float*)lds_raw);
    SEAM(0);
    if (RUN(1)) { EpiZ E; E.zmain = (u16*)(ws + WS_Z + Z_MAIN); E.zgate = (u16*)(ws + WS_Z + Z_GATE); E.rstd = (const float*)(ws + WS_SMALL);
        run_gemm(lds, (const u16*)(ws + WS_Z + Z_TAIL), (const u16*)(ws + WS_WIN), 6144, 2048, E); }
    SEAM(1);
    if (RUN(2)) phase2(P, (u16*)lds_raw);
    SEAM(2);
    if (RUN(3)) { EpiLora E; E.lw = (float*)(ws + WS_Z + Z_LW); E.av = (float*)(ws + WS_Z + Z_A); E.g = (u16*)(ws + WS_Z + Z_G); E.w0 = P.in[4]; E.a0 = P.in[6];
        run_gemm(lds, (const u16*)(ws + WS_X + X_AP), (const u16*)(ws + WS_WLORA), 3072, 512, E); }
    SEAM(3);
    if (RUN(4)) { if ((int)blockIdx.x < NSCAN) scan_phase(P, (float*)lds_raw);
        else { attn_phase(P); __syncthreads();
            { EpiZG E; E.zgate = (u16*)(ws + WS_Z + Z_GATE); E.rstd = (const float*)(ws + WS_SMALL);
              run_gemm_sub(lds, (const u16*)(ws + WS_Z + Z_TAIL), (const u16*)(ws + WS_WIN) + (size_t)6144 * 2048, 3072, 2048, E, (int)gridDim.x - NSCAN, (int)blockIdx.x - NSCAN); }
            for (int id = WT_IN + ((int)blockIdx.x - NSCAN); id < WT_ALL; id += (int)gridDim.x - NSCAN) weight_tile(P, id, (float*)lds_raw); } }
    SEAM(4);
    if (RUN(5)) phase5(P);
    SEAM(5);
    if (RUN(6)) {
        { EpiBranch<0> E; E.mixed = (u16*)(ws + WS_Z); E.zgate = (const u16*)(ws + WS_Z + Z_GATE);
          run_gemm(lds, (const u16*)((unsigned char*)P.out + O_QN), (const u16*)(ws + WS_WBR1), 2048, 1024, E); }
        { EpiBranch<1> E; E.mixed = (u16*)(ws + WS_Z); E.zgate = (const u16*)(ws + WS_Z + Z_GATE);
          run_gemm(lds, (const u16*)(ws + WS_X + X_OATT), (const u16*)(ws + WS_WBR2), 2048, 1024, E); } }
    SEAM(6);
    if (RUN(7)) { EpiOut1 E; E.x = P.in[0]; E.x1 = P.out; E.x1b = (u16*)(ws + WS_X); E.rowss = (float*)(ws + WS_SMALL + 32768);
        run_gemm(lds, (const u16*)(ws + WS_Z), (const u16*)(ws + WS_WOUT), 2048, 2048, E); }
    SEAM(7);
    if (RUN(8)) { EpiUp E; E.uo = (u16*)(ws + WS_Z); E.rowss = (const float*)(ws + WS_SMALL + 32768);
        run_gemm(lds, (const u16*)(ws + WS_X), (const u16*)(ws + WS_WUP), NUP, 2048, E); }
    SEAM(8);
    if (RUN(9)) phase9(P);
    SEAM(9);
    if (RUN(10)) { EpiFinal E; E.out = P.out;
        run_gemm(lds, (const u16*)(ws + WS_ACT), (const u16*)(ws + WS_WDOWN), 2048, DFF, E); }
}

constexpr int LDS_BYTES = 131072;
extern "C" void kernel_launch(void* const* d_in, const int* in_sizes, int n_in, void* d_out, int out_size, void* d_ws, size_t ws_size, hipStream_t stream) {
    static int grid = 0;
    if (grid == 0) {
        if (n_in != 24 || out_size != MT * DM || ws_size < WS_END) { fprintf(stderr, "kernel_launch: unexpected shapes (n_in %d out %d ws %zu need %zu)\n", n_in, out_size, ws_size, (size_t)WS_END); grid = -1; return; }
        int dev = 0, cus = 0, per_cu = 0;
        hipGetDevice(&dev); hipDeviceGetAttribute(&cus, hipDeviceAttributeMultiprocessorCount, dev);
        if (hipFuncSetAttribute((const void*)mega, hipFuncAttributeMaxDynamicSharedMemorySize, LDS_BYTES) != hipSuccess) { fprintf(stderr, "kernel_launch: hipFuncSetAttribute failed\n"); grid = -1; return; }
        if (hipOccupancyMaxActiveBlocksPerMultiprocessor(&per_cu, (const void*)mega, 512, LDS_BYTES) != hipSuccess || per_cu < 1) { fprintf(stderr, "kernel_launch: occupancy query failed (%d)\n", per_cu); grid = -1; return; }
        grid = cus * per_cu; if (grid > 256) grid = 256;
        if (grid < 2 * NSCAN) { fprintf(stderr, "kernel_launch: grid %d too small\n", grid); grid = -1; return; }
    }
    if (grid < 0) return;
    Params p{};
    for (int i = 0; i < 24; ++i) p.in[i] = (const float*)d_in[i];
    p.out = (float*)d_out; p.ws = (unsigned char*)d_ws;
#ifndef SPLIT_LAUNCH
    p.ph_lo = 0; p.ph_hi = NPH;
    { void* args[] = {&p}; hipError_t e = hipLaunchCooperativeKernel((const void*)mega, dim3(grid), dim3(512), args, LDS_BYTES, stream);
      if (e != hipSuccess) fprintf(stderr, "cooperative launch failed: %s (grid %d)\n", hipGetErrorString(e), grid); }
#else
    for (int ph = 0; ph < NPH; ++ph) { p.ph_lo = ph; p.ph_hi = ph + 1; void* args[] = {&p};
        hipError_t e = hipLaunchCooperativeKernel((const void*)mega, dim3(grid), dim3(512), args, LDS_BYTES, stream);
        if (e != hipSuccess) fprintf(stderr, "cooperative launch failed: %s (grid %d)\n", hipGetErrorString(e), grid); }
#endif
}
```

```cpp
#include <hip/hip_runtime.h>
#include <hip/hip_cooperative_groups.h>
#include <cstdio>
#include <cstdint>
namespace cg = cooperative_groups;
namespace pg8 {
#define PG8_LAS __attribute__((address_space(3)))
typedef unsigned short bf16_t;
typedef short bf16x8 __attribute__((ext_vector_type(8)));
typedef float f32x4 __attribute__((ext_vector_type(4)));
typedef unsigned u32x4 __attribute__((ext_vector_type(4)));
constexpr int BM = 256, BK = 64, HALF = 128, HTB = HALF * BK * 2  , STAGE_BYTES = 8 * HTB, NXCD = 8, WGM = 8;

__host__ __device__ __forceinline__ int lds_byte(int r, int c) { const int st = (r >> 4) * 2 + (c >> 5), rr = r & 15, cc = c & 31, ob = rr * 64 + cc * 2; return st * 1024 + (ob ^ (((ob >> 9) & 1) << 5)); }
__host__ __device__ __forceinline__ void stage_rc(int b, int& R, int& C) { const int st = b / 1024, sb = b % 1024, swz = sb ^ (((sb >> 9) & 1) << 5); R = (st >> 1) * 16 + swz / 64; C = (st & 1) * 32 + (swz % 64) / 2; }
__host__ __device__ __forceinline__ int perm32(int rho) { const int n = rho >> 4, i = rho & 15; return 8 * (i >> 2) + 4 * n + (i & 3); }

struct Unit { int pm, pn; };
struct Gemm { const bf16_t* A; const bf16_t* Bt; int M, N, K; };

struct StaticOrder {
    int nM, nN, nwg, G, c;
    __host__ __device__ void init(int M, int N, int G_, int c_) { nM = M / BM; nN = N / BM; nwg = nM * nN; G = G_; c = c_; }
    __host__ __device__ bool next(int i, Unit& u) const {
        const long L = (long)i * G + c; if (L >= nwg) return false;
        int wgid = (int)L; { const int q = nwg / NXCD, r = nwg % NXCD, xcd = wgid % NXCD, off = wgid / NXCD; wgid = (xcd < r ? xcd * (q + 1) : r * (q + 1) + (xcd - r) * q) + off; }
        const int nig = WGM * nN, gid = wgid / nig, fm = gid * WGM, gsz = (nM - fm) < WGM ? (nM - fm) : WGM;
        u.pm = fm + ((wgid % nig) % gsz); u.pn = (wgid % nig) / gsz; return true;
    }
    __device__ __forceinline__ void a_ready(const Unit&) const {}
    __device__ __forceinline__ void done(const Unit&) const {}
};
typedef __bf16 bf16v2_t __attribute__((ext_vector_type(2))); typedef float f32v2_t __attribute__((ext_vector_type(2)));
__device__ __forceinline__ unsigned cvt_pk_bf16(float lo, float hi) { const f32v2_t x = {lo, hi}; const bf16v2_t r = __builtin_convertvector(x, bf16v2_t); return __builtin_bit_cast(unsigned, r); }
template <class Epi, class Sched>
__device__ __forceinline__ void gemm_phase(PG8_LAS unsigned char* lds, const Gemm g, const Sched& S, const Epi& E) {
    const int tid = threadIdx.x, wid = __builtin_amdgcn_readfirstlane(tid >> 6), lane = tid & 63, wr = wid >> 2, wc = wid & 3, fr = lane & 15, fq = lane >> 4;
    const int K = g.K, nt = K / BK;
    unsigned voffA[2], voffB[2];
#pragma unroll
    for (int i = 0; i < 2; ++i) { int R, C; stage_rc(tid * 16 + i * 8192, R, C); const int Rb = Epi::PERM ? ((R & ~31) + perm32(R & 31)) : R;
        voffA[i] = (unsigned)(R * K + C) * 2u; voffB[i] = (unsigned)(Rb * K + C) * 2u; }
    const size_t kstep = (size_t)(BK * 2);
    const size_t hstep = (size_t)HALF * K * 2;
    const size_t tstep = 2 * hstep;
    const unsigned ldsw = (unsigned)wid * 1024u;
    const int aoff = lds_byte(wr * 64 + fr, fq * 8), boff = lds_byte(wc * 32 + fr, fq * 8);
#define PG8_SA(b, h) (((b) * 2 + (h)) * HTB)
#define PG8_SB(b, h) ((4 + (b) * 2 + (h)) * HTB)
#define PG8_STAGE(bufoff, gbase, voff) do { _Pragma("unroll") for (int _i = 0; _i < 2; ++_i) \
        __builtin_amdgcn_global_load_lds((const unsigned*)((const char*)(gbase) + (voff)[_i]), (PG8_LAS unsigned*)(lds + (bufoff) + ldsw + _i * 8192), 16, 0, 0); } while (0)
#define PG8_LDA(dst, b, h) do { _Pragma("unroll") for (int m = 0; m < 4; ++m) _Pragma("unroll") for (int k = 0; k < 2; ++k) dst[m][k] = *(const PG8_LAS bf16x8*)(lds + PG8_SA(b, h) + aoff + m * 2048 + k * 1024); } while (0)
#define PG8_LDB(dst, b, h) do { _Pragma("unroll") for (int n = 0; n < 2; ++n) _Pragma("unroll") for (int k = 0; k < 2; ++k) dst[n][k] = *(const PG8_LAS bf16x8*)(lds + PG8_SB(b, h) + boff + n * 2048 + k * 1024); } while (0)
#define PG8_MMA(ai, bj, At, Bt) do { __builtin_amdgcn_s_setprio(1); _Pragma("unroll") for (int m = 0; m < 4; ++m) _Pragma("unroll") for (int n = 0; n < 2; ++n) _Pragma("unroll") for (int k = 0; k < 2; ++k) \
        acc[ai][bj][m][n] = __builtin_amdgcn_mfma_f32_16x16x32_bf16(Bt[n][k], At[m][k], acc[ai][bj][m][n], 0, 0, 0); __builtin_amdgcn_s_setprio(0); } while (0)
#define PG8_WAIT_V(n) asm volatile("s_waitcnt vmcnt(" #n ")" ::: "memory")
#define PG8_WAIT_L(n) asm volatile("s_waitcnt lgkmcnt(" #n ")" ::: "memory")
#define PG8_BAR __builtin_amdgcn_s_barrier()
#define PG8_SCHED __builtin_amdgcn_sched_barrier(0)
    Unit cur, nxt; int ui = 0;
    if (!S.next(0, cur)) return;
    f32x4 acc[2][2][4][2];
#pragma unroll
    for (int a = 0; a < 2; ++a)
#pragma unroll
        for (int b = 0; b < 2; ++b)
#pragma unroll
            for (int m = 0; m < 4; ++m)
#pragma unroll
                for (int n = 0; n < 2; ++n) acc[a][b][m][n] = (f32x4){0.f, 0.f, 0.f, 0.f};
    bf16x8 At[4][2], B0[2][2], B1[2][2];
    const char* cA = (const char*)g.A + (size_t)cur.pm * tstep; const char* cB = (const char*)g.Bt + (size_t)cur.pn * tstep;
    S.a_ready(cur);
    PG8_STAGE(PG8_SB(0, 0), cB, voffB); PG8_STAGE(PG8_SA(0, 0), cA, voffA); PG8_STAGE(PG8_SB(0, 1), cB + hstep, voffB); PG8_STAGE(PG8_SA(0, 1), cA + hstep, voffA);
    if (wr == 1) PG8_BAR;
    PG8_WAIT_V(4); PG8_BAR;
    PG8_STAGE(PG8_SB(1, 0), cB + kstep, voffB); PG8_STAGE(PG8_SA(1, 0), cA + kstep, voffA); PG8_STAGE(PG8_SB(1, 1), cB + hstep + kstep, voffB);
    PG8_WAIT_V(6); PG8_BAR;
    for (;;) {
        const bool has_next = S.next(ui + 1, nxt);
        const char* nA = has_next ? (const char*)g.A + (size_t)nxt.pm * tstep : cA; const char* nB = has_next ? (const char*)g.Bt + (size_t)nxt.pn * tstep : cB;
        for (int t = 0; t < nt; t += 2) {
            const bool last = (t == nt - 2);
            const char* a1 = cA + (size_t)(t + 1) * kstep;
            const char* a2 = last ? nA : cA + (size_t)(t + 2) * kstep; const char* b2 = last ? nB : cB + (size_t)(t + 2) * kstep;
            const char* a3 = a2 + kstep; const char* b3 = b2 + kstep;
            if (last && has_next) S.a_ready(nxt);
            PG8_LDB(B0, 0, 0); PG8_SCHED; PG8_LDA(At, 0, 0); PG8_STAGE(PG8_SA(1, 1), a1 + hstep, voffA);
            PG8_WAIT_L(8); PG8_BAR; PG8_WAIT_L(0); PG8_MMA(0, 0, At, B0); PG8_BAR; PG8_SCHED;
            PG8_LDB(B1, 0, 1); PG8_STAGE(PG8_SB(0, 0), b2, voffB);
            PG8_BAR; PG8_WAIT_L(0); PG8_MMA(0, 1, At, B1); PG8_BAR;
            PG8_LDA(At, 0, 1); PG8_STAGE(PG8_SA(0, 0), a2, voffA);
            PG8_BAR; PG8_WAIT_L(0); PG8_MMA(1, 0, At, B0); PG8_BAR; PG8_SCHED;
            PG8_STAGE(PG8_SB(0, 1), b2 + hstep, voffB);
            PG8_WAIT_V(6); PG8_BAR; PG8_MMA(1, 1, At, B1); PG8_BAR;
            PG8_LDB(B0, 1, 0); PG8_SCHED; PG8_LDA(At, 1, 0); PG8_STAGE(PG8_SA(0, 1), a2 + hstep, voffA);
            PG8_WAIT_L(8); PG8_BAR; PG8_WAIT_L(0); PG8_MMA(0, 0, At, B0); PG8_BAR; PG8_SCHED;
            PG8_LDB(B1, 1, 1); PG8_STAGE(PG8_SB(1, 0), b3, voffB);
            PG8_BAR; PG8_WAIT_L(0); PG8_MMA(0, 1, At, B1); PG8_BAR;
            PG8_LDA(At, 1, 1); PG8_STAGE(PG8_SA(1, 0), a3, voffA);
            PG8_BAR; PG8_WAIT_L(0); PG8_MMA(1, 0, At, B0); PG8_BAR; PG8_SCHED;
            PG8_STAGE(PG8_SB(1, 1), b3 + hstep, voffB);
            PG8_WAIT_V(6); PG8_BAR; PG8_MMA(1, 1, At, B1); PG8_BAR;
        }
        if constexpr (!Epi::AFTER_DRAIN) { E(acc, cur, wr, wc, fr, fq); S.done(cur); }
        if (!has_next) break;
#pragma unroll
        for (int a = 0; a < 2; ++a)
#pragma unroll
            for (int b = 0; b < 2; ++b)
#pragma unroll
                for (int m = 0; m < 4; ++m)
#pragma unroll
                    for (int n = 0; n < 2; ++n) acc[a][b][m][n] = (f32x4){0.f, 0.f, 0.f, 0.f};
        cur = nxt; cA = nA; cB = nB; ++ui;
    }
    PG8_WAIT_V(0);
    if (wr == 0) PG8_BAR;
    PG8_BAR;
    if constexpr (Epi::AFTER_DRAIN) { E.fused(acc, cur, wr, wc, fr, fq, lds, wid, lane); S.done(cur); }
#undef PG8_SA
#undef PG8_SB
#undef PG8_STAGE
#undef PG8_LDA
#undef PG8_LDB
#undef PG8_MMA
#undef PG8_WAIT_V
#undef PG8_WAIT_L
#undef PG8_BAR
#undef PG8_SCHED
}
}

using pg8::f32x4; using pg8::bf16x8; using pg8::Unit; using pg8::cvt_pk_bf16;
typedef unsigned short u16;
#define LAS __attribute__((address_space(3)))

constexpr int MT = 8192, DM = 2048, SEQ = 4096;
constexpr int NZ = 9216, ZM = 5120, ZG = 4096, DFF = 5632, NUP = 11264, RWD = 1024;
constexpr size_t WS_WDOWN = 0;
constexpr size_t WS_WIN   = WS_WDOWN + (size_t)2048 * 5632 * 2;
constexpr size_t WS_WUP   = WS_WIN + (size_t)9216 * 2048 * 2;
constexpr size_t WS_WBR1  = WS_WUP + (size_t)11264 * 2048 * 2;
constexpr size_t WS_WBR2  = WS_WBR1 + (size_t)2048 * 1024 * 2;
constexpr size_t WS_WOUT  = WS_WBR2 + (size_t)2048 * 1024 * 2;
constexpr size_t WS_WLORA = WS_WOUT + (size_t)2048 * 2048 * 2;
constexpr size_t WS_Z     = WS_WLORA + (size_t)3072 * 512 * 2;
constexpr size_t Z_BYTES  = (size_t)MT * NUP * 2;
constexpr size_t WS_X     = WS_Z + Z_BYTES;
constexpr size_t WS_SMALL = WS_X + (size_t)MT * DM * 2;
constexpr size_t WS_Y     = WS_SMALL + 32768 + (size_t)MT * 32 * 4;
constexpr size_t WS_END   = WS_Y + (size_t)MT * 1024 * 2;
constexpr size_t WS_ACT   = WS_WIN;
static_assert(WS_Z - WS_WIN >= (size_t)MT * DFF * 2, "act overlay");
constexpr size_t Z_MAIN = 0, Z_GATE = (size_t)MT * ZM * 2, Z_TAIL = (size_t)MT * (ZM + ZG) * 2;
constexpr size_t Z_LW = 0, Z_A = (size_t)MT * RWD * 4, Z_G = 2 * (size_t)MT * RWD * 4;
constexpr size_t X_AP = 0, X_KN = (size_t)MT * 512 * 2, X_VT = X_KN + (size_t)MT * 256 * 2, X_OATT = X_VT + (size_t)MT * 256 * 2;
constexpr size_t O_RKV = 0, O_QN = (size_t)MT * 3072 * 2;

struct Params { const float* in[24]; float* out; unsigned char* ws; int ph_lo, ph_hi; };

__device__ __forceinline__ float bf2f(unsigned short b) { return __uint_as_float(((unsigned)b) << 16); }
__device__ __forceinline__ float bflo(unsigned u) { return __uint_as_float(u << 16); }
__device__ __forceinline__ float bfhi(unsigned u) { return __uint_as_float(u & 0xffff0000u); }
__device__ __forceinline__ u16 f2bf(float f) { return (u16)(cvt_pk_bf16(f, f) & 0xffffu); }
__device__ __forceinline__ float wave_sum(float v) {
#pragma unroll
    for (int o = 32; o; o >>= 1) v += __shfl_xor(v, o);
    return v; }
__device__ __forceinline__ float sigmoidf_(float x) { return 1.0f / (1.0f + __expf(-x)); }
template <int CTRL> __device__ __forceinline__ float dppf(float x) { return __int_as_float(__builtin_amdgcn_update_dpp(0, __float_as_int(x), CTRL, 0xF, 0xF, true)); }
__device__ __forceinline__ float row16_sum(float x) { x += dppf<0xB1>(x); x += dppf<0x4E>(x); x += dppf<0x141>(x); x += dppf<0x140>(x); return x; }

#define EPI_ROWS _Pragma("unroll") for (int ai = 0; ai < 2; ++ai) _Pragma("unroll") for (int m = 0; m < 4; ++m)
#define EPI_COLS _Pragma("unroll") for (int bj = 0; bj < 2; ++bj) _Pragma("unroll") for (int n = 0; n < 2; ++n)
struct EpiZ {
    static constexpr bool PERM = false, AFTER_DRAIN = false;
    u16* zmain; u16* zgate; const float* rstd;
    __device__ __forceinline__ void operator()(const f32x4 (&acc)[2][2][4][2], const Unit& u, int wr, int wc, int fr, int fq) const {
        u16* base; int ld, c0;
        if (u.pn < 20) { base = zmain; ld = ZM; c0 = u.pn * 256; } else { base = zgate; ld = ZG; c0 = (u.pn - 20) * 256; }
        const int row0 = u.pm * 256 + wr * 64 + fr; c0 += wc * 32 + 4 * fq;
        EPI_ROWS { const int row = row0 + ai * 128 + m * 16; const float rs = rstd[row]; u16* rp = base + (size_t)row * ld + c0;
            EPI_COLS { const f32x4 v = acc[ai][bj][m][n] * rs; uint2 w; w.x = cvt_pk_bf16(v[0], v[1]); w.y = cvt_pk_bf16(v[2], v[3]); *(uint2*)(rp + bj * 128 + n * 16) = w; } }
    }
};
struct EpiLora {
    static constexpr bool PERM = false, AFTER_DRAIN = false;
    float* lw; float* av; u16* g; const float* w0; const float* a0;
    __device__ __forceinline__ void operator()(const f32x4 (&acc)[2][2][4][2], const Unit& u, int wr, int wc, int fr, int fq) const {
        const int row0 = u.pm * 256 + wr * 64 + fr; const int kind = u.pn >> 2; const int c0 = (u.pn & 3) * 256 + wc * 32 + 4 * fq;
        if (kind == 0) {
            EPI_ROWS { const int row = row0 + ai * 128 + m * 16;
                EPI_COLS { const int col = c0 + bj * 128 + n * 16; const f32x4 v = acc[ai][bj][m][n]; const f32x4 b = *(const f32x4*)(w0 + col); f32x4 o;
#pragma unroll
                    for (int j = 0; j < 4; ++j) { const float y = -(b[j] + v[j]); const float sp = fmaxf(y, 0.f) + __logf(1.0f + __expf(-fabsf(y))); o[j] = -__expf(-sp - 0.5f); }
                    *(f32x4*)(lw + (size_t)row * RWD + col) = o; } }
        } else if (kind == 1) {
            EPI_ROWS { const int row = row0 + ai * 128 + m * 16;
                EPI_COLS { const int col = c0 + bj * 128 + n * 16; const f32x4 v = acc[ai][bj][m][n]; const f32x4 b = *(const f32x4*)(a0 + col); f32x4 o;
#pragma unroll
                    for (int j = 0; j < 4; ++j) o[j] = sigmoidf_(b[j] + v[j]);
                    *(f32x4*)(av + (size_t)row * RWD + col) = o; } }
        } else {
            EPI_ROWS { const int row = row0 + ai * 128 + m * 16;
                EPI_COLS { const int col = c0 + bj * 128 + n * 16; const f32x4 v = acc[ai][bj][m][n];
                    uint2 w; w.x = cvt_pk_bf16(v[0], v[1]); w.y = cvt_pk_bf16(v[2], v[3]); *(uint2*)(g + (size_t)row * RWD + col) = w; } }
        }
    }
};
template <int PASS> struct EpiBranch {
    static constexpr bool PERM = false, AFTER_DRAIN = false;
    u16* mixed; const u16* zgate;
    __device__ __forceinline__ void operator()(const f32x4 (&acc)[2][2][4][2], const Unit& u, int wr, int wc, int fr, int fq) const {
        const int row0 = u.pm * 256 + wr * 64 + fr; const int c0 = u.pn * 256 + wc * 32 + 4 * fq;
        EPI_ROWS { const int row = row0 + ai * 128 + m * 16;
            EPI_COLS { const int col = c0 + bj * 128 + n * 16; const f32x4 v = acc[ai][bj][m][n];
                const uint2 gz = *(const uint2*)(zgate + (size_t)row * ZG + PASS * 2048 + col);
                f32x4 o; o[0] = sigmoidf_(bflo(gz.x)) * v[0]; o[1] = sigmoidf_(bfhi(gz.x)) * v[1]; o[2] = sigmoidf_(bflo(gz.y)) * v[2]; o[3] = sigmoidf_(bfhi(gz.y)) * v[3];
                uint2* mp = (uint2*)(mixed + (size_t)row * DM + col);
                if (PASS == 1) { const uint2 pm = *mp; o[0] += bflo(pm.x); o[1] += bfhi(pm.x); o[2] += bflo(pm.y); o[3] += bfhi(pm.y); }
                uint2 w; w.x = cvt_pk_bf16(o[0], o[1]); w.y = cvt_pk_bf16(o[2], o[3]); *mp = w; } }
    }
};
struct EpiOut1 {
    static constexpr bool PERM = false, AFTER_DRAIN = false;
    const float* x; float* x1; u16* x1b; float* rowss;
    __device__ __forceinline__ void operator()(const f32x4 (&acc)[2][2][4][2], const Unit& u, int wr, int wc, int fr, int fq) const {
        const int row0 = u.pm * 256 + wr * 64 + fr; const int c0 = u.pn * 256 + wc * 32 + 4 * fq;
        EPI_ROWS { const int row = row0 + ai * 128 + m * 16; float ss = 0.f;
            EPI_COLS { const int col = c0 + bj * 128 + n * 16; const size_t o = (size_t)row * DM + col;
                const f32x4 v = acc[ai][bj][m][n] + *(const f32x4*)(x + o);
                *(f32x4*)(x1 + o) = v; ss += v[0] * v[0] + v[1] * v[1] + v[2] * v[2] + v[3] * v[3];
                uint2 w; w.x = cvt_pk_bf16(v[0], v[1]); w.y = cvt_pk_bf16(v[2], v[3]); *(uint2*)(x1b + o) = w; }
            ss += __shfl_xor(ss, 16); ss += __shfl_xor(ss, 32);
            if (fq == 0) rowss[(size_t)row * 32 + u.pn * 4 + wc] = ss; }
    }
};
struct EpiUp {
    static constexpr bool PERM = false, AFTER_DRAIN = false;
    u16* uo; const float* rowss;
    __device__ __forceinline__ void operator()(const f32x4 (&acc)[2][2][4][2], const Unit& u, int wr, int wc, int fr, int fq) const {
        const int row0 = u.pm * 256 + wr * 64 + fr; const int c0 = u.pn * 256 + wc * 32 + 4 * fq;
        EPI_ROWS { const int row = row0 + ai * 128 + m * 16;
            const f32x4 p0 = *(const f32x4*)(rowss + (size_t)row * 32 + fq * 8), p1 = *(const f32x4*)(rowss + (size_t)row * 32 + fq * 8 + 4);
            float ss = ((p0[0] + p0[1]) + (p0[2] + p0[3])) + ((p1[0] + p1[1]) + (p1[2] + p1[3]));
            ss += __shfl_xor(ss, 16); ss += __shfl_xor(ss, 32);
            const float rs = rsqrtf(ss * (1.0f / 2048.0f) + 1e-6f); u16* rp = uo + (size_t)row * NUP + c0;
            EPI_COLS { const f32x4 v = acc[ai][bj][m][n] * rs; uint2 w; w.x = cvt_pk_bf16(v[0], v[1]); w.y = cvt_pk_bf16(v[2], v[3]); *(uint2*)(rp + bj * 128 + n * 16) = w; } }
    }
};
struct EpiFinal {
    static constexpr bool PERM = false, AFTER_DRAIN = false;
    float* out;
    __device__ __forceinline__ void operator()(const f32x4 (&acc)[2][2][4][2], const Unit& u, int wr, int wc, int fr, int fq) const {
        const int row0 = u.pm * 256 + wr * 64 + fr; const int c0 = u.pn * 256 + wc * 32 + 4 * fq;
        EPI_ROWS { const int row = row0 + ai * 128 + m * 16;
            EPI_COLS { float* op = out + (size_t)row * DM + c0 + bj * 128 + n * 16; *(f32x4*)op = *(const f32x4*)op + acc[ai][bj][m][n]; } }
    }
};

template <class Epi> __device__ __forceinline__ void run_gemm(LAS unsigned char* lds, const u16* A, const u16* Bt, int N, int K, const Epi& E) {
    pg8::Gemm g; g.A = A; g.Bt = Bt; g.M = MT; g.N = N; g.K = K;
    pg8::StaticOrder S; S.init(MT, N, (int)gridDim.x, (int)blockIdx.x);
    pg8::gemm_phase<Epi, pg8::StaticOrder>(lds, g, S, E);
}

template <class Epi> __device__ __forceinline__ void run_gemm_sub(LAS unsigned char* lds, const u16* A, const u16* Bt, int N, int K, const Epi& E, int G, int c) {
    pg8::Gemm g; g.A = A; g.Bt = Bt; g.M = MT; g.N = N; g.K = K;
    pg8::StaticOrder S; S.init(MT, N, G, c);
    pg8::gemm_phase<Epi, pg8::StaticOrder>(lds, g, S, E);
}
struct EpiZG {
    static constexpr bool PERM = false, AFTER_DRAIN = false;
    u16* zgate; const float* rstd;
    __device__ __forceinline__ void operator()(const f32x4 (&acc)[2][2][4][2], const Unit& u, int wr, int wc, int fr, int fq) const {
        const int row0 = u.pm * 256 + wr * 64 + fr; const int c0 = 1024 + u.pn * 256 + wc * 32 + 4 * fq;
        EPI_ROWS { const int row = row0 + ai * 128 + m * 16; const float rs = rstd[row]; u16* rp = zgate + (size_t)row * ZG + c0;
            EPI_COLS { const f32x4 v = acc[ai][bj][m][n] * rs; uint2 w; w.x = cvt_pk_bf16(v[0], v[1]); w.y = cvt_pk_bf16(v[2], v[3]); *(uint2*)(rp + bj * 128 + n * 16) = w; } }
    }
};

__device__ __forceinline__ void tr_tile(const float* __restrict__ src, int ldn, int nsrc0, u16* __restrict__ dst, int K, int k0, int ndst0, const float* __restrict__ scale, float* tile) {
    const int tid = threadIdx.x, nc4 = (tid & 15) * 4, kr0 = tid >> 4;
    float4 v[8];
#pragma unroll
    for (int i = 0; i < 8; ++i) { const int kr = kr0 + 32 * i; v[i] = make_float4(0.f, 0.f, 0.f, 0.f);
        if (nsrc0 >= 0) v[i] = *(const float4*)(src + (size_t)(k0 + kr) * ldn + nsrc0 + nc4); }
#pragma unroll
    for (int i = 0; i < 8; ++i) { const int kr = kr0 + 32 * i; const float sc = scale ? scale[k0 + kr] : 1.0f; float* tp = tile + kr * 65 + nc4;
        tp[0] = v[i].x * sc; tp[1] = v[i].y * sc; tp[2] = v[i].z * sc; tp[3] = v[i].w * sc; }
    __syncthreads();
    const int nr = tid >> 3, kb = (tid & 7) * 8;
#pragma unroll
    for (int q = 0; q < 4; ++q) { const int kc = kb + 64 * q; uint4 w;
        w.x = cvt_pk_bf16(tile[(kc + 0) * 65 + nr], tile[(kc + 1) * 65 + nr]); w.y = cvt_pk_bf16(tile[(kc + 2) * 65 + nr], tile[(kc + 3) * 65 + nr]);
        w.z = cvt_pk_bf16(tile[(kc + 4) * 65 + nr], tile[(kc + 5) * 65 + nr]); w.w = cvt_pk_bf16(tile[(kc + 6) * 65 + nr], tile[(kc + 7) * 65 + nr]);
        *(uint4*)(dst + (size_t)(ndst0 + nr) * K + k0 + kc) = w; }
    __syncthreads();
}
constexpr int WT_IN = 1152, WT_ALL = 3776;
__device__ __forceinline__ void weight_tile(const Params& P, int id, float* tile) {
    unsigned char* ws = P.ws;
    if (id < 1152) { const int nt = id % 144, kt = id / 144; const int ns = nt < 55 ? nt * 64 : (nt == 55 ? -1 : nt * 64 - 64);
        tr_tile(P.in[2], 9152, ns, (u16*)(ws + WS_WIN), 2048, kt * 256, nt * 64, P.in[1], tile); }
    else if (id < 1152 + 1408) { const int j = id - 1152, nt = j % 176, kt = j / 176;
        tr_tile(P.in[20], NUP, nt * 64, (u16*)(ws + WS_WUP), 2048, kt * 256, nt * 64, P.in[19], tile); }
    else if (id < 2560 + 704) { const int j = id - 2560, nt = j % 32, kt = j / 32;
        tr_tile(P.in[23], 2048, nt * 64, (u16*)(ws + WS_WDOWN), 5632, kt * 256, nt * 64, nullptr, tile); }
    else if (id < 3264 + 128) { const int j = id - 3264, nt = j % 32, kt = j / 32;
        tr_tile(P.in[17], 2048, nt * 64, (u16*)(ws + WS_WBR1), 1024, kt * 256, nt * 64, nullptr, tile); }
    else if (id < 3392 + 128) { const int j = id - 3392, nt = j % 32, kt = j / 32;
        tr_tile(P.in[17] + (size_t)1024 * 2048, 2048, nt * 64, (u16*)(ws + WS_WBR2), 1024, kt * 256, nt * 64, nullptr, tile); }
    else { const int j = id - 3520, nt = j % 32, kt = j / 32;
        tr_tile(P.in[18], 2048, nt * 64, (u16*)(ws + WS_WOUT), 2048, kt * 256, nt * 64, nullptr, tile); }
}
__device__ void phase0(const Params& P, float* tile) {
    unsigned char* ws = P.ws; const int G = gridDim.x, bid = blockIdx.x, tid = threadIdx.x;
    for (int id = bid; id < WT_IN; id += G) weight_tile(P, id, tile);
    { u16* wl = (u16*)(ws + WS_WLORA);
      for (int idx = bid * 512 + tid; idx < 3072 * 512; idx += G * 512) { const int n = idx >> 9, k = idx & 511; float v = 0.f;
          if (n < 1024) { if (k < 96) v = P.in[5][(size_t)k * 1024 + n]; }
          else if (n < 2048) { if (k >= 96 && k < 192) v = P.in[7][(size_t)(k - 96) * 1024 + (n - 1024)]; }
          else { if (k >= 256) v = P.in[8][(size_t)(k - 256) * 1024 + (n - 2048)]; }
          wl[idx] = f2bf(v); } }
    { const int lane = tid & 63, gw = bid * 8 + (tid >> 6), nw = G * 8; u16* xb = (u16*)(ws + WS_Z + Z_TAIL); float* rstd1 = (float*)(ws + WS_SMALL);
      for (int t = gw; t < MT; t += nw) { const float4* xr = (const float4*)(P.in[0] + (size_t)t * DM); float ss = 0.f;
#pragma unroll
          for (int i = 0; i < 8; ++i) { const float4 v = xr[lane + 64 * i]; ss += v.x * v.x + v.y * v.y + v.z * v.z + v.w * v.w;
              uint2 w; w.x = cvt_pk_bf16(v.x, v.y); w.y = cvt_pk_bf16(v.z, v.w); *(uint2*)(xb + (size_t)t * DM + (lane + 64 * i) * 4) = w; }
          ss = wave_sum(ss); if (lane == 0) rstd1[t] = rsqrtf(ss * (1.0f / 2048.0f) + 1e-6f); } }
}

__device__ void phase2(const Params& P, u16* tile) {
    unsigned char* ws = P.ws; const int G = gridDim.x, bid = blockIdx.x, tid = threadIdx.x, lane = tid & 63;
    const u16* zmain = (const u16*)(ws + WS_Z + Z_MAIN);
    u16* rkv = (u16*)((unsigned char*)P.out + O_RKV); u16* Qn = (u16*)((unsigned char*)P.out + O_QN);
    u16* Ap = (u16*)(ws + WS_X + X_AP); u16* Kn = (u16*)(ws + WS_X + X_KN); u16* Vt = (u16*)(ws + WS_X + X_VT);
    const float* mu = P.in[3];
    const int d0 = (lane * 2) & 63; const float qg0 = P.in[14][d0] * 0.125f, qg1 = P.in[14][d0 + 1] * 0.125f, kg0 = P.in[15][d0], kg1 = P.in[15][d0 + 1];
    for (int t = bid * 8 + (tid >> 6); t < MT; t += G * 8) {
        const u16* zr = zmain + (size_t)t * ZM; const bool hp = (t & (SEQ - 1)) != 0; const u16* zp = hp ? zr - ZM : zr;
        unsigned zz[28], pp[28], qk[10]; float2 m2[28];
#pragma unroll
        for (int i = 0; i < 28; ++i) { const int c = i * 128 + lane * 2; zz[i] = 0u; pp[i] = 0u; m2[i] = make_float2(0.f, 0.f);
            if (i < 27 || lane < 32) { zz[i] = *(const unsigned*)(zr + c); pp[i] = *(const unsigned*)(zp + c); m2[i] = *(const float2*)(mu + c); } }
#pragma unroll
        for (int i = 0; i < 10; ++i) qk[i] = *(const unsigned*)(zr + 3584 + i * 128 + lane * 2);
#pragma unroll
        for (int i = 0; i < 28; ++i) { const int c = i * 128 + lane * 2;
            if (i < 27 || lane < 32) { const unsigned pv = hp ? pp[i] : 0u;
                const float z0 = bflo(zz[i]), z1 = bfhi(zz[i]); const float a0 = z0 + (bflo(pv) - z0) * m2[i].x, a1 = z1 + (bfhi(pv) - z1) * m2[i].y;
                if (i < 24) *(unsigned*)(rkv + (size_t)t * 3072 + c) = cvt_pk_bf16(a0, a1);
                else if (c < 3168) *(unsigned*)(Ap + (size_t)t * 512 + (c - 3072)) = cvt_pk_bf16(tanhf(a0), tanhf(a1));
                else if (c < 3264) *(unsigned*)(Ap + (size_t)t * 512 + 96 + (c - 3168)) = cvt_pk_bf16(a0, a1);
                else *(unsigned*)(Ap + (size_t)t * 512 + 256 + (c - 3264)) = cvt_pk_bf16(sigmoidf_(a0), sigmoidf_(a1)); } }
        if (lane < 32) *(unsigned*)(Ap + (size_t)t * 512 + 192 + lane * 2) = 0u;
#pragma unroll
        for (int i = 0; i < 10; ++i) { const float v0 = bflo(qk[i]), v1 = bfhi(qk[i]); float ss = row16_sum(v0 * v0 + v1 * v1); ss += __shfl_xor(ss, 16);
            const float rs = rsqrtf(ss * (1.0f / 64.0f) + 1e-6f);
            if (i < 8) *(unsigned*)(Qn + (size_t)t * 1024 + i * 128 + lane * 2) = cvt_pk_bf16(v0 * rs * qg0, v1 * rs * qg1);
            else *(unsigned*)(Kn + (size_t)t * 256 + (i - 8) * 128 + lane * 2) = cvt_pk_bf16(v0 * rs * kg0, v1 * rs * kg1); }
    }
    for (int tl = bid; tl < MT / 64; tl += G) { const int t0 = tl * 64;
        __syncthreads();
        for (int i = 0; i < 16; ++i) { const int idx = tid + 512 * i, r = idx >> 7, cp = idx & 127; const unsigned vv = *(const unsigned*)(zmain + (size_t)(t0 + r) * ZM + 4864 + 2 * cp);
            tile[(2 * cp) * 66 + r] = (u16)(vv & 0xffffu); tile[(2 * cp + 1) * 66 + r] = (u16)(vv >> 16); }
        __syncthreads();
        const int b = t0 >> 12, s0 = t0 & (SEQ - 1);
        for (int i = 0; i < 16; ++i) { const int idx = tid + 512 * i, c = idx >> 5, sp = idx & 31;
            const unsigned w = (unsigned)tile[c * 66 + 2 * sp] | ((unsigned)tile[c * 66 + 2 * sp + 1] << 16);
            *(unsigned*)(Vt + ((size_t)(b * 4 + (c >> 6)) * 64 + (c & 63)) * SEQ + s0 + 2 * sp) = w; }
    }
}

constexpr int NS = 4, NSCAN = 32 * NS, TCH = 64, VR = 64 / NS;
__device__ void scan_phase(const Params& P, float* L) {
    unsigned char* ws = P.ws; const int bid = blockIdx.x, tid = threadIdx.x, lane = tid & 63, w = tid >> 6;
    const int hb = bid / NS, vs = bid % NS, b = hb >> 4, h = hb & 15;
    const u16* rkv = (const u16*)((unsigned char*)P.out + O_RKV);
    const float* lwp = (const float*)(ws + WS_Z + Z_LW); const float* ap = (const float*)(ws + WS_Z + Z_A);
    u16* yraw = (u16*)(ws + WS_Y);
    float* R = L; float* Kp = L + 4224; float* Wd = L + 8448; float* KK = L + 12672; float* Bv = L + 16896; float* Vv = L + 21120; float* Yb = L + 22176; float* DUM = L + 23200;
    const int tl = tid >> 3, c8 = (tid & 7) * 8, v2 = (tid & 7) * 2;
    float kkw[8], kaw[8];
#pragma unroll
    for (int j = 0; j < 8; ++j) { kkw[j] = P.in[9][h * 64 + c8 + j]; kaw[j] = P.in[10][h * 64 + c8 + j]; }
    const int vl = lane >> 4, kg = lane & 15, row = (w & 3) * 4 + vl;
    float s0 = 0.f, s1 = 0.f, s2 = 0.f, s3 = 0.f;
    uint4 r8, k8; float4 lw0, lw1, a0, a1; unsigned vv2;
    auto prefetch = [&](int ci) { const size_t t = (size_t)b * SEQ + ci * TCH + tl;
        r8 = *(const uint4*)(rkv + t * 3072 + h * 64 + c8); k8 = *(const uint4*)(rkv + t * 3072 + 1024 + h * 64 + c8);
        vv2 = *(const unsigned*)(rkv + t * 3072 + 2048 + h * 64 + vs * VR + v2);
        lw0 = *(const float4*)(lwp + t * RWD + h * 64 + c8); lw1 = *(const float4*)(lwp + t * RWD + h * 64 + c8 + 4);
        a0 = *(const float4*)(ap + t * RWD + h * 64 + c8); a1 = *(const float4*)(ap + t * RWD + h * 64 + c8 + 4); };
    prefetch(0);
    for (int ci = 0; ci < SEQ / TCH; ++ci) {
        __syncthreads();
        if (ci > 0) { const size_t t = (size_t)b * SEQ + (ci - 1) * TCH + tl; *(unsigned*)(yraw + t * RWD + h * 64 + vs * VR + v2) = cvt_pk_bf16(Yb[tl * VR + v2], Yb[tl * VR + v2 + 1]); }
        { float rr[8], kk_[8], aa[8], ll[8];
          rr[0] = bflo(r8.x); rr[1] = bfhi(r8.x); rr[2] = bflo(r8.y); rr[3] = bfhi(r8.y); rr[4] = bflo(r8.z); rr[5] = bfhi(r8.z); rr[6] = bflo(r8.w); rr[7] = bfhi(r8.w);
          kk_[0] = bflo(k8.x); kk_[1] = bfhi(k8.x); kk_[2] = bflo(k8.y); kk_[3] = bfhi(k8.y); kk_[4] = bflo(k8.z); kk_[5] = bfhi(k8.z); kk_[6] = bflo(k8.w); kk_[7] = bfhi(k8.w);
          aa[0] = a0.x; aa[1] = a0.y; aa[2] = a0.z; aa[3] = a0.w; aa[4] = a1.x; aa[5] = a1.y; aa[6] = a1.z; aa[7] = a1.w;
          ll[0] = lw0.x; ll[1] = lw0.y; ll[2] = lw0.z; ll[3] = lw0.w; ll[4] = lw1.x; ll[5] = lw1.y; ll[6] = lw1.z; ll[7] = lw1.w;
          float q[8]; float ss = 0.f;
#pragma unroll
          for (int j = 0; j < 8; ++j) { q[j] = kk_[j] * kkw[j]; ss += q[j] * q[j]; }
          ss += __shfl_xor(ss, 1); ss += __shfl_xor(ss, 2); ss += __shfl_xor(ss, 4);
          const float inv = 1.0f / fmaxf(sqrtf(ss), 1e-12f);
#pragma unroll
          for (int j = 0; j < 8; ++j) { const float kkn = q[j] * inv; const int o = tl * 64 + c8 + j;
              R[o] = rr[j]; Kp[o] = kk_[j] * (1.0f + (aa[j] - 1.0f) * kaw[j]); Wd[o] = __expf(ll[j]); KK[o] = kkn; Bv[o] = kkn * aa[j]; }
          float* vp = Vv + tl * VR + v2; vp[0] = bflo(vv2); vp[1] = bfhi(vv2); }
        __syncthreads();
        if (ci + 1 < SEQ / TCH) prefetch(ci + 1);
        if (w < 4) {
            typedef float f2 __attribute__((ext_vector_type(2)));
            struct Ops { f2 kkA, kkB, wA, wB, bA, bB, kA, kB, rA, rB; float v; };
            const float* pk_ = KK + 4 * kg; const float* pw_ = Wd + 4 * kg; const float* pb_ = Bv + 4 * kg; const float* pp_ = Kp + 4 * kg; const float* pr_ = R + 4 * kg; const float* pv_ = Vv + row;
            float* ys = (kg == 0) ? (Yb + row) : (DUM + lane);
#define SCAN_LOAD(D, T) do { const int _o = (T) * 64; D.kkA = *(const f2*)(pk_ + _o); D.kkB = *(const f2*)(pk_ + _o + 2); D.wA = *(const f2*)(pw_ + _o); D.wB = *(const f2*)(pw_ + _o + 2); \
                D.bA = *(const f2*)(pb_ + _o); D.bB = *(const f2*)(pb_ + _o + 2); D.kA = *(const f2*)(pp_ + _o); D.kB = *(const f2*)(pp_ + _o + 2); \
                D.rA = *(const f2*)(pr_ + _o); D.rB = *(const f2*)(pr_ + _o + 2); D.v = pv_[(T) * VR]; } while (0)
            Ops c, n1, n2; SCAN_LOAD(c, 0); SCAN_LOAD(n1, 1);
            f2 sA = {s0, s1}, sB = {s2, s3};
#pragma unroll 8
            for (int t = 0; t < TCH; ++t) {
                SCAN_LOAD(n2, t + 2);
                f2 p = sA * c.kkA; p = sB * c.kkB + p;
                const f2 cvv = {c.v, c.v};
                const f2 preA = sA * c.wA + cvv * c.kA, preB = sB * c.wB + cvv * c.kB;
                const float sa = -row16_sum(p.x + p.y); const f2 saa = {sa, sa};
                sA = saa * c.bA + preA; sB = saa * c.bB + preB;
                f2 q = sA * c.rA; q = sB * c.rB + q;
                ys[t * VR] = row16_sum(q.x + q.y);
                c = n1; n1 = n2;
            }
#undef SCAN_LOAD
            s0 = sA.x; s1 = sA.y; s2 = sB.x; s3 = sB.y;
        }
    }
    __syncthreads();
    { const size_t t = (size_t)b * SEQ + (SEQ / TCH - 1) * TCH + tl; *(unsigned*)(yraw + t * RWD + h * 64 + vs * VR + v2) = cvt_pk_bf16(Yb[tl * VR + v2], Yb[tl * VR + v2 + 1]); }
}

__device__ void attn_phase(const Params& P) {
    unsigned char* ws = P.ws; const int tid = threadIdx.x, lane = tid & 63, fr = lane & 15, fq = lane >> 4;
    const u16* Qn = (const u16*)((unsigned char*)P.out + O_QN); const u16* Kn = (const u16*)(ws + WS_X + X_KN); const u16* Vt = (const u16*)(ws + WS_X + X_VT);
    u16* oatt = (u16*)(ws + WS_X + X_OATT);
    const int NA = (int)gridDim.x - NSCAN; const int gw = ((int)blockIdx.x - NSCAN) * 8 + (tid >> 6);
    for (int unit = gw; unit < 8192; unit += NA * 8) {
        const int h = unit & 15, st = (unit >> 4) & 255, b = unit >> 12, kh = h >> 2;
        const int s0 = st * 16; const size_t t0 = (size_t)b * SEQ + s0;
        const float slope = exp2f(-0.5f * (float)(h + 1)), sink = P.in[16][h];
        bf16x8 qf[2];
        qf[0] = *(const bf16x8*)(Qn + (t0 + fr) * 1024 + h * 64 + 8 * fq); qf[1] = *(const bf16x8*)(Qn + (t0 + fr) * 1024 + h * 64 + 32 + 8 * fq);
        f32x4 sc[10]; float mx = sink;
#pragma unroll
        for (int kt = 0; kt < 10; ++kt) { const int ks0 = s0 - 144 + 16 * kt; int kp = ks0 + fr; kp = kp < 0 ? 0 : kp;
            const u16* kr = Kn + ((size_t)b * SEQ + kp) * 256 + kh * 64 + 8 * fq;
            const bf16x8 k0 = *(const bf16x8*)kr, k1 = *(const bf16x8*)(kr + 32);
            f32x4 a = {0.f, 0.f, 0.f, 0.f};
            a = __builtin_amdgcn_mfma_f32_16x16x32_bf16(k0, qf[0], a, 0, 0, 0); a = __builtin_amdgcn_mfma_f32_16x16x32_bf16(k1, qf[1], a, 0, 0, 0);
#pragma unroll
            for (int j = 0; j < 4; ++j) { const int kpos = ks0 + 4 * fq + j; const int dist = s0 + fr - kpos; const bool valid = (dist >= 0) && (dist < 128) && (kpos >= 0);
                const float v = valid ? a[j] - slope * (float)dist : -1e30f; a[j] = v; mx = fmaxf(mx, v); }
            sc[kt] = a; }
        mx = fmaxf(mx, __shfl_xor(mx, 16)); mx = fmaxf(mx, __shfl_xor(mx, 32));
        float sum = 0.f;
#pragma unroll
        for (int kt = 0; kt < 10; ++kt)
#pragma unroll
            for (int j = 0; j < 4; ++j) { const float e = __expf(sc[kt][j] - mx); sc[kt][j] = e; sum += e; }
        sum += __shfl_xor(sum, 16); sum += __shfl_xor(sum, 32);
        const float inv = 1.0f / (sum + __expf(sink - mx));
        f32x4 o[4];
#pragma unroll
        for (int dt = 0; dt < 4; ++dt) o[dt] = (f32x4){0.f, 0.f, 0.f, 0.f};
#pragma unroll
        for (int u = 0; u < 5; ++u) {
            union { bf16x8 v; unsigned w[4]; } pf;
            pf.w[0] = cvt_pk_bf16(sc[2 * u][0] * inv, sc[2 * u][1] * inv); pf.w[1] = cvt_pk_bf16(sc[2 * u][2] * inv, sc[2 * u][3] * inv);
            pf.w[2] = cvt_pk_bf16(sc[2 * u + 1][0] * inv, sc[2 * u + 1][1] * inv); pf.w[3] = cvt_pk_bf16(sc[2 * u + 1][2] * inv, sc[2 * u + 1][3] * inv);
            int ka = s0 - 144 + 32 * u + 4 * fq, kb = ka + 16; ka = ka < 0 ? 0 : ka; kb = kb < 0 ? 0 : kb;
#pragma unroll
            for (int dt = 0; dt < 4; ++dt) { const u16* vr = Vt + ((size_t)(b * 4 + kh) * 64 + dt * 16 + fr) * SEQ;
                union { bf16x8 v; uint2 w[2]; } vf; vf.w[0] = *(const uint2*)(vr + ka); vf.w[1] = *(const uint2*)(vr + kb);
                o[dt] = __builtin_amdgcn_mfma_f32_16x16x32_bf16(pf.v, vf.v, o[dt], 0, 0, 0); } }
#pragma unroll
        for (int dt = 0; dt < 4; ++dt)
#pragma unroll
            for (int j = 0; j < 4; ++j) oatt[(t0 + 4 * fq + j) * 1024 + h * 64 + dt * 16 + fr] = f2bf(o[dt][j]);
    }
}

__device__ void phase5(const Params& P) {
    unsigned char* ws = P.ws; const int G = gridDim.x, bid = blockIdx.x, tid = threadIdx.x, lane = tid & 63;
    const u16* rkv = (const u16*)((unsigned char*)P.out + O_RKV); u16* orw = (u16*)((unsigned char*)P.out + O_QN);
    const u16* yraw = (const u16*)(ws + WS_Y); const float* ap = (const float*)(ws + WS_Z + Z_A); const u16* gp = (const u16*)(ws + WS_Z + Z_G);
    for (int t = bid * 8 + (tid >> 6); t < MT; t += G * 8) {
        float4 y4[4], a4[4]; uint2 r2[4], k2[4], v2[4], g2[4];
#pragma unroll
        for (int it = 0; it < 4; ++it) { const int hc = (it * 4 + (lane >> 4)) * 64 + (lane & 15) * 4; const size_t o = (size_t)t * RWD + hc;
            { const uint2 yb = *(const uint2*)(yraw + o); y4[it] = make_float4(bflo(yb.x), bfhi(yb.x), bflo(yb.y), bfhi(yb.y)); } a4[it] = *(const float4*)(ap + o); g2[it] = *(const uint2*)(gp + o);
            r2[it] = *(const uint2*)(rkv + (size_t)t * 3072 + hc); k2[it] = *(const uint2*)(rkv + (size_t)t * 3072 + 1024 + hc); v2[it] = *(const uint2*)(rkv + (size_t)t * 3072 + 2048 + hc); }
#pragma unroll
        for (int it = 0; it < 4; ++it) { const int hc = (it * 4 + (lane >> 4)) * 64 + (lane & 15) * 4; const size_t o = (size_t)t * RWD + hc;
            const float4 gw = *(const float4*)(P.in[12] + hc), gb = *(const float4*)(P.in[13] + hc), ka = *(const float4*)(P.in[10] + hc), rkw = *(const float4*)(P.in[11] + hc);
            const float4 y = y4[it], a = a4[it];
            const float mu = row16_sum((y.x + y.y) + (y.z + y.w)) * (1.0f / 64.0f);
            const float dx = y.x - mu, dy = y.y - mu, dz = y.z - mu, dw = y.w - mu;
            const float var = row16_sum((dx * dx + dy * dy) + (dz * dz + dw * dw)) * (1.0f / 64.0f); const float rs = rsqrtf(var + 64e-5f);
            const float r0 = bflo(r2[it].x), r1 = bfhi(r2[it].x), r2_ = bflo(r2[it].y), r3 = bfhi(r2[it].y);
            const float k0 = bflo(k2[it].x) * (1.0f + (a.x - 1.0f) * ka.x), k1 = bfhi(k2[it].x) * (1.0f + (a.y - 1.0f) * ka.y), k2_ = bflo(k2[it].y) * (1.0f + (a.z - 1.0f) * ka.z), k3 = bfhi(k2[it].y) * (1.0f + (a.w - 1.0f) * ka.w);
            const float rk = row16_sum((r0 * k0 * rkw.x + r1 * k1 * rkw.y) + (r2_ * k2_ * rkw.z + r3 * k3 * rkw.w));
            const float o0 = (dx * rs * gw.x + gb.x + rk * bflo(v2[it].x)) * bflo(g2[it].x), o1 = (dy * rs * gw.y + gb.y + rk * bfhi(v2[it].x)) * bfhi(g2[it].x);
            const float o2 = (dz * rs * gw.z + gb.z + rk * bflo(v2[it].y)) * bflo(g2[it].y), o3 = (dw * rs * gw.w + gb.w + rk * bfhi(v2[it].y)) * bfhi(g2[it].y);
            uint2 w; w.x = cvt_pk_bf16(o0, o1); w.y = cvt_pk_bf16(o2, o3); *(uint2*)(orw + o) = w; }
    }
}

__device__ void phase9(const Params& P) {
    unsigned char* ws = P.ws; const u16* uu = (const u16*)(ws + WS_Z); u16* act = (u16*)(ws + WS_ACT);
    const float* cw = P.in[21]; const float* cb = P.in[22];
    const int nth = gridDim.x * 512;
    for (int task = blockIdx.x * 512 + threadIdx.x; task < 1024 * 1408; task += nth) {
        const int j0 = (task % 1408) * 4, t0 = (task / 1408) * 8; const bool first = (t0 & (SEQ - 1)) == 0;
        uint2 ra[10], rg[10];
#pragma unroll
        for (int r = 0; r < 10; ++r) { const int t = (first && r < 2) ? t0 : t0 - 2 + r; ra[r] = *(const uint2*)(uu + (size_t)t * NUP + j0); rg[r] = *(const uint2*)(uu + (size_t)t * NUP + DFF + j0); }
        if (first) { ra[0] = make_uint2(0u, 0u); ra[1] = ra[0]; rg[0] = ra[0]; rg[1] = ra[0]; }
        const float4 wa0 = *(const float4*)(cw + j0), wa1 = *(const float4*)(cw + NUP + j0), wa2 = *(const float4*)(cw + 2 * NUP + j0), ba = *(const float4*)(cb + j0);
        const float4 wg0 = *(const float4*)(cw + DFF + j0), wg1 = *(const float4*)(cw + NUP + DFF + j0), wg2 = *(const float4*)(cw + 2 * NUP + DFF + j0), bg = *(const float4*)(cb + DFF + j0);
#pragma unroll
        for (int i = 0; i < 8; ++i) {
            const float cv0 = bflo(ra[i].x) * wa0.x + bflo(ra[i + 1].x) * wa1.x + bflo(ra[i + 2].x) * wa2.x + ba.x, cv1 = bfhi(ra[i].x) * wa0.y + bfhi(ra[i + 1].x) * wa1.y + bfhi(ra[i + 2].x) * wa2.y + ba.y;
            const float cv2 = bflo(ra[i].y) * wa0.z + bflo(ra[i + 1].y) * wa1.z + bflo(ra[i + 2].y) * wa2.z + ba.z, cv3 = bfhi(ra[i].y) * wa0.w + bfhi(ra[i + 1].y) * wa1.w + bfhi(ra[i + 2].y) * wa2.w + ba.w;
            const float cg0 = bflo(rg[i].x) * wg0.x + bflo(rg[i + 1].x) * wg1.x + bflo(rg[i + 2].x) * wg2.x + bg.x, cg1 = bfhi(rg[i].x) * wg0.y + bfhi(rg[i + 1].x) * wg1.y + bfhi(rg[i + 2].x) * wg2.y + bg.y;
            const float cg2 = bflo(rg[i].y) * wg0.z + bflo(rg[i + 1].y) * wg1.z + bflo(rg[i + 2].y) * wg2.z + bg.z, cg3 = bfhi(rg[i].y) * wg0.w + bfhi(rg[i + 1].y) * wg1.w + bfhi(rg[i + 2].y) * wg2.w + bg.w;
            uint2 w; w.x = cvt_pk_bf16(cg0 * sigmoidf_(cg0) * cv0, cg1 * sigmoidf_(cg1) * cv1); w.y = cvt_pk_bf16(cg2 * sigmoidf_(cg2) * cv2, cg3 * sigmoidf_(cg3) * cv3);
            *(uint2*)(act + (size_t)(t0 + i) * DFF + j0) = w; }
    }
}

constexpr int NPH = 11;
__global__ void __launch_bounds__(512, 2) mega(Params P) {
    extern __shared__ __attribute__((aligned(16))) unsigned char lds_raw[];
    cg::grid_group grid = cg::this_grid();
    LAS unsigned char* lds = (LAS unsigned char*)lds_raw;
    unsigned char* ws = P.ws;
#define RUN(i) ((i) >= P.ph_lo && (i) < P.ph_hi)
#define SEAM(i) do { if ((i) >= P.ph_lo && (i) + 1 < P.ph_hi) grid.sync(); } while (0)
    if (RUN(0)) phase0(P, (float*)lds_raw);
    SEAM(0);
    if (RUN(1)) { EpiZ E; E.zmain = (u16*)(ws + WS_Z + Z_MAIN); E.zgate = (u16*)(ws + WS_Z + Z_GATE); E.rstd = (const float*)(ws + WS_SMALL);
        run_gemm(lds, (const u16*)(ws + WS_Z + Z_TAIL), (const u16*)(ws + WS_WIN), 6144, 2048, E); }
    SEAM(1);
    if (RUN(2)) phase2(P, (u16*)lds_raw);
    SEAM(2);
    if (RUN(3)) { EpiLora E; E.lw = (float*)(ws + WS_Z + Z_LW); E.av = (float*)(ws + WS_Z + Z_A); E.g = (u16*)(ws + WS_Z + Z_G); E.w0 = P.in[4]; E.a0 = P.in[6];
        run_gemm(lds, (const u16*)(ws + WS_X + X_AP), (const u16*)(ws + WS_WLORA), 3072, 512, E); }
    SEAM(3);
    if (RUN(4)) { if ((int)blockIdx.x < NSCAN) scan_phase(P, (float*)lds_raw);
        else { attn_phase(P); __syncthreads();
            { EpiZG E; E.zgate = (u16*)(ws + WS_Z + Z_GATE); E.rstd = (const float*)(ws + WS_SMALL);
              run_gemm_sub(lds, (const u16*)(ws + WS_Z + Z_TAIL), (const u16*)(ws + WS_WIN) + (size_t)6144 * 2048, 3072, 2048, E, (int)gridDim.x - NSCAN, (int)blockIdx.x - NSCAN); }
            for (int id = WT_IN + ((int)blockIdx.x - NSCAN); id < WT_ALL; id += (int)gridDim.x - NSCAN) weight_tile(P, id, (float*)lds_raw); } }
    SEAM(4);
    if (RUN(5)) phase5(P);
    SEAM(5);
    if (RUN(6)) {
        { EpiBranch<0> E; E.mixed = (u16*)(ws + WS_Z); E.zgate = (const u16*)(ws + WS_Z + Z_GATE);
          run_gemm(lds, (const u16*)((unsigned char*)P.out + O_QN), (const u16*)(ws + WS_WBR1), 2048, 1024, E); }
        { EpiBranch<1> E; E.mixed = (u16*)(ws + WS_Z); E.zgate = (const u16*)(ws + WS_Z + Z_GATE);
          run_gemm(lds, (const u16*)(ws + WS_X + X_OATT), (const u16*)(ws + WS_WBR2), 2048, 1024, E); } }
    SEAM(6);
    if (RUN(7)) { EpiOut1 E; E.x = P.in[0]; E.x1 = P.out; E.x1b = (u16*)(ws + WS_X); E.rowss = (float*)(ws + WS_SMALL + 32768);
        run_gemm(lds, (const u16*)(ws + WS_Z), (const u16*)(ws + WS_WOUT), 2048, 2048, E); }
    SEAM(7);
    if (RUN(8)) { EpiUp E; E.uo = (u16*)(ws + WS_Z); E.rowss = (const float*)(ws + WS_SMALL + 32768);
        run_gemm(lds, (const u16*)(ws + WS_X), (const u16*)(ws + WS_WUP), NUP, 2048, E); }
    SEAM(8);
    if (RUN(9)) phase9(P);
    SEAM(9);
    if (RUN(10)) { EpiFinal E; E.out = P.out;
        run_gemm(lds, (const u16*)(ws + WS_ACT), (const u16*)(ws + WS_WDOWN), 2048, DFF, E); }
}

constexpr int LDS_BYTES = 131072;
extern "C" void kernel_launch(void* const* d_in, const int* in_sizes, int n_in, void* d_out, int out_size, void* d_ws, size_t ws_size, hipStream_t stream) {
    static int grid = 0;
    if (grid == 0) {
        if (n_in != 24 || out_size != MT * DM || ws_size < WS_END) { fprintf(stderr, "kernel_launch: unexpected shapes (n_in %d out %d ws %zu need %zu)\n", n_in, out_size, ws_size, (size_t)WS_END); grid = -1; return; }
        int dev = 0, cus = 0, per_cu = 0;
        hipGetDevice(&dev); hipDeviceGetAttribute(&cus, hipDeviceAttributeMultiprocessorCount, dev);
        if (hipFuncSetAttribute((const void*)mega, hipFuncAttributeMaxDynamicSharedMemorySize, LDS_BYTES) != hipSuccess) { fprintf(stderr, "kernel_launch: hipFuncSetAttribute failed\n"); grid = -1; return; }
        if (hipOccupancyMaxActiveBlocksPerMultiprocessor(&per_cu, (const void*)mega, 512, LDS_BYTES) != hipSuccess || per_cu < 1) { fprintf(stderr, "kernel_launch: occupancy query failed (%d)\n", per_cu); grid = -1; return; }
        grid = cus * per_cu; if (grid > 256) grid = 256;
        if (grid < 2 * NSCAN) { fprintf(stderr, "kernel_launch: grid %d too small\n", grid); grid = -1; return; }
    }
    if (grid < 0) return;
    Params p{};
    for (int i = 0; i < 24; ++i) p.in[i] = (const float*)d_in[i];
    p.out = (float*)d_out; p.ws = (unsigned char*)d_ws;
#ifndef SPLIT_LAUNCH
    p.ph_lo = 0; p.ph_hi = NPH;
    { void* args[] = {&p}; hipError_t e = hipLaunchCooperativeKernel((const void*)mega, dim3(grid), dim3(512), args, LDS_BYTES, stream);
      if (e != hipSuccess) fprintf(stderr, "cooperative launch failed: %s (grid %d)\n", hipGetErrorString(e), grid); }
#else
    for (int ph = 0; ph < NPH; ++ph) { p.ph_lo = ph; p.ph_hi = ph + 1; void* args[] = {&p};
        hipError_t e = hipLaunchCooperativeKernel((const void*)mega, dim3(grid), dim3(512), args, LDS_BYTES, stream);
        if (e != hipSuccess) fprintf(stderr, "cooperative launch failed: %s (grid %d)\n", hipGetErrorString(e), grid); }
#endif
}
```

```cpp
#include <hip/hip_runtime.h>
#include <hip/hip_cooperative_groups.h>
#include <cstdio>
#include <cstdint>
namespace cg = cooperative_groups;
namespace pg8 {
#define PG8_LAS __attribute__((address_space(3)))
typedef unsigned short bf16_t;
typedef short bf16x8 __attribute__((ext_vector_type(8)));
typedef float f32x4 __attribute__((ext_vector_type(4)));
typedef unsigned u32x4 __attribute__((ext_vector_type(4)));
constexpr int BM = 256, BK = 64, HALF = 128, HTB = HALF * BK * 2  , STAGE_BYTES = 8 * HTB, NXCD = 8, WGM = 8;

__host__ __device__ __forceinline__ int lds_byte(int r, int c) { const int st = (r >> 4) * 2 + (c >> 5), rr = r & 15, cc = c & 31, ob = rr * 64 + cc * 2; return st * 1024 + (ob ^ (((ob >> 9) & 1) << 5)); }
__host__ __device__ __forceinline__ void stage_rc(int b, int& R, int& C) { const int st = b / 1024, sb = b % 1024, swz = sb ^ (((sb >> 9) & 1) << 5); R = (st >> 1) * 16 + swz / 64; C = (st & 1) * 32 + (swz % 64) / 2; }
__host__ __device__ __forceinline__ int perm32(int rho) { const int n = rho >> 4, i = rho & 15; return 8 * (i >> 2) + 4 * n + (i & 3); }

struct Unit { int pm, pn; };
struct Gemm { const bf16_t* A; const bf16_t* Bt; int M, N, K; };

struct StaticOrder {
    int nM, nN, nwg, G, c;
    __host__ __device__ void init(int M, int N, int G_, int c_) { nM = M / BM; nN = N / BM; nwg = nM * nN; G = G_; c = c_; }
    __host__ __device__ bool next(int i, Unit& u) const {
        const long L = (long)i * G + c; if (L >= nwg) return false;
        int wgid = (int)L; { const int q = nwg / NXCD, r = nwg % NXCD, xcd = wgid % NXCD, off = wgid / NXCD; wgid = (xcd < r ? xcd * (q + 1) : r * (q + 1) + (xcd - r) * q) + off; }
        const int nig = WGM * nN, gid = wgid / nig, fm = gid * WGM, gsz = (nM - fm) < WGM ? (nM - fm) : WGM;
        u.pm = fm + ((wgid % nig) % gsz); u.pn = (wgid % nig) / gsz; return true;
    }
    __device__ __forceinline__ void a_ready(const Unit&) const {}
    __device__ __forceinline__ void done(const Unit&) const {}
};
typedef __bf16 bf16v2_t __attribute__((ext_vector_type(2))); typedef float f32v2_t __attribute__((ext_vector_type(2)));
__device__ __forceinline__ unsigned cvt_pk_bf16(float lo, float hi) { const f32v2_t x = {lo, hi}; const bf16v2_t r = __builtin_convertvector(x, bf16v2_t); return __builtin_bit_cast(unsigned, r); }
template <class Epi, class Sched>
__device__ __forceinline__ void gemm_phase(PG8_LAS unsigned char* lds, const Gemm g, const Sched& S, const Epi& E) {
    const int tid = threadIdx.x, wid = __builtin_amdgcn_readfirstlane(tid >> 6), lane = tid & 63, wr = wid >> 2, wc = wid & 3, fr = lane & 15, fq = lane >> 4;
    const int K = g.K, nt = K / BK;
    unsigned voffA[2], voffB[2];
#pragma unroll
    for (int i = 0; i < 2; ++i) { int R, C; stage_rc(tid * 16 + i * 8192, R, C); const int Rb = Epi::PERM ? ((R & ~31) + perm32(R & 31)) : R;
        voffA[i] = (unsigned)(R * K + C) * 2u; voffB[i] = (unsigned)(Rb * K + C) * 2u; }
    const size_t kstep = (size_t)(BK * 2);
    const size_t hstep = (size_t)HALF * K * 2;
    const size_t tstep = 2 * hstep;
    const unsigned ldsw = (unsigned)wid * 1024u;
    const int aoff = lds_byte(wr * 64 + fr, fq * 8), boff = lds_byte(wc * 32 + fr, fq * 8);
#define PG8_SA(b, h) (((b) * 2 + (h)) * HTB)
#define PG8_SB(b, h) ((4 + (b) * 2 + (h)) * HTB)
#define PG8_STAGE(bufoff, gbase, voff) do { _Pragma("unroll") for (int _i = 0; _i < 2; ++_i) \
        __builtin_amdgcn_global_load_lds((const unsigned*)((const char*)(gbase) + (voff)[_i]), (PG8_LAS unsigned*)(lds + (bufoff) + ldsw + _i * 8192), 16, 0, 0); } while (0)
#define PG8_LDA(dst, b, h) do { _Pragma("unroll") for (int m = 0; m < 4; ++m) _Pragma("unroll") for (int k = 0; k < 2; ++k) dst[m][k] = *(const PG8_LAS bf16x8*)(lds + PG8_SA(b, h) + aoff + m * 2048 + k * 1024); } while (0)
#define PG8_LDB(dst, b, h) do { _Pragma("unroll") for (int n = 0; n < 2; ++n) _Pragma("unroll") for (int k = 0; k < 2; ++k) dst[n][k] = *(const PG8_LAS bf16x8*)(lds + PG8_SB(b, h) + boff + n * 2048 + k * 1024); } while (0)
#define PG8_MMA(ai, bj, At, Bt) do { __builtin_amdgcn_s_setprio(1); _Pragma("unroll") for (int m = 0; m < 4; ++m) _Pragma("unroll") for (int n = 0; n < 2; ++n) _Pragma("unroll") for (int k = 0; k < 2; ++k) \
        acc[ai][bj][m][n] = __builtin_amdgcn_mfma_f32_16x16x32_bf16(Bt[n][k], At[m][k], acc[ai][bj][m][n], 0, 0, 0); __builtin_amdgcn_s_setprio(0); } while (0)
#define PG8_WAIT_V(n) asm volatile("s_waitcnt vmcnt(" #n ")" ::: "memory")
#define PG8_WAIT_L(n) asm volatile("s_waitcnt lgkmcnt(" #n ")" ::: "memory")
#define PG8_BAR __builtin_amdgcn_s_barrier()
#define PG8_SCHED __builtin_amdgcn_sched_barrier(0)
    Unit cur, nxt; int ui = 0;
    if (!S.next(0, cur)) return;
    f32x4 acc[2][2][4][2];
#pragma unroll
    for (int a = 0; a < 2; ++a)
#pragma unroll
        for (int b = 0; b < 2; ++b)
#pragma unroll
            for (int m = 0; m < 4; ++m)
#pragma unroll
                for (int n = 0; n < 2; ++n) acc[a][b][m][n] = (f32x4){0.f, 0.f, 0.f, 0.f};
    bf16x8 At[4][2], B0[2][2], B1[2][2];
    const char* cA = (const char*)g.A + (size_t)cur.pm * tstep; const char* cB = (const char*)g.Bt + (size_t)cur.pn * tstep;
    S.a_ready(cur);
    PG8_STAGE(PG8_SB(0, 0), cB, voffB); PG8_STAGE(PG8_SA(0, 0), cA, voffA); PG8_STAGE(PG8_SB(0, 1), cB + hstep, voffB); PG8_STAGE(PG8_SA(0, 1), cA + hstep, voffA);
    if (wr == 1) PG8_BAR;
    PG8_WAIT_V(4); PG8_BAR;
    PG8_STAGE(PG8_SB(1, 0), cB + kstep, voffB); PG8_STAGE(PG8_SA(1, 0), cA + kstep, voffA); PG8_STAGE(PG8_SB(1, 1), cB + hstep + kstep, voffB);
    PG8_WAIT_V(6); PG8_BAR;
    for (;;) {
        const bool has_next = S.next(ui + 1, nxt);
        const char* nA = has_next ? (const char*)g.A + (size_t)nxt.pm * tstep : cA; const char* nB = has_next ? (const char*)g.Bt + (size_t)nxt.pn * tstep : cB;
        for (int t = 0; t < nt; t += 2) {
            const bool last = (t == nt - 2);
            const char* a1 = cA + (size_t)(t + 1) * kstep;
            const char* a2 = last ? nA : cA + (size_t)(t + 2) * kstep; const char* b2 = last ? nB : cB + (size_t)(t + 2) * kstep;
            const char* a3 = a2 + kstep; const char* b3 = b2 + kstep;
            if (last && has_next) S.a_ready(nxt);
            PG8_LDB(B0, 0, 0); PG8_SCHED; PG8_LDA(At, 0, 0); PG8_STAGE(PG8_SA(1, 1), a1 + hstep, voffA);
            PG8_WAIT_L(8); PG8_BAR; PG8_WAIT_L(0); PG8_MMA(0, 0, At, B0); PG8_BAR; PG8_SCHED;
            PG8_LDB(B1, 0, 1); PG8_STAGE(PG8_SB(0, 0), b2, voffB);
            PG8_BAR; PG8_WAIT_L(0); PG8_MMA(0, 1, At, B1); PG8_BAR;
            PG8_LDA(At, 0, 1); PG8_STAGE(PG8_SA(0, 0), a2, voffA);
            PG8_BAR; PG8_WAIT_L(0); PG8_MMA(1, 0, At, B0); PG8_BAR; PG8_SCHED;
            PG8_STAGE(PG8_SB(0, 1), b2 + hstep, voffB);
            PG8_WAIT_V(6); PG8_BAR; PG8_MMA(1, 1, At, B1); PG8_BAR;
            PG8_LDB(B0, 1, 0); PG8_SCHED; PG8_LDA(At, 1, 0); PG8_STAGE(PG8_SA(0, 1), a2 + hstep, voffA);
            PG8_WAIT_L(8); PG8_BAR; PG8_WAIT_L(0); PG8_MMA(0, 0, At, B0); PG8_BAR; PG8_SCHED;
            PG8_LDB(B1, 1, 1); PG8_STAGE(PG8_SB(1, 0), b3, voffB);
            PG8_BAR; PG8_WAIT_L(0); PG8_MMA(0, 1, At, B1); PG8_BAR;
            PG8_LDA(At, 1, 1); PG8_STAGE(PG8_SA(1, 0), a3, voffA);
            PG8_BAR; PG8_WAIT_L(0); PG8_MMA(1, 0, At, B0); PG8_BAR; PG8_SCHED;
            PG8_STAGE(PG8_SB(1, 1), b3 + hstep, voffB);
            PG8_WAIT_V(6); PG8_BAR; PG8_MMA(1, 1, At, B1); PG8_BAR;
        }
        if constexpr (!Epi::AFTER_DRAIN) { E(acc, cur, wr, wc, fr, fq); S.done(cur); }
        if (!has_next) break;
#pragma unroll
        for (int a = 0; a < 2; ++a)
#pragma unroll
            for (int b = 0; b < 2; ++b)
#pragma unroll
                for (int m = 0; m < 4; ++m)
#pragma unroll
                    for (int n = 0; n < 2; ++n) acc[a][b][m][n] = (f32x4){0.f, 0.f, 0.f, 0.f};
        cur = nxt; cA = nA; cB = nB; ++ui;
    }
    PG8_WAIT_V(0);
    if (wr == 0) PG8_BAR;
    PG8_BAR;
    if constexpr (Epi::AFTER_DRAIN) { E.fused(acc, cur, wr, wc, fr, fq, lds, wid, lane); S.done(cur); }
#undef PG8_SA
#undef PG8_SB
#undef PG8_STAGE
#undef PG8_LDA
#undef PG8_LDB
#undef PG8_MMA
#undef PG8_WAIT_V
#undef PG8_WAIT_L
#undef PG8_BAR
#undef PG8_SCHED
}
}

using pg8::f32x4; using pg8::bf16x8; using pg8::Unit; using pg8::cvt_pk_bf16;
typedef unsigned short u16;
#define LAS __attribute__((address_space(3)))

constexpr int MT = 8192, DM = 2048, SEQ = 4096, CH_ = 16;
constexpr int NZ = 9216, ZM = 5120, ZG = 4096, DFF = 5632, NUP = 11264, RWD = 1024;
constexpr size_t WS_WDOWN = 0;
constexpr size_t WS_WIN   = WS_WDOWN + (size_t)2048 * 5632 * 2;
constexpr size_t WS_WUP   = WS_WIN + (size_t)9216 * 2048 * 2;
constexpr size_t WS_WBR1  = WS_WUP + (size_t)11264 * 2048 * 2;
constexpr size_t WS_WBR2  = WS_WBR1 + (size_t)2048 * 1024 * 2;
constexpr size_t WS_WOUT  = WS_WBR2 + (size_t)2048 * 1024 * 2;
constexpr size_t WS_WLORA = WS_WOUT + (size_t)2048 * 2048 * 2;
constexpr size_t WS_Z     = WS_WLORA + (size_t)3072 * 512 * 2;
constexpr size_t Z_BYTES  = (size_t)MT * NUP * 2;
constexpr size_t WS_X     = WS_Z + Z_BYTES;
constexpr size_t WS_SMALL = WS_X + (size_t)MT * DM * 2;
constexpr size_t WS_Y     = WS_SMALL + 32768 + (size_t)MT * 32 * 4;
constexpr size_t WS_G     = WS_Y + (size_t)MT * 1024 * 2;
constexpr size_t WS_RK    = WS_G + (size_t)8192 * 64 * 4;
constexpr size_t WS_CNT   = WS_RK + (size_t)MT * 16 * 4;
constexpr size_t WS_BAR   = WS_CNT + 256;
constexpr size_t WS_END   = WS_BAR + 16384;
constexpr size_t WS_ACT   = WS_WIN;
static_assert(WS_Z - WS_WIN >= (size_t)MT * DFF * 2, "act overlay");
constexpr size_t Z_MAIN = 0, Z_GATE = (size_t)MT * ZM * 2, Z_TAIL = (size_t)MT * (ZM + ZG) * 2;
constexpr size_t Z_LW = 0, Z_A = (size_t)MT * RWD * 4, Z_G = 2 * (size_t)MT * RWD * 4;
constexpr size_t X_AP = 0, X_KN = (size_t)MT * 512 * 2, X_VT = X_KN + (size_t)MT * 256 * 2, X_OATT = X_VT + (size_t)MT * 256 * 2;
constexpr size_t O_RKV = 0, O_QN = (size_t)MT * 3072 * 2;

struct Params { const float* in[24]; float* out; unsigned char* ws; int ph_lo, ph_hi; };

__device__ __forceinline__ float bf2f(unsigned short b) { return __uint_as_float(((unsigned)b) << 16); }
__device__ __forceinline__ float bflo(unsigned u) { return __uint_as_float(u << 16); }
__device__ __forceinline__ float bfhi(unsigned u) { return __uint_as_float(u & 0xffff0000u); }
__device__ __forceinline__ u16 f2bf(float f) { return (u16)(cvt_pk_bf16(f, f) & 0xffffu); }
__device__ __forceinline__ float wave_sum(float v) {
#pragma unroll
    for (int o = 32; o; o >>= 1) v += __shfl_xor(v, o);
    return v; }
__device__ __forceinline__ float sigmoidf_(float x) { return 1.0f / (1.0f + __expf(-x)); }
template <int CTRL> __device__ __forceinline__ float dppf(float x) { return __int_as_float(__builtin_amdgcn_update_dpp(0, __float_as_int(x), CTRL, 0xF, 0xF, true)); }
__device__ __forceinline__ float row16_sum(float x) { x += dppf<0xB1>(x); x += dppf<0x4E>(x); x += dppf<0x141>(x); x += dppf<0x140>(x); return x; }

#define EPI_ROWS _Pragma("unroll") for (int ai = 0; ai < 2; ++ai) _Pragma("unroll") for (int m = 0; m < 4; ++m)
#define EPI_COLS _Pragma("unroll") for (int bj = 0; bj < 2; ++bj) _Pragma("unroll") for (int n = 0; n < 2; ++n)
struct EpiZ {
    static constexpr bool PERM = true, AFTER_DRAIN = false;
    u16* zmain; u16* zgate; const float* rstd;
    __device__ __forceinline__ void operator()(const f32x4 (&acc)[2][2][4][2], const Unit& u, int wr, int wc, int fr, int fq) const {
        u16* base; int ld, c0;
        if (u.pn < 20) { base = zmain; ld = ZM; c0 = u.pn * 256; } else { base = zgate; ld = ZG; c0 = (u.pn - 20) * 256; }
        const int row0 = u.pm * 256 + wr * 64 + fr; c0 += wc * 32 + 8 * fq;
        float rsv[2][4];
        EPI_ROWS rsv[ai][m] = rstd[row0 + ai * 128 + m * 16];
        EPI_ROWS { const int row = row0 + ai * 128 + m * 16; const float rs = rsv[ai][m]; u16* rp = base + (size_t)row * ld + c0;
#pragma unroll
            for (int bj = 0; bj < 2; ++bj) { const f32x4 v0 = acc[ai][bj][m][0] * rs, v1 = acc[ai][bj][m][1] * rs;
                uint4 w; w.x = cvt_pk_bf16(v0[0], v0[1]); w.y = cvt_pk_bf16(v0[2], v0[3]); w.z = cvt_pk_bf16(v1[0], v1[1]); w.w = cvt_pk_bf16(v1[2], v1[3]); *(uint4*)(rp + bj * 128) = w; } }
    }
};
struct EpiLora {
    static constexpr bool PERM = true, AFTER_DRAIN = false;
    float* lw; float* av; u16* g; const float* w0; const float* a0;
    __device__ __forceinline__ void operator()(const f32x4 (&acc)[2][2][4][2], const Unit& u, int wr, int wc, int fr, int fq) const {
        const int row0 = u.pm * 256 + wr * 64 + fr; const int kind = u.pn >> 2; const int c0 = (u.pn & 3) * 256 + wc * 32 + 8 * fq;
        if (kind == 0) {
            EPI_ROWS { const int row = row0 + ai * 128 + m * 16;
                EPI_COLS { const int col = c0 + bj * 128 + n * 4; const f32x4 v = acc[ai][bj][m][n]; const f32x4 b = *(const f32x4*)(w0 + col); f32x4 o;
#pragma unroll
                    for (int j = 0; j < 4; ++j) { const float y = -(b[j] + v[j]); const float sp = fmaxf(y, 0.f) + __logf(1.0f + __expf(-fabsf(y))); o[j] = -__expf(-sp - 0.5f); }
                    *(f32x4*)(lw + (size_t)row * RWD + col) = o; } }
        } else if (kind == 1) {
            EPI_ROWS { const int row = row0 + ai * 128 + m * 16;
                EPI_COLS { const int col = c0 + bj * 128 + n * 4; const f32x4 v = acc[ai][bj][m][n]; const f32x4 b = *(const f32x4*)(a0 + col); f32x4 o;
#pragma unroll
                    for (int j = 0; j < 4; ++j) o[j] = sigmoidf_(b[j] + v[j]);
                    *(f32x4*)(av + (size_t)row * RWD + col) = o; } }
        } else {
            EPI_ROWS { const int row = row0 + ai * 128 + m * 16;
#pragma unroll
                for (int bj = 0; bj < 2; ++bj) { const f32x4 v0 = acc[ai][bj][m][0], v1 = acc[ai][bj][m][1];
                    uint4 w; w.x = cvt_pk_bf16(v0[0], v0[1]); w.y = cvt_pk_bf16(v0[2], v0[3]); w.z = cvt_pk_bf16(v1[0], v1[1]); w.w = cvt_pk_bf16(v1[2], v1[3]); *(uint4*)(g + (size_t)row * RWD + c0 + bj * 128) = w; } }
        }
    }
};
template <int PASS> struct EpiBranch {
    static constexpr bool PERM = true, AFTER_DRAIN = false;
    u16* mixed; const u16* zgate;
    __device__ __forceinline__ void operator()(const f32x4 (&acc)[2][2][4][2], const Unit& u, int wr, int wc, int fr, int fq) const {
        const int row0 = u.pm * 256 + wr * 64 + fr; const int c0 = u.pn * 256 + wc * 32 + 8 * fq;
        EPI_ROWS { const int row = row0 + ai * 128 + m * 16;
#pragma unroll
            for (int bj = 0; bj < 2; ++bj) { const int col = c0 + bj * 128; const f32x4 v0 = acc[ai][bj][m][0], v1 = acc[ai][bj][m][1];
                const uint4 gz = *(const uint4*)(zgate + (size_t)row * ZG + PASS * 2048 + col);
                float o[8]; o[0] = sigmoidf_(bflo(gz.x)) * v0[0]; o[1] = sigmoidf_(bfhi(gz.x)) * v0[1]; o[2] = sigmoidf_(bflo(gz.y)) * v0[2]; o[3] = sigmoidf_(bfhi(gz.y)) * v0[3];
                o[4] = sigmoidf_(bflo(gz.z)) * v1[0]; o[5] = sigmoidf_(bfhi(gz.z)) * v1[1]; o[6] = sigmoidf_(bflo(gz.w)) * v1[2]; o[7] = sigmoidf_(bfhi(gz.w)) * v1[3];
                uint4* mp = (uint4*)(mixed + (size_t)row * DM + col);
                if (PASS == 1) { const uint4 pm = *mp; o[0] += bflo(pm.x); o[1] += bfhi(pm.x); o[2] += bflo(pm.y); o[3] += bfhi(pm.y); o[4] += bflo(pm.z); o[5] += bfhi(pm.z); o[6] += bflo(pm.w); o[7] += bfhi(pm.w); }
                uint4 w; w.x = cvt_pk_bf16(o[0], o[1]); w.y = cvt_pk_bf16(o[2], o[3]); w.z = cvt_pk_bf16(o[4], o[5]); w.w = cvt_pk_bf16(o[6], o[7]); *mp = w; } }
    }
};
struct EpiOut1 {
    static constexpr bool PERM = true, AFTER_DRAIN = false;
    const float* x; float* x1; u16* x1b; float* rowss;
    __device__ __forceinline__ void operator()(const f32x4 (&acc)[2][2][4][2], const Unit& u, int wr, int wc, int fr, int fq) const {
        const int row0 = u.pm * 256 + wr * 64 + fr; const int c0 = u.pn * 256 + wc * 32 + 8 * fq;
        EPI_ROWS { const int row = row0 + ai * 128 + m * 16; float ss = 0.f;
#pragma unroll
            for (int bj = 0; bj < 2; ++bj) { const size_t o = (size_t)row * DM + c0 + bj * 128;
                const f32x4 v0 = acc[ai][bj][m][0] + *(const f32x4*)(x + o), v1 = acc[ai][bj][m][1] + *(const f32x4*)(x + o + 4);
                *(f32x4*)(x1 + o) = v0; *(f32x4*)(x1 + o + 4) = v1;
                ss += (v0[0] * v0[0] + v0[1] * v0[1] + v0[2] * v0[2] + v0[3] * v0[3]) + (v1[0] * v1[0] + v1[1] * v1[1] + v1[2] * v1[2] + v1[3] * v1[3]);
                uint4 w; w.x = cvt_pk_bf16(v0[0], v0[1]); w.y = cvt_pk_bf16(v0[2], v0[3]); w.z = cvt_pk_bf16(v1[0], v1[1]); w.w = cvt_pk_bf16(v1[2], v1[3]); *(uint4*)(x1b + o) = w; }
            ss += __shfl_xor(ss, 16); ss += __shfl_xor(ss, 32);
            if (fq == 0) rowss[(size_t)row * 32 + u.pn * 4 + wc] = ss; }
    }
};
struct EpiUp {
    static constexpr bool PERM = true, AFTER_DRAIN = false;
    u16* uo; const float* rowss;
    __device__ __forceinline__ void operator()(const f32x4 (&acc)[2][2][4][2], const Unit& u, int wr, int wc, int fr, int fq) const {
        const int row0 = u.pm * 256 + wr * 64 + fr; const int c0 = u.pn * 256 + wc * 32 + 8 * fq;
        float rsv[2][4];
        EPI_ROWS { const int row = row0 + ai * 128 + m * 16;
            const f32x4 p0 = *(const f32x4*)(rowss + (size_t)row * 32 + fq * 8), p1 = *(const f32x4*)(rowss + (size_t)row * 32 + fq * 8 + 4);
            float ss = ((p0[0] + p0[1]) + (p0[2] + p0[3])) + ((p1[0] + p1[1]) + (p1[2] + p1[3]));
            ss += __shfl_xor(ss, 16); ss += __shfl_xor(ss, 32);
            rsv[ai][m] = rsqrtf(ss * (1.0f / 2048.0f) + 1e-6f); }
        EPI_ROWS { const int row = row0 + ai * 128 + m * 16; const float rs = rsv[ai][m]; u16* rp = uo + (size_t)row * NUP + c0;
#pragma unroll
            for (int bj = 0; bj < 2; ++bj) { const f32x4 v0 = acc[ai][bj][m][0] * rs, v1 = acc[ai][bj][m][1] * rs;
                uint4 w; w.x = cvt_pk_bf16(v0[0], v0[1]); w.y = cvt_pk_bf16(v0[2], v0[3]); w.z = cvt_pk_bf16(v1[0], v1[1]); w.w = cvt_pk_bf16(v1[2], v1[3]); *(uint4*)(rp + bj * 128) = w; } }
    }
};
struct EpiFinal {
    static constexpr bool PERM = true, AFTER_DRAIN = false;
    float* out;
    __device__ __forceinline__ void operator()(const f32x4 (&acc)[2][2][4][2], const Unit& u, int wr, int wc, int fr, int fq) const {
        const int row0 = u.pm * 256 + wr * 64 + fr; const int c0 = u.pn * 256 + wc * 32 + 8 * fq;
        EPI_ROWS { const int row = row0 + ai * 128 + m * 16;
#pragma unroll
            for (int bj = 0; bj < 2; ++bj) { float* op = out + (size_t)row * DM + c0 + bj * 128;
                const f32x4 a0 = *(const f32x4*)op + acc[ai][bj][m][0], a1 = *(const f32x4*)(op + 4) + acc[ai][bj][m][1]; *(f32x4*)op = a0; *(f32x4*)(op + 4) = a1; } }
    }
};

template <class Epi> __device__ __forceinline__ void run_gemm(LAS unsigned char* lds, const u16* A, const u16* Bt, int N, int K, const Epi& E) {
    pg8::Gemm g; g.A = A; g.Bt = Bt; g.M = MT; g.N = N; g.K = K;
    pg8::StaticOrder S; S.init(MT, N, (int)gridDim.x, (int)blockIdx.x);
    pg8::gemm_phase<Epi, pg8::StaticOrder>(lds, g, S, E);
}

template <class Epi> __device__ __forceinline__ void run_gemm_sub(LAS unsigned char* lds, const u16* A, const u16* Bt, int N, int K, const Epi& E, int G, int c) {
    pg8::Gemm g; g.A = A; g.Bt = Bt; g.M = MT; g.N = N; g.K = K;
    pg8::StaticOrder S; S.init(MT, N, G, c);
    pg8::gemm_phase<Epi, pg8::StaticOrder>(lds, g, S, E);
}
struct EpiZG {
    static constexpr bool PERM = true, AFTER_DRAIN = false;
    u16* zgate; const float* rstd;
    __device__ __forceinline__ void operator()(const f32x4 (&acc)[2][2][4][2], const Unit& u, int wr, int wc, int fr, int fq) const {
        const int row0 = u.pm * 256 + wr * 64 + fr; const int c0 = 1024 + u.pn * 256 + wc * 32 + 8 * fq;
        float rsv[2][4];
        EPI_ROWS rsv[ai][m] = rstd[row0 + ai * 128 + m * 16];
        EPI_ROWS { const int row = row0 + ai * 128 + m * 16; const float rs = rsv[ai][m]; u16* rp = zgate + (size_t)row * ZG + c0;
#pragma unroll
            for (int bj = 0; bj < 2; ++bj) { const f32x4 v0 = acc[ai][bj][m][0] * rs, v1 = acc[ai][bj][m][1] * rs;
                uint4 w; w.x = cvt_pk_bf16(v0[0], v0[1]); w.y = cvt_pk_bf16(v0[2], v0[3]); w.z = cvt_pk_bf16(v1[0], v1[1]); w.w = cvt_pk_bf16(v1[2], v1[3]); *(uint4*)(rp + bj * 128) = w; } }
    }
};

__device__ __forceinline__ void tr_tile(const float* __restrict__ src, int ldn, int nsrc0, u16* __restrict__ dst, int K, int k0, int ndst0, const float* __restrict__ scale, float* tile) {
    const int tid = threadIdx.x, nc4 = (tid & 15) * 4, kr0 = tid >> 4;
    float4 v[8];
#pragma unroll
    for (int i = 0; i < 8; ++i) { const int kr = kr0 + 32 * i; v[i] = make_float4(0.f, 0.f, 0.f, 0.f);
        if (nsrc0 >= 0) v[i] = *(const float4*)(src + (size_t)(k0 + kr) * ldn + nsrc0 + nc4); }
#pragma unroll
    for (int i = 0; i < 8; ++i) { const int kr = kr0 + 32 * i; const float sc = scale ? scale[k0 + kr] : 1.0f; float* tp = tile + kr * 65 + nc4;
        tp[0] = v[i].x * sc; tp[1] = v[i].y * sc; tp[2] = v[i].z * sc; tp[3] = v[i].w * sc; }
    __syncthreads();
    const int nr = tid >> 3, kb = (tid & 7) * 8;
#pragma unroll
    for (int q = 0; q < 4; ++q) { const int kc = kb + 64 * q; uint4 w;
        w.x = cvt_pk_bf16(tile[(kc + 0) * 65 + nr], tile[(kc + 1) * 65 + nr]); w.y = cvt_pk_bf16(tile[(kc + 2) * 65 + nr], tile[(kc + 3) * 65 + nr]);
        w.z = cvt_pk_bf16(tile[(kc + 4) * 65 + nr], tile[(kc + 5) * 65 + nr]); w.w = cvt_pk_bf16(tile[(kc + 6) * 65 + nr], tile[(kc + 7) * 65 + nr]);
        *(uint4*)(dst + (size_t)(ndst0 + nr) * K + k0 + kc) = w; }
    __syncthreads();
}
constexpr int WT_IN = 1152, WT_ALL = 3776;
__device__ __forceinline__ void weight_tile(const Params& P, int id, float* tile) {
    unsigned char* ws = P.ws;
    if (id < 1152) { const int nt = id % 144, kt = id / 144; const int ns = nt < 55 ? nt * 64 : (nt == 55 ? -1 : nt * 64 - 64);
        tr_tile(P.in[2], 9152, ns, (u16*)(ws + WS_WIN), 2048, kt * 256, nt * 64, P.in[1], tile); }
    else if (id < 1152 + 1408) { const int j = id - 1152, nt = j % 176, kt = j / 176;
        tr_tile(P.in[20], NUP, nt * 64, (u16*)(ws + WS_WUP), 2048, kt * 256, nt * 64, P.in[19], tile); }
    else if (id < 2560 + 704) { const int j = id - 2560, nt = j % 32, kt = j / 32;
        tr_tile(P.in[23], 2048, nt * 64, (u16*)(ws + WS_WDOWN), 5632, kt * 256, nt * 64, nullptr, tile); }
    else if (id < 3264 + 128) { const int j = id - 3264, nt = j % 32, kt = j / 32;
        tr_tile(P.in[17], 2048, nt * 64, (u16*)(ws + WS_WBR1), 1024, kt * 256, nt * 64, nullptr, tile); }
    else if (id < 3392 + 128) { const int j = id - 3392, nt = j % 32, kt = j / 32;
        tr_tile(P.in[17] + (size_t)1024 * 2048, 2048, nt * 64, (u16*)(ws + WS_WBR2), 1024, kt * 256, nt * 64, nullptr, tile); }
    else { const int j = id - 3520, nt = j % 32, kt = j / 32;
        tr_tile(P.in[18], 2048, nt * 64, (u16*)(ws + WS_WOUT), 2048, kt * 256, nt * 64, nullptr, tile); }
}
__device__ __forceinline__ void win_tile(const Params& P, int kt, int nt, float* tile) {
    const int ns = nt < 55 ? nt * 64 : (nt == 55 ? -1 : nt * 64 - 64);
    tr_tile(P.in[2], 9152, ns, (u16*)(P.ws + WS_WIN), 2048, kt * 256, nt * 64, P.in[1], tile);
}
__device__ void phase0(const Params& P, float* tile) {
    unsigned char* ws = P.ws; const int G = gridDim.x, bid = blockIdx.x, tid = threadIdx.x;
    if (bid == 0 && tid == 0) *(unsigned*)(ws + WS_CNT) = 0u;
    for (int id = bid; id < 1152; id += G) win_tile(P, id / 144, id % 144, tile);
    { u16* w2t = (u16*)(ws + WS_WLORA); u16* a2t = w2t + 1024 * 96; u16* g2t = a2t + 1024 * 96;
      for (int idx = bid * 512 + tid; idx < 448 * 1024; idx += G * 512) { const int kk = idx >> 10, n = idx & 1023;
          if (kk < 96) w2t[n * 96 + kk] = f2bf(P.in[5][(size_t)kk * 1024 + n]);
          else if (kk < 192) a2t[n * 96 + (kk - 96)] = f2bf(P.in[7][(size_t)(kk - 96) * 1024 + n]);
          else g2t[n * 256 + (kk - 192)] = f2bf(P.in[8][(size_t)(kk - 192) * 1024 + n]); } }
    { const int lane = tid & 63, gw = bid * 8 + (tid >> 6), nw = G * 8; u16* xb = (u16*)(ws + WS_Z + Z_TAIL); float* rstd1 = (float*)(ws + WS_SMALL);
      for (int t = gw; t < MT; t += nw) { const float4* xr = (const float4*)(P.in[0] + (size_t)t * DM); float ss = 0.f;
#pragma unroll
          for (int i = 0; i < 8; ++i) { const float4 v = xr[lane + 64 * i]; ss += v.x * v.x + v.y * v.y + v.z * v.z + v.w * v.w;
              uint2 w; w.x = cvt_pk_bf16(v.x, v.y); w.y = cvt_pk_bf16(v.z, v.w); *(uint2*)(xb + (size_t)t * DM + (lane + 64 * i) * 4) = w; }
          ss = wave_sum(ss); if (lane == 0) rstd1[t] = rsqrtf(ss * (1.0f / 2048.0f) + 1e-6f); } }
}

__device__ void phase2(const Params& P, u16* tile) {
    unsigned char* ws = P.ws; const int G = gridDim.x, bid = blockIdx.x, tid = threadIdx.x, lane = tid & 63;
    const u16* zmain = (const u16*)(ws + WS_Z + Z_MAIN);
    u16* rkv = (u16*)((unsigned char*)P.out + O_RKV); u16* Qn = (u16*)((unsigned char*)P.out + O_QN);
    u16* Ap = (u16*)(ws + WS_X + X_AP); u16* Kn = (u16*)(ws + WS_X + X_KN); u16* Vt = (u16*)(ws + WS_X + X_VT);
    const float* mu = P.in[3];
    const int d0 = (lane * 2) & 63; const float qg0 = P.in[14][d0] * 0.125f, qg1 = P.in[14][d0 + 1] * 0.125f, kg0 = P.in[15][d0], kg1 = P.in[15][d0 + 1];
    for (int t = bid * 8 + (tid >> 6); t < MT; t += G * 8) {
        const u16* zr = zmain + (size_t)t * ZM; const bool hp = (t & (SEQ - 1)) != 0; const u16* zp = hp ? zr - ZM : zr;
        unsigned zz[28], pp[28], qk[10]; float2 m2[28];
#pragma unroll
        for (int i = 0; i < 28; ++i) { const int c = i * 128 + lane * 2; zz[i] = 0u; pp[i] = 0u; m2[i] = make_float2(0.f, 0.f);
            if (i < 27 || lane < 32) { zz[i] = *(const unsigned*)(zr + c); pp[i] = *(const unsigned*)(zp + c); m2[i] = *(const float2*)(mu + c); } }
#pragma unroll
        for (int i = 0; i < 10; ++i) qk[i] = *(const unsigned*)(zr + 3584 + i * 128 + lane * 2);
#pragma unroll
        for (int i = 0; i < 28; ++i) { const int c = i * 128 + lane * 2;
            if (i < 27 || lane < 32) { const unsigned pv = hp ? pp[i] : 0u;
                const float z0 = bflo(zz[i]), z1 = bfhi(zz[i]); const float a0 = z0 + (bflo(pv) - z0) * m2[i].x, a1 = z1 + (bfhi(pv) - z1) * m2[i].y;
                if (i < 24) *(unsigned*)(rkv + (size_t)t * 3072 + c) = cvt_pk_bf16(a0, a1);
                else if (c < 3168) *(unsigned*)(Ap + (size_t)t * 512 + (c - 3072)) = cvt_pk_bf16(tanhf(a0), tanhf(a1));
                else if (c < 3264) *(unsigned*)(Ap + (size_t)t * 512 + 96 + (c - 3168)) = cvt_pk_bf16(a0, a1);
                else *(unsigned*)(Ap + (size_t)t * 512 + 256 + (c - 3264)) = cvt_pk_bf16(sigmoidf_(a0), sigmoidf_(a1)); } }
        if (lane < 32) *(unsigned*)(Ap + (size_t)t * 512 + 192 + lane * 2) = 0u;
#pragma unroll
        for (int i = 0; i < 10; ++i) { const float v0 = bflo(qk[i]), v1 = bfhi(qk[i]); float ss = row16_sum(v0 * v0 + v1 * v1); ss += __shfl_xor(ss, 16);
            const float rs = rsqrtf(ss * (1.0f / 64.0f) + 1e-6f);
            if (i < 8) *(unsigned*)(Qn + (size_t)t * 1024 + i * 128 + lane * 2) = cvt_pk_bf16(v0 * rs * qg0, v1 * rs * qg1);
            else *(unsigned*)(Kn + (size_t)t * 256 + (i - 8) * 128 + lane * 2) = cvt_pk_bf16(v0 * rs * kg0, v1 * rs * kg1); }
    }
    for (int tl = bid; tl < MT / 64; tl += G) { const int t0 = tl * 64;
        __syncthreads();
        for (int i = 0; i < 16; ++i) { const int idx = tid + 512 * i, r = idx >> 7, cp = idx & 127; const unsigned vv = *(const unsigned*)(zmain + (size_t)(t0 + r) * ZM + 4864 + 2 * cp);
            tile[(2 * cp) * 66 + r] = (u16)(vv & 0xffffu); tile[(2 * cp + 1) * 66 + r] = (u16)(vv >> 16); }
        __syncthreads();
        const int b = t0 >> 12, s0 = t0 & (SEQ - 1);
        for (int i = 0; i < 16; ++i) { const int idx = tid + 512 * i, c = idx >> 5, sp = idx & 31;
            const unsigned w = (unsigned)tile[c * 66 + 2 * sp] | ((unsigned)tile[c * 66 + 2 * sp + 1] << 16);
            *(unsigned*)(Vt + ((size_t)(b * 4 + (c >> 6)) * 64 + (c & 63)) * SEQ + s0 + 2 * sp) = w; }
    }
}

constexpr int NSCAN = 32;
#define LDS_BARRIER() do { asm volatile("s_waitcnt lgkmcnt(0)" ::: "memory"); __builtin_amdgcn_s_barrier(); asm volatile("" ::: "memory"); } while (0)
__device__ __forceinline__ float row8_sum(float x) { x += dppf<0xB1>(x); x += dppf<0x4E>(x); x += dppf<0x141>(x); return x; }
__device__ void rwkv_prep(const Params& P, unsigned char* lds_raw) {
    unsigned char* ws = P.ws; const int tid = threadIdx.x, q4 = tid >> 7, lt = tid & 127, lane = tid & 63, qw = (tid >> 6) & 1, fr = lane & 15, fq = lane >> 4;
    unsigned char* lwb = ws + WS_Z + Z_LW; unsigned char* ab = ws + WS_Z + Z_A; u16* rkv = (u16*)((unsigned char*)P.out + O_RKV);
    float* gbuf = (float*)(ws + WS_G); float* rkb = (float*)(ws + WS_RK);
    const u16* Apx = (const u16*)(ws + WS_X + X_AP); const u16* w2t = (const u16*)(ws + WS_WLORA); const u16* a2t = w2t + 1024 * 96; const u16* g2t = a2t + 1024 * 96; u16* gout = (u16*)(ws + WS_Z + Z_G);
    unsigned char* L0 = lds_raw + q4 * 32768;
    u16* sAt = (u16*)L0; u16* sBt = sAt + 16 * 72; u16* sKt = sBt + 16 * 72; u16* sRt = sKt + 16 * 72;
    u16* sVt = (u16*)(L0 + 9216); u16* sAak = (u16*)(L0 + 12288); float* sN = (float*)(L0 + 13312); float* sRHS = (float*)(L0 + 14400); float* sL = (float*)(L0 + 22848); float* sAf = (float*)(L0 + 26944);
    const int tl = lt >> 3, c8 = (lt & 7) * 8;
    uint4 n_r, n_k, n_v; float4 n_kkw[2], n_kaw[2], n_rkw[2]; bf16x8 n_At[3], n_Aa[3], n_Ag[8];
    auto unit_of = [&](int it_) { if ((int)gridDim.x == 256) { const int s_ = (it_ & 255) * 4 + q4; return (s_ >> 5) * 256 + (s_ & 31) + 32 * (it_ >> 8); } return it_ * 4 + q4; };
    auto fetch = [&](int it_) { const int unit_ = unit_of(it_), b_ = unit_ >> 12, h_ = (unit_ >> 8) & 15, c_ = unit_ & 255; const size_t t_ = (size_t)b_ * SEQ + c_ * CH_ + tl; const int hc_ = h_ * 64 + c8;
        n_r = *(const uint4*)(rkv + t_ * 3072 + hc_); n_k = *(const uint4*)(rkv + t_ * 3072 + 1024 + hc_); n_v = *(const uint4*)(rkv + t_ * 3072 + 2048 + hc_);
#pragma unroll
        for (int i = 0; i < 2; ++i) {
            n_kkw[i] = *(const float4*)(P.in[9] + hc_ + 4 * i); n_kaw[i] = *(const float4*)(P.in[10] + hc_ + 4 * i); n_rkw[i] = *(const float4*)(P.in[11] + hc_ + 4 * i); }
        const u16* ar_ = Apx + ((size_t)b_ * SEQ + c_ * CH_ + fr) * 512 + 8 * fq;
#pragma unroll
        for (int ks = 0; ks < 3; ++ks) { n_At[ks] = *(const bf16x8*)(ar_ + 32 * ks); n_Aa[ks] = *(const bf16x8*)(ar_ + 96 + 32 * ks); }
#pragma unroll
        for (int ks = 0; ks < 8; ++ks) n_Ag[ks] = *(const bf16x8*)(ar_ + 256 + 32 * ks); };
    if ((int)blockIdx.x < 2048) fetch(blockIdx.x);
    for (int it = blockIdx.x; it < 2048; it += gridDim.x) {
        const int unit = unit_of(it), b = unit >> 12, h = (unit >> 8) & 15, c = unit & 255; const size_t t0 = (size_t)b * SEQ + c * CH_, t = t0 + tl;
#pragma unroll
        for (int n2 = 0; n2 < 2; ++n2) { const int cn = (qw * 2 + n2) * 16 + fr, nrow = h * 64 + cn;
            f32x4 accw = {0.f, 0.f, 0.f, 0.f}, acca = {0.f, 0.f, 0.f, 0.f}, accg = {0.f, 0.f, 0.f, 0.f};
#pragma unroll
            for (int ks = 0; ks < 3; ++ks) { const bf16x8 bw = *(const bf16x8*)(w2t + nrow * 96 + 32 * ks + 8 * fq), ba = *(const bf16x8*)(a2t + nrow * 96 + 32 * ks + 8 * fq);
                accw = __builtin_amdgcn_mfma_f32_16x16x32_bf16(n_At[ks], bw, accw, 0, 0, 0); acca = __builtin_amdgcn_mfma_f32_16x16x32_bf16(n_Aa[ks], ba, acca, 0, 0, 0); }
#pragma unroll
            for (int ks = 0; ks < 8; ++ks) { const bf16x8 bg = *(const bf16x8*)(g2t + nrow * 256 + 32 * ks + 8 * fq); accg = __builtin_amdgcn_mfma_f32_16x16x32_bf16(n_Ag[ks], bg, accg, 0, 0, 0); }
            const float w0v = P.in[4][nrow], a0v = P.in[6][nrow];
#pragma unroll
            for (int j = 0; j < 4; ++j) { const int tt = 4 * fq + j; const float y = -(w0v + accw[j]); const float sp = fmaxf(y, 0.f) + __logf(1.0f + __expf(-fabsf(y)));
                sL[tt * 64 + cn] = -__expf(-sp - 0.5f); sAf[tt * 64 + cn] = sigmoidf_(a0v + acca[j]); gout[(t0 + tt) * RWD + nrow] = f2bf(accg[j]); } }
        LDS_BARRIER();
        const unsigned ru[4] = {n_r.x, n_r.y, n_r.z, n_r.w}, ku[4] = {n_k.x, n_k.y, n_k.z, n_k.w}, vu[4] = {n_v.x, n_v.y, n_v.z, n_v.w};
        float rr[8], kr[8], aa[8], lw[8], kkw_[8], kaw_[8], rkw_[8];
        { const float4 l0 = *(const float4*)(sL + tl * 64 + c8), l1 = *(const float4*)(sL + tl * 64 + c8 + 4), q0 = *(const float4*)(sAf + tl * 64 + c8), q1 = *(const float4*)(sAf + tl * 64 + c8 + 4);
          lw[0] = l0.x; lw[1] = l0.y; lw[2] = l0.z; lw[3] = l0.w; lw[4] = l1.x; lw[5] = l1.y; lw[6] = l1.z; lw[7] = l1.w; aa[0] = q0.x; aa[1] = q0.y; aa[2] = q0.z; aa[3] = q0.w; aa[4] = q1.x; aa[5] = q1.y; aa[6] = q1.z; aa[7] = q1.w; }
#pragma unroll
        for (int i = 0; i < 4; ++i) { rr[2 * i] = bflo(ru[i]); rr[2 * i + 1] = bfhi(ru[i]); kr[2 * i] = bflo(ku[i]); kr[2 * i + 1] = bfhi(ku[i]); }
#pragma unroll
        for (int i = 0; i < 2; ++i) {
            kkw_[4 * i] = n_kkw[i].x; kkw_[4 * i + 1] = n_kkw[i].y; kkw_[4 * i + 2] = n_kkw[i].z; kkw_[4 * i + 3] = n_kkw[i].w; kaw_[4 * i] = n_kaw[i].x; kaw_[4 * i + 1] = n_kaw[i].y; kaw_[4 * i + 2] = n_kaw[i].z; kaw_[4 * i + 3] = n_kaw[i].w;
            rkw_[4 * i] = n_rkw[i].x; rkw_[4 * i + 1] = n_rkw[i].y; rkw_[4 * i + 2] = n_rkw[i].z; rkw_[4 * i + 3] = n_rkw[i].w; }
        float qq[8], kk[8], bb[8], kp[8]; float ss = 0.f, rks = 0.f;
#pragma unroll
        for (int j = 0; j < 8; ++j) { qq[j] = kr[j] * kkw_[j]; ss += qq[j] * qq[j]; }
        ss = row8_sum(ss); const float inv = 1.0f / fmaxf(sqrtf(ss), 1e-12f);
#pragma unroll
        for (int j = 0; j < 8; ++j) { kk[j] = qq[j] * inv; bb[j] = kk[j] * aa[j]; kp[j] = kr[j] * (1.0f + (aa[j] - 1.0f) * kaw_[j]); rks += rr[j] * kp[j] * rkw_[j]; }
        rks = row8_sum(rks); if ((lt & 7) == 0) rkb[t * 16 + h] = rks;
#pragma unroll
        for (int i = 0; i < 4; ++i) { sVt[(c8 + 2 * i) * 24 + tl] = (u16)(vu[i] & 0xffffu); sVt[(c8 + 2 * i + 1) * 24 + tl] = (u16)(vu[i] >> 16); }
        LDS_BARRIER();
        if (lt < 64) { float lv[16];
#pragma unroll
            for (int i = 0; i < 16; ++i) lv[i] = sL[i * 64 + lt];
#pragma unroll
            for (int i = 1; i < 16; ++i) lv[i] += lv[i - 1];
#pragma unroll
            for (int i = 0; i < 16; ++i) sL[i * 64 + lt] = lv[i]; }
        LDS_BARRIER();
        { const float4 La = *(const float4*)(sL + tl * 64 + c8), Lb = *(const float4*)(sL + tl * 64 + c8 + 4), Ta = *(const float4*)(sL + 15 * 64 + c8), Tb = *(const float4*)(sL + 15 * 64 + c8 + 4);
          const float Lc[8] = {La.x, La.y, La.z, La.w, Lb.x, Lb.y, Lb.z, Lb.w}, Lt[8] = {Ta.x, Ta.y, Ta.z, Ta.w, Tb.x, Tb.y, Tb.z, Tb.w};
          float at[8], bt[8], kt[8], rt[8], bh[8], kh[8];
#pragma unroll
          for (int j = 0; j < 8; ++j) { const float eL = __expf(Lc[j]), eLp = __expf(Lc[j] - lw[j]), eNL = __expf(-Lc[j]), eH = __expf(Lt[j] - Lc[j]);
              at[j] = -kk[j] * eLp; bt[j] = bb[j] * eNL; kt[j] = kp[j] * eNL; rt[j] = rr[j] * eL; bh[j] = bb[j] * eH; kh[j] = kp[j] * eH; }
          uint4 w; w.x = cvt_pk_bf16(at[0], at[1]); w.y = cvt_pk_bf16(at[2], at[3]); w.z = cvt_pk_bf16(at[4], at[5]); w.w = cvt_pk_bf16(at[6], at[7]); *(uint4*)(sAt + tl * 72 + c8) = w;
          w.x = cvt_pk_bf16(bt[0], bt[1]); w.y = cvt_pk_bf16(bt[2], bt[3]); w.z = cvt_pk_bf16(bt[4], bt[5]); w.w = cvt_pk_bf16(bt[6], bt[7]); *(uint4*)(sBt + tl * 72 + c8) = w;
          w.x = cvt_pk_bf16(kt[0], kt[1]); w.y = cvt_pk_bf16(kt[2], kt[3]); w.z = cvt_pk_bf16(kt[4], kt[5]); w.w = cvt_pk_bf16(kt[6], kt[7]); *(uint4*)(sKt + tl * 72 + c8) = w;
          w.x = cvt_pk_bf16(rt[0], rt[1]); w.y = cvt_pk_bf16(rt[2], rt[3]); w.z = cvt_pk_bf16(rt[4], rt[5]); w.w = cvt_pk_bf16(rt[6], rt[7]); *(uint4*)(sRt + tl * 72 + c8) = w;
          *(uint4*)(lwb + (t * 1024 + h * 64) * 4 + 128 + c8 * 2) = w;
          *(float4*)(sRHS + tl * 132 + c8) = make_float4(at[0], at[1], at[2], at[3]); *(float4*)(sRHS + tl * 132 + c8 + 4) = make_float4(at[4], at[5], at[6], at[7]);
#pragma unroll
          for (int j = 0; j < 8; ++j) { unsigned char* dst = ab + ((t0 + (c8 >> 2) + (j >> 2)) * 1024 + h * 64) * 4 + (j & 3) * 64;
              *(u16*)(dst + tl * 2) = f2bf(bh[j]); *(u16*)(dst + (16 + tl) * 2) = f2bf(kh[j]); }
          if (tl == 0) { *(float4*)(gbuf + (size_t)unit * 64 + c8) = make_float4(__expf(Lt[0]), __expf(Lt[1]), __expf(Lt[2]), __expf(Lt[3]));
              *(float4*)(gbuf + (size_t)unit * 64 + c8 + 4) = make_float4(__expf(Lt[4]), __expf(Lt[5]), __expf(Lt[6]), __expf(Lt[7])); } }
        LDS_BARRIER();
        if (it + (int)gridDim.x < 2048) fetch(it + (int)gridDim.x);
        { const u16* X = qw == 0 ? sAt : sRt;
          const bf16x8 a0 = *(const bf16x8*)(X + fr * 72 + 8 * fq), a1 = *(const bf16x8*)(X + fr * 72 + 32 + 8 * fq);
#pragma unroll
          for (int pi = 0; pi < 2; ++pi) { const u16* Y = pi ? sKt : sBt; const int hw = qw * 2 + pi;
              const bf16x8 b0 = *(const bf16x8*)(Y + fr * 72 + 8 * fq), b1 = *(const bf16x8*)(Y + fr * 72 + 32 + 8 * fq);
              f32x4 acc = {0.f, 0.f, 0.f, 0.f};
              acc = __builtin_amdgcn_mfma_f32_16x16x32_bf16(a0, b0, acc, 0, 0, 0); acc = __builtin_amdgcn_mfma_f32_16x16x32_bf16(a1, b1, acc, 0, 0, 0);
#pragma unroll
              for (int j = 0; j < 4; ++j) { const int tt = 4 * fq + j, i = fr; const bool keep = hw < 2 ? (i < tt) : (i <= tt); const float val = keep ? acc[j] : 0.f;
                  if (hw == 0) sN[tt * 17 + i] = val;
                  else if (hw == 1) sAak[tt * 24 + i] = f2bf(val);
                  else rkv[(t0 + tt) * 3072 + h * 64 + (hw == 3 ? 16 : 0) + i] = f2bf(val); } } }
        LDS_BARRIER();
#pragma unroll
        for (int vi = 0; vi < 2; ++vi) { const int vt = qw * 2 + vi; bf16x8 af = {0, 0, 0, 0, 0, 0, 0, 0}, bf = {0, 0, 0, 0, 0, 0, 0, 0};
          if (fq < 2) { af = *(const bf16x8*)(sAak + fr * 24 + 8 * fq); bf = *(const bf16x8*)(sVt + (vt * 16 + fr) * 24 + 8 * fq); }
          f32x4 acc = {0.f, 0.f, 0.f, 0.f}; acc = __builtin_amdgcn_mfma_f32_16x16x32_bf16(af, bf, acc, 0, 0, 0);
#pragma unroll
          for (int j = 0; j < 4; ++j) sRHS[(4 * fq + j) * 132 + 64 + vt * 16 + fr] = acc[j]; }
        LDS_BARRIER();
        { const int col = qw * 64 + lane; float x[16];
#pragma unroll
            for (int i = 0; i < 16; ++i) { float v = sRHS[i * 132 + col];
#pragma unroll
                for (int j = 0; j < i; ++j) v += sN[i * 17 + j] * x[j];
                x[i] = v; }
            if (qw == 0) {
#pragma unroll
                for (int i = 0; i < 16; ++i) *(u16*)(lwb + ((t0 + i) * 1024 + h * 64) * 4 + lane * 2) = f2bf(x[i]); }
            else { uint4 w0, w1; w0.x = cvt_pk_bf16(x[0], x[1]); w0.y = cvt_pk_bf16(x[2], x[3]); w0.z = cvt_pk_bf16(x[4], x[5]); w0.w = cvt_pk_bf16(x[6], x[7]);
                w1.x = cvt_pk_bf16(x[8], x[9]); w1.y = cvt_pk_bf16(x[10], x[11]); w1.z = cvt_pk_bf16(x[12], x[13]); w1.w = cvt_pk_bf16(x[14], x[15]);
                u16* wp = rkv + (t0 + (lane >> 2)) * 3072 + 1024 + h * 64 + (lane & 3) * 16;
                *(uint4*)wp = w0; *(uint4*)(wp + 8) = w1; } }
    }
}
__device__ void rwkv_serial(const Params& P, unsigned char* lds_raw) {
    unsigned char* ws = P.ws; const int tid = threadIdx.x, lane = tid & 63, w = __builtin_amdgcn_readfirstlane(tid >> 6), fr = lane & 15, fq = lane >> 4;
    const int hb = blockIdx.x, b = hb >> 4, h = hb & 15;
    const unsigned char* lwb = ws + WS_Z + Z_LW; const unsigned char* ab = ws + WS_Z + Z_A; const u16* rkv = (const u16*)((unsigned char*)P.out + O_RKV);
    const float* gbuf = (const float*)(ws + WS_G); u16* yb = (u16*)(ws + WS_Y);
    u16* Sb = (u16*)lds_raw; u16* UVt = (u16*)(lds_raw + 18432);
    for (int i = tid; i < 64 * 72; i += 512) Sb[i] = 0;
    const int kt = w >> 1, vt0 = (w & 1) * 2, ut = w & 3, kr = kt * 16 + fr, uv = ut * 16 + fr;
    f32x4 st0 = {0.f, 0.f, 0.f, 0.f}, st1 = {0.f, 0.f, 0.f, 0.f};
    typedef unsigned u32x2_t __attribute__((ext_vector_type(2)));
    struct Pre { bf16x8 f0, f1, x, bk; f32x4 g; unsigned vv; };
#define PRE_LOAD(c_, p) do { const size_t t0_ = (size_t)b * SEQ + (size_t)(c_) * CH_; \
        const unsigned char* ls_ = lwb + ((t0_ + fr) * 1024 + h * 64) * 4 + (w < 4 ? 0 : 128) + fq * 16; \
        const void* a0_ = ls_; const void* a1_ = ls_ + 64; \
        const void* a2_ = (w < 4) ? (const void*)(rkv + (t0_ + (uv >> 2)) * 3072 + 1024 + h * 64 + (uv & 3) * 16 + fq * 4) : (const void*)(rkv + (t0_ + fr) * 3072 + h * 64 + fq * 8); \
        const void* a4_ = ab + ((t0_ + (kr >> 2)) * 1024 + h * 64) * 4 + (kr & 3) * 64 + fq * 16; \
        const void* a5_ = gbuf + ((size_t)hb * 256 + (c_)) * 64 + kt * 16 + 4 * fq; \
        const void* a6_ = rkv + (t0_ + (tid >> 5)) * 3072 + 2048 + h * 64 + (tid & 31) * 2; \
        asm volatile("global_load_dwordx4 %0, %1, off" : "=v"(p.f0) : "v"(a0_) : "memory"); \
        asm volatile("global_load_dwordx4 %0, %1, off" : "=v"(p.f1) : "v"(a1_) : "memory"); \
        asm volatile("global_load_dwordx4 %0, %1, off" : "=v"(p.x) : "v"(a2_) : "memory"); \
        asm volatile("global_load_dwordx4 %0, %1, off" : "=v"(p.bk) : "v"(a4_) : "memory"); \
        asm volatile("global_load_dwordx4 %0, %1, off" : "=v"(p.g) : "v"(a5_) : "memory"); \
        asm volatile("global_load_dword %0, %1, off" : "=v"(p.vv) : "v"(a6_) : "memory"); } while (0)
#define PRE_WAIT(p, N) asm volatile("s_waitcnt vmcnt(" #N ")" : "+v"(p.f0), "+v"(p.f1), "+v"(p.x), "+v"(p.bk), "+v"(p.g), "+v"(p.vv) :: "memory")
    auto step = [&](int c, const Pre& cur) {
        const u16* S = Sb + (c & 1) * (64 * 72); u16* Sn = Sb + ((c & 1) ^ 1) * (64 * 72); const size_t t0 = (size_t)b * SEQ + c * CH_;
        { const int tv = tid >> 5, v2 = (tid & 31) * 2; UVt[v2 * 40 + 16 + tv] = (u16)(cur.vv & 0xffffu); UVt[(v2 + 1) * 40 + 16 + tv] = (u16)(cur.vv >> 16); }
        const bf16x8 s0 = *(const bf16x8*)(S + uv * 72 + 8 * fq), s1 = *(const bf16x8*)(S + uv * 72 + 32 + 8 * fq);
        f32x4 acc = {0.f, 0.f, 0.f, 0.f};
        if (w < 4) { const unsigned wx = (unsigned)(unsigned short)cur.x[0] | ((unsigned)(unsigned short)cur.x[1] << 16), wy = (unsigned)(unsigned short)cur.x[2] | ((unsigned)(unsigned short)cur.x[3] << 16);
            acc[0] = bflo(wx); acc[1] = bfhi(wx); acc[2] = bflo(wy); acc[3] = bfhi(wy); }
        acc = __builtin_amdgcn_mfma_f32_16x16x32_bf16(cur.f0, s0, acc, 0, 0, 0); acc = __builtin_amdgcn_mfma_f32_16x16x32_bf16(cur.f1, s1, acc, 0, 0, 0);
        if (w < 4) { uint2 o; o.x = cvt_pk_bf16(acc[0], acc[1]); o.y = cvt_pk_bf16(acc[2], acc[3]); *(uint2*)(UVt + uv * 40 + 4 * fq) = o; }
        LDS_BARRIER();
        if (w >= 4) { const bf16x8 uf = *(const bf16x8*)(UVt + uv * 40 + 8 * fq); acc = __builtin_amdgcn_mfma_f32_16x16x32_bf16(cur.x, uf, acc, 0, 0, 0);
#pragma unroll
            for (int j = 0; j < 4; ++j) yb[(t0 + 4 * fq + j) * RWD + h * 64 + uv] = f2bf(acc[j]); }
        { const bf16x8 u0 = *(const bf16x8*)(UVt + ((vt0 + 0) * 16 + fr) * 40 + 8 * fq), u1 = *(const bf16x8*)(UVt + ((vt0 + 1) * 16 + fr) * 40 + 8 * fq);
          st0 = __builtin_amdgcn_mfma_f32_16x16x32_bf16(cur.bk, u0, st0 * cur.g, 0, 0, 0); st1 = __builtin_amdgcn_mfma_f32_16x16x32_bf16(cur.bk, u1, st1 * cur.g, 0, 0, 0);
          uint2 o; o.x = cvt_pk_bf16(st0[0], st0[1]); o.y = cvt_pk_bf16(st0[2], st0[3]); *(uint2*)(Sn + ((vt0 + 0) * 16 + fr) * 72 + kt * 16 + 4 * fq) = o;
          o.x = cvt_pk_bf16(st1[0], st1[1]); o.y = cvt_pk_bf16(st1[2], st1[3]); *(uint2*)(Sn + ((vt0 + 1) * 16 + fr) * 72 + kt * 16 + 4 * fq) = o; }
        LDS_BARRIER(); };
    Pre q0, q1, q2, q3, q4, q5; PRE_LOAD(0, q0); PRE_LOAD(1, q1); PRE_LOAD(2, q2); PRE_LOAD(3, q3); PRE_LOAD(4, q4); PRE_LOAD(5, q5);
    __syncthreads();
    constexpr int NCH = SEQ / CH_;
    for (int c = 0; c < 252; c += 6) {
        PRE_WAIT(q0, 30); step(c, q0);     PRE_LOAD(min(c + 6, NCH - 1), q0);
        PRE_WAIT(q1, 30); step(c + 1, q1); PRE_LOAD(min(c + 7, NCH - 1), q1);
        PRE_WAIT(q2, 30); step(c + 2, q2); PRE_LOAD(min(c + 8, NCH - 1), q2);
        PRE_WAIT(q3, 30); step(c + 3, q3); PRE_LOAD(min(c + 9, NCH - 1), q3);
        PRE_WAIT(q4, 30); step(c + 4, q4); PRE_LOAD(min(c + 10, NCH - 1), q4);
        PRE_WAIT(q5, 30); step(c + 5, q5); PRE_LOAD(min(c + 11, NCH - 1), q5);
    }
    PRE_WAIT(q0, 0); PRE_WAIT(q1, 0); PRE_WAIT(q2, 0); PRE_WAIT(q3, 0); PRE_WAIT(q4, 0); PRE_WAIT(q5, 0);
    step(252, q0); step(253, q1); step(254, q2); step(255, q3);
#undef PRE_LOAD
#undef PRE_WAIT
}

__device__ void attn_phase(const Params& P) {
    unsigned char* ws = P.ws; const int tid = threadIdx.x, lane = tid & 63, fr = lane & 15, fq = lane >> 4;
    const u16* Qn = (const u16*)((unsigned char*)P.out + O_QN); const u16* Kn = (const u16*)(ws + WS_X + X_KN); const u16* Vt = (const u16*)(ws + WS_X + X_VT);
    u16* oatt = (u16*)(ws + WS_X + X_OATT);
    const int NA = (int)gridDim.x - NSCAN; const int gw = ((int)blockIdx.x - NSCAN) * 8 + (tid >> 6);
    for (int unit = gw; unit < 8192; unit += NA * 8) {
        const int h = unit & 15, st = (unit >> 4) & 255, b = unit >> 12, kh = h >> 2;
        const int s0 = st * 16; const size_t t0 = (size_t)b * SEQ + s0;
        const float slope = exp2f(-0.5f * (float)(h + 1)), sink = P.in[16][h];
        bf16x8 qf[2];
        qf[0] = *(const bf16x8*)(Qn + (t0 + fr) * 1024 + h * 64 + 8 * fq); qf[1] = *(const bf16x8*)(Qn + (t0 + fr) * 1024 + h * 64 + 32 + 8 * fq);
        f32x4 sc[10]; float mx = sink;
#pragma unroll
        for (int kt = 0; kt < 10; ++kt) { const int ks0 = s0 - 144 + 16 * kt; int kp = ks0 + fr; kp = kp < 0 ? 0 : kp;
            const u16* kr = Kn + ((size_t)b * SEQ + kp) * 256 + kh * 64 + 8 * fq;
            const bf16x8 k0 = *(const bf16x8*)kr, k1 = *(const bf16x8*)(kr + 32);
            f32x4 a = {0.f, 0.f, 0.f, 0.f};
            a = __builtin_amdgcn_mfma_f32_16x16x32_bf16(k0, qf[0], a, 0, 0, 0); a = __builtin_amdgcn_mfma_f32_16x16x32_bf16(k1, qf[1], a, 0, 0, 0);
#pragma unroll
            for (int j = 0; j < 4; ++j) { const int kpos = ks0 + 4 * fq + j; const int dist = s0 + fr - kpos; const bool valid = (dist >= 0) && (dist < 128) && (kpos >= 0);
                const float v = valid ? a[j] - slope * (float)dist : -1e30f; a[j] = v; mx = fmaxf(mx, v); }
            sc[kt] = a; }
        mx = fmaxf(mx, __shfl_xor(mx, 16)); mx = fmaxf(mx, __shfl_xor(mx, 32));
        float sum = 0.f;
#pragma unroll
        for (int kt = 0; kt < 10; ++kt)
#pragma unroll
            for (int j = 0; j < 4; ++j) { const float e = __expf(sc[kt][j] - mx); sc[kt][j] = e; sum += e; }
        sum += __shfl_xor(sum, 16); sum += __shfl_xor(sum, 32);
        const float inv = 1.0f / (sum + __expf(sink - mx));
        f32x4 o[4];
#pragma unroll
        for (int dt = 0; dt < 4; ++dt) o[dt] = (f32x4){0.f, 0.f, 0.f, 0.f};
#pragma unroll
        for (int u = 0; u < 5; ++u) {
            union { bf16x8 v; unsigned w[4]; } pf;
            pf.w[0] = cvt_pk_bf16(sc[2 * u][0] * inv, sc[2 * u][1] * inv); pf.w[1] = cvt_pk_bf16(sc[2 * u][2] * inv, sc[2 * u][3] * inv);
            pf.w[2] = cvt_pk_bf16(sc[2 * u + 1][0] * inv, sc[2 * u + 1][1] * inv); pf.w[3] = cvt_pk_bf16(sc[2 * u + 1][2] * inv, sc[2 * u + 1][3] * inv);
            int ka = s0 - 144 + 32 * u + 4 * fq, kb = ka + 16; ka = ka < 0 ? 0 : ka; kb = kb < 0 ? 0 : kb;
#pragma unroll
            for (int dt = 0; dt < 4; ++dt) { const u16* vr = Vt + ((size_t)(b * 4 + kh) * 64 + dt * 16 + fr) * SEQ;
                union { bf16x8 v; uint2 w[2]; } vf; vf.w[0] = *(const uint2*)(vr + ka); vf.w[1] = *(const uint2*)(vr + kb);
                o[dt] = __builtin_amdgcn_mfma_f32_16x16x32_bf16(pf.v, vf.v, o[dt], 0, 0, 0); } }
#pragma unroll
        for (int dt = 0; dt < 4; ++dt)
#pragma unroll
            for (int j = 0; j < 4; ++j) oatt[(t0 + 4 * fq + j) * 1024 + h * 64 + dt * 16 + fr] = f2bf(o[dt][j]);
    }
}

__device__ void phase5(const Params& P) {
    unsigned char* ws = P.ws; const int G = gridDim.x, bid = blockIdx.x, tid = threadIdx.x, lane = tid & 63;
    const u16* rkv = (const u16*)((unsigned char*)P.out + O_RKV); u16* orw = (u16*)((unsigned char*)P.out + O_QN);
    const u16* yraw = (const u16*)(ws + WS_Y); const u16* gp = (const u16*)(ws + WS_Z + Z_G); const float* rkb = (const float*)(ws + WS_RK);
    for (int t = bid * 8 + (tid >> 6); t < MT; t += G * 8) {
        uint2 y2[4], v2[4], g2[4]; float rk[4];
#pragma unroll
        for (int it = 0; it < 4; ++it) { const int hh = it * 4 + (lane >> 4), hc = hh * 64 + (lane & 15) * 4; const size_t o = (size_t)t * RWD + hc;
            y2[it] = *(const uint2*)(yraw + o); g2[it] = *(const uint2*)(gp + o); v2[it] = *(const uint2*)(rkv + (size_t)t * 3072 + 2048 + hc); rk[it] = rkb[(size_t)t * 16 + hh]; }
#pragma unroll
        for (int it = 0; it < 4; ++it) { const int hc = (it * 4 + (lane >> 4)) * 64 + (lane & 15) * 4; const size_t o = (size_t)t * RWD + hc;
            const float4 gw = *(const float4*)(P.in[12] + hc), gb = *(const float4*)(P.in[13] + hc);
            const float yx = bflo(y2[it].x), yy = bfhi(y2[it].x), yz = bflo(y2[it].y), yw = bfhi(y2[it].y);
            const float mu = row16_sum((yx + yy) + (yz + yw)) * (1.0f / 64.0f);
            const float dx = yx - mu, dy = yy - mu, dz = yz - mu, dw = yw - mu;
            const float var = row16_sum((dx * dx + dy * dy) + (dz * dz + dw * dw)) * (1.0f / 64.0f); const float rs = rsqrtf(var + 64e-5f);
            const float o0 = (dx * rs * gw.x + gb.x + rk[it] * bflo(v2[it].x)) * bflo(g2[it].x), o1 = (dy * rs * gw.y + gb.y + rk[it] * bfhi(v2[it].x)) * bfhi(g2[it].x);
            const float o2 = (dz * rs * gw.z + gb.z + rk[it] * bflo(v2[it].y)) * bflo(g2[it].y), o3 = (dw * rs * gw.w + gb.w + rk[it] * bfhi(v2[it].y)) * bfhi(g2[it].y);
            uint2 w; w.x = cvt_pk_bf16(o0, o1); w.y = cvt_pk_bf16(o2, o3); *(uint2*)(orw + o) = w; }
    }
}

__device__ void phase9(const Params& P) {
    unsigned char* ws = P.ws; const u16* uu = (const u16*)(ws + WS_Z); u16* act = (u16*)(ws + WS_ACT);
    const float* cw = P.in[21]; const float* cb = P.in[22];
    const int nth = gridDim.x * 512;
    for (int task = blockIdx.x * 512 + threadIdx.x; task < 1024 * 1408; task += nth) {
        const int j0 = (task % 1408) * 4, t0 = (task / 1408) * 8; const bool first = (t0 & (SEQ - 1)) == 0;
        uint2 ra[10], rg[10];
#pragma unroll
        for (int r = 0; r < 10; ++r) { const int t = (first && r < 2) ? t0 : t0 - 2 + r; ra[r] = *(const uint2*)(uu + (size_t)t * NUP + j0); rg[r] = *(const uint2*)(uu + (size_t)t * NUP + DFF + j0); }
        if (first) { ra[0] = make_uint2(0u, 0u); ra[1] = ra[0]; rg[0] = ra[0]; rg[1] = ra[0]; }
        const float4 wa0 = *(const float4*)(cw + j0), wa1 = *(const float4*)(cw + NUP + j0), wa2 = *(const float4*)(cw + 2 * NUP + j0), ba = *(const float4*)(cb + j0);
        const float4 wg0 = *(const float4*)(cw + DFF + j0), wg1 = *(const float4*)(cw + NUP + DFF + j0), wg2 = *(const float4*)(cw + 2 * NUP + DFF + j0), bg = *(const float4*)(cb + DFF + j0);
#pragma unroll
        for (int i = 0; i < 8; ++i) {
            const float cv0 = bflo(ra[i].x) * wa0.x + bflo(ra[i + 1].x) * wa1.x + bflo(ra[i + 2].x) * wa2.x + ba.x, cv1 = bfhi(ra[i].x) * wa0.y + bfhi(ra[i + 1].x) * wa1.y + bfhi(ra[i + 2].x) * wa2.y + ba.y;
            const float cv2 = bflo(ra[i].y) * wa0.z + bflo(ra[i + 1].y) * wa1.z + bflo(ra[i + 2].y) * wa2.z + ba.z, cv3 = bfhi(ra[i].y) * wa0.w + bfhi(ra[i + 1].y) * wa1.w + bfhi(ra[i + 2].y) * wa2.w + ba.w;
            const float cg0 = bflo(rg[i].x) * wg0.x + bflo(rg[i + 1].x) * wg1.x + bflo(rg[i + 2].x) * wg2.x + bg.x, cg1 = bfhi(rg[i].x) * wg0.y + bfhi(rg[i + 1].x) * wg1.y + bfhi(rg[i + 2].x) * wg2.y + bg.y;
            const float cg2 = bflo(rg[i].y) * wg0.z + bflo(rg[i + 1].y) * wg1.z + bflo(rg[i + 2].y) * wg2.z + bg.z, cg3 = bfhi(rg[i].y) * wg0.w + bfhi(rg[i + 1].y) * wg1.w + bfhi(rg[i + 2].y) * wg2.w + bg.w;
            uint2 w; w.x = cvt_pk_bf16(cg0 * sigmoidf_(cg0) * cv0, cg1 * sigmoidf_(cg1) * cv1); w.y = cvt_pk_bf16(cg2 * sigmoidf_(cg2) * cv2, cg3 * sigmoidf_(cg3) * cv3);
            *(uint2*)(act + (size_t)(t0 + i) * DFF + j0) = w; }
    }
}

#define XB_TMO      128
#define XB_XCNT(j)  (256  + 64 * (j))
#define XB_XSUB(j)  (1280 + 64 * (j))
#define XB_XGEN(j)  (2304 + 64 * (j))
#define XB_TOP      3328
#define XB_TOPGEN   3392
#define XCD_BAR_WORDS 3456
#define XB_SPIN_CAP (1u << 18)

__device__ __forceinline__ unsigned xb_ld(unsigned* p)              { return __hip_atomic_load(p, __ATOMIC_RELAXED, __HIP_MEMORY_SCOPE_AGENT); }
__device__ __forceinline__ unsigned xb_add(unsigned* p, unsigned v) { return __hip_atomic_fetch_add(p, v, __ATOMIC_RELAXED, __HIP_MEMORY_SCOPE_AGENT); }
__device__ __forceinline__ unsigned xb_xcc_id() { return (unsigned)__builtin_amdgcn_s_getreg((3 << 11) | 20) & 0xFu; }
#define XB_SPIN(cond, bar) do { unsigned _sp = 0; while (cond) { __builtin_amdgcn_s_sleep(1); \
    if ((++_sp & 255u) == 0u) { if (xb_ld(&(bar)[XB_TMO])) break; if (_sp > XB_SPIN_CAP) { atomicAdd(&(bar)[XB_TMO], 1u); break; } } } } while (0)

struct XcdBarrier {
    unsigned* bar; unsigned x;
    volatile LAS unsigned* st;
};

__device__ __forceinline__ XcdBarrier xcd_barrier_post(unsigned* bar, volatile LAS unsigned* st) {
    XcdBarrier b; b.bar = bar; b.x = xb_xcc_id(); b.st = st;
    if (threadIdx.x == 0) (void)xb_add(&bar[XB_XCNT(b.x)], 1u);
    return b;
}
__device__ __forceinline__ void xcd_barrier_complete(unsigned* bar, unsigned x, unsigned& nloc, unsigned& nx) {
    const unsigned G = gridDim.x * gridDim.y * gridDim.z;
    unsigned sum, cnt, mine, sp = 0u;
    for (;;) {
        sum = 0u; cnt = 0u; mine = 0u;
#pragma unroll
        for (unsigned j = 0; j < 16; ++j) { const unsigned c = xb_ld(&bar[XB_XCNT(j)]); sum += c; cnt += (c > 0u) ? 1u : 0u; mine = (j == x) ? c : mine; }
        if (sum == G) break;
        __builtin_amdgcn_s_sleep(1);
        if ((++sp & 255u) == 0u) { if (xb_ld(&bar[XB_TMO])) break; if (sp > XB_SPIN_CAP) { atomicAdd(&bar[XB_TMO], 1u); break; } }
    }
    nloc = mine > 0u ? mine : 1u; nx = cnt > 0u ? cnt : 1u;
}

__device__ __forceinline__ void xcd_barrier(const XcdBarrier& b) {
    asm volatile("s_waitcnt vmcnt(0)" ::: "memory");
    __syncthreads();
    if (threadIdx.x == 0) {
        unsigned* bar = b.bar;
        __builtin_amdgcn_s_waitcnt(0);
        unsigned nloc = b.st[0], nx = b.st[1];
        if (nloc == 0u) { xcd_barrier_complete(bar, b.x, nloc, nx); b.st[0] = nloc; b.st[1] = nx; }
        const unsigned old = xb_add(&bar[XB_XSUB(b.x)], 1u);
        const unsigned gen = old / nloc;
        if (old + 1u == (gen + 1u) * nloc) {
            __builtin_amdgcn_fence(__ATOMIC_RELEASE, "agent");
            asm volatile("s_waitcnt vmcnt(0)" ::: "memory");
            const unsigned og = xb_add(&bar[XB_TOP], 1u);
            const unsigned tg = og / nx;
            if (og + 1u == (tg + 1u) * nx) xb_add(&bar[XB_TOPGEN], 1u);
            else XB_SPIN(xb_ld(&bar[XB_TOPGEN]) == tg, bar);
            __builtin_amdgcn_fence(__ATOMIC_ACQUIRE, "agent");
            xb_add(&bar[XB_XGEN(b.x)], 1u);
            asm volatile("s_waitcnt vmcnt(0)" ::: "memory");
        } else {
            XB_SPIN(xb_ld(&bar[XB_XGEN(b.x)]) == gen, bar);
            __builtin_amdgcn_fence(__ATOMIC_ACQUIRE, "agent");
            asm volatile("s_waitcnt vmcnt(0)" ::: "memory");
        }
    }
    __syncthreads();
}

constexpr int NPH = 12;
__global__ void __launch_bounds__(512, 2) mega(Params P) {
    extern __shared__ __attribute__((aligned(16))) unsigned char lds_raw[];
    LAS unsigned char* lds = (LAS unsigned char*)lds_raw;
    unsigned char* ws = P.ws;
    volatile LAS unsigned* xst = (volatile LAS unsigned*)(lds + 131072);
    if (threadIdx.x < 4) xst[threadIdx.x] = 0u;
    __syncthreads();
    XcdBarrier xb = xcd_barrier_post((unsigned*)(ws + WS_BAR), xst);
#define RUN(i) ((i) >= P.ph_lo && (i) < P.ph_hi)
#define SEAM(i) do { if ((i) >= P.ph_lo && (i) + 1 < P.ph_hi) { xcd_barrier(xb); } } while (0)
    if (RUN(0)) phase0(P, (float*)lds_raw);
    SEAM(0);
    if (RUN(1)) { EpiZ E; E.zmain = (u16*)(ws + WS_Z + Z_MAIN); E.zgate = (u16*)(ws + WS_Z + Z_GATE); E.rstd = (const float*)(ws + WS_SMALL);
        run_gemm(lds, (const u16*)(ws + WS_Z + Z_TAIL), (const u16*)(ws + WS_WIN), 6144, 2048, E); }
    SEAM(1);
    if (RUN(2)) phase2(P, (u16*)lds_raw);
    SEAM(2);
    if (RUN(4)) rwkv_prep(P, lds_raw);
    SEAM(4);
    if (RUN(5)) {
        if ((int)blockIdx.x < NSCAN) rwkv_serial(P, lds_raw);
        else { attn_phase(P); __syncthreads();
            { EpiZG E; E.zgate = (u16*)(ws + WS_Z + Z_GATE); E.rstd = (const float*)(ws + WS_SMALL);
              run_gemm_sub(lds, (const u16*)(ws + WS_Z + Z_TAIL), (const u16*)(ws + WS_WIN) + (size_t)6144 * 2048, 3072, 2048, E, (int)gridDim.x - NSCAN, (int)blockIdx.x - NSCAN); } }
        { volatile int* qid = (volatile int*)(lds_raw + 98304); unsigned* head = (unsigned*)(ws + WS_CNT);
          for (;;) { __syncthreads(); if (threadIdx.x == 0) qid[0] = (int)atomicAdd(head, 1u); __syncthreads();
              const int q = qid[0]; if (q >= 1920) break;
              weight_tile(P, q < 1408 ? 1152 + q : 3264 + (q - 1408), (float*)lds_raw); } }
    }
    SEAM(5);
    if (RUN(6)) phase5(P);
    SEAM(6);
    if (RUN(7)) {
        { EpiBranch<0> E; E.mixed = (u16*)(ws + WS_Z); E.zgate = (const u16*)(ws + WS_Z + Z_GATE);
          run_gemm(lds, (const u16*)((unsigned char*)P.out + O_QN), (const u16*)(ws + WS_WBR1), 2048, 1024, E); }
        { EpiBranch<1> E; E.mixed = (u16*)(ws + WS_Z); E.zgate = (const u16*)(ws + WS_Z + Z_GATE);
          run_gemm(lds, (const u16*)(ws + WS_X + X_OATT), (const u16*)(ws + WS_WBR2), 2048, 1024, E); } }
    SEAM(7);
    if (RUN(8)) { EpiOut1 E; E.x = P.in[0]; E.x1 = P.out; E.x1b = (u16*)(ws + WS_X); E.rowss = (float*)(ws + WS_SMALL + 32768);
        run_gemm(lds, (const u16*)(ws + WS_Z), (const u16*)(ws + WS_WOUT), 2048, 2048, E); }
    SEAM(8);
    if (RUN(9)) { EpiUp E; E.uo = (u16*)(ws + WS_Z); E.rowss = (const float*)(ws + WS_SMALL + 32768);
        run_gemm(lds, (const u16*)(ws + WS_X), (const u16*)(ws + WS_WUP), NUP, 2048, E);
        { const int G_ = (int)gridDim.x, nfull = 1408 % G_, bid_ = (int)blockIdx.x;
          if (bid_ >= nfull) { __syncthreads(); for (int id = 2560 + (bid_ - nfull); id < 3264; id += G_ - nfull) weight_tile(P, id, (float*)lds_raw); } } }
    SEAM(9);
    if (RUN(10)) phase9(P);
    SEAM(10);
    if (RUN(11)) { EpiFinal E; E.out = P.out;
        run_gemm(lds, (const u16*)(ws + WS_ACT), (const u16*)(ws + WS_WDOWN), 2048, DFF, E); }
}

constexpr int LDS_BYTES = 131072 + 16;
extern "C" void kernel_launch(void* const* d_in, const int* in_sizes, int n_in, void* d_out, int out_size, void* d_ws, size_t ws_size, hipStream_t stream) {
    static int grid = 0;
    if (grid == 0) {
        if (n_in != 24 || out_size != MT * DM || ws_size < WS_END) { fprintf(stderr, "kernel_launch: unexpected shapes (n_in %d out %d ws %zu need %zu)\n", n_in, out_size, ws_size, (size_t)WS_END); grid = -1; return; }
        int dev = 0, cus = 0, per_cu = 0;
        hipGetDevice(&dev); hipDeviceGetAttribute(&cus, hipDeviceAttributeMultiprocessorCount, dev);
        if (hipFuncSetAttribute((const void*)mega, hipFuncAttributeMaxDynamicSharedMemorySize, LDS_BYTES) != hipSuccess) { fprintf(stderr, "kernel_launch: hipFuncSetAttribute failed\n"); grid = -1; return; }
        if (hipOccupancyMaxActiveBlocksPerMultiprocessor(&per_cu, (const void*)mega, 512, LDS_BYTES) != hipSuccess || per_cu < 1) { fprintf(stderr, "kernel_launch: occupancy query failed (%d)\n", per_cu); grid = -1; return; }
        grid = cus * per_cu; if (grid > 256) grid = 256;
        if (grid < 2 * NSCAN) { fprintf(stderr, "kernel_launch: grid %d too small\n", grid); grid = -1; return; }
    }
    if (grid < 0) return;
    Params p{};
    for (int i = 0; i < 24; ++i) p.in[i] = (const float*)d_in[i];
    p.out = (float*)d_out; p.ws = (unsigned char*)d_ws;
    if (hipMemsetAsync((unsigned char*)d_ws + WS_BAR, 0, 16384, stream) != hipSuccess) { fprintf(stderr, "kernel_launch: hipMemsetAsync of the barrier words failed\n"); return; }
    p.ph_lo = 0; p.ph_hi = NPH;
    { void* args[] = {&p}; hipError_t e = hipLaunchCooperativeKernel((const void*)mega, dim3(grid), dim3(512), args, LDS_BYTES, stream);
      if (e != hipSuccess) fprintf(stderr, "cooperative launch failed: %s (grid %d)\n", hipGetErrorString(e), grid); }

}
```

```cpp
#include <hip/hip_runtime.h>
#include <hip/hip_cooperative_groups.h>
#include <cstdio>
#include <cstdint>
namespace cg = cooperative_groups;
namespace pg8 {
#define PG8_LAS __attribute__((address_space(3)))
typedef unsigned short bf16_t;
typedef short bf16x8 __attribute__((ext_vector_type(8)));
typedef float f32x4 __attribute__((ext_vector_type(4)));
typedef unsigned u32x4 __attribute__((ext_vector_type(4)));
constexpr int BM = 256, BK = 64, HALF = 128, HTB = HALF * BK * 2  , STAGE_BYTES = 8 * HTB, NXCD = 8, WGM = 8;

__host__ __device__ __forceinline__ int lds_byte(int r, int c) { const int st = (r >> 4) * 2 + (c >> 5), rr = r & 15, cc = c & 31, ob = rr * 64 + cc * 2; return st * 1024 + (ob ^ (((ob >> 9) & 1) << 5)); }
__host__ __device__ __forceinline__ void stage_rc(int b, int& R, int& C) { const int st = b / 1024, sb = b % 1024, swz = sb ^ (((sb >> 9) & 1) << 5); R = (st >> 1) * 16 + swz / 64; C = (st & 1) * 32 + (swz % 64) / 2; }
__host__ __device__ __forceinline__ int perm32(int rho) { const int n = rho >> 4, i = rho & 15; return 8 * (i >> 2) + 4 * n + (i & 3); }

struct Unit { int pm, pn; };
struct Gemm { const bf16_t* A; const bf16_t* Bt; int M, N, K; };

struct StaticOrder {
    int nM, nN, nwg, G, c;
    __host__ __device__ void init(int M, int N, int G_, int c_) { nM = M / BM; nN = N / BM; nwg = nM * nN; G = G_; c = c_; }
    __host__ __device__ bool next(int i, Unit& u) const {
        const long L = (long)i * G + c; if (L >= nwg) return false;
        int wgid = (int)L; { const int q = nwg / NXCD, r = nwg % NXCD, xcd = wgid % NXCD, off = wgid / NXCD; wgid = (xcd < r ? xcd * (q + 1) : r * (q + 1) + (xcd - r) * q) + off; }
        const int nig = WGM * nN, gid = wgid / nig, fm = gid * WGM, gsz = (nM - fm) < WGM ? (nM - fm) : WGM;
        u.pm = fm + ((wgid % nig) % gsz); u.pn = (wgid % nig) / gsz; return true;
    }
    __device__ __forceinline__ void a_ready(const Unit&) const {}
    __device__ __forceinline__ void done(const Unit&) const {}
};
typedef __bf16 bf16v2_t __attribute__((ext_vector_type(2))); typedef float f32v2_t __attribute__((ext_vector_type(2)));
__device__ __forceinline__ unsigned cvt_pk_bf16(float lo, float hi) { const f32v2_t x = {lo, hi}; const bf16v2_t r = __builtin_convertvector(x, bf16v2_t); return __builtin_bit_cast(unsigned, r); }
template <class Epi, class Sched>
__device__ __forceinline__ void gemm_phase(PG8_LAS unsigned char* lds, const Gemm g, const Sched& S, const Epi& E) {
    const int tid = threadIdx.x, wid = __builtin_amdgcn_readfirstlane(tid >> 6), lane = tid & 63, wr = wid >> 2, wc = wid & 3, fr = lane & 15, fq = lane >> 4;
    const int K = g.K, nt = K / BK;
    unsigned voffA[2], voffB[2];
#pragma unroll
    for (int i = 0; i < 2; ++i) { int R, C; stage_rc(tid * 16 + i * 8192, R, C); const int Rb = Epi::PERM ? ((R & ~31) + perm32(R & 31)) : R;
        voffA[i] = (unsigned)(R * K + C) * 2u; voffB[i] = (unsigned)(Rb * K + C) * 2u; }
    const size_t kstep = (size_t)(BK * 2);
    const size_t hstep = (size_t)HALF * K * 2;
    const size_t tstep = 2 * hstep;
    const unsigned ldsw = (unsigned)wid * 1024u;
    const int aoff = lds_byte(wr * 64 + fr, fq * 8), boff = lds_byte(wc * 32 + fr, fq * 8);
#define PG8_SA(b, h) (((b) * 2 + (h)) * HTB)
#define PG8_SB(b, h) ((4 + (b) * 2 + (h)) * HTB)
#define PG8_STAGE(bufoff, gbase, voff) do { _Pragma("unroll") for (int _i = 0; _i < 2; ++_i) \
        __builtin_amdgcn_global_load_lds((const unsigned*)((const char*)(gbase) + (voff)[_i]), (PG8_LAS unsigned*)(lds + (bufoff) + ldsw + _i * 8192), 16, 0, 0); } while (0)
#define PG8_LDA(dst, b, h) do { _Pragma("unroll") for (int m = 0; m < 4; ++m) _Pragma("unroll") for (int k = 0; k < 2; ++k) dst[m][k] = *(const PG8_LAS bf16x8*)(lds + PG8_SA(b, h) + aoff + m * 2048 + k * 1024); } while (0)
#define PG8_LDB(dst, b, h) do { _Pragma("unroll") for (int n = 0; n < 2; ++n) _Pragma("unroll") for (int k = 0; k < 2; ++k) dst[n][k] = *(const PG8_LAS bf16x8*)(lds + PG8_SB(b, h) + boff + n * 2048 + k * 1024); } while (0)
#define PG8_MMA(ai, bj, At, Bt) do { __builtin_amdgcn_s_setprio(1); _Pragma("unroll") for (int m = 0; m < 4; ++m) _Pragma("unroll") for (int n = 0; n < 2; ++n) _Pragma("unroll") for (int k = 0; k < 2; ++k) \
        acc[ai][bj][m][n] = __builtin_amdgcn_mfma_f32_16x16x32_bf16(Bt[n][k], At[m][k], acc[ai][bj][m][n], 0, 0, 0); __builtin_amdgcn_s_setprio(0); } while (0)
#define PG8_WAIT_V(n) asm volatile("s_waitcnt vmcnt(" #n ")" ::: "memory")
#define PG8_WAIT_L(n) asm volatile("s_waitcnt lgkmcnt(" #n ")" ::: "memory")
#define PG8_BAR __builtin_amdgcn_s_barrier()
#define PG8_SCHED __builtin_amdgcn_sched_barrier(0)
    Unit cur, nxt; int ui = 0;
    if (!S.next(0, cur)) return;
    f32x4 acc[2][2][4][2];
#pragma unroll
    for (int a = 0; a < 2; ++a)
#pragma unroll
        for (int b = 0; b < 2; ++b)
#pragma unroll
            for (int m = 0; m < 4; ++m)
#pragma unroll
                for (int n = 0; n < 2; ++n) acc[a][b][m][n] = (f32x4){0.f, 0.f, 0.f, 0.f};
    bf16x8 At[4][2], B0[2][2], B1[2][2];
    const char* cA = (const char*)g.A + (size_t)cur.pm * tstep; const char* cB = (const char*)g.Bt + (size_t)cur.pn * tstep;
    S.a_ready(cur);
    PG8_STAGE(PG8_SB(0, 0), cB, voffB); PG8_STAGE(PG8_SA(0, 0), cA, voffA); PG8_STAGE(PG8_SB(0, 1), cB + hstep, voffB); PG8_STAGE(PG8_SA(0, 1), cA + hstep, voffA);
    if (wr == 1) PG8_BAR;
    PG8_WAIT_V(4); PG8_BAR;
    PG8_STAGE(PG8_SB(1, 0), cB + kstep, voffB); PG8_STAGE(PG8_SA(1, 0), cA + kstep, voffA); PG8_STAGE(PG8_SB(1, 1), cB + hstep + kstep, voffB);
    PG8_WAIT_V(6); PG8_BAR;
    for (;;) {
        const bool has_next = S.next(ui + 1, nxt);
        const char* nA = has_next ? (const char*)g.A + (size_t)nxt.pm * tstep : cA; const char* nB = has_next ? (const char*)g.Bt + (size_t)nxt.pn * tstep : cB;
        for (int t = 0; t < nt; t += 2) {
            const bool last = (t == nt - 2);
            const char* a1 = cA + (size_t)(t + 1) * kstep;
            const char* a2 = last ? nA : cA + (size_t)(t + 2) * kstep; const char* b2 = last ? nB : cB + (size_t)(t + 2) * kstep;
            const char* a3 = a2 + kstep; const char* b3 = b2 + kstep;
            if (last && has_next) S.a_ready(nxt);
            PG8_LDB(B0, 0, 0); PG8_SCHED; PG8_LDA(At, 0, 0); PG8_STAGE(PG8_SA(1, 1), a1 + hstep, voffA);
            PG8_WAIT_L(8); PG8_BAR; PG8_WAIT_L(0); PG8_MMA(0, 0, At, B0); PG8_BAR; PG8_SCHED;
            PG8_LDB(B1, 0, 1); PG8_STAGE(PG8_SB(0, 0), b2, voffB);
            PG8_BAR; PG8_WAIT_L(0); PG8_MMA(0, 1, At, B1); PG8_BAR;
            PG8_LDA(At, 0, 1); PG8_STAGE(PG8_SA(0, 0), a2, voffA);
            PG8_BAR; PG8_WAIT_L(0); PG8_MMA(1, 0, At, B0); PG8_BAR; PG8_SCHED;
            PG8_STAGE(PG8_SB(0, 1), b2 + hstep, voffB);
            PG8_WAIT_V(6); PG8_BAR; PG8_MMA(1, 1, At, B1); PG8_BAR;
            PG8_LDB(B0, 1, 0); PG8_SCHED; PG8_LDA(At, 1, 0); PG8_STAGE(PG8_SA(0, 1), a2 + hstep, voffA);
            PG8_WAIT_L(8); PG8_BAR; PG8_WAIT_L(0); PG8_MMA(0, 0, At, B0); PG8_BAR; PG8_SCHED;
            PG8_LDB(B1, 1, 1); PG8_STAGE(PG8_SB(1, 0), b3, voffB);
            PG8_BAR; PG8_WAIT_L(0); PG8_MMA(0, 1, At, B1); PG8_BAR;
            PG8_LDA(At, 1, 1); PG8_STAGE(PG8_SA(1, 0), a3, voffA);
            PG8_BAR; PG8_WAIT_L(0); PG8_MMA(1, 0, At, B0); PG8_BAR; PG8_SCHED;
            PG8_STAGE(PG8_SB(1, 1), b3 + hstep, voffB);
            PG8_WAIT_V(6); PG8_BAR; PG8_MMA(1, 1, At, B1); PG8_BAR;
        }
        if (wr == 0) PG8_BAR;
        if constexpr (!Epi::AFTER_DRAIN) { E(acc, cur, wr, wc, fr, fq); S.done(cur); }
        if (!has_next) break;
#pragma unroll
        for (int a = 0; a < 2; ++a)
#pragma unroll
            for (int b = 0; b < 2; ++b)
#pragma unroll
                for (int m = 0; m < 4; ++m)
#pragma unroll
                    for (int n = 0; n < 2; ++n) acc[a][b][m][n] = (f32x4){0.f, 0.f, 0.f, 0.f};
        cur = nxt; cA = nA; cB = nB; ++ui;
        if (wr == 1) PG8_BAR;
    }
    PG8_WAIT_V(0);
    PG8_BAR;
    if constexpr (Epi::AFTER_DRAIN) { E.fused(acc, cur, wr, wc, fr, fq, lds, wid, lane); S.done(cur); }
#undef PG8_SA
#undef PG8_SB
#undef PG8_STAGE
#undef PG8_LDA
#undef PG8_LDB
#undef PG8_MMA
#undef PG8_WAIT_V
#undef PG8_WAIT_L
#undef PG8_BAR
#undef PG8_SCHED
}
}

using pg8::f32x4; using pg8::bf16x8; using pg8::Unit; using pg8::cvt_pk_bf16;
typedef unsigned short u16;
#define LAS __attribute__((address_space(3)))

constexpr int MT = 8192, DM = 2048, SEQ = 4096, CH_ = 16;
constexpr int NZ = 9216, ZM = 5120, ZG = 4096, DFF = 5632, NUP = 11264, RWD = 1024;
constexpr size_t WS_WDOWN = 0;
constexpr size_t WS_WIN   = WS_WDOWN + (size_t)2048 * 5632 * 2;
constexpr size_t WS_WUP   = WS_WIN + (size_t)9216 * 2048 * 2;
constexpr size_t WS_WBR1  = WS_WUP + (size_t)11264 * 2048 * 2;
constexpr size_t WS_WBR2  = WS_WBR1 + (size_t)2048 * 1024 * 2;
constexpr size_t WS_WOUT  = WS_WBR2 + (size_t)2048 * 1024 * 2;
constexpr size_t WS_WLORA = WS_WOUT + (size_t)2048 * 2048 * 2;
constexpr size_t WS_Z     = WS_WLORA + (size_t)3072 * 512 * 2;
constexpr size_t Z_BYTES  = (size_t)MT * NUP * 2;
constexpr size_t WS_X     = WS_Z + Z_BYTES;
constexpr size_t WS_SMALL = WS_X + (size_t)MT * DM * 2;
constexpr size_t WS_Y     = WS_SMALL + 32768 + (size_t)MT * 32 * 4;
constexpr size_t WS_G     = WS_Y + (size_t)MT * 1024 * 2;
constexpr size_t WS_RK    = WS_G + (size_t)8192 * 64 * 4;
constexpr size_t WS_CNT   = WS_RK + (size_t)MT * 16 * 4;
constexpr size_t WS_BAR   = WS_CNT + 256;
constexpr size_t WS_END   = WS_BAR + 16384;
constexpr size_t WS_ACT   = WS_WIN;
static_assert(WS_Z - WS_WIN >= (size_t)MT * DFF * 2, "act overlay");
constexpr size_t Z_MAIN = 0, Z_GATE = (size_t)MT * ZM * 2, Z_TAIL = (size_t)MT * (ZM + ZG) * 2;
constexpr size_t Z_LW = 0, Z_A = (size_t)MT * RWD * 4, Z_G = 2 * (size_t)MT * RWD * 4;
constexpr size_t X_AP = 0, X_KN = (size_t)MT * 512 * 2, X_VT = X_KN + (size_t)MT * 256 * 2, X_OATT = X_VT + (size_t)MT * 256 * 2;
constexpr size_t O_RKV = 0, O_QN = (size_t)MT * 3072 * 2;

struct Params { const float* in[24]; float* out; unsigned char* ws; int ph_lo, ph_hi; };

__device__ __forceinline__ float bf2f(unsigned short b) { return __uint_as_float(((unsigned)b) << 16); }
__device__ __forceinline__ float bflo(unsigned u) { return __uint_as_float(u << 16); }
__device__ __forceinline__ float bfhi(unsigned u) { return __uint_as_float(u & 0xffff0000u); }
__device__ __forceinline__ u16 f2bf(float f) { return (u16)(cvt_pk_bf16(f, f) & 0xffffu); }
__device__ __forceinline__ float wave_sum(float v) {
#pragma unroll
    for (int o = 32; o; o >>= 1) v += __shfl_xor(v, o);
    return v; }
__device__ __forceinline__ float sigmoidf_(float x) { return 1.0f / (1.0f + __expf(-x)); }
template <int CTRL> __device__ __forceinline__ float dppf(float x) { return __int_as_float(__builtin_amdgcn_update_dpp(0, __float_as_int(x), CTRL, 0xF, 0xF, true)); }
__device__ __forceinline__ float row16_sum(float x) { x += dppf<0xB1>(x); x += dppf<0x4E>(x); x += dppf<0x141>(x); x += dppf<0x140>(x); return x; }

#define EPI_ROWS _Pragma("unroll") for (int ai = 0; ai < 2; ++ai) _Pragma("unroll") for (int m = 0; m < 4; ++m)
#define EPI_COLS _Pragma("unroll") for (int bj = 0; bj < 2; ++bj) _Pragma("unroll") for (int n = 0; n < 2; ++n)
struct EpiZ {
    static constexpr bool PERM = true, AFTER_DRAIN = false;
    u16* zmain; u16* zgate; const float* rstd;
    __device__ __forceinline__ void operator()(const f32x4 (&acc)[2][2][4][2], const Unit& u, int wr, int wc, int fr, int fq) const {
        u16* base; int ld, c0;
        if (u.pn < 20) { base = zmain; ld = ZM; c0 = u.pn * 256; } else { base = zgate; ld = ZG; c0 = (u.pn - 20) * 256; }
        const int row0 = u.pm * 256 + wr * 64 + fr; c0 += wc * 32 + 8 * fq;
        float rsv[2][4];
        EPI_ROWS rsv[ai][m] = rstd[row0 + ai * 128 + m * 16];
        EPI_ROWS { const int row = row0 + ai * 128 + m * 16; const float rs = rsv[ai][m]; u16* rp = base + (size_t)row * ld + c0;
#pragma unroll
            for (int bj = 0; bj < 2; ++bj) { const f32x4 v0 = acc[ai][bj][m][0] * rs, v1 = acc[ai][bj][m][1] * rs;
                uint4 w; w.x = cvt_pk_bf16(v0[0], v0[1]); w.y = cvt_pk_bf16(v0[2], v0[3]); w.z = cvt_pk_bf16(v1[0], v1[1]); w.w = cvt_pk_bf16(v1[2], v1[3]); *(uint4*)(rp + bj * 128) = w; } }
    }
};
struct EpiLora {
    static constexpr bool PERM = true, AFTER_DRAIN = false;
    float* lw; float* av; u16* g; const float* w0; const float* a0;
    __device__ __forceinline__ void operator()(const f32x4 (&acc)[2][2][4][2], const Unit& u, int wr, int wc, int fr, int fq) const {
        const int row0 = u.pm * 256 + wr * 64 + fr; const int kind = u.pn >> 2; const int c0 = (u.pn & 3) * 256 + wc * 32 + 8 * fq;
        if (kind == 0) {
            EPI_ROWS { const int row = row0 + ai * 128 + m * 16;
                EPI_COLS { const int col = c0 + bj * 128 + n * 4; const f32x4 v = acc[ai][bj][m][n]; const f32x4 b = *(const f32x4*)(w0 + col); f32x4 o;
#pragma unroll
                    for (int j = 0; j < 4; ++j) { const float y = -(b[j] + v[j]); const float sp = fmaxf(y, 0.f) + __logf(1.0f + __expf(-fabsf(y))); o[j] = -__expf(-sp - 0.5f); }
                    *(f32x4*)(lw + (size_t)row * RWD + col) = o; } }
        } else if (kind == 1) {
            EPI_ROWS { const int row = row0 + ai * 128 + m * 16;
                EPI_COLS { const int col = c0 + bj * 128 + n * 4; const f32x4 v = acc[ai][bj][m][n]; const f32x4 b = *(const f32x4*)(a0 + col); f32x4 o;
#pragma unroll
                    for (int j = 0; j < 4; ++j) o[j] = sigmoidf_(b[j] + v[j]);
                    *(f32x4*)(av + (size_t)row * RWD + col) = o; } }
        } else {
            EPI_ROWS { const int row = row0 + ai * 128 + m * 16;
#pragma unroll
                for (int bj = 0; bj < 2; ++bj) { const f32x4 v0 = acc[ai][bj][m][0], v1 = acc[ai][bj][m][1];
                    uint4 w; w.x = cvt_pk_bf16(v0[0], v0[1]); w.y = cvt_pk_bf16(v0[2], v0[3]); w.z = cvt_pk_bf16(v1[0], v1[1]); w.w = cvt_pk_bf16(v1[2], v1[3]); *(uint4*)(g + (size_t)row * RWD + c0 + bj * 128) = w; } }
        }
    }
};
template <int PASS> struct EpiBranch {
    static constexpr bool PERM = true, AFTER_DRAIN = false;
    u16* mixed; const u16* zgate;
    __device__ __forceinline__ void operator()(const f32x4 (&acc)[2][2][4][2], const Unit& u, int wr, int wc, int fr, int fq) const {
        const int row0 = u.pm * 256 + wr * 64 + fr; const int c0 = u.pn * 256 + wc * 32 + 8 * fq;
        EPI_ROWS { const int row = row0 + ai * 128 + m * 16;
#pragma unroll
            for (int bj = 0; bj < 2; ++bj) { const int col = c0 + bj * 128; const f32x4 v0 = acc[ai][bj][m][0], v1 = acc[ai][bj][m][1];
                const uint4 gz = *(const uint4*)(zgate + (size_t)row * ZG + PASS * 2048 + col);
                float o[8]; o[0] = sigmoidf_(bflo(gz.x)) * v0[0]; o[1] = sigmoidf_(bfhi(gz.x)) * v0[1]; o[2] = sigmoidf_(bflo(gz.y)) * v0[2]; o[3] = sigmoidf_(bfhi(gz.y)) * v0[3];
                o[4] = sigmoidf_(bflo(gz.z)) * v1[0]; o[5] = sigmoidf_(bfhi(gz.z)) * v1[1]; o[6] = sigmoidf_(bflo(gz.w)) * v1[2]; o[7] = sigmoidf_(bfhi(gz.w)) * v1[3];
                uint4* mp = (uint4*)(mixed + (size_t)row * DM + col);
                if (PASS == 1) { const uint4 pm = *mp; o[0] += bflo(pm.x); o[1] += bfhi(pm.x); o[2] += bflo(pm.y); o[3] += bfhi(pm.y); o[4] += bflo(pm.z); o[5] += bfhi(pm.z); o[6] += bflo(pm.w); o[7] += bfhi(pm.w); }
                uint4 w; w.x = cvt_pk_bf16(o[0], o[1]); w.y = cvt_pk_bf16(o[2], o[3]); w.z = cvt_pk_bf16(o[4], o[5]); w.w = cvt_pk_bf16(o[6], o[7]); *mp = w; } }
    }
};
struct EpiOut1 {
    static constexpr bool PERM = true, AFTER_DRAIN = false;
    const float* x; float* x1; u16* x1b; float* rowss;
    __device__ __forceinline__ void operator()(const f32x4 (&acc)[2][2][4][2], const Unit& u, int wr, int wc, int fr, int fq) const {
        const int row0 = u.pm * 256 + wr * 64 + fr; const int c0 = u.pn * 256 + wc * 32 + 8 * fq;
        EPI_ROWS { const int row = row0 + ai * 128 + m * 16; float ss = 0.f;
#pragma unroll
            for (int bj = 0; bj < 2; ++bj) { const size_t o = (size_t)row * DM + c0 + bj * 128;
                const f32x4 v0 = acc[ai][bj][m][0] + *(const f32x4*)(x + o), v1 = acc[ai][bj][m][1] + *(const f32x4*)(x + o + 4);
                *(f32x4*)(x1 + o) = v0; *(f32x4*)(x1 + o + 4) = v1;
                ss += (v0[0] * v0[0] + v0[1] * v0[1] + v0[2] * v0[2] + v0[3] * v0[3]) + (v1[0] * v1[0] + v1[1] * v1[1] + v1[2] * v1[2] + v1[3] * v1[3]);
                uint4 w; w.x = cvt_pk_bf16(v0[0], v0[1]); w.y = cvt_pk_bf16(v0[2], v0[3]); w.z = cvt_pk_bf16(v1[0], v1[1]); w.w = cvt_pk_bf16(v1[2], v1[3]); *(uint4*)(x1b + o) = w; }
            ss += __shfl_xor(ss, 16); ss += __shfl_xor(ss, 32);
            if (fq == 0) rowss[(size_t)row * 32 + u.pn * 4 + wc] = ss; }
    }
};
struct EpiUp {
    static constexpr bool PERM = true, AFTER_DRAIN = false;
    u16* uo; const float* rowss;
    __device__ __forceinline__ void operator()(const f32x4 (&acc)[2][2][4][2], const Unit& u, int wr, int wc, int fr, int fq) const {
        const int row0 = u.pm * 256 + wr * 64 + fr; const int c0 = u.pn * 256 + wc * 32 + 8 * fq;
        float rsv[2][4];
        EPI_ROWS { const int row = row0 + ai * 128 + m * 16;
            const f32x4 p0 = *(const f32x4*)(rowss + (size_t)row * 32 + fq * 8), p1 = *(const f32x4*)(rowss + (size_t)row * 32 + fq * 8 + 4);
            float ss = ((p0[0] + p0[1]) + (p0[2] + p0[3])) + ((p1[0] + p1[1]) + (p1[2] + p1[3]));
            ss += __shfl_xor(ss, 16); ss += __shfl_xor(ss, 32);
            rsv[ai][m] = rsqrtf(ss * (1.0f / 2048.0f) + 1e-6f); }
        EPI_ROWS { const int row = row0 + ai * 128 + m * 16; const float rs = rsv[ai][m]; u16* rp = uo + (size_t)row * NUP + c0;
#pragma unroll
            for (int bj = 0; bj < 2; ++bj) { const f32x4 v0 = acc[ai][bj][m][0] * rs, v1 = acc[ai][bj][m][1] * rs;
                uint4 w; w.x = cvt_pk_bf16(v0[0], v0[1]); w.y = cvt_pk_bf16(v0[2], v0[3]); w.z = cvt_pk_bf16(v1[0], v1[1]); w.w = cvt_pk_bf16(v1[2], v1[3]); *(uint4*)(rp + bj * 128) = w; } }
    }
};
struct EpiFinal {
    static constexpr bool PERM = true, AFTER_DRAIN = false;
    float* out;
    __device__ __forceinline__ void operator()(const f32x4 (&acc)[2][2][4][2], const Unit& u, int wr, int wc, int fr, int fq) const {
        const int row0 = u.pm * 256 + wr * 64 + fr; const int c0 = u.pn * 256 + wc * 32 + 8 * fq;
        EPI_ROWS { const int row = row0 + ai * 128 + m * 16;
#pragma unroll
            for (int bj = 0; bj < 2; ++bj) { float* op = out + (size_t)row * DM + c0 + bj * 128;
                const f32x4 a0 = *(const f32x4*)op + acc[ai][bj][m][0], a1 = *(const f32x4*)(op + 4) + acc[ai][bj][m][1]; *(f32x4*)op = a0; *(f32x4*)(op + 4) = a1; } }
    }
};

template <class Epi> __device__ __forceinline__ void run_gemm(LAS unsigned char* lds, const u16* A, const u16* Bt, int N, int K, const Epi& E) {
    pg8::Gemm g; g.A = A; g.Bt = Bt; g.M = MT; g.N = N; g.K = K;
    pg8::StaticOrder S; S.init(MT, N, (int)gridDim.x, (int)blockIdx.x);
    pg8::gemm_phase<Epi, pg8::StaticOrder>(lds, g, S, E);
}

template <class Epi> __device__ __forceinline__ void run_gemm_sub(LAS unsigned char* lds, const u16* A, const u16* Bt, int N, int K, const Epi& E, int G, int c) {
    pg8::Gemm g; g.A = A; g.Bt = Bt; g.M = MT; g.N = N; g.K = K;
    pg8::StaticOrder S; S.init(MT, N, G, c);
    pg8::gemm_phase<Epi, pg8::StaticOrder>(lds, g, S, E);
}
struct EpiZG {
    static constexpr bool PERM = true, AFTER_DRAIN = false;
    u16* zgate; const float* rstd;
    __device__ __forceinline__ void operator()(const f32x4 (&acc)[2][2][4][2], const Unit& u, int wr, int wc, int fr, int fq) const {
        const int row0 = u.pm * 256 + wr * 64 + fr; const int c0 = 1024 + u.pn * 256 + wc * 32 + 8 * fq;
        float rsv[2][4];
        EPI_ROWS rsv[ai][m] = rstd[row0 + ai * 128 + m * 16];
        EPI_ROWS { const int row = row0 + ai * 128 + m * 16; const float rs = rsv[ai][m]; u16* rp = zgate + (size_t)row * ZG + c0;
#pragma unroll
            for (int bj = 0; bj < 2; ++bj) { const f32x4 v0 = acc[ai][bj][m][0] * rs, v1 = acc[ai][bj][m][1] * rs;
                uint4 w; w.x = cvt_pk_bf16(v0[0], v0[1]); w.y = cvt_pk_bf16(v0[2], v0[3]); w.z = cvt_pk_bf16(v1[0], v1[1]); w.w = cvt_pk_bf16(v1[2], v1[3]); *(uint4*)(rp + bj * 128) = w; } }
    }
};

__device__ __forceinline__ void tr_tile(const float* __restrict__ src, int ldn, int nsrc0, u16* __restrict__ dst, int K, int k0, int ndst0, const float* __restrict__ scale, float* tile) {
    const int tid = threadIdx.x, nc4 = (tid & 15) * 4, kr0 = tid >> 4;
    float4 v[8];
#pragma unroll
    for (int i = 0; i < 8; ++i) { const int kr = kr0 + 32 * i; v[i] = make_float4(0.f, 0.f, 0.f, 0.f);
        if (nsrc0 >= 0) v[i] = *(const float4*)(src + (size_t)(k0 + kr) * ldn + nsrc0 + nc4); }
#pragma unroll
    for (int i = 0; i < 8; ++i) { const int kr = kr0 + 32 * i; const float sc = scale ? scale[k0 + kr] : 1.0f; float* tp = tile + kr * 65 + nc4;
        tp[0] = v[i].x * sc; tp[1] = v[i].y * sc; tp[2] = v[i].z * sc; tp[3] = v[i].w * sc; }
    __syncthreads();
    const int nr = tid >> 3, kb = (tid & 7) * 8;
#pragma unroll
    for (int q = 0; q < 4; ++q) { const int kc = kb + 64 * q; uint4 w;
        w.x = cvt_pk_bf16(tile[(kc + 0) * 65 + nr], tile[(kc + 1) * 65 + nr]); w.y = cvt_pk_bf16(tile[(kc + 2) * 65 + nr], tile[(kc + 3) * 65 + nr]);
        w.z = cvt_pk_bf16(tile[(kc + 4) * 65 + nr], tile[(kc + 5) * 65 + nr]); w.w = cvt_pk_bf16(tile[(kc + 6) * 65 + nr], tile[(kc + 7) * 65 + nr]);
        *(uint4*)(dst + (size_t)(ndst0 + nr) * K + k0 + kc) = w; }
    __syncthreads();
}
constexpr int WT_IN = 1152, WT_ALL = 3776;
__device__ __forceinline__ void weight_tile(const Params& P, int id, float* tile) {
    unsigned char* ws = P.ws;
    if (id < 1152) { const int nt = id % 144, kt = id / 144; const int ns = nt < 55 ? nt * 64 : (nt == 55 ? -1 : nt * 64 - 64);
        tr_tile(P.in[2], 9152, ns, (u16*)(ws + WS_WIN), 2048, kt * 256, nt * 64, P.in[1], tile); }
    else if (id < 1152 + 1408) { const int j = id - 1152, nt = j % 176, kt = j / 176;
        tr_tile(P.in[20], NUP, nt * 64, (u16*)(ws + WS_WUP), 2048, kt * 256, nt * 64, P.in[19], tile); }
    else if (id < 2560 + 704) { const int j = id - 2560, nt = j % 32, kt = j / 32;
        tr_tile(P.in[23], 2048, nt * 64, (u16*)(ws + WS_WDOWN), 5632, kt * 256, nt * 64, nullptr, tile); }
    else if (id < 3264 + 128) { const int j = id - 3264, nt = j % 32, kt = j / 32;
        tr_tile(P.in[17], 2048, nt * 64, (u16*)(ws + WS_WBR1), 1024, kt * 256, nt * 64, nullptr, tile); }
    else if (id < 3392 + 128) { const int j = id - 3392, nt = j % 32, kt = j / 32;
        tr_tile(P.in[17] + (size_t)1024 * 2048, 2048, nt * 64, (u16*)(ws + WS_WBR2), 1024, kt * 256, nt * 64, nullptr, tile); }
    else { const int j = id - 3520, nt = j % 32, kt = j / 32;
        tr_tile(P.in[18], 2048, nt * 64, (u16*)(ws + WS_WOUT), 2048, kt * 256, nt * 64, nullptr, tile); }
}
__device__ __forceinline__ void win_tile(const Params& P, int kt, int nt, float* tile) {
    const int ns = nt < 55 ? nt * 64 : (nt == 55 ? -1 : nt * 64 - 64);
    tr_tile(P.in[2], 9152, ns, (u16*)(P.ws + WS_WIN), 2048, kt * 256, nt * 64, P.in[1], tile);
}
__device__ void phase0(const Params& P, float* tile) {
    unsigned char* ws = P.ws; const int G = gridDim.x, bid = blockIdx.x, tid = threadIdx.x;
    if (bid == 0 && tid == 0) *(unsigned*)(ws + WS_CNT) = 0u;
    for (int id = bid; id < 1152; id += G) win_tile(P, id / 144, id % 144, tile);
    { u16* w2t = (u16*)(ws + WS_WLORA); u16* a2t = w2t + 1024 * 96; u16* g2t = a2t + 1024 * 96;
      for (int idx = bid * 512 + tid; idx < 448 * 1024; idx += G * 512) { const int kk = idx >> 10, n = idx & 1023;
          if (kk < 96) w2t[n * 96 + kk] = f2bf(P.in[5][(size_t)kk * 1024 + n]);
          else if (kk < 192) a2t[n * 96 + (kk - 96)] = f2bf(P.in[7][(size_t)(kk - 96) * 1024 + n]);
          else g2t[n * 256 + (kk - 192)] = f2bf(P.in[8][(size_t)(kk - 192) * 1024 + n]); } }
    { const int lane = tid & 63, gw = bid * 8 + (tid >> 6), nw = G * 8; u16* xb = (u16*)(ws + WS_Z + Z_TAIL); float* rstd1 = (float*)(ws + WS_SMALL);
      for (int t = gw; t < MT; t += nw) { const float4* xr = (const float4*)(P.in[0] + (size_t)t * DM); float ss = 0.f;
#pragma unroll
          for (int i = 0; i < 8; ++i) { const float4 v = xr[lane + 64 * i]; ss += v.x * v.x + v.y * v.y + v.z * v.z + v.w * v.w;
              uint2 w; w.x = cvt_pk_bf16(v.x, v.y); w.y = cvt_pk_bf16(v.z, v.w); *(uint2*)(xb + (size_t)t * DM + (lane + 64 * i) * 4) = w; }
          ss = wave_sum(ss); if (lane == 0) rstd1[t] = rsqrtf(ss * (1.0f / 2048.0f) + 1e-6f); } }
}

__device__ void phase2(const Params& P, u16* tile) {
    unsigned char* ws = P.ws; const int G = gridDim.x, bid = blockIdx.x, tid = threadIdx.x, lane = tid & 63;
    const u16* zmain = (const u16*)(ws + WS_Z + Z_MAIN);
    u16* rkv = (u16*)((unsigned char*)P.out + O_RKV); u16* Qn = (u16*)((unsigned char*)P.out + O_QN);
    u16* Ap = (u16*)(ws + WS_X + X_AP); u16* Kn = (u16*)(ws + WS_X + X_KN); u16* Vt = (u16*)(ws + WS_X + X_VT);
    const float* mu = P.in[3];
    const int d0 = (lane * 2) & 63; const float qg0 = P.in[14][d0] * 0.125f, qg1 = P.in[14][d0 + 1] * 0.125f, kg0 = P.in[15][d0], kg1 = P.in[15][d0 + 1];
    for (int t = bid * 8 + (tid >> 6); t < MT; t += G * 8) {
        const u16* zr = zmain + (size_t)t * ZM; const bool hp = (t & (SEQ - 1)) != 0; const u16* zp = hp ? zr - ZM : zr;
        unsigned zz[28], pp[28], qk[10]; float2 m2[28];
#pragma unroll
        for (int i = 0; i < 28; ++i) { const int c = i * 128 + lane * 2; zz[i] = 0u; pp[i] = 0u; m2[i] = make_float2(0.f, 0.f);
            if (i < 27 || lane < 32) { zz[i] = *(const unsigned*)(zr + c); pp[i] = *(const unsigned*)(zp + c); m2[i] = *(const float2*)(mu + c); } }
#pragma unroll
        for (int i = 0; i < 10; ++i) qk[i] = *(const unsigned*)(zr + 3584 + i * 128 + lane * 2);
#pragma unroll
        for (int i = 0; i < 28; ++i) { const int c = i * 128 + lane * 2;
            if (i < 27 || lane < 32) { const unsigned pv = hp ? pp[i] : 0u;
                const float z0 = bflo(zz[i]), z1 = bfhi(zz[i]); const float a0 = z0 + (bflo(pv) - z0) * m2[i].x, a1 = z1 + (bfhi(pv) - z1) * m2[i].y;
                if (i < 24) *(unsigned*)(rkv + (size_t)t * 3072 + c) = cvt_pk_bf16(a0, a1);
                else if (c < 3168) *(unsigned*)(Ap + (size_t)t * 512 + (c - 3072)) = cvt_pk_bf16(tanhf(a0), tanhf(a1));
                else if (c < 3264) *(unsigned*)(Ap + (size_t)t * 512 + 96 + (c - 3168)) = cvt_pk_bf16(a0, a1);
                else *(unsigned*)(Ap + (size_t)t * 512 + 256 + (c - 3264)) = cvt_pk_bf16(sigmoidf_(a0), sigmoidf_(a1)); } }
        if (lane < 32) *(unsigned*)(Ap + (size_t)t * 512 + 192 + lane * 2) = 0u;
#pragma unroll
        for (int i = 0; i < 10; ++i) { const float v0 = bflo(qk[i]), v1 = bfhi(qk[i]); float ss = row16_sum(v0 * v0 + v1 * v1); ss += __shfl_xor(ss, 16);
            const float rs = rsqrtf(ss * (1.0f / 64.0f) + 1e-6f);
            if (i < 8) *(unsigned*)(Qn + (size_t)t * 1024 + i * 128 + lane * 2) = cvt_pk_bf16(v0 * rs * qg0, v1 * rs * qg1);
            else *(unsigned*)(Kn + (size_t)t * 256 + (i - 8) * 128 + lane * 2) = cvt_pk_bf16(v0 * rs * kg0, v1 * rs * kg1); }
    }
    for (int tl = bid; tl < MT / 64; tl += G) { const int t0 = tl * 64;
        __syncthreads();
        for (int i = 0; i < 16; ++i) { const int idx = tid + 512 * i, r = idx >> 7, cp = idx & 127; const unsigned vv = *(const unsigned*)(zmain + (size_t)(t0 + r) * ZM + 4864 + 2 * cp);
            tile[(2 * cp) * 66 + r] = (u16)(vv & 0xffffu); tile[(2 * cp + 1) * 66 + r] = (u16)(vv >> 16); }
        __syncthreads();
        const int b = t0 >> 12, s0 = t0 & (SEQ - 1);
        for (int i = 0; i < 16; ++i) { const int idx = tid + 512 * i, c = idx >> 5, sp = idx & 31;
            const unsigned w = (unsigned)tile[c * 66 + 2 * sp] | ((unsigned)tile[c * 66 + 2 * sp + 1] << 16);
            *(unsigned*)(Vt + ((size_t)(b * 4 + (c >> 6)) * 64 + (c & 63)) * SEQ + s0 + 2 * sp) = w; }
    }
}

constexpr int NSCAN = 32;
#define LDS_BARRIER() do { asm volatile("s_waitcnt lgkmcnt(0)" ::: "memory"); __builtin_amdgcn_s_barrier(); asm volatile("" ::: "memory"); } while (0)
__device__ __forceinline__ float row8_sum(float x) { x += dppf<0xB1>(x); x += dppf<0x4E>(x); x += dppf<0x141>(x); return x; }
__device__ void rwkv_prep(const Params& P, unsigned char* lds_raw) {
    unsigned char* ws = P.ws; const int tid = threadIdx.x, q4 = tid >> 7, lt = tid & 127, lane = tid & 63, qw = (tid >> 6) & 1, fr = lane & 15, fq = lane >> 4;
    unsigned char* lwb = ws + WS_Z + Z_LW; unsigned char* ab = ws + WS_Z + Z_A; u16* rkv = (u16*)((unsigned char*)P.out + O_RKV);
    float* gbuf = (float*)(ws + WS_G); float* rkb = (float*)(ws + WS_RK);
    const u16* Apx = (const u16*)(ws + WS_X + X_AP); const u16* w2t = (const u16*)(ws + WS_WLORA); const u16* a2t = w2t + 1024 * 96; const u16* g2t = a2t + 1024 * 96; u16* gout = (u16*)(ws + WS_Z + Z_G);
    unsigned char* L0 = lds_raw + q4 * 32768;
    u16* sAt = (u16*)L0; u16* sBt = sAt + 16 * 72; u16* sKt = sBt + 16 * 72; u16* sRt = sKt + 16 * 72;
    u16* sVt = (u16*)(L0 + 9216); u16* sAak = (u16*)(L0 + 12288); float* sN = (float*)(L0 + 13312); float* sRHS = (float*)(L0 + 14400); float* sL = (float*)(L0 + 22848); float* sAf = (float*)(L0 + 26944);
    const int tl = lt >> 3, c8 = (lt & 7) * 8;
    uint4 n_r, n_k, n_v; float4 n_kkw[2], n_kaw[2], n_rkw[2]; bf16x8 n_At[3], n_Aa[3], n_Ag[8];
    auto unit_of = [&](int it_) { if ((int)gridDim.x == 256) { const int s_ = (it_ & 255) * 4 + q4; return (s_ >> 5) * 256 + (s_ & 31) + 32 * (it_ >> 8); } return it_ * 4 + q4; };
    auto fetch = [&](int it_) { const int unit_ = unit_of(it_), b_ = unit_ >> 12, h_ = (unit_ >> 8) & 15, c_ = unit_ & 255; const size_t t_ = (size_t)b_ * SEQ + c_ * CH_ + tl; const int hc_ = h_ * 64 + c8;
        n_r = *(const uint4*)(rkv + t_ * 3072 + hc_); n_k = *(const uint4*)(rkv + t_ * 3072 + 1024 + hc_); n_v = *(const uint4*)(rkv + t_ * 3072 + 2048 + hc_);
#pragma unroll
        for (int i = 0; i < 2; ++i) {
            n_kkw[i] = *(const float4*)(P.in[9] + hc_ + 4 * i); n_kaw[i] = *(const float4*)(P.in[10] + hc_ + 4 * i); n_rkw[i] = *(const float4*)(P.in[11] + hc_ + 4 * i); }
        const u16* ar_ = Apx + ((size_t)b_ * SEQ + c_ * CH_ + fr) * 512 + 8 * fq;
#pragma unroll
        for (int ks = 0; ks < 3; ++ks) { n_At[ks] = *(const bf16x8*)(ar_ + 32 * ks); n_Aa[ks] = *(const bf16x8*)(ar_ + 96 + 32 * ks); }
#pragma unroll
        for (int ks = 0; ks < 8; ++ks) n_Ag[ks] = *(const bf16x8*)(ar_ + 256 + 32 * ks); };
    if ((int)blockIdx.x < 2048) fetch(blockIdx.x);
    for (int it = blockIdx.x; it < 2048; it += gridDim.x) {
        const int unit = unit_of(it), b = unit >> 12, h = (unit >> 8) & 15, c = unit & 255; const size_t t0 = (size_t)b * SEQ + c * CH_, t = t0 + tl;
#pragma unroll
        for (int n2 = 0; n2 < 2; ++n2) { const int cn = (qw * 2 + n2) * 16 + fr, nrow = h * 64 + cn;
            f32x4 accw = {0.f, 0.f, 0.f, 0.f}, acca = {0.f, 0.f, 0.f, 0.f}, accg = {0.f, 0.f, 0.f, 0.f};
#pragma unroll
            for (int ks = 0; ks < 3; ++ks) { const bf16x8 bw = *(const bf16x8*)(w2t + nrow * 96 + 32 * ks + 8 * fq), ba = *(const bf16x8*)(a2t + nrow * 96 + 32 * ks + 8 * fq);
                accw = __builtin_amdgcn_mfma_f32_16x16x32_bf16(n_At[ks], bw, accw, 0, 0, 0); acca = __builtin_amdgcn_mfma_f32_16x16x32_bf16(n_Aa[ks], ba, acca, 0, 0, 0); }
#pragma unroll
            for (int ks = 0; ks < 8; ++ks) { const bf16x8 bg = *(const bf16x8*)(g2t + nrow * 256 + 32 * ks + 8 * fq); accg = __builtin_amdgcn_mfma_f32_16x16x32_bf16(n_Ag[ks], bg, accg, 0, 0, 0); }
            const float w0v = P.in[4][nrow], a0v = P.in[6][nrow];
#pragma unroll
            for (int j = 0; j < 4; ++j) { const int tt = 4 * fq + j; const float y = -(w0v + accw[j]); const float sp = fmaxf(y, 0.f) + __logf(1.0f + __expf(-fabsf(y)));
                sL[tt * 64 + cn] = -__expf(-sp - 0.5f); sAf[tt * 64 + cn] = sigmoidf_(a0v + acca[j]); gout[(t0 + tt) * RWD + nrow] = f2bf(accg[j]); } }
        LDS_BARRIER();
        const unsigned ru[4] = {n_r.x, n_r.y, n_r.z, n_r.w}, ku[4] = {n_k.x, n_k.y, n_k.z, n_k.w}, vu[4] = {n_v.x, n_v.y, n_v.z, n_v.w};
        float rr[8], kr[8], aa[8], lw[8], kkw_[8], kaw_[8], rkw_[8];
        { const float4 l0 = *(const float4*)(sL + tl * 64 + c8), l1 = *(const float4*)(sL + tl * 64 + c8 + 4), q0 = *(const float4*)(sAf + tl * 64 + c8), q1 = *(const float4*)(sAf + tl * 64 + c8 + 4);
          lw[0] = l0.x; lw[1] = l0.y; lw[2] = l0.z; lw[3] = l0.w; lw[4] = l1.x; lw[5] = l1.y; lw[6] = l1.z; lw[7] = l1.w; aa[0] = q0.x; aa[1] = q0.y; aa[2] = q0.z; aa[3] = q0.w; aa[4] = q1.x; aa[5] = q1.y; aa[6] = q1.z; aa[7] = q1.w; }
#pragma unroll
        for (int i = 0; i < 4; ++i) { rr[2 * i] = bflo(ru[i]); rr[2 * i + 1] = bfhi(ru[i]); kr[2 * i] = bflo(ku[i]); kr[2 * i + 1] = bfhi(ku[i]); }
#pragma unroll
        for (int i = 0; i < 2; ++i) {
            kkw_[4 * i] = n_kkw[i].x; kkw_[4 * i + 1] = n_kkw[i].y; kkw_[4 * i + 2] = n_kkw[i].z; kkw_[4 * i + 3] = n_kkw[i].w; kaw_[4 * i] = n_kaw[i].x; kaw_[4 * i + 1] = n_kaw[i].y; kaw_[4 * i + 2] = n_kaw[i].z; kaw_[4 * i + 3] = n_kaw[i].w;
            rkw_[4 * i] = n_rkw[i].x; rkw_[4 * i + 1] = n_rkw[i].y; rkw_[4 * i + 2] = n_rkw[i].z; rkw_[4 * i + 3] = n_rkw[i].w; }
        float qq[8], kk[8], bb[8], kp[8]; float ss = 0.f, rks = 0.f;
#pragma unroll
        for (int j = 0; j < 8; ++j) { qq[j] = kr[j] * kkw_[j]; ss += qq[j] * qq[j]; }
        ss = row8_sum(ss); const float inv = 1.0f / fmaxf(sqrtf(ss), 1e-12f);
#pragma unroll
        for (int j = 0; j < 8; ++j) { kk[j] = qq[j] * inv; bb[j] = kk[j] * aa[j]; kp[j] = kr[j] * (1.0f + (aa[j] - 1.0f) * kaw_[j]); rks += rr[j] * kp[j] * rkw_[j]; }
        rks = row8_sum(rks); if ((lt & 7) == 0) rkb[t * 16 + h] = rks;
#pragma unroll
        for (int i = 0; i < 4; ++i) { sVt[(c8 + 2 * i) * 24 + tl] = (u16)(vu[i] & 0xffffu); sVt[(c8 + 2 * i + 1) * 24 + tl] = (u16)(vu[i] >> 16); }
        LDS_BARRIER();
        if (lt < 64) { float lv[16];
#pragma unroll
            for (int i = 0; i < 16; ++i) lv[i] = sL[i * 64 + lt];
#pragma unroll
            for (int i = 1; i < 16; ++i) lv[i] += lv[i - 1];
#pragma unroll
            for (int i = 0; i < 16; ++i) sL[i * 64 + lt] = lv[i]; }
        LDS_BARRIER();
        { const float4 La = *(const float4*)(sL + tl * 64 + c8), Lb = *(const float4*)(sL + tl * 64 + c8 + 4), Ta = *(const float4*)(sL + 15 * 64 + c8), Tb = *(const float4*)(sL + 15 * 64 + c8 + 4);
          const float Lc[8] = {La.x, La.y, La.z, La.w, Lb.x, Lb.y, Lb.z, Lb.w}, Lt[8] = {Ta.x, Ta.y, Ta.z, Ta.w, Tb.x, Tb.y, Tb.z, Tb.w};
          float at[8], bt[8], kt[8], rt[8], bh[8], kh[8];
#pragma unroll
          for (int j = 0; j < 8; ++j) { const float eL = __expf(Lc[j]), eLp = __expf(Lc[j] - lw[j]), eNL = __expf(-Lc[j]), eH = __expf(Lt[j] - Lc[j]);
              at[j] = -kk[j] * eLp; bt[j] = bb[j] * eNL; kt[j] = kp[j] * eNL; rt[j] = rr[j] * eL; bh[j] = bb[j] * eH; kh[j] = kp[j] * eH; }
          uint4 w; w.x = cvt_pk_bf16(at[0], at[1]); w.y = cvt_pk_bf16(at[2], at[3]); w.z = cvt_pk_bf16(at[4], at[5]); w.w = cvt_pk_bf16(at[6], at[7]); *(uint4*)(sAt + tl * 72 + c8) = w;
          w.x = cvt_pk_bf16(bt[0], bt[1]); w.y = cvt_pk_bf16(bt[2], bt[3]); w.z = cvt_pk_bf16(bt[4], bt[5]); w.w = cvt_pk_bf16(bt[6], bt[7]); *(uint4*)(sBt + tl * 72 + c8) = w;
          w.x = cvt_pk_bf16(kt[0], kt[1]); w.y = cvt_pk_bf16(kt[2], kt[3]); w.z = cvt_pk_bf16(kt[4], kt[5]); w.w = cvt_pk_bf16(kt[6], kt[7]); *(uint4*)(sKt + tl * 72 + c8) = w;
          w.x = cvt_pk_bf16(rt[0], rt[1]); w.y = cvt_pk_bf16(rt[2], rt[3]); w.z = cvt_pk_bf16(rt[4], rt[5]); w.w = cvt_pk_bf16(rt[6], rt[7]); *(uint4*)(sRt + tl * 72 + c8) = w;
          *(uint4*)(lwb + (t * 1024 + h * 64) * 4 + 128 + c8 * 2) = w;
          *(float4*)(sRHS + tl * 132 + c8) = make_float4(at[0], at[1], at[2], at[3]); *(float4*)(sRHS + tl * 132 + c8 + 4) = make_float4(at[4], at[5], at[6], at[7]);
#pragma unroll
          for (int j = 0; j < 8; ++j) { unsigned char* dst = ab + ((t0 + (c8 >> 2) + (j >> 2)) * 1024 + h * 64) * 4 + (j & 3) * 64;
              *(u16*)(dst + tl * 2) = f2bf(bh[j]); *(u16*)(dst + (16 + tl) * 2) = f2bf(kh[j]); }
          if (tl == 0) { *(float4*)(gbuf + (size_t)unit * 64 + c8) = make_float4(__expf(Lt[0]), __expf(Lt[1]), __expf(Lt[2]), __expf(Lt[3]));
              *(float4*)(gbuf + (size_t)unit * 64 + c8 + 4) = make_float4(__expf(Lt[4]), __expf(Lt[5]), __expf(Lt[6]), __expf(Lt[7])); } }
        LDS_BARRIER();
        if (it + (int)gridDim.x < 2048) fetch(it + (int)gridDim.x);
        { const u16* X = qw == 0 ? sAt : sRt;
          const bf16x8 a0 = *(const bf16x8*)(X + fr * 72 + 8 * fq), a1 = *(const bf16x8*)(X + fr * 72 + 32 + 8 * fq);
#pragma unroll
          for (int pi = 0; pi < 2; ++pi) { const u16* Y = pi ? sKt : sBt; const int hw = qw * 2 + pi;
              const bf16x8 b0 = *(const bf16x8*)(Y + fr * 72 + 8 * fq), b1 = *(const bf16x8*)(Y + fr * 72 + 32 + 8 * fq);
              f32x4 acc = {0.f, 0.f, 0.f, 0.f};
              acc = __builtin_amdgcn_mfma_f32_16x16x32_bf16(a0, b0, acc, 0, 0, 0); acc = __builtin_amdgcn_mfma_f32_16x16x32_bf16(a1, b1, acc, 0, 0, 0);
#pragma unroll
              for (int j = 0; j < 4; ++j) { const int tt = 4 * fq + j, i = fr; const bool keep = hw < 2 ? (i < tt) : (i <= tt); const float val = keep ? acc[j] : 0.f;
                  if (hw == 0) sN[tt * 17 + i] = val;
                  else if (hw == 1) sAak[tt * 24 + i] = f2bf(val);
                  else rkv[(t0 + tt) * 3072 + h * 64 + (hw == 3 ? 16 : 0) + i] = f2bf(val); } } }
        LDS_BARRIER();
#pragma unroll
        for (int vi = 0; vi < 2; ++vi) { const int vt = qw * 2 + vi; bf16x8 af = {0, 0, 0, 0, 0, 0, 0, 0}, bf = {0, 0, 0, 0, 0, 0, 0, 0};
          if (fq < 2) { af = *(const bf16x8*)(sAak + fr * 24 + 8 * fq); bf = *(const bf16x8*)(sVt + (vt * 16 + fr) * 24 + 8 * fq); }
          f32x4 acc = {0.f, 0.f, 0.f, 0.f}; acc = __builtin_amdgcn_mfma_f32_16x16x32_bf16(af, bf, acc, 0, 0, 0);
#pragma unroll
          for (int j = 0; j < 4; ++j) sRHS[(4 * fq + j) * 132 + 64 + vt * 16 + fr] = acc[j]; }
        LDS_BARRIER();
        { const int col = qw * 64 + lane; float x[16];
#pragma unroll
            for (int i = 0; i < 16; ++i) { float v = sRHS[i * 132 + col];
#pragma unroll
                for (int j = 0; j < i; ++j) v += sN[i * 17 + j] * x[j];
                x[i] = v; }
            if (qw == 0) {
#pragma unroll
                for (int i = 0; i < 16; ++i) *(u16*)(lwb + ((t0 + i) * 1024 + h * 64) * 4 + lane * 2) = f2bf(x[i]); }
            else { uint4 w0, w1; w0.x = cvt_pk_bf16(x[0], x[1]); w0.y = cvt_pk_bf16(x[2], x[3]); w0.z = cvt_pk_bf16(x[4], x[5]); w0.w = cvt_pk_bf16(x[6], x[7]);
                w1.x = cvt_pk_bf16(x[8], x[9]); w1.y = cvt_pk_bf16(x[10], x[11]); w1.z = cvt_pk_bf16(x[12], x[13]); w1.w = cvt_pk_bf16(x[14], x[15]);
                u16* wp = rkv + (t0 + (lane >> 2)) * 3072 + 1024 + h * 64 + (lane & 3) * 16;
                *(uint4*)wp = w0; *(uint4*)(wp + 8) = w1; } }
    }
}
__device__ void rwkv_serial(const Params& P, unsigned char* lds_raw) {
    unsigned char* ws = P.ws; const int tid = threadIdx.x, lane = tid & 63, w = __builtin_amdgcn_readfirstlane(tid >> 6), fr = lane & 15, fq = lane >> 4;
    const int hb = blockIdx.x, b = hb >> 4, h = hb & 15;
    const unsigned char* lwb = ws + WS_Z + Z_LW; const unsigned char* ab = ws + WS_Z + Z_A; const u16* rkv = (const u16*)((unsigned char*)P.out + O_RKV);
    const float* gbuf = (const float*)(ws + WS_G); u16* yb = (u16*)(ws + WS_Y);
    u16* Sb = (u16*)lds_raw; u16* UVt = (u16*)(lds_raw + 18432);
    for (int i = tid; i < 64 * 72; i += 512) Sb[i] = 0;
    const int kt = w >> 1, vt0 = (w & 1) * 2, ut = w & 3, kr = kt * 16 + fr, uv = ut * 16 + fr;
    f32x4 st0 = {0.f, 0.f, 0.f, 0.f}, st1 = {0.f, 0.f, 0.f, 0.f};
    typedef unsigned u32x2_t __attribute__((ext_vector_type(2)));
    struct Pre { bf16x8 f0, f1, x, bk; f32x4 g; unsigned vv; };
#define PRE_LOAD(c_, p) do { const size_t t0_ = (size_t)b * SEQ + (size_t)(c_) * CH_; \
        const unsigned char* ls_ = lwb + ((t0_ + fr) * 1024 + h * 64) * 4 + (w < 4 ? 0 : 128) + fq * 16; \
        const void* a0_ = ls_; const void* a1_ = ls_ + 64; \
        const void* a2_ = (w < 4) ? (const void*)(rkv + (t0_ + (uv >> 2)) * 3072 + 1024 + h * 64 + (uv & 3) * 16 + fq * 4) : (const void*)(rkv + (t0_ + fr) * 3072 + h * 64 + fq * 8); \
        const void* a4_ = ab + ((t0_ + (kr >> 2)) * 1024 + h * 64) * 4 + (kr & 3) * 64 + fq * 16; \
        const void* a5_ = gbuf + ((size_t)hb * 256 + (c_)) * 64 + kt * 16 + 4 * fq; \
        const void* a6_ = rkv + (t0_ + (tid >> 5)) * 3072 + 2048 + h * 64 + (tid & 31) * 2; \
        asm volatile("global_load_dwordx4 %0, %1, off" : "=v"(p.f0) : "v"(a0_) : "memory"); \
        asm volatile("global_load_dwordx4 %0, %1, off" : "=v"(p.f1) : "v"(a1_) : "memory"); \
        asm volatile("global_load_dwordx4 %0, %1, off" : "=v"(p.x) : "v"(a2_) : "memory"); \
        asm volatile("global_load_dwordx4 %0, %1, off" : "=v"(p.bk) : "v"(a4_) : "memory"); \
        asm volatile("global_load_dwordx4 %0, %1, off" : "=v"(p.g) : "v"(a5_) : "memory"); \
        asm volatile("global_load_dword %0, %1, off" : "=v"(p.vv) : "v"(a6_) : "memory"); } while (0)
#define PRE_WAIT(p, N) asm volatile("s_waitcnt vmcnt(" #N ")" : "+v"(p.f0), "+v"(p.f1), "+v"(p.x), "+v"(p.bk), "+v"(p.g), "+v"(p.vv) :: "memory")
    auto step = [&](int c, const Pre& cur) {
        const u16* S = Sb + (c & 1) * (64 * 72); u16* Sn = Sb + ((c & 1) ^ 1) * (64 * 72); const size_t t0 = (size_t)b * SEQ + c * CH_;
        { const int tv = tid >> 5, v2 = (tid & 31) * 2; UVt[v2 * 40 + 16 + tv] = (u16)(cur.vv & 0xffffu); UVt[(v2 + 1) * 40 + 16 + tv] = (u16)(cur.vv >> 16); }
        const bf16x8 s0 = *(const bf16x8*)(S + uv * 72 + 8 * fq), s1 = *(const bf16x8*)(S + uv * 72 + 32 + 8 * fq);
        f32x4 acc = {0.f, 0.f, 0.f, 0.f};
        if (w < 4) { const unsigned wx = (unsigned)(unsigned short)cur.x[0] | ((unsigned)(unsigned short)cur.x[1] << 16), wy = (unsigned)(unsigned short)cur.x[2] | ((unsigned)(unsigned short)cur.x[3] << 16);
            acc[0] = bflo(wx); acc[1] = bfhi(wx); acc[2] = bflo(wy); acc[3] = bfhi(wy); }
        acc = __builtin_amdgcn_mfma_f32_16x16x32_bf16(cur.f0, s0, acc, 0, 0, 0); acc = __builtin_amdgcn_mfma_f32_16x16x32_bf16(cur.f1, s1, acc, 0, 0, 0);
        if (w < 4) { uint2 o; o.x = cvt_pk_bf16(acc[0], acc[1]); o.y = cvt_pk_bf16(acc[2], acc[3]); *(uint2*)(UVt + uv * 40 + 4 * fq) = o; }
        LDS_BARRIER();
        if (w >= 4) { const bf16x8 uf = *(const bf16x8*)(UVt + uv * 40 + 8 * fq); acc = __builtin_amdgcn_mfma_f32_16x16x32_bf16(cur.x, uf, acc, 0, 0, 0);
#pragma unroll
            for (int j = 0; j < 4; ++j) yb[(t0 + 4 * fq + j) * RWD + h * 64 + uv] = f2bf(acc[j]); }
        { const bf16x8 u0 = *(const bf16x8*)(UVt + ((vt0 + 0) * 16 + fr) * 40 + 8 * fq), u1 = *(const bf16x8*)(UVt + ((vt0 + 1) * 16 + fr) * 40 + 8 * fq);
          st0 = __builtin_amdgcn_mfma_f32_16x16x32_bf16(cur.bk, u0, st0 * cur.g, 0, 0, 0); st1 = __builtin_amdgcn_mfma_f32_16x16x32_bf16(cur.bk, u1, st1 * cur.g, 0, 0, 0);
          uint2 o; o.x = cvt_pk_bf16(st0[0], st0[1]); o.y = cvt_pk_bf16(st0[2], st0[3]); *(uint2*)(Sn + ((vt0 + 0) * 16 + fr) * 72 + kt * 16 + 4 * fq) = o;
          o.x = cvt_pk_bf16(st1[0], st1[1]); o.y = cvt_pk_bf16(st1[2], st1[3]); *(uint2*)(Sn + ((vt0 + 1) * 16 + fr) * 72 + kt * 16 + 4 * fq) = o; }
        LDS_BARRIER(); };
    Pre q0, q1, q2, q3, q4, q5; PRE_LOAD(0, q0); PRE_LOAD(1, q1); PRE_LOAD(2, q2); PRE_LOAD(3, q3); PRE_LOAD(4, q4); PRE_LOAD(5, q5);
    __syncthreads();
    constexpr int NCH = SEQ / CH_;
    for (int c = 0; c < 252; c += 6) {
        PRE_WAIT(q0, 30); step(c, q0);     PRE_LOAD(min(c + 6, NCH - 1), q0);
        PRE_WAIT(q1, 30); step(c + 1, q1); PRE_LOAD(min(c + 7, NCH - 1), q1);
        PRE_WAIT(q2, 30); step(c + 2, q2); PRE_LOAD(min(c + 8, NCH - 1), q2);
        PRE_WAIT(q3, 30); step(c + 3, q3); PRE_LOAD(min(c + 9, NCH - 1), q3);
        PRE_WAIT(q4, 30); step(c + 4, q4); PRE_LOAD(min(c + 10, NCH - 1), q4);
        PRE_WAIT(q5, 30); step(c + 5, q5); PRE_LOAD(min(c + 11, NCH - 1), q5);
    }
    PRE_WAIT(q0, 0); PRE_WAIT(q1, 0); PRE_WAIT(q2, 0); PRE_WAIT(q3, 0); PRE_WAIT(q4, 0); PRE_WAIT(q5, 0);
    step(252, q0); step(253, q1); step(254, q2); step(255, q3);
#undef PRE_LOAD
#undef PRE_WAIT
}

__device__ void attn_phase(const Params& P) {
    unsigned char* ws = P.ws; const int tid = threadIdx.x, lane = tid & 63, fr = lane & 15, fq = lane >> 4;
    const u16* Qn = (const u16*)((unsigned char*)P.out + O_QN); const u16* Kn = (const u16*)(ws + WS_X + X_KN); const u16* Vt = (const u16*)(ws + WS_X + X_VT);
    u16* oatt = (u16*)(ws + WS_X + X_OATT);
    const int NA = (int)gridDim.x - NSCAN; const int gw = ((int)blockIdx.x - NSCAN) * 8 + (tid >> 6);
    for (int unit = gw; unit < 8192; unit += NA * 8) {
        const int h = unit & 15, st = (unit >> 4) & 255, b = unit >> 12, kh = h >> 2;
        const int s0 = st * 16; const size_t t0 = (size_t)b * SEQ + s0;
        const float slope = exp2f(-0.5f * (float)(h + 1)), sink = P.in[16][h];
        bf16x8 qf[2];
        qf[0] = *(const bf16x8*)(Qn + (t0 + fr) * 1024 + h * 64 + 8 * fq); qf[1] = *(const bf16x8*)(Qn + (t0 + fr) * 1024 + h * 64 + 32 + 8 * fq);
        f32x4 sc[10]; float mx = sink;
#pragma unroll
        for (int kt = 0; kt < 10; ++kt) { const int ks0 = s0 - 144 + 16 * kt; int kp = ks0 + fr; kp = kp < 0 ? 0 : kp;
            const u16* kr = Kn + ((size_t)b * SEQ + kp) * 256 + kh * 64 + 8 * fq;
            const bf16x8 k0 = *(const bf16x8*)kr, k1 = *(const bf16x8*)(kr + 32);
            f32x4 a = {0.f, 0.f, 0.f, 0.f};
            a = __builtin_amdgcn_mfma_f32_16x16x32_bf16(k0, qf[0], a, 0, 0, 0); a = __builtin_amdgcn_mfma_f32_16x16x32_bf16(k1, qf[1], a, 0, 0, 0);
#pragma unroll
            for (int j = 0; j < 4; ++j) { const int kpos = ks0 + 4 * fq + j; const int dist = s0 + fr - kpos; const bool valid = (dist >= 0) && (dist < 128) && (kpos >= 0);
                const float v = valid ? a[j] - slope * (float)dist : -1e30f; a[j] = v; mx = fmaxf(mx, v); }
            sc[kt] = a; }
        mx = fmaxf(mx, __shfl_xor(mx, 16)); mx = fmaxf(mx, __shfl_xor(mx, 32));
        float sum = 0.f;
#pragma unroll
        for (int kt = 0; kt < 10; ++kt)
#pragma unroll
            for (int j = 0; j < 4; ++j) { const float e = __expf(sc[kt][j] - mx); sc[kt][j] = e; sum += e; }
        sum += __shfl_xor(sum, 16); sum += __shfl_xor(sum, 32);
        const float inv = 1.0f / (sum + __expf(sink - mx));
        f32x4 o[4];
#pragma unroll
        for (int dt = 0; dt < 4; ++dt) o[dt] = (f32x4){0.f, 0.f, 0.f, 0.f};
#pragma unroll
        for (int u = 0; u < 5; ++u) {
            union { bf16x8 v; unsigned w[4]; } pf;
            pf.w[0] = cvt_pk_bf16(sc[2 * u][0] * inv, sc[2 * u][1] * inv); pf.w[1] = cvt_pk_bf16(sc[2 * u][2] * inv, sc[2 * u][3] * inv);
            pf.w[2] = cvt_pk_bf16(sc[2 * u + 1][0] * inv, sc[2 * u + 1][1] * inv); pf.w[3] = cvt_pk_bf16(sc[2 * u + 1][2] * inv, sc[2 * u + 1][3] * inv);
            int ka = s0 - 144 + 32 * u + 4 * fq, kb = ka + 16; ka = ka < 0 ? 0 : ka; kb = kb < 0 ? 0 : kb;
#pragma unroll
            for (int dt = 0; dt < 4; ++dt) { const u16* vr = Vt + ((size_t)(b * 4 + kh) * 64 + dt * 16 + fr) * SEQ;
                union { bf16x8 v; uint2 w[2]; } vf; vf.w[0] = *(const uint2*)(vr + ka); vf.w[1] = *(const uint2*)(vr + kb);
                o[dt] = __builtin_amdgcn_mfma_f32_16x16x32_bf16(pf.v, vf.v, o[dt], 0, 0, 0); } }
#pragma unroll
        for (int dt = 0; dt < 4; ++dt)
#pragma unroll
            for (int j = 0; j < 4; ++j) oatt[(t0 + 4 * fq + j) * 1024 + h * 64 + dt * 16 + fr] = f2bf(o[dt][j]);
    }
}

__device__ void phase5(const Params& P) {
    unsigned char* ws = P.ws; const int G = gridDim.x, bid = blockIdx.x, tid = threadIdx.x, lane = tid & 63;
    const u16* rkv = (const u16*)((unsigned char*)P.out + O_RKV); u16* orw = (u16*)((unsigned char*)P.out + O_QN);
    const u16* yraw = (const u16*)(ws + WS_Y); const u16* gp = (const u16*)(ws + WS_Z + Z_G); const float* rkb = (const float*)(ws + WS_RK);
    for (int t = bid * 8 + (tid >> 6); t < MT; t += G * 8) {
        uint2 y2[4], v2[4], g2[4]; float rk[4];
#pragma unroll
        for (int it = 0; it < 4; ++it) { const int hh = it * 4 + (lane >> 4), hc = hh * 64 + (lane & 15) * 4; const size_t o = (size_t)t * RWD + hc;
            y2[it] = *(const uint2*)(yraw + o); g2[it] = *(const uint2*)(gp + o); v2[it] = *(const uint2*)(rkv + (size_t)t * 3072 + 2048 + hc); rk[it] = rkb[(size_t)t * 16 + hh]; }
#pragma unroll
        for (int it = 0; it < 4; ++it) { const int hc = (it * 4 + (lane >> 4)) * 64 + (lane & 15) * 4; const size_t o = (size_t)t * RWD + hc;
            const float4 gw = *(const float4*)(P.in[12] + hc), gb = *(const float4*)(P.in[13] + hc);
            const float yx = bflo(y2[it].x), yy = bfhi(y2[it].x), yz = bflo(y2[it].y), yw = bfhi(y2[it].y);
            const float mu = row16_sum((yx + yy) + (yz + yw)) * (1.0f / 64.0f);
            const float dx = yx - mu, dy = yy - mu, dz = yz - mu, dw = yw - mu;
            const float var = row16_sum((dx * dx + dy * dy) + (dz * dz + dw * dw)) * (1.0f / 64.0f); const float rs = rsqrtf(var + 64e-5f);
            const float o0 = (dx * rs * gw.x + gb.x + rk[it] * bflo(v2[it].x)) * bflo(g2[it].x), o1 = (dy * rs * gw.y + gb.y + rk[it] * bfhi(v2[it].x)) * bfhi(g2[it].x);
            const float o2 = (dz * rs * gw.z + gb.z + rk[it] * bflo(v2[it].y)) * bflo(g2[it].y), o3 = (dw * rs * gw.w + gb.w + rk[it] * bfhi(v2[it].y)) * bfhi(g2[it].y);
            uint2 w; w.x = cvt_pk_bf16(o0, o1); w.y = cvt_pk_bf16(o2, o3); *(uint2*)(orw + o) = w; }
    }
}

__device__ void phase9(const Params& P) {
    unsigned char* ws = P.ws; const u16* uu = (const u16*)(ws + WS_Z); u16* act = (u16*)(ws + WS_ACT);
    const float* cw = P.in[21]; const float* cb = P.in[22];
    const int nth = gridDim.x * 512;
    for (int task = blockIdx.x * 512 + threadIdx.x; task < 1024 * 1408; task += nth) {
        const int j0 = (task % 1408) * 4, t0 = (task / 1408) * 8; const bool first = (t0 & (SEQ - 1)) == 0;
        uint2 ra[10], rg[10];
#pragma unroll
        for (int r = 0; r < 10; ++r) { const int t = (first && r < 2) ? t0 : t0 - 2 + r; ra[r] = *(const uint2*)(uu + (size_t)t * NUP + j0); rg[r] = *(const uint2*)(uu + (size_t)t * NUP + DFF + j0); }
        if (first) { ra[0] = make_uint2(0u, 0u); ra[1] = ra[0]; rg[0] = ra[0]; rg[1] = ra[0]; }
        const float4 wa0 = *(const float4*)(cw + j0), wa1 = *(const float4*)(cw + NUP + j0), wa2 = *(const float4*)(cw + 2 * NUP + j0), ba = *(const float4*)(cb + j0);
        const float4 wg0 = *(const float4*)(cw + DFF + j0), wg1 = *(const float4*)(cw + NUP + DFF + j0), wg2 = *(const float4*)(cw + 2 * NUP + DFF + j0), bg = *(const float4*)(cb + DFF + j0);
#pragma unroll
        for (int i = 0; i < 8; ++i) {
            const float cv0 = bflo(ra[i].x) * wa0.x + bflo(ra[i + 1].x) * wa1.x + bflo(ra[i + 2].x) * wa2.x + ba.x, cv1 = bfhi(ra[i].x) * wa0.y + bfhi(ra[i + 1].x) * wa1.y + bfhi(ra[i + 2].x) * wa2.y + ba.y;
            const float cv2 = bflo(ra[i].y) * wa0.z + bflo(ra[i + 1].y) * wa1.z + bflo(ra[i + 2].y) * wa2.z + ba.z, cv3 = bfhi(ra[i].y) * wa0.w + bfhi(ra[i + 1].y) * wa1.w + bfhi(ra[i + 2].y) * wa2.w + ba.w;
            const float cg0 = bflo(rg[i].x) * wg0.x + bflo(rg[i + 1].x) * wg1.x + bflo(rg[i + 2].x) * wg2.x + bg.x, cg1 = bfhi(rg[i].x) * wg0.y + bfhi(rg[i + 1].x) * wg1.y + bfhi(rg[i + 2].x) * wg2.y + bg.y;
            const float cg2 = bflo(rg[i].y) * wg0.z + bflo(rg[i + 1].y) * wg1.z + bflo(rg[i + 2].y) * wg2.z + bg.z, cg3 = bfhi(rg[i].y) * wg0.w + bfhi(rg[i + 1].y) * wg1.w + bfhi(rg[i + 2].y) * wg2.w + bg.w;
            uint2 w; w.x = cvt_pk_bf16(cg0 * sigmoidf_(cg0) * cv0, cg1 * sigmoidf_(cg1) * cv1); w.y = cvt_pk_bf16(cg2 * sigmoidf_(cg2) * cv2, cg3 * sigmoidf_(cg3) * cv3);
            *(uint2*)(act + (size_t)(t0 + i) * DFF + j0) = w; }
    }
}

#define XB_TMO      128
#define XB_XCNT(j)  (256  + 64 * (j))
#define XB_XSUB(j)  (1280 + 64 * (j))
#define XB_XGEN(j)  (2304 + 64 * (j))
#define XB_TOP      3328
#define XB_TOPGEN   3392
#define XCD_BAR_WORDS 3456
#define XB_SPIN_CAP (1u << 18)

__device__ __forceinline__ unsigned xb_ld(unsigned* p)              { return __hip_atomic_load(p, __ATOMIC_RELAXED, __HIP_MEMORY_SCOPE_AGENT); }
__device__ __forceinline__ unsigned xb_add(unsigned* p, unsigned v) { return __hip_atomic_fetch_add(p, v, __ATOMIC_RELAXED, __HIP_MEMORY_SCOPE_AGENT); }
__device__ __forceinline__ unsigned xb_xcc_id() { return (unsigned)__builtin_amdgcn_s_getreg((3 << 11) | 20) & 0xFu; }
#define XB_SPIN(cond, bar) do { unsigned _sp = 0; while (cond) { __builtin_amdgcn_s_sleep(1); \
    if ((++_sp & 255u) == 0u) { if (xb_ld(&(bar)[XB_TMO])) break; if (_sp > XB_SPIN_CAP) { atomicAdd(&(bar)[XB_TMO], 1u); break; } } } } while (0)

struct XcdBarrier {
    unsigned* bar; unsigned x;
    volatile LAS unsigned* st;
};

__device__ __forceinline__ XcdBarrier xcd_barrier_post(unsigned* bar, volatile LAS unsigned* st) {
    XcdBarrier b; b.bar = bar; b.x = xb_xcc_id(); b.st = st;
    if (threadIdx.x == 0) (void)xb_add(&bar[XB_XCNT(b.x)], 1u);
    return b;
}
__device__ __forceinline__ void xcd_barrier_complete(unsigned* bar, unsigned x, unsigned& nloc, unsigned& nx) {
    const unsigned G = gridDim.x * gridDim.y * gridDim.z;
    unsigned sum, cnt, mine, sp = 0u;
    for (;;) {
        sum = 0u; cnt = 0u; mine = 0u;
#pragma unroll
        for (unsigned j = 0; j < 16; ++j) { const unsigned c = xb_ld(&bar[XB_XCNT(j)]); sum += c; cnt += (c > 0u) ? 1u : 0u; mine = (j == x) ? c : mine; }
        if (sum == G) break;
        __builtin_amdgcn_s_sleep(1);
        if ((++sp & 255u) == 0u) { if (xb_ld(&bar[XB_TMO])) break; if (sp > XB_SPIN_CAP) { atomicAdd(&bar[XB_TMO], 1u); break; } }
    }
    nloc = mine > 0u ? mine : 1u; nx = cnt > 0u ? cnt : 1u;
}

__device__ __forceinline__ void xcd_barrier(const XcdBarrier& b) {
    asm volatile("s_waitcnt vmcnt(0)" ::: "memory");
    __syncthreads();
    if (threadIdx.x == 0) {
        unsigned* bar = b.bar;
        __builtin_amdgcn_s_waitcnt(0);
        unsigned nloc = b.st[0], nx = b.st[1];
        if (nloc == 0u) { xcd_barrier_complete(bar, b.x, nloc, nx); b.st[0] = nloc; b.st[1] = nx; }
        const unsigned old = xb_add(&bar[XB_XSUB(b.x)], 1u);
        const unsigned gen = old / nloc;
        if (old + 1u == (gen + 1u) * nloc) {
            __builtin_amdgcn_fence(__ATOMIC_RELEASE, "agent");
            asm volatile("s_waitcnt vmcnt(0)" ::: "memory");
            const unsigned og = xb_add(&bar[XB_TOP], 1u);
            const unsigned tg = og / nx;
            if (og + 1u == (tg + 1u) * nx) xb_add(&bar[XB_TOPGEN], 1u);
            else XB_SPIN(xb_ld(&bar[XB_TOPGEN]) == tg, bar);
            __builtin_amdgcn_fence(__ATOMIC_ACQUIRE, "agent");
            xb_add(&bar[XB_XGEN(b.x)], 1u);
            asm volatile("s_waitcnt vmcnt(0)" ::: "memory");
        } else {
            XB_SPIN(xb_ld(&bar[XB_XGEN(b.x)]) == gen, bar);
            __builtin_amdgcn_fence(__ATOMIC_ACQUIRE, "agent");
            asm volatile("s_waitcnt vmcnt(0)" ::: "memory");
        }
    }
    __syncthreads();
}

constexpr int NPH = 12;
__global__ void __launch_bounds__(512, 2) mega(Params P) {
    extern __shared__ __attribute__((aligned(16))) unsigned char lds_raw[];
    LAS unsigned char* lds = (LAS unsigned char*)lds_raw;
    unsigned char* ws = P.ws;
    volatile LAS unsigned* xst = (volatile LAS unsigned*)(lds + 131072);
    if (threadIdx.x < 4) xst[threadIdx.x] = 0u;
    __syncthreads();
    XcdBarrier xb = xcd_barrier_post((unsigned*)(ws + WS_BAR), xst);
#define RUN(i) ((i) >= P.ph_lo && (i) < P.ph_hi)
#define SEAM(i) do { if ((i) >= P.ph_lo && (i) + 1 < P.ph_hi) { xcd_barrier(xb); } } while (0)
    if (RUN(0)) phase0(P, (float*)lds_raw);
    SEAM(0);
    if (RUN(1)) { EpiZ E; E.zmain = (u16*)(ws + WS_Z + Z_MAIN); E.zgate = (u16*)(ws + WS_Z + Z_GATE); E.rstd = (const float*)(ws + WS_SMALL);
        run_gemm(lds, (const u16*)(ws + WS_Z + Z_TAIL), (const u16*)(ws + WS_WIN), 6144, 2048, E); }
    SEAM(1);
    if (RUN(2)) phase2(P, (u16*)lds_raw);
    SEAM(2);
    if (RUN(4)) rwkv_prep(P, lds_raw);
    SEAM(4);
    if (RUN(5)) {
        if ((int)blockIdx.x < NSCAN) rwkv_serial(P, lds_raw);
        else { attn_phase(P); __syncthreads();
            { EpiZG E; E.zgate = (u16*)(ws + WS_Z + Z_GATE); E.rstd = (const float*)(ws + WS_SMALL);
              run_gemm_sub(lds, (const u16*)(ws + WS_Z + Z_TAIL), (const u16*)(ws + WS_WIN) + (size_t)6144 * 2048, 3072, 2048, E, (int)gridDim.x - NSCAN, (int)blockIdx.x - NSCAN); } }
        { volatile int* qid = (volatile int*)(lds_raw + 98304); unsigned* head = (unsigned*)(ws + WS_CNT);
          for (;;) { __syncthreads(); if (threadIdx.x == 0) qid[0] = (int)atomicAdd(head, 1u); __syncthreads();
              const int q = qid[0]; if (q >= 1920) break;
              weight_tile(P, q < 1408 ? 1152 + q : 3264 + (q - 1408), (float*)lds_raw); } }
    }
    SEAM(5);
    if (RUN(6)) phase5(P);
    SEAM(6);
    if (RUN(7)) {
        { EpiBranch<0> E; E.mixed = (u16*)(ws + WS_Z); E.zgate = (const u16*)(ws + WS_Z + Z_GATE);
          run_gemm(lds, (const u16*)((unsigned char*)P.out + O_QN), (const u16*)(ws + WS_WBR1), 2048, 1024, E); }
        { EpiBranch<1> E; E.mixed = (u16*)(ws + WS_Z); E.zgate = (const u16*)(ws + WS_Z + Z_GATE);
          run_gemm(lds, (const u16*)(ws + WS_X + X_OATT), (const u16*)(ws + WS_WBR2), 2048, 1024, E); } }
    SEAM(7);
    if (RUN(8)) { EpiOut1 E; E.x = P.in[0]; E.x1 = P.out; E.x1b = (u16*)(ws + WS_X); E.rowss = (float*)(ws + WS_SMALL + 32768);
        run_gemm(lds, (const u16*)(ws + WS_Z), (const u16*)(ws + WS_WOUT), 2048, 2048, E); }
    SEAM(8);
    if (RUN(9)) { EpiUp E; E.uo = (u16*)(ws + WS_Z); E.rowss = (const float*)(ws + WS_SMALL + 32768);
        run_gemm(lds, (const u16*)(ws + WS_X), (const u16*)(ws + WS_WUP), NUP, 2048, E);
        { const int G_ = (int)gridDim.x, nfull = 1408 % G_, bid_ = (int)blockIdx.x;
          if (bid_ >= nfull) { __syncthreads(); for (int id = 2560 + (bid_ - nfull); id < 3264; id += G_ - nfull) weight_tile(P, id, (float*)lds_raw); } } }
    SEAM(9);
    if (RUN(10)) phase9(P);
    SEAM(10);
    if (RUN(11)) { EpiFinal E; E.out = P.out;
        run_gemm(lds, (const u16*)(ws + WS_ACT), (const u16*)(ws + WS_WDOWN), 2048, DFF, E); }
}

constexpr int LDS_BYTES = 131072 + 16;
extern "C" void kernel_launch(void* const* d_in, const int* in_sizes, int n_in, void* d_out, int out_size, void* d_ws, size_t ws_size, hipStream_t stream) {
    static int grid = 0;
    if (grid == 0) {
        if (n_in != 24 || out_size != MT * DM || ws_size < WS_END) { fprintf(stderr, "kernel_launch: unexpected shapes (n_in %d out %d ws %zu need %zu)\n", n_in, out_size, ws_size, (size_t)WS_END); grid = -1; return; }
        int dev = 0, cus = 0, per_cu = 0;
        hipGetDevice(&dev); hipDeviceGetAttribute(&cus, hipDeviceAttributeMultiprocessorCount, dev);
        if (hipFuncSetAttribute((const void*)mega, hipFuncAttributeMaxDynamicSharedMemorySize, LDS_BYTES) != hipSuccess) { fprintf(stderr, "kernel_launch: hipFuncSetAttribute failed\n"); grid = -1; return; }
        if (hipOccupancyMaxActiveBlocksPerMultiprocessor(&per_cu, (const void*)mega, 512, LDS_BYTES) != hipSuccess || per_cu < 1) { fprintf(stderr, "kernel_launch: occupancy query failed (%d)\n", per_cu); grid = -1; return; }
        grid = cus * per_cu; if (grid > 256) grid = 256;
        if (grid < 2 * NSCAN) { fprintf(stderr, "kernel_launch: grid %d too small\n", grid); grid = -1; return; }
    }
    if (grid < 0) return;
    Params p{};
    for (int i = 0; i < 24; ++i) p.in[i] = (const float*)d_in[i];
    p.out = (float*)d_out; p.ws = (unsigned char*)d_ws;
    if (hipMemsetAsync((unsigned char*)d_ws + WS_BAR, 0, 16384, stream) != hipSuccess) { fprintf(stderr, "kernel_launch: hipMemsetAsync of the barrier words failed\n"); return; }
    p.ph_lo = 0; p.ph_hi = NPH;
    { void* args[] = {&p}; hipError_t e = hipLaunchCooperativeKernel((const void*)mega, dim3(grid), dim3(512), args, LDS_BYTES, stream);
      if (e != hipSuccess) fprintf(stderr, "cooperative launch failed: %s (grid %d)\n", hipGetErrorString(e), grid); }

}
```

```cpp
#include <hip/hip_runtime.h>
#include <hip/hip_cooperative_groups.h>
#include <cstdio>
#include <cstdint>
namespace cg = cooperative_groups;
namespace pg8 {
#define PG8_LAS __attribute__((address_space(3)))
typedef unsigned short bf16_t;
typedef short bf16x8 __attribute__((ext_vector_type(8)));
typedef float f32x4 __attribute__((ext_vector_type(4)));
typedef unsigned u32x4 __attribute__((ext_vector_type(4)));
constexpr int BM = 256, BK = 64, HALF = 128, HTB = HALF * BK * 2  , STAGE_BYTES = 8 * HTB, NXCD = 8, WGM = 8;

__host__ __device__ __forceinline__ int lds_byte(int r, int c) { const int st = (r >> 4) * 2 + (c >> 5), rr = r & 15, cc = c & 31, ob = rr * 64 + cc * 2; return st * 1024 + (ob ^ (((ob >> 9) & 1) << 5)); }
__host__ __device__ __forceinline__ void stage_rc(int b, int& R, int& C) { const int st = b / 1024, sb = b % 1024, swz = sb ^ (((sb >> 9) & 1) << 5); R = (st >> 1) * 16 + swz / 64; C = (st & 1) * 32 + (swz % 64) / 2; }
__host__ __device__ __forceinline__ int perm32(int rho) { const int n = rho >> 4, i = rho & 15; return 8 * (i >> 2) + 4 * n + (i & 3); }

struct Unit { int pm, pn; };
struct Gemm { const bf16_t* A; const bf16_t* Bt; int M, N, K; };

struct StaticOrder {
    int nM, nN, nwg, G, c;
    __host__ __device__ void init(int M, int N, int G_, int c_) { nM = M / BM; nN = N / BM; nwg = nM * nN; G = G_; c = c_; }
    __host__ __device__ bool next(int i, Unit& u) const {
        const long L = (long)i * G + c; if (L >= nwg) return false;
        int wgid = (int)L; { const int q = nwg / NXCD, r = nwg % NXCD, xcd = wgid % NXCD, off = wgid / NXCD; wgid = (xcd < r ? xcd * (q + 1) : r * (q + 1) + (xcd - r) * q) + off; }
        const int nig = WGM * nN, gid = wgid / nig, fm = gid * WGM, gsz = (nM - fm) < WGM ? (nM - fm) : WGM;
        u.pm = fm + ((wgid % nig) % gsz); u.pn = (wgid % nig) / gsz; return true;
    }
    __device__ __forceinline__ void a_ready(const Unit&) const {}
    __device__ __forceinline__ void done(const Unit&) const {}
};
typedef __bf16 bf16v2_t __attribute__((ext_vector_type(2))); typedef float f32v2_t __attribute__((ext_vector_type(2)));
__device__ __forceinline__ unsigned cvt_pk_bf16(float lo, float hi) { const f32v2_t x = {lo, hi}; const bf16v2_t r = __builtin_convertvector(x, bf16v2_t); return __builtin_bit_cast(unsigned, r); }
template <class Epi, class Sched, bool ALIGN_EPI = false, bool SP2 = false>
__device__ __forceinline__ void gemm_phase(PG8_LAS unsigned char* lds, const Gemm g, const Sched& S, const Epi& E) {
    const int tid = threadIdx.x, wid = __builtin_amdgcn_readfirstlane(tid >> 6), lane = tid & 63, wr = wid >> 2, wc = wid & 3, fr = lane & 15, fq = lane >> 4;
    const int K = g.K, nt = K / BK;
    unsigned voffA[2], voffB[2];
#pragma unroll
    for (int i = 0; i < 2; ++i) { int R, C; stage_rc(tid * 16 + i * 8192, R, C); const int Rb = Epi::PERM ? ((R & ~31) + perm32(R & 31)) : R;
        voffA[i] = (unsigned)(R * K + C) * 2u; voffB[i] = (unsigned)(Rb * K + C) * 2u; }
    const size_t kstep = (size_t)(BK * 2);
    const size_t hstep = (size_t)HALF * K * 2;
    const size_t tstep = 2 * hstep;
    const unsigned ldsw = (unsigned)wid * 1024u;
    const int aoff = lds_byte(wr * 64 + fr, fq * 8), boff = lds_byte(wc * 32 + fr, fq * 8);
#define PG8_SA(b, h) (((b) * 2 + (h)) * HTB)
#define PG8_SB(b, h) ((4 + (b) * 2 + (h)) * HTB)
#define PG8_STAGE(bufoff, gbase, voff) do { _Pragma("unroll") for (int _i = 0; _i < 2; ++_i) \
        __builtin_amdgcn_global_load_lds((const unsigned*)((const char*)(gbase) + (voff)[_i]), (PG8_LAS unsigned*)(lds + (bufoff) + ldsw + _i * 8192), 16, 0, 0); } while (0)
#define PG8_LDA(dst, b, h) do { _Pragma("unroll") for (int m = 0; m < 4; ++m) _Pragma("unroll") for (int k = 0; k < 2; ++k) dst[m][k] = *(const PG8_LAS bf16x8*)(lds + PG8_SA(b, h) + aoff + m * 2048 + k * 1024); } while (0)
#define PG8_LDB(dst, b, h) do { _Pragma("unroll") for (int n = 0; n < 2; ++n) _Pragma("unroll") for (int k = 0; k < 2; ++k) dst[n][k] = *(const PG8_LAS bf16x8*)(lds + PG8_SB(b, h) + boff + n * 2048 + k * 1024); } while (0)
#define PG8_MMA(ai, bj, At, Bt) do { __builtin_amdgcn_s_setprio(1); _Pragma("unroll") for (int m = 0; m < 4; ++m) _Pragma("unroll") for (int n = 0; n < 2; ++n) _Pragma("unroll") for (int k = 0; k < 2; ++k) \
        acc[ai][bj][m][n] = __builtin_amdgcn_mfma_f32_16x16x32_bf16(Bt[n][k], At[m][k], acc[ai][bj][m][n], 0, 0, 0); __builtin_amdgcn_s_setprio(0); } while (0)
#define PG8_WAIT_V(n) asm volatile("s_waitcnt vmcnt(" #n ")" ::: "memory")
#define PG8_WAIT_L(n) asm volatile("s_waitcnt lgkmcnt(" #n ")" ::: "memory")
#define PG8_BAR __builtin_amdgcn_s_barrier()
#define PG8_SCHED __builtin_amdgcn_sched_barrier(0)
    Unit cur, nxt; int ui = 0;
    if (!S.next(0, cur)) return;
    f32x4 acc[2][2][4][2];
#pragma unroll
    for (int a = 0; a < 2; ++a)
#pragma unroll
        for (int b = 0; b < 2; ++b)
#pragma unroll
            for (int m = 0; m < 4; ++m)
#pragma unroll
                for (int n = 0; n < 2; ++n) acc[a][b][m][n] = (f32x4){0.f, 0.f, 0.f, 0.f};
    bf16x8 At[4][2], B0[2][2], B1[2][2];
    const char* cA = (const char*)g.A + (size_t)cur.pm * tstep; const char* cB = (const char*)g.Bt + (size_t)cur.pn * tstep;
    S.a_ready(cur);
    if constexpr (SP2) {
        PG8_STAGE(PG8_SB(0, 0), cB, voffB); PG8_STAGE(PG8_SB(0, 1), cB + hstep, voffB); PG8_STAGE(PG8_SA(0, 0), cA, voffA); PG8_STAGE(PG8_SA(0, 1), cA + hstep, voffA);
        if (wr == 1) PG8_BAR;
        PG8_WAIT_V(2); PG8_BAR;
        PG8_STAGE(PG8_SB(1, 0), cB + kstep, voffB); PG8_STAGE(PG8_SA(1, 0), cA + kstep, voffA); PG8_STAGE(PG8_SB(1, 1), cB + hstep + kstep, voffB);
        PG8_WAIT_V(6); PG8_BAR;
    } else {
        PG8_STAGE(PG8_SB(0, 0), cB, voffB); PG8_STAGE(PG8_SA(0, 0), cA, voffA); PG8_STAGE(PG8_SB(0, 1), cB + hstep, voffB); PG8_STAGE(PG8_SA(0, 1), cA + hstep, voffA);
        if (wr == 1) PG8_BAR;
        PG8_WAIT_V(4); PG8_BAR;
        PG8_STAGE(PG8_SB(1, 0), cB + kstep, voffB); PG8_STAGE(PG8_SA(1, 0), cA + kstep, voffA); PG8_STAGE(PG8_SB(1, 1), cB + hstep + kstep, voffB);
        PG8_WAIT_V(6); PG8_BAR;
    }
    for (;;) {
        const bool has_next = S.next(ui + 1, nxt);
        const char* nA = has_next ? (const char*)g.A + (size_t)nxt.pm * tstep : cA; const char* nB = has_next ? (const char*)g.Bt + (size_t)nxt.pn * tstep : cB;
        for (int t = 0; t < nt; t += 2) {
            const bool last = (t == nt - 2);
            const char* a1 = cA + (size_t)(t + 1) * kstep;
            const char* a2 = last ? nA : cA + (size_t)(t + 2) * kstep; const char* b2 = last ? nB : cB + (size_t)(t + 2) * kstep;
            const char* a3 = a2 + kstep; const char* b3 = b2 + kstep;
            if (last && has_next) S.a_ready(nxt);
            if constexpr (SP2) {
            PG8_LDB(B0, 0, 0); PG8_LDB(B1, 0, 1); PG8_SCHED; PG8_LDA(At, 0, 0); PG8_STAGE(PG8_SA(1, 1), a1 + hstep, voffA);
            PG8_WAIT_V(8); PG8_WAIT_L(0); PG8_BAR; PG8_MMA(0, 0, At, B0); PG8_MMA(0, 1, At, B1); PG8_BAR; PG8_SCHED;
            PG8_LDA(At, 0, 1); PG8_STAGE(PG8_SB(0, 0), b2, voffB); PG8_STAGE(PG8_SB(0, 1), b2 + hstep, voffB); PG8_STAGE(PG8_SA(0, 0), a2, voffA);
            PG8_WAIT_V(8); PG8_WAIT_L(0); PG8_BAR; PG8_MMA(1, 0, At, B0); PG8_MMA(1, 1, At, B1); PG8_BAR; PG8_SCHED;
            PG8_LDB(B0, 1, 0); PG8_LDB(B1, 1, 1); PG8_SCHED; PG8_LDA(At, 1, 0); PG8_STAGE(PG8_SA(0, 1), a2 + hstep, voffA);
            PG8_WAIT_V(8); PG8_WAIT_L(0); PG8_BAR; PG8_MMA(0, 0, At, B0); PG8_MMA(0, 1, At, B1); PG8_BAR; PG8_SCHED;
            PG8_LDA(At, 1, 1); PG8_STAGE(PG8_SB(1, 0), b3, voffB); PG8_STAGE(PG8_SB(1, 1), b3 + hstep, voffB); PG8_STAGE(PG8_SA(1, 0), a3, voffA);
            PG8_WAIT_V(8); PG8_WAIT_L(0); PG8_BAR; PG8_MMA(1, 0, At, B0); PG8_MMA(1, 1, At, B1); PG8_BAR; PG8_SCHED;
            } else {
            PG8_LDB(B0, 0, 0); PG8_SCHED; PG8_LDA(At, 0, 0); PG8_STAGE(PG8_SA(1, 1), a1 + hstep, voffA);
            PG8_WAIT_L(8); PG8_BAR; PG8_WAIT_L(0); PG8_MMA(0, 0, At, B0); PG8_BAR; PG8_SCHED;
            PG8_LDB(B1, 0, 1); PG8_STAGE(PG8_SB(0, 0), b2, voffB);
            PG8_BAR; PG8_WAIT_L(0); PG8_MMA(0, 1, At, B1); PG8_BAR;
            PG8_LDA(At, 0, 1); PG8_STAGE(PG8_SA(0, 0), a2, voffA);
            PG8_BAR; PG8_WAIT_L(0); PG8_MMA(1, 0, At, B0); PG8_BAR; PG8_SCHED;
            PG8_STAGE(PG8_SB(0, 1), b2 + hstep, voffB);
            PG8_WAIT_V(6); PG8_BAR; PG8_MMA(1, 1, At, B1); PG8_BAR;
            PG8_LDB(B0, 1, 0); PG8_SCHED; PG8_LDA(At, 1, 0); PG8_STAGE(PG8_SA(0, 1), a2 + hstep, voffA);
            PG8_WAIT_L(8); PG8_BAR; PG8_WAIT_L(0); PG8_MMA(0, 0, At, B0); PG8_BAR; PG8_SCHED;
            PG8_LDB(B1, 1, 1); PG8_STAGE(PG8_SB(1, 0), b3, voffB);
            PG8_BAR; PG8_WAIT_L(0); PG8_MMA(0, 1, At, B1); PG8_BAR;
            PG8_LDA(At, 1, 1); PG8_STAGE(PG8_SA(1, 0), a3, voffA);
            PG8_BAR; PG8_WAIT_L(0); PG8_MMA(1, 0, At, B0); PG8_BAR; PG8_SCHED;
            PG8_STAGE(PG8_SB(1, 1), b3 + hstep, voffB);
            PG8_WAIT_V(6); PG8_BAR; PG8_MMA(1, 1, At, B1); PG8_BAR;
            }
        }
        if constexpr (ALIGN_EPI) { if (wr == 0) PG8_BAR; }
        if constexpr (!Epi::AFTER_DRAIN) { E(acc, cur, wr, wc, fr, fq); S.done(cur); }
        if (!has_next) break;
#pragma unroll
        for (int a = 0; a < 2; ++a)
#pragma unroll
            for (int b = 0; b < 2; ++b)
#pragma unroll
                for (int m = 0; m < 4; ++m)
#pragma unroll
                    for (int n = 0; n < 2; ++n) acc[a][b][m][n] = (f32x4){0.f, 0.f, 0.f, 0.f};
        cur = nxt; cA = nA; cB = nB; ++ui;
        if constexpr (ALIGN_EPI) { if (wr == 1) PG8_BAR; }
    }
    PG8_WAIT_V(0);
    if constexpr (!ALIGN_EPI) { if (wr == 0) PG8_BAR; }
    PG8_BAR;
    if constexpr (Epi::AFTER_DRAIN) { E.fused(acc, cur, wr, wc, fr, fq, lds, wid, lane); S.done(cur); }
#undef PG8_SA
#undef PG8_SB
#undef PG8_STAGE
#undef PG8_LDA
#undef PG8_LDB
#undef PG8_MMA
#undef PG8_WAIT_V
#undef PG8_WAIT_L
#undef PG8_BAR
#undef PG8_SCHED
}
}

using pg8::f32x4; using pg8::bf16x8; using pg8::Unit; using pg8::cvt_pk_bf16;
typedef unsigned short u16;
#define LAS __attribute__((address_space(3)))

constexpr int MT = 8192, DM = 2048, SEQ = 4096, CH_ = 16;
constexpr int NZ = 9216, ZM = 5120, ZG = 4096, DFF = 5632, NUP = 11264, RWD = 1024;
constexpr size_t WS_WDOWN = 0;
constexpr size_t WS_WIN   = WS_WDOWN + (size_t)2048 * 5632 * 2;
constexpr size_t WS_WUP   = WS_WIN + (size_t)9216 * 2048 * 2;
constexpr size_t WS_WBR1  = WS_WUP + (size_t)11264 * 2048 * 2;
constexpr size_t WS_WBR2  = WS_WBR1 + (size_t)2048 * 1024 * 2;
constexpr size_t WS_WOUT  = WS_WBR2 + (size_t)2048 * 1024 * 2;
constexpr size_t WS_WLORA = WS_WOUT + (size_t)2048 * 2048 * 2;
constexpr size_t WS_Z     = WS_WLORA + (size_t)3072 * 512 * 2;
constexpr size_t Z_BYTES  = (size_t)MT * NUP * 2;
constexpr size_t WS_X     = WS_Z + Z_BYTES;
constexpr size_t WS_SMALL = WS_X + (size_t)MT * DM * 2;
constexpr size_t WS_Y     = WS_SMALL + 32768 + (size_t)MT * 32 * 4;
constexpr size_t WS_G     = WS_Y + (size_t)MT * 1024 * 2;
constexpr size_t WS_RK    = WS_G + (size_t)8192 * 64 * 4;
constexpr size_t WS_CNT   = WS_RK + (size_t)MT * 16 * 4;
constexpr size_t WS_BAR   = WS_CNT + 256;
constexpr size_t WS_END   = WS_BAR + 16384;
constexpr size_t WS_ACT   = WS_WIN;
static_assert(WS_Z - WS_WIN >= (size_t)MT * DFF * 2, "act overlay");
constexpr size_t Z_MAIN = 0, Z_GATE = (size_t)MT * ZM * 2, Z_TAIL = (size_t)MT * (ZM + ZG) * 2;
constexpr size_t Z_LW = 0, Z_A = (size_t)MT * RWD * 4, Z_G = 2 * (size_t)MT * RWD * 4;
constexpr size_t X_AP = 0, X_KN = (size_t)MT * 512 * 2, X_VT = X_KN + (size_t)MT * 256 * 2, X_OATT = X_VT + (size_t)MT * 256 * 2;
constexpr size_t O_RKV = 0, O_QN = (size_t)MT * 3072 * 2;

struct Params { const float* in[24]; float* out; unsigned char* ws; int ph_lo, ph_hi; };

__device__ __forceinline__ float bf2f(unsigned short b) { return __uint_as_float(((unsigned)b) << 16); }
__device__ __forceinline__ float bflo(unsigned u) { return __uint_as_float(u << 16); }
__device__ __forceinline__ float bfhi(unsigned u) { return __uint_as_float(u & 0xffff0000u); }
__device__ __forceinline__ u16 f2bf(float f) { return (u16)(cvt_pk_bf16(f, f) & 0xffffu); }
__device__ __forceinline__ float wave_sum(float v) {
#pragma unroll
    for (int o = 32; o; o >>= 1) v += __shfl_xor(v, o);
    return v; }
__device__ __forceinline__ float sigmoidf_(float x) { return 1.0f / (1.0f + __expf(-x)); }
template <int CTRL> __device__ __forceinline__ float dppf(float x) { return __int_as_float(__builtin_amdgcn_update_dpp(0, __float_as_int(x), CTRL, 0xF, 0xF, true)); }
__device__ __forceinline__ float row16_sum(float x) { x += dppf<0xB1>(x); x += dppf<0x4E>(x); x += dppf<0x141>(x); x += dppf<0x140>(x); return x; }

#define EPI_ROWS _Pragma("unroll") for (int ai = 0; ai < 2; ++ai) _Pragma("unroll") for (int m = 0; m < 4; ++m)
#define EPI_COLS _Pragma("unroll") for (int bj = 0; bj < 2; ++bj) _Pragma("unroll") for (int n = 0; n < 2; ++n)
struct EpiZ {
    static constexpr bool PERM = true, AFTER_DRAIN = false;
    u16* zmain; u16* zgate; const float* rstd;
    __device__ __forceinline__ void operator()(const f32x4 (&acc)[2][2][4][2], const Unit& u, int wr, int wc, int fr, int fq) const {
        u16* base; int ld, c0;
        if (u.pn < 20) { base = zmain; ld = ZM; c0 = u.pn * 256; } else { base = zgate; ld = ZG; c0 = (u.pn - 20) * 256; }
        const int row0 = u.pm * 256 + wr * 64 + fr; c0 += wc * 32 + 8 * fq;
        float rsv[2][4];
        EPI_ROWS rsv[ai][m] = rstd[row0 + ai * 128 + m * 16];
        EPI_ROWS { const int row = row0 + ai * 128 + m * 16; const float rs = rsv[ai][m]; u16* rp = base + (size_t)row * ld + c0;
#pragma unroll
            for (int bj = 0; bj < 2; ++bj) { const f32x4 v0 = acc[ai][bj][m][0] * rs, v1 = acc[ai][bj][m][1] * rs;
                uint4 w; w.x = cvt_pk_bf16(v0[0], v0[1]); w.y = cvt_pk_bf16(v0[2], v0[3]); w.z = cvt_pk_bf16(v1[0], v1[1]); w.w = cvt_pk_bf16(v1[2], v1[3]); *(uint4*)(rp + bj * 128) = w; } }
    }
};
struct EpiLora {
    static constexpr bool PERM = true, AFTER_DRAIN = false;
    float* lw; float* av; u16* g; const float* w0; const float* a0;
    __device__ __forceinline__ void operator()(const f32x4 (&acc)[2][2][4][2], const Unit& u, int wr, int wc, int fr, int fq) const {
        const int row0 = u.pm * 256 + wr * 64 + fr; const int kind = u.pn >> 2; const int c0 = (u.pn & 3) * 256 + wc * 32 + 8 * fq;
        if (kind == 0) {
            EPI_ROWS { const int row = row0 + ai * 128 + m * 16;
                EPI_COLS { const int col = c0 + bj * 128 + n * 4; const f32x4 v = acc[ai][bj][m][n]; const f32x4 b = *(const f32x4*)(w0 + col); f32x4 o;
#pragma unroll
                    for (int j = 0; j < 4; ++j) { const float y = -(b[j] + v[j]); const float sp = fmaxf(y, 0.f) + __logf(1.0f + __expf(-fabsf(y))); o[j] = -__expf(-sp - 0.5f); }
                    *(f32x4*)(lw + (size_t)row * RWD + col) = o; } }
        } else if (kind == 1) {
            EPI_ROWS { const int row = row0 + ai * 128 + m * 16;
                EPI_COLS { const int col = c0 + bj * 128 + n * 4; const f32x4 v = acc[ai][bj][m][n]; const f32x4 b = *(const f32x4*)(a0 + col); f32x4 o;
#pragma unroll
                    for (int j = 0; j < 4; ++j) o[j] = sigmoidf_(b[j] + v[j]);
                    *(f32x4*)(av + (size_t)row * RWD + col) = o; } }
        } else {
            EPI_ROWS { const int row = row0 + ai * 128 + m * 16;
#pragma unroll
                for (int bj = 0; bj < 2; ++bj) { const f32x4 v0 = acc[ai][bj][m][0], v1 = acc[ai][bj][m][1];
                    uint4 w; w.x = cvt_pk_bf16(v0[0], v0[1]); w.y = cvt_pk_bf16(v0[2], v0[3]); w.z = cvt_pk_bf16(v1[0], v1[1]); w.w = cvt_pk_bf16(v1[2], v1[3]); *(uint4*)(g + (size_t)row * RWD + c0 + bj * 128) = w; } }
        }
    }
};
template <int PASS> struct EpiBranch {
    static constexpr bool PERM = true, AFTER_DRAIN = false;
    u16* mixed; const u16* zgate;
    __device__ __forceinline__ void operator()(const f32x4 (&acc)[2][2][4][2], const Unit& u, int wr, int wc, int fr, int fq) const {
        const int row0 = u.pm * 256 + wr * 64 + fr; const int c0 = u.pn * 256 + wc * 32 + 8 * fq;
        EPI_ROWS { const int row = row0 + ai * 128 + m * 16;
#pragma unroll
            for (int bj = 0; bj < 2; ++bj) { const int col = c0 + bj * 128; const f32x4 v0 = acc[ai][bj][m][0], v1 = acc[ai][bj][m][1];
                const uint4 gz = *(const uint4*)(zgate + (size_t)row * ZG + PASS * 2048 + col);
                float o[8]; o[0] = sigmoidf_(bflo(gz.x)) * v0[0]; o[1] = sigmoidf_(bfhi(gz.x)) * v0[1]; o[2] = sigmoidf_(bflo(gz.y)) * v0[2]; o[3] = sigmoidf_(bfhi(gz.y)) * v0[3];
                o[4] = sigmoidf_(bflo(gz.z)) * v1[0]; o[5] = sigmoidf_(bfhi(gz.z)) * v1[1]; o[6] = sigmoidf_(bflo(gz.w)) * v1[2]; o[7] = sigmoidf_(bfhi(gz.w)) * v1[3];
                uint4* mp = (uint4*)(mixed + (size_t)row * DM + col);
                if (PASS == 1) { const uint4 pm = *mp; o[0] += bflo(pm.x); o[1] += bfhi(pm.x); o[2] += bflo(pm.y); o[3] += bfhi(pm.y); o[4] += bflo(pm.z); o[5] += bfhi(pm.z); o[6] += bflo(pm.w); o[7] += bfhi(pm.w); }
                uint4 w; w.x = cvt_pk_bf16(o[0], o[1]); w.y = cvt_pk_bf16(o[2], o[3]); w.z = cvt_pk_bf16(o[4], o[5]); w.w = cvt_pk_bf16(o[6], o[7]); *mp = w; } }
    }
};
struct EpiOut1 {
    static constexpr bool PERM = true, AFTER_DRAIN = false;
    const float* x; float* x1; u16* x1b; float* rowss;
    __device__ __forceinline__ void operator()(const f32x4 (&acc)[2][2][4][2], const Unit& u, int wr, int wc, int fr, int fq) const {
        const int row0 = u.pm * 256 + wr * 64 + fr; const int c0 = u.pn * 256 + wc * 32 + 8 * fq;
        EPI_ROWS { const int row = row0 + ai * 128 + m * 16; float ss = 0.f;
#pragma unroll
            for (int bj = 0; bj < 2; ++bj) { const size_t o = (size_t)row * DM + c0 + bj * 128;
                const f32x4 v0 = acc[ai][bj][m][0] + *(const f32x4*)(x + o), v1 = acc[ai][bj][m][1] + *(const f32x4*)(x + o + 4);
                *(f32x4*)(x1 + o) = v0; *(f32x4*)(x1 + o + 4) = v1;
                ss += (v0[0] * v0[0] + v0[1] * v0[1] + v0[2] * v0[2] + v0[3] * v0[3]) + (v1[0] * v1[0] + v1[1] * v1[1] + v1[2] * v1[2] + v1[3] * v1[3]);
                uint4 w; w.x = cvt_pk_bf16(v0[0], v0[1]); w.y = cvt_pk_bf16(v0[2], v0[3]); w.z = cvt_pk_bf16(v1[0], v1[1]); w.w = cvt_pk_bf16(v1[2], v1[3]); *(uint4*)(x1b + o) = w; }
            ss += __shfl_xor(ss, 16); ss += __shfl_xor(ss, 32);
            if (fq == 0) rowss[(size_t)row * 32 + u.pn * 4 + wc] = ss; }
    }
};
struct EpiUp {
    static constexpr bool PERM = true, AFTER_DRAIN = false;
    u16* uo; const float* rowss;
    __device__ __forceinline__ void operator()(const f32x4 (&acc)[2][2][4][2], const Unit& u, int wr, int wc, int fr, int fq) const {
        const int row0 = u.pm * 256 + wr * 64 + fr; const int c0 = u.pn * 256 + wc * 32 + 8 * fq;
        float rsv[2][4];
        EPI_ROWS { const int row = row0 + ai * 128 + m * 16;
            const f32x4 p0 = *(const f32x4*)(rowss + (size_t)row * 32 + fq * 8), p1 = *(const f32x4*)(rowss + (size_t)row * 32 + fq * 8 + 4);
            float ss = ((p0[0] + p0[1]) + (p0[2] + p0[3])) + ((p1[0] + p1[1]) + (p1[2] + p1[3]));
            ss += __shfl_xor(ss, 16); ss += __shfl_xor(ss, 32);
            rsv[ai][m] = rsqrtf(ss * (1.0f / 2048.0f) + 1e-6f); }
        EPI_ROWS { const int row = row0 + ai * 128 + m * 16; const float rs = rsv[ai][m]; u16* rp = uo + (size_t)row * NUP + c0;
#pragma unroll
            for (int bj = 0; bj < 2; ++bj) { const f32x4 v0 = acc[ai][bj][m][0] * rs, v1 = acc[ai][bj][m][1] * rs;
                uint4 w; w.x = cvt_pk_bf16(v0[0], v0[1]); w.y = cvt_pk_bf16(v0[2], v0[3]); w.z = cvt_pk_bf16(v1[0], v1[1]); w.w = cvt_pk_bf16(v1[2], v1[3]); *(uint4*)(rp + bj * 128) = w; } }
    }
};
struct EpiFinal {
    static constexpr bool PERM = true, AFTER_DRAIN = false;
    float* out;
    __device__ __forceinline__ void operator()(const f32x4 (&acc)[2][2][4][2], const Unit& u, int wr, int wc, int fr, int fq) const {
        const int row0 = u.pm * 256 + wr * 64 + fr; const int c0 = u.pn * 256 + wc * 32 + 8 * fq;
        EPI_ROWS { const int row = row0 + ai * 128 + m * 16;
#pragma unroll
            for (int bj = 0; bj < 2; ++bj) { float* op = out + (size_t)row * DM + c0 + bj * 128;
                const f32x4 a0 = *(const f32x4*)op + acc[ai][bj][m][0], a1 = *(const f32x4*)(op + 4) + acc[ai][bj][m][1]; *(f32x4*)op = a0; *(f32x4*)(op + 4) = a1; } }
    }
};

template <class Epi> __device__ __forceinline__ void run_gemm(LAS unsigned char* lds, const u16* A, const u16* Bt, int N, int K, const Epi& E) {
    pg8::Gemm g; g.A = A; g.Bt = Bt; g.M = MT; g.N = N; g.K = K;
    pg8::StaticOrder S; S.init(MT, N, (int)gridDim.x, (int)blockIdx.x);
    pg8::gemm_phase<Epi, pg8::StaticOrder, true, true>(lds, g, S, E);
}

template <class Epi> __device__ __forceinline__ void run_gemm_sub(LAS unsigned char* lds, const u16* A, const u16* Bt, int N, int K, const Epi& E, int G, int c) {
    pg8::Gemm g; g.A = A; g.Bt = Bt; g.M = MT; g.N = N; g.K = K;
    pg8::StaticOrder S; S.init(MT, N, G, c);
    pg8::gemm_phase<Epi, pg8::StaticOrder, true, true>(lds, g, S, E);
}
struct EpiZG {
    static constexpr bool PERM = true, AFTER_DRAIN = false;
    u16* zgate; const float* rstd;
    __device__ __forceinline__ void operator()(const f32x4 (&acc)[2][2][4][2], const Unit& u, int wr, int wc, int fr, int fq) const {
        const int row0 = u.pm * 256 + wr * 64 + fr; const int c0 = 1024 + u.pn * 256 + wc * 32 + 8 * fq;
        float rsv[2][4];
        EPI_ROWS rsv[ai][m] = rstd[row0 + ai * 128 + m * 16];
        EPI_ROWS { const int row = row0 + ai * 128 + m * 16; const float rs = rsv[ai][m]; u16* rp = zgate + (size_t)row * ZG + c0;
#pragma unroll
            for (int bj = 0; bj < 2; ++bj) { const f32x4 v0 = acc[ai][bj][m][0] * rs, v1 = acc[ai][bj][m][1] * rs;
                uint4 w; w.x = cvt_pk_bf16(v0[0], v0[1]); w.y = cvt_pk_bf16(v0[2], v0[3]); w.z = cvt_pk_bf16(v1[0], v1[1]); w.w = cvt_pk_bf16(v1[2], v1[3]); *(uint4*)(rp + bj * 128) = w; } }
    }
};

__device__ __forceinline__ void tr_tile(const float* __restrict__ src, int ldn, int nsrc0, u16* __restrict__ dst, int K, int k0, int ndst0, const float* __restrict__ scale, float* tile) {
    const int tid = threadIdx.x, nc4 = (tid & 15) * 4, kr0 = tid >> 4;
    float4 v[8];
#pragma unroll
    for (int i = 0; i < 8; ++i) { const int kr = kr0 + 32 * i; v[i] = make_float4(0.f, 0.f, 0.f, 0.f);
        if (nsrc0 >= 0) v[i] = *(const float4*)(src + (size_t)(k0 + kr) * ldn + nsrc0 + nc4); }
#pragma unroll
    for (int i = 0; i < 8; ++i) { const int kr = kr0 + 32 * i; const float sc = scale ? scale[k0 + kr] : 1.0f; float* tp = tile + kr * 65 + nc4;
        tp[0] = v[i].x * sc; tp[1] = v[i].y * sc; tp[2] = v[i].z * sc; tp[3] = v[i].w * sc; }
    __syncthreads();
    const int nr = tid >> 3, kb = (tid & 7) * 8;
#pragma unroll
    for (int q = 0; q < 4; ++q) { const int kc = kb + 64 * q; uint4 w;
        w.x = cvt_pk_bf16(tile[(kc + 0) * 65 + nr], tile[(kc + 1) * 65 + nr]); w.y = cvt_pk_bf16(tile[(kc + 2) * 65 + nr], tile[(kc + 3) * 65 + nr]);
        w.z = cvt_pk_bf16(tile[(kc + 4) * 65 + nr], tile[(kc + 5) * 65 + nr]); w.w = cvt_pk_bf16(tile[(kc + 6) * 65 + nr], tile[(kc + 7) * 65 + nr]);
        *(uint4*)(dst + (size_t)(ndst0 + nr) * K + k0 + kc) = w; }
    __syncthreads();
}
constexpr int WT_IN = 1152, WT_ALL = 3776;
__device__ __forceinline__ void weight_tile(const Params& P, int id, float* tile) {
    unsigned char* ws = P.ws;
    if (id < 1152) { const int nt = id % 144, kt = id / 144; const int ns = nt < 55 ? nt * 64 : (nt == 55 ? -1 : nt * 64 - 64);
        tr_tile(P.in[2], 9152, ns, (u16*)(ws + WS_WIN), 2048, kt * 256, nt * 64, P.in[1], tile); }
    else if (id < 1152 + 1408) { const int j = id - 1152, nt = j % 176, kt = j / 176;
        tr_tile(P.in[20], NUP, nt * 64, (u16*)(ws + WS_WUP), 2048, kt * 256, nt * 64, P.in[19], tile); }
    else if (id < 2560 + 704) { const int j = id - 2560, nt = j % 32, kt = j / 32;
        tr_tile(P.in[23], 2048, nt * 64, (u16*)(ws + WS_WDOWN), 5632, kt * 256, nt * 64, nullptr, tile); }
    else if (id < 3264 + 128) { const int j = id - 3264, nt = j % 32, kt = j / 32;
        tr_tile(P.in[17], 2048, nt * 64, (u16*)(ws + WS_WBR1), 1024, kt * 256, nt * 64, nullptr, tile); }
    else if (id < 3392 + 128) { const int j = id - 3392, nt = j % 32, kt = j / 32;
        tr_tile(P.in[17] + (size_t)1024 * 2048, 2048, nt * 64, (u16*)(ws + WS_WBR2), 1024, kt * 256, nt * 64, nullptr, tile); }
    else { const int j = id - 3520, nt = j % 32, kt = j / 32;
        tr_tile(P.in[18], 2048, nt * 64, (u16*)(ws + WS_WOUT), 2048, kt * 256, nt * 64, nullptr, tile); }
}
__device__ __forceinline__ void win_tile(const Params& P, int kt, int nt, float* tile) {
    const int ns = nt < 55 ? nt * 64 : (nt == 55 ? -1 : nt * 64 - 64);
    tr_tile(P.in[2], 9152, ns, (u16*)(P.ws + WS_WIN), 2048, kt * 256, nt * 64, P.in[1], tile);
}
__device__ void phase0(const Params& P, float* tile) {
    unsigned char* ws = P.ws; const int G = gridDim.x, bid = blockIdx.x, tid = threadIdx.x;
    if (bid == 0 && tid == 0) *(unsigned*)(ws + WS_CNT) = 0u;
    for (int id = bid; id < 1152; id += G) win_tile(P, id / 144, id % 144, tile);
    { u16* w2t = (u16*)(ws + WS_WLORA); u16* a2t = w2t + 1024 * 96; u16* g2t = a2t + 1024 * 96;
      for (int idx = bid * 512 + tid; idx < 448 * 1024; idx += G * 512) { const int kk = idx >> 10, n = idx & 1023;
          if (kk < 96) w2t[n * 96 + kk] = f2bf(P.in[5][(size_t)kk * 1024 + n]);
          else if (kk < 192) a2t[n * 96 + (kk - 96)] = f2bf(P.in[7][(size_t)(kk - 96) * 1024 + n]);
          else g2t[n * 256 + (kk - 192)] = f2bf(P.in[8][(size_t)(kk - 192) * 1024 + n]); } }
    { const int lane = tid & 63, gw = bid * 8 + (tid >> 6), nw = G * 8; u16* xb = (u16*)(ws + WS_Z + Z_TAIL); float* rstd1 = (float*)(ws + WS_SMALL);
      for (int t = gw; t < MT; t += nw) { const float4* xr = (const float4*)(P.in[0] + (size_t)t * DM); float ss = 0.f;
#pragma unroll
          for (int i = 0; i < 8; ++i) { const float4 v = xr[lane + 64 * i]; ss += v.x * v.x + v.y * v.y + v.z * v.z + v.w * v.w;
              uint2 w; w.x = cvt_pk_bf16(v.x, v.y); w.y = cvt_pk_bf16(v.z, v.w); *(uint2*)(xb + (size_t)t * DM + (lane + 64 * i) * 4) = w; }
          ss = wave_sum(ss); if (lane == 0) rstd1[t] = rsqrtf(ss * (1.0f / 2048.0f) + 1e-6f); } }
}

__device__ void phase2(const Params& P, u16* tile) {
    unsigned char* ws = P.ws; const int G = gridDim.x, bid = blockIdx.x, tid = threadIdx.x, lane = tid & 63;
    const u16* zmain = (const u16*)(ws + WS_Z + Z_MAIN);
    u16* rkv = (u16*)((unsigned char*)P.out + O_RKV); u16* Qn = (u16*)((unsigned char*)P.out + O_QN);
    u16* Ap = (u16*)(ws + WS_X + X_AP); u16* Kn = (u16*)(ws + WS_X + X_KN); u16* Vt = (u16*)(ws + WS_X + X_VT);
    const float* mu = P.in[3];
    const int d0 = (lane * 2) & 63; const float qg0 = P.in[14][d0] * 0.125f, qg1 = P.in[14][d0 + 1] * 0.125f, kg0 = P.in[15][d0], kg1 = P.in[15][d0 + 1];
    for (int t = bid * 8 + (tid >> 6); t < MT; t += G * 8) {
        const u16* zr = zmain + (size_t)t * ZM; const bool hp = (t & (SEQ - 1)) != 0; const u16* zp = hp ? zr - ZM : zr;
        unsigned zz[28], pp[28], qk[10]; float2 m2[28];
#pragma unroll
        for (int i = 0; i < 28; ++i) { const int c = i * 128 + lane * 2; zz[i] = 0u; pp[i] = 0u; m2[i] = make_float2(0.f, 0.f);
            if (i < 27 || lane < 32) { zz[i] = *(const unsigned*)(zr + c); pp[i] = *(const unsigned*)(zp + c); m2[i] = *(const float2*)(mu + c); } }
#pragma unroll
        for (int i = 0; i < 10; ++i) qk[i] = *(const unsigned*)(zr + 3584 + i * 128 + lane * 2);
#pragma unroll
        for (int i = 0; i < 28; ++i) { const int c = i * 128 + lane * 2;
            if (i < 27 || lane < 32) { const unsigned pv = hp ? pp[i] : 0u;
                const float z0 = bflo(zz[i]), z1 = bfhi(zz[i]); const float a0 = z0 + (bflo(pv) - z0) * m2[i].x, a1 = z1 + (bfhi(pv) - z1) * m2[i].y;
                if (i < 24) *(unsigned*)(rkv + (size_t)t * 3072 + c) = cvt_pk_bf16(a0, a1);
                else if (c < 3168) *(unsigned*)(Ap + (size_t)t * 512 + (c - 3072)) = cvt_pk_bf16(tanhf(a0), tanhf(a1));
                else if (c < 3264) *(unsigned*)(Ap + (size_t)t * 512 + 96 + (c - 3168)) = cvt_pk_bf16(a0, a1);
                else *(unsigned*)(Ap + (size_t)t * 512 + 256 + (c - 3264)) = cvt_pk_bf16(sigmoidf_(a0), sigmoidf_(a1)); } }
        if (lane < 32) *(unsigned*)(Ap + (size_t)t * 512 + 192 + lane * 2) = 0u;
#pragma unroll
        for (int i = 0; i < 10; ++i) { const float v0 = bflo(qk[i]), v1 = bfhi(qk[i]); float ss = row16_sum(v0 * v0 + v1 * v1); ss += __shfl_xor(ss, 16);
            const float rs = rsqrtf(ss * (1.0f / 64.0f) + 1e-6f);
            if (i < 8) *(unsigned*)(Qn + (size_t)t * 1024 + i * 128 + lane * 2) = cvt_pk_bf16(v0 * rs * qg0, v1 * rs * qg1);
            else *(unsigned*)(Kn + (size_t)t * 256 + (i - 8) * 128 + lane * 2) = cvt_pk_bf16(v0 * rs * kg0, v1 * rs * kg1); }
    }
    for (int tl = bid; tl < MT / 64; tl += G) { const int t0 = tl * 64;
        __syncthreads();
        for (int i = 0; i < 16; ++i) { const int idx = tid + 512 * i, r = idx >> 7, cp = idx & 127; const unsigned vv = *(const unsigned*)(zmain + (size_t)(t0 + r) * ZM + 4864 + 2 * cp);
            tile[(2 * cp) * 66 + r] = (u16)(vv & 0xffffu); tile[(2 * cp + 1) * 66 + r] = (u16)(vv >> 16); }
        __syncthreads();
        const int b = t0 >> 12, s0 = t0 & (SEQ - 1);
        for (int i = 0; i < 16; ++i) { const int idx = tid + 512 * i, c = idx >> 5, sp = idx & 31;
            const unsigned w = (unsigned)tile[c * 66 + 2 * sp] | ((unsigned)tile[c * 66 + 2 * sp + 1] << 16);
            *(unsigned*)(Vt + ((size_t)(b * 4 + (c >> 6)) * 64 + (c & 63)) * SEQ + s0 + 2 * sp) = w; }
    }
}

constexpr int NSCAN = 32;
#define LDS_BARRIER() do { asm volatile("s_waitcnt lgkmcnt(0)" ::: "memory"); __builtin_amdgcn_s_barrier(); asm volatile("" ::: "memory"); } while (0)
__device__ __forceinline__ float row8_sum(float x) { x += dppf<0xB1>(x); x += dppf<0x4E>(x); x += dppf<0x141>(x); return x; }
__device__ void rwkv_prep(const Params& P, unsigned char* lds_raw) {
    unsigned char* ws = P.ws; const int tid = threadIdx.x, q4 = tid >> 7, lt = tid & 127, lane = tid & 63, qw = (tid >> 6) & 1, fr = lane & 15, fq = lane >> 4;
    unsigned char* lwb = ws + WS_Z + Z_LW; unsigned char* ab = ws + WS_Z + Z_A; u16* rkv = (u16*)((unsigned char*)P.out + O_RKV);
    float* gbuf = (float*)(ws + WS_G); float* rkb = (float*)(ws + WS_RK);
    const u16* Apx = (const u16*)(ws + WS_X + X_AP); const u16* w2t = (const u16*)(ws + WS_WLORA); const u16* a2t = w2t + 1024 * 96; const u16* g2t = a2t + 1024 * 96; u16* gout = (u16*)(ws + WS_Z + Z_G);
    unsigned char* L0 = lds_raw + q4 * 32768;
    u16* sAt = (u16*)L0; u16* sBt = sAt + 16 * 72; u16* sKt = sBt + 16 * 72; u16* sRt = sKt + 16 * 72;
    u16* sVt = (u16*)(L0 + 9216); u16* sAak = (u16*)(L0 + 12288); float* sN = (float*)(L0 + 13312); float* sRHS = (float*)(L0 + 14400); float* sL = (float*)(L0 + 22848); float* sAf = (float*)(L0 + 26944);
    const int tl = lt >> 3, c8 = (lt & 7) * 8;
    uint4 n_r, n_k, n_v; float4 n_kkw[2], n_kaw[2], n_rkw[2]; bf16x8 n_At[3], n_Aa[3], n_Ag[8];
    auto unit_of = [&](int it_) { if ((int)gridDim.x == 256) { const int s_ = (it_ & 255) * 4 + q4; return (s_ >> 5) * 256 + (s_ & 31) + 32 * (it_ >> 8); } return it_ * 4 + q4; };
    auto fetch = [&](int it_) { const int unit_ = unit_of(it_), b_ = unit_ >> 12, h_ = (unit_ >> 8) & 15, c_ = unit_ & 255; const size_t t_ = (size_t)b_ * SEQ + c_ * CH_ + tl; const int hc_ = h_ * 64 + c8;
        n_r = *(const uint4*)(rkv + t_ * 3072 + hc_); n_k = *(const uint4*)(rkv + t_ * 3072 + 1024 + hc_); n_v = *(const uint4*)(rkv + t_ * 3072 + 2048 + hc_);
#pragma unroll
        for (int i = 0; i < 2; ++i) {
            n_kkw[i] = *(const float4*)(P.in[9] + hc_ + 4 * i); n_kaw[i] = *(const float4*)(P.in[10] + hc_ + 4 * i); n_rkw[i] = *(const float4*)(P.in[11] + hc_ + 4 * i); }
        const u16* ar_ = Apx + ((size_t)b_ * SEQ + c_ * CH_ + fr) * 512 + 8 * fq;
#pragma unroll
        for (int ks = 0; ks < 3; ++ks) { n_At[ks] = *(const bf16x8*)(ar_ + 32 * ks); n_Aa[ks] = *(const bf16x8*)(ar_ + 96 + 32 * ks); }
#pragma unroll
        for (int ks = 0; ks < 8; ++ks) n_Ag[ks] = *(const bf16x8*)(ar_ + 256 + 32 * ks); };
    if ((int)blockIdx.x < 2048) fetch(blockIdx.x);
    for (int it = blockIdx.x; it < 2048; it += gridDim.x) {
        const int unit = unit_of(it), b = unit >> 12, h = (unit >> 8) & 15, c = unit & 255; const size_t t0 = (size_t)b * SEQ + c * CH_, t = t0 + tl;
#pragma unroll
        for (int n2 = 0; n2 < 2; ++n2) { const int cn = (qw * 2 + n2) * 16 + fr, nrow = h * 64 + cn;
            f32x4 accw = {0.f, 0.f, 0.f, 0.f}, acca = {0.f, 0.f, 0.f, 0.f}, accg = {0.f, 0.f, 0.f, 0.f};
#pragma unroll
            for (int ks = 0; ks < 3; ++ks) { const bf16x8 bw = *(const bf16x8*)(w2t + nrow * 96 + 32 * ks + 8 * fq), ba = *(const bf16x8*)(a2t + nrow * 96 + 32 * ks + 8 * fq);
                accw = __builtin_amdgcn_mfma_f32_16x16x32_bf16(n_At[ks], bw, accw, 0, 0, 0); acca = __builtin_amdgcn_mfma_f32_16x16x32_bf16(n_Aa[ks], ba, acca, 0, 0, 0); }
#pragma unroll
            for (int ks = 0; ks < 8; ++ks) { const bf16x8 bg = *(const bf16x8*)(g2t + nrow * 256 + 32 * ks + 8 * fq); accg = __builtin_amdgcn_mfma_f32_16x16x32_bf16(n_Ag[ks], bg, accg, 0, 0, 0); }
            const float w0v = P.in[4][nrow], a0v = P.in[6][nrow];
#pragma unroll
            for (int j = 0; j < 4; ++j) { const int tt = 4 * fq + j; const float y = -(w0v + accw[j]); const float sp = fmaxf(y, 0.f) + __logf(1.0f + __expf(-fabsf(y)));
                sL[tt * 64 + cn] = -__expf(-sp - 0.5f); sAf[tt * 64 + cn] = sigmoidf_(a0v + acca[j]); gout[(t0 + tt) * RWD + nrow] = f2bf(accg[j]); } }
        LDS_BARRIER();
        const unsigned ru[4] = {n_r.x, n_r.y, n_r.z, n_r.w}, ku[4] = {n_k.x, n_k.y, n_k.z, n_k.w}, vu[4] = {n_v.x, n_v.y, n_v.z, n_v.w};
        float rr[8], kr[8], aa[8], lw[8], kkw_[8], kaw_[8], rkw_[8];
        { const float4 l0 = *(const float4*)(sL + tl * 64 + c8), l1 = *(const float4*)(sL + tl * 64 + c8 + 4), q0 = *(const float4*)(sAf + tl * 64 + c8), q1 = *(const float4*)(sAf + tl * 64 + c8 + 4);
          lw[0] = l0.x; lw[1] = l0.y; lw[2] = l0.z; lw[3] = l0.w; lw[4] = l1.x; lw[5] = l1.y; lw[6] = l1.z; lw[7] = l1.w; aa[0] = q0.x; aa[1] = q0.y; aa[2] = q0.z; aa[3] = q0.w; aa[4] = q1.x; aa[5] = q1.y; aa[6] = q1.z; aa[7] = q1.w; }
#pragma unroll
        for (int i = 0; i < 4; ++i) { rr[2 * i] = bflo(ru[i]); rr[2 * i + 1] = bfhi(ru[i]); kr[2 * i] = bflo(ku[i]); kr[2 * i + 1] = bfhi(ku[i]); }
#pragma unroll
        for (int i = 0; i < 2; ++i) {
            kkw_[4 * i] = n_kkw[i].x; kkw_[4 * i + 1] = n_kkw[i].y; kkw_[4 * i + 2] = n_kkw[i].z; kkw_[4 * i + 3] = n_kkw[i].w; kaw_[4 * i] = n_kaw[i].x; kaw_[4 * i + 1] = n_kaw[i].y; kaw_[4 * i + 2] = n_kaw[i].z; kaw_[4 * i + 3] = n_kaw[i].w;
            rkw_[4 * i] = n_rkw[i].x; rkw_[4 * i + 1] = n_rkw[i].y; rkw_[4 * i + 2] = n_rkw[i].z; rkw_[4 * i + 3] = n_rkw[i].w; }
        float qq[8], kk[8], bb[8], kp[8]; float ss = 0.f, rks = 0.f;
#pragma unroll
        for (int j = 0; j < 8; ++j) { qq[j] = kr[j] * kkw_[j]; ss += qq[j] * qq[j]; }
        ss = row8_sum(ss); const float inv = 1.0f / fmaxf(sqrtf(ss), 1e-12f);
#pragma unroll
        for (int j = 0; j < 8; ++j) { kk[j] = qq[j] * inv; bb[j] = kk[j] * aa[j]; kp[j] = kr[j] * (1.0f + (aa[j] - 1.0f) * kaw_[j]); rks += rr[j] * kp[j] * rkw_[j]; }
        rks = row8_sum(rks); if ((lt & 7) == 0) rkb[t * 16 + h] = rks;
#pragma unroll
        for (int i = 0; i < 4; ++i) { sVt[(c8 + 2 * i) * 24 + tl] = (u16)(vu[i] & 0xffffu); sVt[(c8 + 2 * i + 1) * 24 + tl] = (u16)(vu[i] >> 16); }
        LDS_BARRIER();
        if (lt < 64) { float lv[16];
#pragma unroll
            for (int i = 0; i < 16; ++i) lv[i] = sL[i * 64 + lt];
#pragma unroll
            for (int i = 1; i < 16; ++i) lv[i] += lv[i - 1];
#pragma unroll
            for (int i = 0; i < 16; ++i) sL[i * 64 + lt] = lv[i]; }
        LDS_BARRIER();
        { const float4 La = *(const float4*)(sL + tl * 64 + c8), Lb = *(const float4*)(sL + tl * 64 + c8 + 4), Ta = *(const float4*)(sL + 15 * 64 + c8), Tb = *(const float4*)(sL + 15 * 64 + c8 + 4);
          const float Lc[8] = {La.x, La.y, La.z, La.w, Lb.x, Lb.y, Lb.z, Lb.w}, Lt[8] = {Ta.x, Ta.y, Ta.z, Ta.w, Tb.x, Tb.y, Tb.z, Tb.w};
          float at[8], bt[8], kt[8], rt[8], bh[8], kh[8];
#pragma unroll
          for (int j = 0; j < 8; ++j) { const float eL = __expf(Lc[j]), eLp = __expf(Lc[j] - lw[j]), eNL = __expf(-Lc[j]), eH = __expf(Lt[j] - Lc[j]);
              at[j] = -kk[j] * eLp; bt[j] = bb[j] * eNL; kt[j] = kp[j] * eNL; rt[j] = rr[j] * eL; bh[j] = bb[j] * eH; kh[j] = kp[j] * eH; }
          uint4 w; w.x = cvt_pk_bf16(at[0], at[1]); w.y = cvt_pk_bf16(at[2], at[3]); w.z = cvt_pk_bf16(at[4], at[5]); w.w = cvt_pk_bf16(at[6], at[7]); *(uint4*)(sAt + tl * 72 + c8) = w;
          w.x = cvt_pk_bf16(bt[0], bt[1]); w.y = cvt_pk_bf16(bt[2], bt[3]); w.z = cvt_pk_bf16(bt[4], bt[5]); w.w = cvt_pk_bf16(bt[6], bt[7]); *(uint4*)(sBt + tl * 72 + c8) = w;
          w.x = cvt_pk_bf16(kt[0], kt[1]); w.y = cvt_pk_bf16(kt[2], kt[3]); w.z = cvt_pk_bf16(kt[4], kt[5]); w.w = cvt_pk_bf16(kt[6], kt[7]); *(uint4*)(sKt + tl * 72 + c8) = w;
          w.x = cvt_pk_bf16(rt[0], rt[1]); w.y = cvt_pk_bf16(rt[2], rt[3]); w.z = cvt_pk_bf16(rt[4], rt[5]); w.w = cvt_pk_bf16(rt[6], rt[7]); *(uint4*)(sRt + tl * 72 + c8) = w;
          *(uint4*)(lwb + (t * 1024 + h * 64) * 4 + 128 + c8 * 2) = w;
          *(float4*)(sRHS + tl * 132 + c8) = make_float4(at[0], at[1], at[2], at[3]); *(float4*)(sRHS + tl * 132 + c8 + 4) = make_float4(at[4], at[5], at[6], at[7]);
#pragma unroll
          for (int j = 0; j < 8; ++j) { unsigned char* dst = ab + ((t0 + (c8 >> 2) + (j >> 2)) * 1024 + h * 64) * 4 + (j & 3) * 64;
              *(u16*)(dst + tl * 2) = f2bf(bh[j]); *(u16*)(dst + (16 + tl) * 2) = f2bf(kh[j]); }
          if (tl == 0) { *(float4*)(gbuf + (size_t)unit * 64 + c8) = make_float4(__expf(Lt[0]), __expf(Lt[1]), __expf(Lt[2]), __expf(Lt[3]));
              *(float4*)(gbuf + (size_t)unit * 64 + c8 + 4) = make_float4(__expf(Lt[4]), __expf(Lt[5]), __expf(Lt[6]), __expf(Lt[7])); } }
        LDS_BARRIER();
        if (it + (int)gridDim.x < 2048) fetch(it + (int)gridDim.x);
        { const u16* X = qw == 0 ? sAt : sRt;
          const bf16x8 a0 = *(const bf16x8*)(X + fr * 72 + 8 * fq), a1 = *(const bf16x8*)(X + fr * 72 + 32 + 8 * fq);
#pragma unroll
          for (int pi = 0; pi < 2; ++pi) { const u16* Y = pi ? sKt : sBt; const int hw = qw * 2 + pi;
              const bf16x8 b0 = *(const bf16x8*)(Y + fr * 72 + 8 * fq), b1 = *(const bf16x8*)(Y + fr * 72 + 32 + 8 * fq);
              f32x4 acc = {0.f, 0.f, 0.f, 0.f};
              acc = __builtin_amdgcn_mfma_f32_16x16x32_bf16(a0, b0, acc, 0, 0, 0); acc = __builtin_amdgcn_mfma_f32_16x16x32_bf16(a1, b1, acc, 0, 0, 0);
#pragma unroll
              for (int j = 0; j < 4; ++j) { const int tt = 4 * fq + j, i = fr; const bool keep = hw < 2 ? (i < tt) : (i <= tt); const float val = keep ? acc[j] : 0.f;
                  if (hw == 0) sN[tt * 17 + i] = val;
                  else if (hw == 1) sAak[tt * 24 + i] = f2bf(val);
                  else rkv[(t0 + tt) * 3072 + h * 64 + (hw == 3 ? 16 : 0) + i] = f2bf(val); } } }
        LDS_BARRIER();
#pragma unroll
        for (int vi = 0; vi < 2; ++vi) { const int vt = qw * 2 + vi; bf16x8 af = {0, 0, 0, 0, 0, 0, 0, 0}, bf = {0, 0, 0, 0, 0, 0, 0, 0};
          if (fq < 2) { af = *(const bf16x8*)(sAak + fr * 24 + 8 * fq); bf = *(const bf16x8*)(sVt + (vt * 16 + fr) * 24 + 8 * fq); }
          f32x4 acc = {0.f, 0.f, 0.f, 0.f}; acc = __builtin_amdgcn_mfma_f32_16x16x32_bf16(af, bf, acc, 0, 0, 0);
#pragma unroll
          for (int j = 0; j < 4; ++j) sRHS[(4 * fq + j) * 132 + 64 + vt * 16 + fr] = acc[j]; }
        LDS_BARRIER();
        { const int col = qw * 64 + lane; float x[16];
#pragma unroll
            for (int i = 0; i < 16; ++i) { float v = sRHS[i * 132 + col];
#pragma unroll
                for (int j = 0; j < i; ++j) v += sN[i * 17 + j] * x[j];
                x[i] = v; }
            if (qw == 0) {
#pragma unroll
                for (int i = 0; i < 16; ++i) *(u16*)(lwb + ((t0 + i) * 1024 + h * 64) * 4 + lane * 2) = f2bf(x[i]); }
            else { uint4 w0, w1; w0.x = cvt_pk_bf16(x[0], x[1]); w0.y = cvt_pk_bf16(x[2], x[3]); w0.z = cvt_pk_bf16(x[4], x[5]); w0.w = cvt_pk_bf16(x[6], x[7]);
                w1.x = cvt_pk_bf16(x[8], x[9]); w1.y = cvt_pk_bf16(x[10], x[11]); w1.z = cvt_pk_bf16(x[12], x[13]); w1.w = cvt_pk_bf16(x[14], x[15]);
                u16* wp = rkv + (t0 + (lane >> 2)) * 3072 + 1024 + h * 64 + (lane & 3) * 16;
                *(uint4*)wp = w0; *(uint4*)(wp + 8) = w1; } }
    }
}
__device__ void rwkv_serial(const Params& P, unsigned char* lds_raw) {
    unsigned char* ws = P.ws; const int tid = threadIdx.x, lane = tid & 63, w = __builtin_amdgcn_readfirstlane(tid >> 6), fr = lane & 15, fq = lane >> 4;
    const int hb = blockIdx.x, b = hb >> 4, h = hb & 15;
    const unsigned char* lwb = ws + WS_Z + Z_LW; const unsigned char* ab = ws + WS_Z + Z_A; const u16* rkv = (const u16*)((unsigned char*)P.out + O_RKV);
    const float* gbuf = (const float*)(ws + WS_G); u16* yb = (u16*)(ws + WS_Y);
    u16* Sb = (u16*)lds_raw; u16* UVt = (u16*)(lds_raw + 18432);
    for (int i = tid; i < 64 * 72; i += 512) Sb[i] = 0;
    const int kt = w >> 1, vt0 = (w & 1) * 2, ut = w & 3, kr = kt * 16 + fr, uv = ut * 16 + fr;
    f32x4 st0 = {0.f, 0.f, 0.f, 0.f}, st1 = {0.f, 0.f, 0.f, 0.f};
    typedef unsigned u32x2_t __attribute__((ext_vector_type(2)));
    struct Pre { bf16x8 f0, f1, x, bk; f32x4 g; unsigned vv; };
#define PRE_LOAD(c_, p) do { const size_t t0_ = (size_t)b * SEQ + (size_t)(c_) * CH_; \
        const unsigned char* ls_ = lwb + ((t0_ + fr) * 1024 + h * 64) * 4 + (w < 4 ? 0 : 128) + fq * 16; \
        const void* a0_ = ls_; const void* a1_ = ls_ + 64; \
        const void* a2_ = (w < 4) ? (const void*)(rkv + (t0_ + (uv >> 2)) * 3072 + 1024 + h * 64 + (uv & 3) * 16 + fq * 4) : (const void*)(rkv + (t0_ + fr) * 3072 + h * 64 + fq * 8); \
        const void* a4_ = ab + ((t0_ + (kr >> 2)) * 1024 + h * 64) * 4 + (kr & 3) * 64 + fq * 16; \
        const void* a5_ = gbuf + ((size_t)hb * 256 + (c_)) * 64 + kt * 16 + 4 * fq; \
        const void* a6_ = rkv + (t0_ + (tid >> 5)) * 3072 + 2048 + h * 64 + (tid & 31) * 2; \
        asm volatile("global_load_dwordx4 %0, %1, off" : "=v"(p.f0) : "v"(a0_) : "memory"); \
        asm volatile("global_load_dwordx4 %0, %1, off" : "=v"(p.f1) : "v"(a1_) : "memory"); \
        asm volatile("global_load_dwordx4 %0, %1, off" : "=v"(p.x) : "v"(a2_) : "memory"); \
        asm volatile("global_load_dwordx4 %0, %1, off" : "=v"(p.bk) : "v"(a4_) : "memory"); \
        asm volatile("global_load_dwordx4 %0, %1, off" : "=v"(p.g) : "v"(a5_) : "memory"); \
        asm volatile("global_load_dword %0, %1, off" : "=v"(p.vv) : "v"(a6_) : "memory"); } while (0)
#define PRE_WAIT(p, N) asm volatile("s_waitcnt vmcnt(" #N ")" : "+v"(p.f0), "+v"(p.f1), "+v"(p.x), "+v"(p.bk), "+v"(p.g), "+v"(p.vv) :: "memory")
    auto step = [&](int c, const Pre& cur) {
        const u16* S = Sb + (c & 1) * (64 * 72); u16* Sn = Sb + ((c & 1) ^ 1) * (64 * 72); const size_t t0 = (size_t)b * SEQ + c * CH_;
        { const int tv = tid >> 5, v2 = (tid & 31) * 2; UVt[v2 * 40 + 16 + tv] = (u16)(cur.vv & 0xffffu); UVt[(v2 + 1) * 40 + 16 + tv] = (u16)(cur.vv >> 16); }
        const bf16x8 s0 = *(const bf16x8*)(S + uv * 72 + 8 * fq), s1 = *(const bf16x8*)(S + uv * 72 + 32 + 8 * fq);
        f32x4 acc = {0.f, 0.f, 0.f, 0.f};
        if (w < 4) { const unsigned wx = (unsigned)(unsigned short)cur.x[0] | ((unsigned)(unsigned short)cur.x[1] << 16), wy = (unsigned)(unsigned short)cur.x[2] | ((unsigned)(unsigned short)cur.x[3] << 16);
            acc[0] = bflo(wx); acc[1] = bfhi(wx); acc[2] = bflo(wy); acc[3] = bfhi(wy); }
        acc = __builtin_amdgcn_mfma_f32_16x16x32_bf16(cur.f0, s0, acc, 0, 0, 0); acc = __builtin_amdgcn_mfma_f32_16x16x32_bf16(cur.f1, s1, acc, 0, 0, 0);
        if (w < 4) { uint2 o; o.x = cvt_pk_bf16(acc[0], acc[1]); o.y = cvt_pk_bf16(acc[2], acc[3]); *(uint2*)(UVt + uv * 40 + 4 * fq) = o; }
        LDS_BARRIER();
        if (w >= 4) { const bf16x8 uf = *(const bf16x8*)(UVt + uv * 40 + 8 * fq); acc = __builtin_amdgcn_mfma_f32_16x16x32_bf16(cur.x, uf, acc, 0, 0, 0);
#pragma unroll
            for (int j = 0; j < 4; ++j) yb[(t0 + 4 * fq + j) * RWD + h * 64 + uv] = f2bf(acc[j]); }
        { const bf16x8 u0 = *(const bf16x8*)(UVt + ((vt0 + 0) * 16 + fr) * 40 + 8 * fq), u1 = *(const bf16x8*)(UVt + ((vt0 + 1) * 16 + fr) * 40 + 8 * fq);
          st0 = __builtin_amdgcn_mfma_f32_16x16x32_bf16(cur.bk, u0, st0 * cur.g, 0, 0, 0); st1 = __builtin_amdgcn_mfma_f32_16x16x32_bf16(cur.bk, u1, st1 * cur.g, 0, 0, 0);
          uint2 o; o.x = cvt_pk_bf16(st0[0], st0[1]); o.y = cvt_pk_bf16(st0[2], st0[3]); *(uint2*)(Sn + ((vt0 + 0) * 16 + fr) * 72 + kt * 16 + 4 * fq) = o;
          o.x = cvt_pk_bf16(st1[0], st1[1]); o.y = cvt_pk_bf16(st1[2], st1[3]); *(uint2*)(Sn + ((vt0 + 1) * 16 + fr) * 72 + kt * 16 + 4 * fq) = o; }
        LDS_BARRIER(); };
    Pre q0, q1, q2, q3, q4, q5; PRE_LOAD(0, q0); PRE_LOAD(1, q1); PRE_LOAD(2, q2); PRE_LOAD(3, q3); PRE_LOAD(4, q4); PRE_LOAD(5, q5);
    __syncthreads();
    constexpr int NCH = SEQ / CH_;
    for (int c = 0; c < 252; c += 6) {
        PRE_WAIT(q0, 30); step(c, q0);     PRE_LOAD(min(c + 6, NCH - 1), q0);
        PRE_WAIT(q1, 30); step(c + 1, q1); PRE_LOAD(min(c + 7, NCH - 1), q1);
        PRE_WAIT(q2, 30); step(c + 2, q2); PRE_LOAD(min(c + 8, NCH - 1), q2);
        PRE_WAIT(q3, 30); step(c + 3, q3); PRE_LOAD(min(c + 9, NCH - 1), q3);
        PRE_WAIT(q4, 30); step(c + 4, q4); PRE_LOAD(min(c + 10, NCH - 1), q4);
        PRE_WAIT(q5, 30); step(c + 5, q5); PRE_LOAD(min(c + 11, NCH - 1), q5);
    }
    PRE_WAIT(q0, 0); PRE_WAIT(q1, 0); PRE_WAIT(q2, 0); PRE_WAIT(q3, 0); PRE_WAIT(q4, 0); PRE_WAIT(q5, 0);
    step(252, q0); step(253, q1); step(254, q2); step(255, q3);
#undef PRE_LOAD
#undef PRE_WAIT
}

__device__ void attn_phase(const Params& P) {
    unsigned char* ws = P.ws; const int tid = threadIdx.x, lane = tid & 63, fr = lane & 15, fq = lane >> 4;
    const u16* Qn = (const u16*)((unsigned char*)P.out + O_QN); const u16* Kn = (const u16*)(ws + WS_X + X_KN); const u16* Vt = (const u16*)(ws + WS_X + X_VT);
    u16* oatt = (u16*)(ws + WS_X + X_OATT);
    const int NA = (int)gridDim.x - NSCAN; const int gw = ((int)blockIdx.x - NSCAN) * 8 + (tid >> 6);
    for (int unit = gw; unit < 8192; unit += NA * 8) {
        const int h = unit & 15, st = (unit >> 4) & 255, b = unit >> 12, kh = h >> 2;
        const int s0 = st * 16; const size_t t0 = (size_t)b * SEQ + s0;
        const float slope = exp2f(-0.5f * (float)(h + 1)), sink = P.in[16][h];
        bf16x8 qf[2];
        qf[0] = *(const bf16x8*)(Qn + (t0 + fr) * 1024 + h * 64 + 8 * fq); qf[1] = *(const bf16x8*)(Qn + (t0 + fr) * 1024 + h * 64 + 32 + 8 * fq);
        f32x4 sc[10]; float mx = sink;
#pragma unroll
        for (int kt = 0; kt < 10; ++kt) { const int ks0 = s0 - 144 + 16 * kt; int kp = ks0 + fr; kp = kp < 0 ? 0 : kp;
            const u16* kr = Kn + ((size_t)b * SEQ + kp) * 256 + kh * 64 + 8 * fq;
            const bf16x8 k0 = *(const bf16x8*)kr, k1 = *(const bf16x8*)(kr + 32);
            f32x4 a = {0.f, 0.f, 0.f, 0.f};
            a = __builtin_amdgcn_mfma_f32_16x16x32_bf16(k0, qf[0], a, 0, 0, 0); a = __builtin_amdgcn_mfma_f32_16x16x32_bf16(k1, qf[1], a, 0, 0, 0);
#pragma unroll
            for (int j = 0; j < 4; ++j) { const int kpos = ks0 + 4 * fq + j; const int dist = s0 + fr - kpos; const bool valid = (dist >= 0) && (dist < 128) && (kpos >= 0);
                const float v = valid ? a[j] - slope * (float)dist : -1e30f; a[j] = v; mx = fmaxf(mx, v); }
            sc[kt] = a; }
        mx = fmaxf(mx, __shfl_xor(mx, 16)); mx = fmaxf(mx, __shfl_xor(mx, 32));
        float sum = 0.f;
#pragma unroll
        for (int kt = 0; kt < 10; ++kt)
#pragma unroll
            for (int j = 0; j < 4; ++j) { const float e = __expf(sc[kt][j] - mx); sc[kt][j] = e; sum += e; }
        sum += __shfl_xor(sum, 16); sum += __shfl_xor(sum, 32);
        const float inv = 1.0f / (sum + __expf(sink - mx));
        f32x4 o[4];
#pragma unroll
        for (int dt = 0; dt < 4; ++dt) o[dt] = (f32x4){0.f, 0.f, 0.f, 0.f};
#pragma unroll
        for (int u = 0; u < 5; ++u) {
            union { bf16x8 v; unsigned w[4]; } pf;
            pf.w[0] = cvt_pk_bf16(sc[2 * u][0] * inv, sc[2 * u][1] * inv); pf.w[1] = cvt_pk_bf16(sc[2 * u][2] * inv, sc[2 * u][3] * inv);
            pf.w[2] = cvt_pk_bf16(sc[2 * u + 1][0] * inv, sc[2 * u + 1][1] * inv); pf.w[3] = cvt_pk_bf16(sc[2 * u + 1][2] * inv, sc[2 * u + 1][3] * inv);
            int ka = s0 - 144 + 32 * u + 4 * fq, kb = ka + 16; ka = ka < 0 ? 0 : ka; kb = kb < 0 ? 0 : kb;
#pragma unroll
            for (int dt = 0; dt < 4; ++dt) { const u16* vr = Vt + ((size_t)(b * 4 + kh) * 64 + dt * 16 + fr) * SEQ;
                union { bf16x8 v; uint2 w[2]; } vf; vf.w[0] = *(const uint2*)(vr + ka); vf.w[1] = *(const uint2*)(vr + kb);
                o[dt] = __builtin_amdgcn_mfma_f32_16x16x32_bf16(pf.v, vf.v, o[dt], 0, 0, 0); } }
#pragma unroll
        for (int dt = 0; dt < 4; ++dt)
#pragma unroll
            for (int j = 0; j < 4; ++j) oatt[(t0 + 4 * fq + j) * 1024 + h * 64 + dt * 16 + fr] = f2bf(o[dt][j]);
    }
}

__device__ void phase5(const Params& P) {
    unsigned char* ws = P.ws; const int G = gridDim.x, bid = blockIdx.x, tid = threadIdx.x, lane = tid & 63;
    const u16* rkv = (const u16*)((unsigned char*)P.out + O_RKV); u16* orw = (u16*)((unsigned char*)P.out + O_QN);
    const u16* yraw = (const u16*)(ws + WS_Y); const u16* gp = (const u16*)(ws + WS_Z + Z_G); const float* rkb = (const float*)(ws + WS_RK);
    for (int t = bid * 8 + (tid >> 6); t < MT; t += G * 8) {
        uint2 y2[4], v2[4], g2[4]; float rk[4];
#pragma unroll
        for (int it = 0; it < 4; ++it) { const int hh = it * 4 + (lane >> 4), hc = hh * 64 + (lane & 15) * 4; const size_t o = (size_t)t * RWD + hc;
            y2[it] = *(const uint2*)(yraw + o); g2[it] = *(const uint2*)(gp + o); v2[it] = *(const uint2*)(rkv + (size_t)t * 3072 + 2048 + hc); rk[it] = rkb[(size_t)t * 16 + hh]; }
#pragma unroll
        for (int it = 0; it < 4; ++it) { const int hc = (it * 4 + (lane >> 4)) * 64 + (lane & 15) * 4; const size_t o = (size_t)t * RWD + hc;
            const float4 gw = *(const float4*)(P.in[12] + hc), gb = *(const float4*)(P.in[13] + hc);
            const float yx = bflo(y2[it].x), yy = bfhi(y2[it].x), yz = bflo(y2[it].y), yw = bfhi(y2[it].y);
            const float mu = row16_sum((yx + yy) + (yz + yw)) * (1.0f / 64.0f);
            const float dx = yx - mu, dy = yy - mu, dz = yz - mu, dw = yw - mu;
            const float var = row16_sum((dx * dx + dy * dy) + (dz * dz + dw * dw)) * (1.0f / 64.0f); const float rs = rsqrtf(var + 64e-5f);
            const float o0 = (dx * rs * gw.x + gb.x + rk[it] * bflo(v2[it].x)) * bflo(g2[it].x), o1 = (dy * rs * gw.y + gb.y + rk[it] * bfhi(v2[it].x)) * bfhi(g2[it].x);
            const float o2 = (dz * rs * gw.z + gb.z + rk[it] * bflo(v2[it].y)) * bflo(g2[it].y), o3 = (dw * rs * gw.w + gb.w + rk[it] * bfhi(v2[it].y)) * bfhi(g2[it].y);
            uint2 w; w.x = cvt_pk_bf16(o0, o1); w.y = cvt_pk_bf16(o2, o3); *(uint2*)(orw + o) = w; }
    }
}

__device__ void phase9(const Params& P) {
    unsigned char* ws = P.ws; const u16* uu = (const u16*)(ws + WS_Z); u16* act = (u16*)(ws + WS_ACT);
    const float* cw = P.in[21]; const float* cb = P.in[22];
    const int nth = gridDim.x * 512;
    for (int task = blockIdx.x * 512 + threadIdx.x; task < 1024 * 1408; task += nth) {
        const int j0 = (task % 1408) * 4, t0 = (task / 1408) * 8; const bool first = (t0 & (SEQ - 1)) == 0;
        uint2 ra[10], rg[10];
#pragma unroll
        for (int r = 0; r < 10; ++r) { const int t = (first && r < 2) ? t0 : t0 - 2 + r; ra[r] = *(const uint2*)(uu + (size_t)t * NUP + j0); rg[r] = *(const uint2*)(uu + (size_t)t * NUP + DFF + j0); }
        if (first) { ra[0] = make_uint2(0u, 0u); ra[1] = ra[0]; rg[0] = ra[0]; rg[1] = ra[0]; }
        const float4 wa0 = *(const float4*)(cw + j0), wa1 = *(const float4*)(cw + NUP + j0), wa2 = *(const float4*)(cw + 2 * NUP + j0), ba = *(const float4*)(cb + j0);
        const float4 wg0 = *(const float4*)(cw + DFF + j0), wg1 = *(const float4*)(cw + NUP + DFF + j0), wg2 = *(const float4*)(cw + 2 * NUP + DFF + j0), bg = *(const float4*)(cb + DFF + j0);
#pragma unroll
        for (int i = 0; i < 8; ++i) {
            const float cv0 = bflo(ra[i].x) * wa0.x + bflo(ra[i + 1].x) * wa1.x + bflo(ra[i + 2].x) * wa2.x + ba.x, cv1 = bfhi(ra[i].x) * wa0.y + bfhi(ra[i + 1].x) * wa1.y + bfhi(ra[i + 2].x) * wa2.y + ba.y;
            const float cv2 = bflo(ra[i].y) * wa0.z + bflo(ra[i + 1].y) * wa1.z + bflo(ra[i + 2].y) * wa2.z + ba.z, cv3 = bfhi(ra[i].y) * wa0.w + bfhi(ra[i + 1].y) * wa1.w + bfhi(ra[i + 2].y) * wa2.w + ba.w;
            const float cg0 = bflo(rg[i].x) * wg0.x + bflo(rg[i + 1].x) * wg1.x + bflo(rg[i + 2].x) * wg2.x + bg.x, cg1 = bfhi(rg[i].x) * wg0.y + bfhi(rg[i + 1].x) * wg1.y + bfhi(rg[i + 2].x) * wg2.y + bg.y;
            const float cg2 = bflo(rg[i].y) * wg0.z + bflo(rg[i + 1].y) * wg1.z + bflo(rg[i + 2].y) * wg2.z + bg.z, cg3 = bfhi(rg[i].y) * wg0.w + bfhi(rg[i + 1].y) * wg1.w + bfhi(rg[i + 2].y) * wg2.w + bg.w;
            uint2 w; w.x = cvt_pk_bf16(cg0 * sigmoidf_(cg0) * cv0, cg1 * sigmoidf_(cg1) * cv1); w.y = cvt_pk_bf16(cg2 * sigmoidf_(cg2) * cv2, cg3 * sigmoidf_(cg3) * cv3);
            *(uint2*)(act + (size_t)(t0 + i) * DFF + j0) = w; }
    }
}

#define XB_TMO      128
#define XB_XCNT(j)  (256  + 64 * (j))
#define XB_XSUB(j)  (1280 + 64 * (j))
#define XB_XGEN(j)  (2304 + 64 * (j))
#define XB_TOP      3328
#define XB_TOPGEN   3392
#define XCD_BAR_WORDS 3456
#define XB_SPIN_CAP (1u << 18)

__device__ __forceinline__ unsigned xb_ld(unsigned* p)              { return __hip_atomic_load(p, __ATOMIC_RELAXED, __HIP_MEMORY_SCOPE_AGENT); }
__device__ __forceinline__ unsigned xb_add(unsigned* p, unsigned v) { return __hip_atomic_fetch_add(p, v, __ATOMIC_RELAXED, __HIP_MEMORY_SCOPE_AGENT); }
__device__ __forceinline__ unsigned xb_xcc_id() { return (unsigned)__builtin_amdgcn_s_getreg((3 << 11) | 20) & 0xFu; }
#define XB_SPIN(cond, bar) do { unsigned _sp = 0; while (cond) { __builtin_amdgcn_s_sleep(1); \
    if ((++_sp & 255u) == 0u) { if (xb_ld(&(bar)[XB_TMO])) break; if (_sp > XB_SPIN_CAP) { atomicAdd(&(bar)[XB_TMO], 1u); break; } } } } while (0)

struct XcdBarrier {
    unsigned* bar; unsigned x;
    volatile LAS unsigned* st;
};

__device__ __forceinline__ XcdBarrier xcd_barrier_post(unsigned* bar, volatile LAS unsigned* st) {
    XcdBarrier b; b.bar = bar; b.x = xb_xcc_id(); b.st = st;
    if (threadIdx.x == 0) (void)xb_add(&bar[XB_XCNT(b.x)], 1u);
    return b;
}
__device__ __forceinline__ void xcd_barrier_complete(unsigned* bar, unsigned x, unsigned& nloc, unsigned& nx) {
    const unsigned G = gridDim.x * gridDim.y * gridDim.z;
    unsigned sum, cnt, mine, sp = 0u;
    for (;;) {
        sum = 0u; cnt = 0u; mine = 0u;
#pragma unroll
        for (unsigned j = 0; j < 16; ++j) { const unsigned c = xb_ld(&bar[XB_XCNT(j)]); sum += c; cnt += (c > 0u) ? 1u : 0u; mine = (j == x) ? c : mine; }
        if (sum == G) break;
        __builtin_amdgcn_s_sleep(1);
        if ((++sp & 255u) == 0u) { if (xb_ld(&bar[XB_TMO])) break; if (sp > XB_SPIN_CAP) { atomicAdd(&bar[XB_TMO], 1u); break; } }
    }
    nloc = mine > 0u ? mine : 1u; nx = cnt > 0u ? cnt : 1u;
}

__device__ __forceinline__ void xcd_barrier(const XcdBarrier& b) {
    asm volatile("s_waitcnt vmcnt(0)" ::: "memory");
    __syncthreads();
    if (threadIdx.x == 0) {
        unsigned* bar = b.bar;
        __builtin_amdgcn_s_waitcnt(0);
        unsigned nloc = b.st[0], nx = b.st[1];
        if (nloc == 0u) { xcd_barrier_complete(bar, b.x, nloc, nx); b.st[0] = nloc; b.st[1] = nx; }
        const unsigned old = xb_add(&bar[XB_XSUB(b.x)], 1u);
        const unsigned gen = old / nloc;
        if (old + 1u == (gen + 1u) * nloc) {
            __builtin_amdgcn_fence(__ATOMIC_RELEASE, "agent");
            asm volatile("s_waitcnt vmcnt(0)" ::: "memory");
            const unsigned og = xb_add(&bar[XB_TOP], 1u);
            const unsigned tg = og / nx;
            if (og + 1u == (tg + 1u) * nx) xb_add(&bar[XB_TOPGEN], 1u);
            else XB_SPIN(xb_ld(&bar[XB_TOPGEN]) == tg, bar);
            __builtin_amdgcn_fence(__ATOMIC_ACQUIRE, "agent");
            xb_add(&bar[XB_XGEN(b.x)], 1u);
            asm volatile("s_waitcnt vmcnt(0)" ::: "memory");
        } else {
            XB_SPIN(xb_ld(&bar[XB_XGEN(b.x)]) == gen, bar);
            __builtin_amdgcn_fence(__ATOMIC_ACQUIRE, "agent");
            asm volatile("s_waitcnt vmcnt(0)" ::: "memory");
        }
    }
    __syncthreads();
}

constexpr int NPH = 12;
__global__ void __launch_bounds__(512, 2) mega(Params P) {
    extern __shared__ __attribute__((aligned(16))) unsigned char lds_raw[];
    LAS unsigned char* lds = (LAS unsigned char*)lds_raw;
    unsigned char* ws = P.ws;
    volatile LAS unsigned* xst = (volatile LAS unsigned*)(lds + 131072);
    if (threadIdx.x < 4) xst[threadIdx.x] = 0u;
    __syncthreads();
    XcdBarrier xb = xcd_barrier_post((unsigned*)(ws + WS_BAR), xst);
#define RUN(i) ((i) >= P.ph_lo && (i) < P.ph_hi)
#define SEAM(i) do { if ((i) >= P.ph_lo && (i) + 1 < P.ph_hi) { xcd_barrier(xb); } } while (0)
    if (RUN(0)) phase0(P, (float*)lds_raw);
    SEAM(0);
    if (RUN(1)) { EpiZ E; E.zmain = (u16*)(ws + WS_Z + Z_MAIN); E.zgate = (u16*)(ws + WS_Z + Z_GATE); E.rstd = (const float*)(ws + WS_SMALL);
        run_gemm(lds, (const u16*)(ws + WS_Z + Z_TAIL), (const u16*)(ws + WS_WIN), 6144, 2048, E); }
    SEAM(1);
    if (RUN(2)) phase2(P, (u16*)lds_raw);
    SEAM(2);
    if (RUN(4)) rwkv_prep(P, lds_raw);
    SEAM(4);
    if (RUN(5)) {
        if ((int)blockIdx.x < NSCAN) rwkv_serial(P, lds_raw);
        else { attn_phase(P); __syncthreads();
            { EpiZG E; E.zgate = (u16*)(ws + WS_Z + Z_GATE); E.rstd = (const float*)(ws + WS_SMALL);
              run_gemm_sub(lds, (const u16*)(ws + WS_Z + Z_TAIL), (const u16*)(ws + WS_WIN) + (size_t)6144 * 2048, 3072, 2048, E, (int)gridDim.x - NSCAN, (int)blockIdx.x - NSCAN); } }
        { volatile int* qid = (volatile int*)(lds_raw + 98304); unsigned* head = (unsigned*)(ws + WS_CNT);
          for (;;) { __syncthreads(); if (threadIdx.x == 0) qid[0] = (int)atomicAdd(head, 1u); __syncthreads();
              const int q = qid[0]; if (q >= 1920) break;
              weight_tile(P, q < 1408 ? 1152 + q : 3264 + (q - 1408), (float*)lds_raw); } }
    }
    SEAM(5);
    if (RUN(6)) phase5(P);
    SEAM(6);
    if (RUN(7)) {
        { EpiBranch<0> E; E.mixed = (u16*)(ws + WS_Z); E.zgate = (const u16*)(ws + WS_Z + Z_GATE);
          run_gemm(lds, (const u16*)((unsigned char*)P.out + O_QN), (const u16*)(ws + WS_WBR1), 2048, 1024, E); }
        { EpiBranch<1> E; E.mixed = (u16*)(ws + WS_Z); E.zgate = (const u16*)(ws + WS_Z + Z_GATE);
          run_gemm(lds, (const u16*)(ws + WS_X + X_OATT), (const u16*)(ws + WS_WBR2), 2048, 1024, E); } }
    SEAM(7);
    if (RUN(8)) { EpiOut1 E; E.x = P.in[0]; E.x1 = P.out; E.x1b = (u16*)(ws + WS_X); E.rowss = (float*)(ws + WS_SMALL + 32768);
        run_gemm(lds, (const u16*)(ws + WS_Z), (const u16*)(ws + WS_WOUT), 2048, 2048, E); }
    SEAM(8);
    if (RUN(9)) { EpiUp E; E.uo = (u16*)(ws + WS_Z); E.rowss = (const float*)(ws + WS_SMALL + 32768);
        run_gemm(lds, (const u16*)(ws + WS_X), (const u16*)(ws + WS_WUP), NUP, 2048, E);
        { const int G_ = (int)gridDim.x, nfull = 1408 % G_, bid_ = (int)blockIdx.x;
          if (bid_ >= nfull) { __syncthreads(); for (int id = 2560 + (bid_ - nfull); id < 3264; id += G_ - nfull) weight_tile(P, id, (float*)lds_raw); } } }
    SEAM(9);
    if (RUN(10)) phase9(P);
    SEAM(10);
    if (RUN(11)) { EpiFinal E; E.out = P.out;
        run_gemm(lds, (const u16*)(ws + WS_ACT), (const u16*)(ws + WS_WDOWN), 2048, DFF, E); }
}

constexpr int LDS_BYTES = 131072 + 16;
extern "C" void kernel_launch(void* const* d_in, const int* in_sizes, int n_in, void* d_out, int out_size, void* d_ws, size_t ws_size, hipStream_t stream) {
    static int grid = 0;
    if (grid == 0) {
        if (n_in != 24 || out_size != MT * DM || ws_size < WS_END) { fprintf(stderr, "kernel_launch: unexpected shapes (n_in %d out %d ws %zu need %zu)\n", n_in, out_size, ws_size, (size_t)WS_END); grid = -1; return; }
        int dev = 0, cus = 0, per_cu = 0;
        hipGetDevice(&dev); hipDeviceGetAttribute(&cus, hipDeviceAttributeMultiprocessorCount, dev);
        if (hipFuncSetAttribute((const void*)mega, hipFuncAttributeMaxDynamicSharedMemorySize, LDS_BYTES) != hipSuccess) { fprintf(stderr, "kernel_launch: hipFuncSetAttribute failed\n"); grid = -1; return; }
        if (hipOccupancyMaxActiveBlocksPerMultiprocessor(&per_cu, (const void*)mega, 512, LDS_BYTES) != hipSuccess || per_cu < 1) { fprintf(stderr, "kernel_launch: occupancy query failed (%d)\n", per_cu); grid = -1; return; }
        grid = cus * per_cu; if (grid > 256) grid = 256;
        if (grid < 2 * NSCAN) { fprintf(stderr, "kernel_launch: grid %d too small\n", grid); grid = -1; return; }
    }
    if (grid < 0) return;
    Params p{};
    for (int i = 0; i < 24; ++i) p.in[i] = (const float*)d_in[i];
    p.out = (float*)d_out; p.ws = (unsigned char*)d_ws;
    if (hipMemsetAsync((unsigned char*)d_ws + WS_BAR, 0, 16384, stream) != hipSuccess) { fprintf(stderr, "kernel_launch: hipMemsetAsync of the barrier words failed\n"); return; }
    p.ph_lo = 0; p.ph_hi = NPH;
    { void* args[] = {&p}; hipError_t e = hipLaunchCooperativeKernel((const void*)mega, dim3(grid), dim3(512), args, LDS_BYTES, stream);
      if (e != hipSuccess) fprintf(stderr, "cooperative launch failed: %s (grid %d)\n", hipGetErrorString(e), grid); }

}
```

```cpp
#include <hip/hip_runtime.h>
#include <hip/hip_cooperative_groups.h>
#include <cstdio>
#include <cstdint>
namespace cg = cooperative_groups;
namespace pg8 {
#define PG8_LAS __attribute__((address_space(3)))
typedef unsigned short bf16_t;
typedef short bf16x8 __attribute__((ext_vector_type(8)));
typedef float f32x4 __attribute__((ext_vector_type(4)));
typedef unsigned u32x4 __attribute__((ext_vector_type(4)));
constexpr int BM = 256, BK = 64, HALF = 128, HTB = HALF * BK * 2  , STAGE_BYTES = 8 * HTB, NXCD = 8, WGM = 8;

__host__ __device__ __forceinline__ int lds_byte(int r, int c) { const int st = (r >> 4) * 2 + (c >> 5), rr = r & 15, cc = c & 31, ob = rr * 64 + cc * 2; return st * 1024 + (ob ^ (((ob >> 9) & 1) << 5)); }
__host__ __device__ __forceinline__ void stage_rc(int b, int& R, int& C) { const int st = b / 1024, sb = b % 1024, swz = sb ^ (((sb >> 9) & 1) << 5); R = (st >> 1) * 16 + swz / 64; C = (st & 1) * 32 + (swz % 64) / 2; }
__host__ __device__ __forceinline__ int perm32(int rho) { const int n = rho >> 4, i = rho & 15; return 8 * (i >> 2) + 4 * n + (i & 3); }

struct Unit { int pm, pn; };
struct Gemm { const bf16_t* A; const bf16_t* Bt; int M, N, K; };

struct StaticOrder {
    int nM, nN, nwg, G, c;
    __host__ __device__ void init(int M, int N, int G_, int c_) { nM = M / BM; nN = N / BM; nwg = nM * nN; G = G_; c = c_; }
    __host__ __device__ bool next(int i, Unit& u) const {
        const long L = (long)i * G + c; if (L >= nwg) return false;
        int wgid = (int)L; { const int q = nwg / NXCD, r = nwg % NXCD, xcd = wgid % NXCD, off = wgid / NXCD; wgid = (xcd < r ? xcd * (q + 1) : r * (q + 1) + (xcd - r) * q) + off; }
        const int nig = WGM * nN, gid = wgid / nig, fm = gid * WGM, gsz = (nM - fm) < WGM ? (nM - fm) : WGM;
        u.pm = fm + ((wgid % nig) % gsz); u.pn = (wgid % nig) / gsz; return true;
    }
    __device__ __forceinline__ void a_ready(const Unit&) const {}
    __device__ __forceinline__ void done(const Unit&) const {}
};
typedef __bf16 bf16v2_t __attribute__((ext_vector_type(2))); typedef float f32v2_t __attribute__((ext_vector_type(2)));
__device__ __forceinline__ unsigned cvt_pk_bf16(float lo, float hi) { const f32v2_t x = {lo, hi}; const bf16v2_t r = __builtin_convertvector(x, bf16v2_t); return __builtin_bit_cast(unsigned, r); }
template <class Epi, class Sched, bool ALIGN_EPI = false, bool SP2 = false>
__device__ __forceinline__ void gemm_phase(PG8_LAS unsigned char* lds, const Gemm g, const Sched& S, const Epi& E) {
    const int tid = threadIdx.x, wid = __builtin_amdgcn_readfirstlane(tid >> 6), lane = tid & 63, wr = wid >> 2, wc = wid & 3, fr = lane & 15, fq = lane >> 4;
    const int K = g.K, nt = K / BK;
    unsigned voffA[2], voffB[2];
#pragma unroll
    for (int i = 0; i < 2; ++i) { int R, C; stage_rc(tid * 16 + i * 8192, R, C); const int Rb = Epi::PERM ? ((R & ~31) + perm32(R & 31)) : R;
        voffA[i] = (unsigned)(R * K + C) * 2u; voffB[i] = (unsigned)(Rb * K + C) * 2u; }
    const size_t kstep = (size_t)(BK * 2);
    const size_t hstep = (size_t)HALF * K * 2;
    const size_t tstep = 2 * hstep;
    const unsigned ldsw = (unsigned)wid * 1024u;
    const int aoff = lds_byte(wr * 64 + fr, fq * 8), boff = lds_byte(wc * 32 + fr, fq * 8);
#define PG8_SA(b, h) (((b) * 2 + (h)) * HTB)
#define PG8_SB(b, h) ((4 + (b) * 2 + (h)) * HTB)
#define PG8_STAGE(bufoff, gbase, voff) do { _Pragma("unroll") for (int _i = 0; _i < 2; ++_i) \
        __builtin_amdgcn_global_load_lds((const unsigned*)((const char*)(gbase) + (voff)[_i]), (PG8_LAS unsigned*)(lds + (bufoff) + ldsw + _i * 8192), 16, 0, 0); } while (0)
#define PG8_LDA(dst, b, h) do { _Pragma("unroll") for (int m = 0; m < 4; ++m) _Pragma("unroll") for (int k = 0; k < 2; ++k) dst[m][k] = *(const PG8_LAS bf16x8*)(lds + PG8_SA(b, h) + aoff + m * 2048 + k * 1024); } while (0)
#define PG8_LDB(dst, b, h) do { _Pragma("unroll") for (int n = 0; n < 2; ++n) _Pragma("unroll") for (int k = 0; k < 2; ++k) dst[n][k] = *(const PG8_LAS bf16x8*)(lds + PG8_SB(b, h) + boff + n * 2048 + k * 1024); } while (0)
#define PG8_MMA(ai, bj, At, Bt) do { __builtin_amdgcn_s_setprio(1); _Pragma("unroll") for (int m = 0; m < 4; ++m) _Pragma("unroll") for (int n = 0; n < 2; ++n) _Pragma("unroll") for (int k = 0; k < 2; ++k) \
        acc[ai][bj][m][n] = __builtin_amdgcn_mfma_f32_16x16x32_bf16(Bt[n][k], At[m][k], acc[ai][bj][m][n], 0, 0, 0); __builtin_amdgcn_s_setprio(0); } while (0)
#define PG8_WAIT_V(n) asm volatile("s_waitcnt vmcnt(" #n ")" ::: "memory")
#define PG8_WAIT_L(n) asm volatile("s_waitcnt lgkmcnt(" #n ")" ::: "memory")
#define PG8_BAR __builtin_amdgcn_s_barrier()
#define PG8_SCHED __builtin_amdgcn_sched_barrier(0)
    Unit cur, nxt; int ui = 0;
    if (!S.next(0, cur)) return;
    f32x4 acc[2][2][4][2];
#pragma unroll
    for (int a = 0; a < 2; ++a)
#pragma unroll
        for (int b = 0; b < 2; ++b)
#pragma unroll
            for (int m = 0; m < 4; ++m)
#pragma unroll
                for (int n = 0; n < 2; ++n) acc[a][b][m][n] = (f32x4){0.f, 0.f, 0.f, 0.f};
    bf16x8 At[4][2], B0[2][2], B1[2][2];
    const char* cA = (const char*)g.A + (size_t)cur.pm * tstep; const char* cB = (const char*)g.Bt + (size_t)cur.pn * tstep;
    S.a_ready(cur);
    if constexpr (SP2) {
        PG8_STAGE(PG8_SB(0, 0), cB, voffB); PG8_STAGE(PG8_SB(0, 1), cB + hstep, voffB); PG8_STAGE(PG8_SA(0, 0), cA, voffA); PG8_STAGE(PG8_SA(0, 1), cA + hstep, voffA);
        if (wr == 1) PG8_BAR;
        PG8_WAIT_V(2); PG8_BAR;
        PG8_STAGE(PG8_SB(1, 0), cB + kstep, voffB); PG8_STAGE(PG8_SA(1, 0), cA + kstep, voffA); PG8_STAGE(PG8_SB(1, 1), cB + hstep + kstep, voffB);
        PG8_WAIT_V(6); PG8_BAR;
    } else {
        PG8_STAGE(PG8_SB(0, 0), cB, voffB); PG8_STAGE(PG8_SA(0, 0), cA, voffA); PG8_STAGE(PG8_SB(0, 1), cB + hstep, voffB); PG8_STAGE(PG8_SA(0, 1), cA + hstep, voffA);
        if (wr == 1) PG8_BAR;
        PG8_WAIT_V(4); PG8_BAR;
        PG8_STAGE(PG8_SB(1, 0), cB + kstep, voffB); PG8_STAGE(PG8_SA(1, 0), cA + kstep, voffA); PG8_STAGE(PG8_SB(1, 1), cB + hstep + kstep, voffB);
        PG8_WAIT_V(6); PG8_BAR;
    }
    for (;;) {
        const bool has_next = S.next(ui + 1, nxt);
        const char* nA = has_next ? (const char*)g.A + (size_t)nxt.pm * tstep : cA; const char* nB = has_next ? (const char*)g.Bt + (size_t)nxt.pn * tstep : cB;
        for (int t = 0; t < nt; t += 2) {
            const bool last = (t == nt - 2);
            const char* a1 = cA + (size_t)(t + 1) * kstep;
            const char* a2 = last ? nA : cA + (size_t)(t + 2) * kstep; const char* b2 = last ? nB : cB + (size_t)(t + 2) * kstep;
            const char* a3 = a2 + kstep; const char* b3 = b2 + kstep;
            if (last && has_next) S.a_ready(nxt);
            if constexpr (SP2) {
            PG8_LDB(B0, 0, 0); PG8_LDB(B1, 0, 1); PG8_SCHED; PG8_LDA(At, 0, 0); PG8_STAGE(PG8_SA(1, 1), a1 + hstep, voffA);
            PG8_WAIT_V(8); PG8_WAIT_L(0); PG8_BAR; PG8_MMA(0, 0, At, B0); PG8_MMA(0, 1, At, B1); PG8_BAR; PG8_SCHED;
            PG8_LDA(At, 0, 1); PG8_STAGE(PG8_SB(0, 0), b2, voffB); PG8_STAGE(PG8_SB(0, 1), b2 + hstep, voffB); PG8_STAGE(PG8_SA(0, 0), a2, voffA);
            PG8_WAIT_V(8); PG8_WAIT_L(0); PG8_BAR; PG8_MMA(1, 0, At, B0); PG8_MMA(1, 1, At, B1); PG8_BAR; PG8_SCHED;
            PG8_LDB(B0, 1, 0); PG8_LDB(B1, 1, 1); PG8_SCHED; PG8_LDA(At, 1, 0); PG8_STAGE(PG8_SA(0, 1), a2 + hstep, voffA);
            PG8_WAIT_V(8); PG8_WAIT_L(0); PG8_BAR; PG8_MMA(0, 0, At, B0); PG8_MMA(0, 1, At, B1); PG8_BAR; PG8_SCHED;
            PG8_LDA(At, 1, 1); PG8_STAGE(PG8_SB(1, 0), b3, voffB); PG8_STAGE(PG8_SB(1, 1), b3 + hstep, voffB); PG8_STAGE(PG8_SA(1, 0), a3, voffA);
            PG8_WAIT_V(8); PG8_WAIT_L(0); PG8_BAR; PG8_MMA(1, 0, At, B0); PG8_MMA(1, 1, At, B1); PG8_BAR; PG8_SCHED;
            } else {
            PG8_LDB(B0, 0, 0); PG8_SCHED; PG8_LDA(At, 0, 0); PG8_STAGE(PG8_SA(1, 1), a1 + hstep, voffA);
            PG8_WAIT_L(8); PG8_BAR; PG8_WAIT_L(0); PG8_MMA(0, 0, At, B0); PG8_BAR; PG8_SCHED;
            PG8_LDB(B1, 0, 1); PG8_STAGE(PG8_SB(0, 0), b2, voffB);
            PG8_BAR; PG8_WAIT_L(0); PG8_MMA(0, 1, At, B1); PG8_BAR;
            PG8_LDA(At, 0, 1); PG8_STAGE(PG8_SA(0, 0), a2, voffA);
            PG8_BAR; PG8_WAIT_L(0); PG8_MMA(1, 0, At, B0); PG8_BAR; PG8_SCHED;
            PG8_STAGE(PG8_SB(0, 1), b2 + hstep, voffB);
            PG8_WAIT_V(6); PG8_BAR; PG8_MMA(1, 1, At, B1); PG8_BAR;
            PG8_LDB(B0, 1, 0); PG8_SCHED; PG8_LDA(At, 1, 0); PG8_STAGE(PG8_SA(0, 1), a2 + hstep, voffA);
            PG8_WAIT_L(8); PG8_BAR; PG8_WAIT_L(0); PG8_MMA(0, 0, At, B0); PG8_BAR; PG8_SCHED;
            PG8_LDB(B1, 1, 1); PG8_STAGE(PG8_SB(1, 0), b3, voffB);
            PG8_BAR; PG8_WAIT_L(0); PG8_MMA(0, 1, At, B1); PG8_BAR;
            PG8_LDA(At, 1, 1); PG8_STAGE(PG8_SA(1, 0), a3, voffA);
            PG8_BAR; PG8_WAIT_L(0); PG8_MMA(1, 0, At, B0); PG8_BAR; PG8_SCHED;
            PG8_STAGE(PG8_SB(1, 1), b3 + hstep, voffB);
            PG8_WAIT_V(6); PG8_BAR; PG8_MMA(1, 1, At, B1); PG8_BAR;
            }
        }
        if constexpr (ALIGN_EPI) { if (wr == 0) PG8_BAR; }
        if constexpr (!Epi::AFTER_DRAIN) { E(acc, cur, wr, wc, fr, fq); S.done(cur); }
        if (!has_next) break;
#pragma unroll
        for (int a = 0; a < 2; ++a)
#pragma unroll
            for (int b = 0; b < 2; ++b)
#pragma unroll
                for (int m = 0; m < 4; ++m)
#pragma unroll
                    for (int n = 0; n < 2; ++n) acc[a][b][m][n] = (f32x4){0.f, 0.f, 0.f, 0.f};
        cur = nxt; cA = nA; cB = nB; ++ui;
        if constexpr (ALIGN_EPI) { if (wr == 1) PG8_BAR; }
    }
    PG8_WAIT_V(0);
    if constexpr (!ALIGN_EPI) { if (wr == 0) PG8_BAR; }
    PG8_BAR;
    if constexpr (Epi::AFTER_DRAIN) { E.fused(acc, cur, wr, wc, fr, fq, lds, wid, lane); S.done(cur); }
#undef PG8_SA
#undef PG8_SB
#undef PG8_STAGE
#undef PG8_LDA
#undef PG8_LDB
#undef PG8_MMA
#undef PG8_WAIT_V
#undef PG8_WAIT_L
#undef PG8_BAR
#undef PG8_SCHED
}
}

using pg8::f32x4; using pg8::bf16x8; using pg8::Unit; using pg8::cvt_pk_bf16;
typedef unsigned short u16;
#define LAS __attribute__((address_space(3)))

constexpr int MT = 8192, DM = 2048, SEQ = 4096, CH_ = 16;
constexpr int NZ = 9216, ZM = 5120, ZG = 4096, DFF = 5632, NUP = 11264, RWD = 1024;
constexpr size_t WS_WDOWN = 0;
constexpr size_t WS_WIN   = WS_WDOWN + (size_t)2048 * 5632 * 2;
constexpr size_t WS_WUP   = WS_WIN + (size_t)9216 * 2048 * 2;
constexpr size_t WS_WBR1  = WS_WUP + (size_t)11264 * 2048 * 2;
constexpr size_t WS_WBR2  = WS_WBR1 + (size_t)2048 * 1024 * 2;
constexpr size_t WS_WOUT  = WS_WBR2 + (size_t)2048 * 1024 * 2;
constexpr size_t WS_WLORA = WS_WOUT + (size_t)2048 * 2048 * 2;
constexpr size_t WS_Z     = WS_WLORA + (size_t)3072 * 512 * 2;
constexpr size_t Z_BYTES  = (size_t)MT * NUP * 2;
constexpr size_t WS_X     = WS_Z + Z_BYTES;
constexpr size_t WS_SMALL = WS_X + (size_t)MT * DM * 2;
constexpr size_t WS_Y     = WS_SMALL + 32768 + (size_t)MT * 32 * 4;
constexpr size_t WS_G     = WS_Y + (size_t)MT * 1024 * 2;
constexpr size_t WS_RK    = WS_G + (size_t)8192 * 64 * 4;
constexpr size_t WS_CNT   = WS_RK + (size_t)MT * 16 * 4;
constexpr size_t WS_BAR   = WS_CNT + 256;
constexpr size_t WS_END   = WS_BAR + 16384;
constexpr size_t WS_ACT   = WS_WIN;
static_assert(WS_Z - WS_WIN >= (size_t)MT * DFF * 2, "act overlay");
constexpr size_t Z_MAIN = 0, Z_GATE = (size_t)MT * ZM * 2, Z_TAIL = (size_t)MT * (ZM + ZG) * 2;
constexpr size_t Z_LW = 0, Z_A = (size_t)MT * RWD * 4, Z_G = 2 * (size_t)MT * RWD * 4;
constexpr size_t X_AP = 0, X_KN = (size_t)MT * 512 * 2, X_VT = X_KN + (size_t)MT * 256 * 2, X_OATT = X_VT + (size_t)MT * 256 * 2;
constexpr size_t O_RKV = 0, O_QN = (size_t)MT * 3072 * 2;

struct Params { const float* in[24]; float* out; unsigned char* ws; int ph_lo, ph_hi; };

__device__ __forceinline__ float bf2f(unsigned short b) { return __uint_as_float(((unsigned)b) << 16); }
__device__ __forceinline__ float bflo(unsigned u) { return __uint_as_float(u << 16); }
__device__ __forceinline__ float bfhi(unsigned u) { return __uint_as_float(u & 0xffff0000u); }
__device__ __forceinline__ u16 f2bf(float f) { return (u16)(cvt_pk_bf16(f, f) & 0xffffu); }
__device__ __forceinline__ float wave_sum(float v) {
#pragma unroll
    for (int o = 32; o; o >>= 1) v += __shfl_xor(v, o);
    return v; }
__device__ __forceinline__ float sigmoidf_(float x) { return 1.0f / (1.0f + __expf(-x)); }
template <int CTRL> __device__ __forceinline__ float dppf(float x) { return __int_as_float(__builtin_amdgcn_update_dpp(0, __float_as_int(x), CTRL, 0xF, 0xF, true)); }
__device__ __forceinline__ float row16_sum(float x) { x += dppf<0xB1>(x); x += dppf<0x4E>(x); x += dppf<0x141>(x); x += dppf<0x140>(x); return x; }

#define EPI_ROWS _Pragma("unroll") for (int ai = 0; ai < 2; ++ai) _Pragma("unroll") for (int m = 0; m < 4; ++m)
#define EPI_COLS _Pragma("unroll") for (int bj = 0; bj < 2; ++bj) _Pragma("unroll") for (int n = 0; n < 2; ++n)
struct EpiZ {
    static constexpr bool PERM = true, AFTER_DRAIN = false;
    u16* zmain; u16* zgate; const float* rstd;
    __device__ __forceinline__ void operator()(const f32x4 (&acc)[2][2][4][2], const Unit& u, int wr, int wc, int fr, int fq) const {
        u16* base; int ld, c0;
        if (u.pn < 20) { base = zmain; ld = ZM; c0 = u.pn * 256; } else { base = zgate; ld = ZG; c0 = (u.pn - 20) * 256; }
        const int row0 = u.pm * 256 + wr * 64 + fr; c0 += wc * 32 + 8 * fq;
        float rsv[2][4];
        EPI_ROWS rsv[ai][m] = rstd[row0 + ai * 128 + m * 16];
        EPI_ROWS { const int row = row0 + ai * 128 + m * 16; const float rs = rsv[ai][m]; u16* rp = base + (size_t)row * ld + c0;
#pragma unroll
            for (int bj = 0; bj < 2; ++bj) { const f32x4 v0 = acc[ai][bj][m][0] * rs, v1 = acc[ai][bj][m][1] * rs;
                uint4 w; w.x = cvt_pk_bf16(v0[0], v0[1]); w.y = cvt_pk_bf16(v0[2], v0[3]); w.z = cvt_pk_bf16(v1[0], v1[1]); w.w = cvt_pk_bf16(v1[2], v1[3]); *(uint4*)(rp + bj * 128) = w; } }
    }
};
struct EpiLora {
    static constexpr bool PERM = true, AFTER_DRAIN = false;
    float* lw; float* av; u16* g; const float* w0; const float* a0;
    __device__ __forceinline__ void operator()(const f32x4 (&acc)[2][2][4][2], const Unit& u, int wr, int wc, int fr, int fq) const {
        const int row0 = u.pm * 256 + wr * 64 + fr; const int kind = u.pn >> 2; const int c0 = (u.pn & 3) * 256 + wc * 32 + 8 * fq;
        if (kind == 0) {
            EPI_ROWS { const int row = row0 + ai * 128 + m * 16;
                EPI_COLS { const int col = c0 + bj * 128 + n * 4; const f32x4 v = acc[ai][bj][m][n]; const f32x4 b = *(const f32x4*)(w0 + col); f32x4 o;
#pragma unroll
                    for (int j = 0; j < 4; ++j) { const float y = -(b[j] + v[j]); const float sp = fmaxf(y, 0.f) + __logf(1.0f + __expf(-fabsf(y))); o[j] = -__expf(-sp - 0.5f); }
                    *(f32x4*)(lw + (size_t)row * RWD + col) = o; } }
        } else if (kind == 1) {
            EPI_ROWS { const int row = row0 + ai * 128 + m * 16;
                EPI_COLS { const int col = c0 + bj * 128 + n * 4; const f32x4 v = acc[ai][bj][m][n]; const f32x4 b = *(const f32x4*)(a0 + col); f32x4 o;
#pragma unroll
                    for (int j = 0; j < 4; ++j) o[j] = sigmoidf_(b[j] + v[j]);
                    *(f32x4*)(av + (size_t)row * RWD + col) = o; } }
        } else {
            EPI_ROWS { const int row = row0 + ai * 128 + m * 16;
#pragma unroll
                for (int bj = 0; bj < 2; ++bj) { const f32x4 v0 = acc[ai][bj][m][0], v1 = acc[ai][bj][m][1];
                    uint4 w; w.x = cvt_pk_bf16(v0[0], v0[1]); w.y = cvt_pk_bf16(v0[2], v0[3]); w.z = cvt_pk_bf16(v1[0], v1[1]); w.w = cvt_pk_bf16(v1[2], v1[3]); *(uint4*)(g + (size_t)row * RWD + c0 + bj * 128) = w; } }
        }
    }
};
template <int PASS> struct EpiBranch {
    static constexpr bool PERM = true, AFTER_DRAIN = false;
    u16* mixed; const u16* zgate;
    __device__ __forceinline__ void operator()(const f32x4 (&acc)[2][2][4][2], const Unit& u, int wr, int wc, int fr, int fq) const {
        const int row0 = u.pm * 256 + wr * 64 + fr; const int c0 = u.pn * 256 + wc * 32 + 8 * fq;
        uint4 ga[2], gn[2], ma[2], mn[2];
#pragma unroll
        for (int bj = 0; bj < 2; ++bj) { ga[bj] = *(const uint4*)(zgate + (size_t)row0 * ZG + PASS * 2048 + c0 + bj * 128); ma[bj] = make_uint4(0u, 0u, 0u, 0u); if (PASS == 1) ma[bj] = *(const uint4*)(mixed + (size_t)row0 * DM + c0 + bj * 128); gn[bj] = ga[bj]; mn[bj] = ma[bj]; }
#pragma unroll
        for (int r = 0; r < 8; ++r) { const int ai = r >> 2, m = r & 3; const int row = row0 + ai * 128 + m * 16;
            if (r < 7) { const int rown = row0 + ((r + 1) >> 2) * 128 + ((r + 1) & 3) * 16;
#pragma unroll
                for (int bj = 0; bj < 2; ++bj) { gn[bj] = *(const uint4*)(zgate + (size_t)rown * ZG + PASS * 2048 + c0 + bj * 128); if (PASS == 1) mn[bj] = *(const uint4*)(mixed + (size_t)rown * DM + c0 + bj * 128); } }
#pragma unroll
            for (int bj = 0; bj < 2; ++bj) { const int col = c0 + bj * 128; const f32x4 v0 = acc[ai][bj][m][0], v1 = acc[ai][bj][m][1]; const uint4 gz = ga[bj];
                float o[8]; o[0] = sigmoidf_(bflo(gz.x)) * v0[0]; o[1] = sigmoidf_(bfhi(gz.x)) * v0[1]; o[2] = sigmoidf_(bflo(gz.y)) * v0[2]; o[3] = sigmoidf_(bfhi(gz.y)) * v0[3];
                o[4] = sigmoidf_(bflo(gz.z)) * v1[0]; o[5] = sigmoidf_(bfhi(gz.z)) * v1[1]; o[6] = sigmoidf_(bflo(gz.w)) * v1[2]; o[7] = sigmoidf_(bfhi(gz.w)) * v1[3];
                if (PASS == 1) { const uint4 pm = ma[bj]; o[0] += bflo(pm.x); o[1] += bfhi(pm.x); o[2] += bflo(pm.y); o[3] += bfhi(pm.y); o[4] += bflo(pm.z); o[5] += bfhi(pm.z); o[6] += bflo(pm.w); o[7] += bfhi(pm.w); }
                uint4 w; w.x = cvt_pk_bf16(o[0], o[1]); w.y = cvt_pk_bf16(o[2], o[3]); w.z = cvt_pk_bf16(o[4], o[5]); w.w = cvt_pk_bf16(o[6], o[7]); *(uint4*)(mixed + (size_t)row * DM + col) = w; }
#pragma unroll
            for (int bj = 0; bj < 2; ++bj) { ga[bj] = gn[bj]; ma[bj] = mn[bj]; } }
    }
};
struct EpiOut1 {
    static constexpr bool PERM = true, AFTER_DRAIN = false;
    const float* x; float* x1; u16* x1b; float* rowss;
    __device__ __forceinline__ void operator()(const f32x4 (&acc)[2][2][4][2], const Unit& u, int wr, int wc, int fr, int fq) const {
        const int row0 = u.pm * 256 + wr * 64 + fr; const int c0 = u.pn * 256 + wc * 32 + 8 * fq;
        f32x4 xa[2][2], xn[2][2];
#pragma unroll
        for (int bj = 0; bj < 2; ++bj) { const size_t o = (size_t)row0 * DM + c0 + bj * 128; xa[bj][0] = *(const f32x4*)(x + o); xa[bj][1] = *(const f32x4*)(x + o + 4); }
#pragma unroll
        for (int r = 0; r < 8; ++r) { const int ai = r >> 2, m = r & 3; const int row = row0 + ai * 128 + m * 16; float ss = 0.f;
            if (r < 7) { const int rown = row0 + ((r + 1) >> 2) * 128 + ((r + 1) & 3) * 16;
#pragma unroll
                for (int bj = 0; bj < 2; ++bj) { const size_t o = (size_t)rown * DM + c0 + bj * 128; xn[bj][0] = *(const f32x4*)(x + o); xn[bj][1] = *(const f32x4*)(x + o + 4); } }
#pragma unroll
            for (int bj = 0; bj < 2; ++bj) { const size_t o = (size_t)row * DM + c0 + bj * 128;
                const f32x4 v0 = acc[ai][bj][m][0] + xa[bj][0], v1 = acc[ai][bj][m][1] + xa[bj][1];
                *(f32x4*)(x1 + o) = v0; *(f32x4*)(x1 + o + 4) = v1;
                ss += (v0[0] * v0[0] + v0[1] * v0[1] + v0[2] * v0[2] + v0[3] * v0[3]) + (v1[0] * v1[0] + v1[1] * v1[1] + v1[2] * v1[2] + v1[3] * v1[3]);
                uint4 w; w.x = cvt_pk_bf16(v0[0], v0[1]); w.y = cvt_pk_bf16(v0[2], v0[3]); w.z = cvt_pk_bf16(v1[0], v1[1]); w.w = cvt_pk_bf16(v1[2], v1[3]); *(uint4*)(x1b + o) = w; }
            ss += __shfl_xor(ss, 16); ss += __shfl_xor(ss, 32);
            if (fq == 0) rowss[(size_t)row * 32 + u.pn * 4 + wc] = ss;
#pragma unroll
            for (int bj = 0; bj < 2; ++bj) { xa[bj][0] = xn[bj][0]; xa[bj][1] = xn[bj][1]; } }
    }
};
struct EpiUp {
    static constexpr bool PERM = true, AFTER_DRAIN = false;
    u16* uo; const float* rowss;
    __device__ __forceinline__ void operator()(const f32x4 (&acc)[2][2][4][2], const Unit& u, int wr, int wc, int fr, int fq) const {
        const int row0 = u.pm * 256 + wr * 64 + fr; const int c0 = u.pn * 256 + wc * 32 + 8 * fq;
        float rsv[2][4];
        EPI_ROWS { const int row = row0 + ai * 128 + m * 16;
            const f32x4 p0 = *(const f32x4*)(rowss + (size_t)row * 32 + fq * 8), p1 = *(const f32x4*)(rowss + (size_t)row * 32 + fq * 8 + 4);
            float ss = ((p0[0] + p0[1]) + (p0[2] + p0[3])) + ((p1[0] + p1[1]) + (p1[2] + p1[3]));
            ss += __shfl_xor(ss, 16); ss += __shfl_xor(ss, 32);
            rsv[ai][m] = rsqrtf(ss * (1.0f / 2048.0f) + 1e-6f); }
        EPI_ROWS { const int row = row0 + ai * 128 + m * 16; const float rs = rsv[ai][m]; u16* rp = uo + (size_t)row * NUP + c0;
#pragma unroll
            for (int bj = 0; bj < 2; ++bj) { const f32x4 v0 = acc[ai][bj][m][0] * rs, v1 = acc[ai][bj][m][1] * rs;
                uint4 w; w.x = cvt_pk_bf16(v0[0], v0[1]); w.y = cvt_pk_bf16(v0[2], v0[3]); w.z = cvt_pk_bf16(v1[0], v1[1]); w.w = cvt_pk_bf16(v1[2], v1[3]); *(uint4*)(rp + bj * 128) = w; } }
    }
};
struct EpiFinal {
    static constexpr bool PERM = true, AFTER_DRAIN = false;
    float* out;
    __device__ __forceinline__ void operator()(const f32x4 (&acc)[2][2][4][2], const Unit& u, int wr, int wc, int fr, int fq) const {
        const int row0 = u.pm * 256 + wr * 64 + fr; const int c0 = u.pn * 256 + wc * 32 + 8 * fq;
        f32x4 xa[2][2], xn[2][2];
#pragma unroll
        for (int bj = 0; bj < 2; ++bj) { const float* op = out + (size_t)row0 * DM + c0 + bj * 128; xa[bj][0] = *(const f32x4*)op; xa[bj][1] = *(const f32x4*)(op + 4); }
#pragma unroll
        for (int r = 0; r < 8; ++r) { const int ai = r >> 2, m = r & 3; const int row = row0 + ai * 128 + m * 16;
            if (r < 7) { const int rown = row0 + ((r + 1) >> 2) * 128 + ((r + 1) & 3) * 16;
#pragma unroll
                for (int bj = 0; bj < 2; ++bj) { const float* op = out + (size_t)rown * DM + c0 + bj * 128; xn[bj][0] = *(const f32x4*)op; xn[bj][1] = *(const f32x4*)(op + 4); } }
#pragma unroll
            for (int bj = 0; bj < 2; ++bj) { float* op = out + (size_t)row * DM + c0 + bj * 128; *(f32x4*)op = xa[bj][0] + acc[ai][bj][m][0]; *(f32x4*)(op + 4) = xa[bj][1] + acc[ai][bj][m][1]; }
#pragma unroll
            for (int bj = 0; bj < 2; ++bj) { xa[bj][0] = xn[bj][0]; xa[bj][1] = xn[bj][1]; } }
    }
};

template <class Epi> __device__ __forceinline__ void run_gemm(LAS unsigned char* lds, const u16* A, const u16* Bt, int N, int K, const Epi& E) {
    pg8::Gemm g; g.A = A; g.Bt = Bt; g.M = MT; g.N = N; g.K = K;
    pg8::StaticOrder S; S.init(MT, N, (int)gridDim.x, (int)blockIdx.x);
    pg8::gemm_phase<Epi, pg8::StaticOrder, true, true>(lds, g, S, E);
}

template <class Epi> __device__ __forceinline__ void run_gemm_sub(LAS unsigned char* lds, const u16* A, const u16* Bt, int N, int K, const Epi& E, int G, int c) {
    pg8::Gemm g; g.A = A; g.Bt = Bt; g.M = MT; g.N = N; g.K = K;
    pg8::StaticOrder S; S.init(MT, N, G, c);
    pg8::gemm_phase<Epi, pg8::StaticOrder, true, true>(lds, g, S, E);
}
struct EpiZG {
    static constexpr bool PERM = true, AFTER_DRAIN = false;
    u16* zgate; const float* rstd;
    __device__ __forceinline__ void operator()(const f32x4 (&acc)[2][2][4][2], const Unit& u, int wr, int wc, int fr, int fq) const {
        const int row0 = u.pm * 256 + wr * 64 + fr; const int c0 = 1024 + u.pn * 256 + wc * 32 + 8 * fq;
        float rsv[2][4];
        EPI_ROWS rsv[ai][m] = rstd[row0 + ai * 128 + m * 16];
        EPI_ROWS { const int row = row0 + ai * 128 + m * 16; const float rs = rsv[ai][m]; u16* rp = zgate + (size_t)row * ZG + c0;
#pragma unroll
            for (int bj = 0; bj < 2; ++bj) { const f32x4 v0 = acc[ai][bj][m][0] * rs, v1 = acc[ai][bj][m][1] * rs;
                uint4 w; w.x = cvt_pk_bf16(v0[0], v0[1]); w.y = cvt_pk_bf16(v0[2], v0[3]); w.z = cvt_pk_bf16(v1[0], v1[1]); w.w = cvt_pk_bf16(v1[2], v1[3]); *(uint4*)(rp + bj * 128) = w; } }
    }
};

__device__ __forceinline__ void tr_tile(const float* __restrict__ src, int ldn, int nsrc0, u16* __restrict__ dst, int K, int k0, int ndst0, const float* __restrict__ scale, float* tile) {
    const int tid = threadIdx.x, nc4 = (tid & 15) * 4, kr0 = tid >> 4;
    float4 v[8];
#pragma unroll
    for (int i = 0; i < 8; ++i) { const int kr = kr0 + 32 * i; v[i] = make_float4(0.f, 0.f, 0.f, 0.f);
        if (nsrc0 >= 0) v[i] = *(const float4*)(src + (size_t)(k0 + kr) * ldn + nsrc0 + nc4); }
#pragma unroll
    for (int i = 0; i < 8; ++i) { const int kr = kr0 + 32 * i; const float sc = scale ? scale[k0 + kr] : 1.0f; float* tp = tile + kr * 65 + nc4;
        tp[0] = v[i].x * sc; tp[1] = v[i].y * sc; tp[2] = v[i].z * sc; tp[3] = v[i].w * sc; }
    __syncthreads();
    const int nr = tid >> 3, kb = (tid & 7) * 8;
#pragma unroll
    for (int q = 0; q < 4; ++q) { const int kc = kb + 64 * q; uint4 w;
        w.x = cvt_pk_bf16(tile[(kc + 0) * 65 + nr], tile[(kc + 1) * 65 + nr]); w.y = cvt_pk_bf16(tile[(kc + 2) * 65 + nr], tile[(kc + 3) * 65 + nr]);
        w.z = cvt_pk_bf16(tile[(kc + 4) * 65 + nr], tile[(kc + 5) * 65 + nr]); w.w = cvt_pk_bf16(tile[(kc + 6) * 65 + nr], tile[(kc + 7) * 65 + nr]);
        *(uint4*)(dst + (size_t)(ndst0 + nr) * K + k0 + kc) = w; }
    __syncthreads();
}
constexpr int WT_IN = 1152, WT_ALL = 3776;
__device__ __forceinline__ void weight_tile(const Params& P, int id, float* tile) {
    unsigned char* ws = P.ws;
    if (id < 1152) { const int nt = id % 144, kt = id / 144; const int ns = nt < 55 ? nt * 64 : (nt == 55 ? -1 : nt * 64 - 64);
        tr_tile(P.in[2], 9152, ns, (u16*)(ws + WS_WIN), 2048, kt * 256, nt * 64, P.in[1], tile); }
    else if (id < 1152 + 1408) { const int j = id - 1152, nt = j % 176, kt = j / 176;
        tr_tile(P.in[20], NUP, nt * 64, (u16*)(ws + WS_WUP), 2048, kt * 256, nt * 64, P.in[19], tile); }
    else if (id < 2560 + 704) { const int j = id - 2560, nt = j % 32, kt = j / 32;
        tr_tile(P.in[23], 2048, nt * 64, (u16*)(ws + WS_WDOWN), 5632, kt * 256, nt * 64, nullptr, tile); }
    else if (id < 3264 + 128) { const int j = id - 3264, nt = j % 32, kt = j / 32;
        tr_tile(P.in[17], 2048, nt * 64, (u16*)(ws + WS_WBR1), 1024, kt * 256, nt * 64, nullptr, tile); }
    else if (id < 3392 + 128) { const int j = id - 3392, nt = j % 32, kt = j / 32;
        tr_tile(P.in[17] + (size_t)1024 * 2048, 2048, nt * 64, (u16*)(ws + WS_WBR2), 1024, kt * 256, nt * 64, nullptr, tile); }
    else { const int j = id - 3520, nt = j % 32, kt = j / 32;
        tr_tile(P.in[18], 2048, nt * 64, (u16*)(ws + WS_WOUT), 2048, kt * 256, nt * 64, nullptr, tile); }
}
__device__ __forceinline__ void win_tile(const Params& P, int kt, int nt, float* tile) {
    const int ns = nt < 55 ? nt * 64 : (nt == 55 ? -1 : nt * 64 - 64);
    tr_tile(P.in[2], 9152, ns, (u16*)(P.ws + WS_WIN), 2048, kt * 256, nt * 64, P.in[1], tile);
}
__device__ void phase0(const Params& P, float* tile) {
    unsigned char* ws = P.ws; const int G = gridDim.x, bid = blockIdx.x, tid = threadIdx.x;
    if (bid == 0 && tid == 0) *(unsigned*)(ws + WS_CNT) = 0u;
    for (int id = bid; id < 1152; id += G) win_tile(P, id / 144, id % 144, tile);
    { u16* w2t = (u16*)(ws + WS_WLORA); u16* a2t = w2t + 1024 * 96; u16* g2t = a2t + 1024 * 96;
      for (int idx = bid * 512 + tid; idx < 448 * 1024; idx += G * 512) { const int kk = idx >> 10, n = idx & 1023;
          if (kk < 96) w2t[n * 96 + kk] = f2bf(P.in[5][(size_t)kk * 1024 + n]);
          else if (kk < 192) a2t[n * 96 + (kk - 96)] = f2bf(P.in[7][(size_t)(kk - 96) * 1024 + n]);
          else g2t[n * 256 + (kk - 192)] = f2bf(P.in[8][(size_t)(kk - 192) * 1024 + n]); } }
    { const int lane = tid & 63, gw = bid * 8 + (tid >> 6), nw = G * 8; u16* xb = (u16*)(ws + WS_Z + Z_TAIL); float* rstd1 = (float*)(ws + WS_SMALL);
      for (int t = gw; t < MT; t += nw) { const float4* xr = (const float4*)(P.in[0] + (size_t)t * DM); float ss = 0.f;
#pragma unroll
          for (int i = 0; i < 8; ++i) { const float4 v = xr[lane + 64 * i]; ss += v.x * v.x + v.y * v.y + v.z * v.z + v.w * v.w;
              uint2 w; w.x = cvt_pk_bf16(v.x, v.y); w.y = cvt_pk_bf16(v.z, v.w); *(uint2*)(xb + (size_t)t * DM + (lane + 64 * i) * 4) = w; }
          ss = wave_sum(ss); if (lane == 0) rstd1[t] = rsqrtf(ss * (1.0f / 2048.0f) + 1e-6f); } }
}

__device__ void phase2(const Params& P, u16* tile) {
    unsigned char* ws = P.ws; const int G = gridDim.x, bid = blockIdx.x, tid = threadIdx.x, lane = tid & 63;
    const u16* zmain = (const u16*)(ws + WS_Z + Z_MAIN);
    u16* rkv = (u16*)((unsigned char*)P.out + O_RKV); u16* Qn = (u16*)((unsigned char*)P.out + O_QN);
    u16* Ap = (u16*)(ws + WS_X + X_AP); u16* Kn = (u16*)(ws + WS_X + X_KN); u16* Vt = (u16*)(ws + WS_X + X_VT);
    const float* mu = P.in[3];
    const int d0 = (lane * 2) & 63; const float qg0 = P.in[14][d0] * 0.125f, qg1 = P.in[14][d0 + 1] * 0.125f, kg0 = P.in[15][d0], kg1 = P.in[15][d0 + 1];
    for (int t = bid * 8 + (tid >> 6); t < MT; t += G * 8) {
        const u16* zr = zmain + (size_t)t * ZM; const bool hp = (t & (SEQ - 1)) != 0; const u16* zp = hp ? zr - ZM : zr;
        unsigned zz[28], pp[28], qk[10]; float2 m2[28];
#pragma unroll
        for (int i = 0; i < 28; ++i) { const int c = i * 128 + lane * 2; zz[i] = 0u; pp[i] = 0u; m2[i] = make_float2(0.f, 0.f);
            if (i < 27 || lane < 32) { zz[i] = *(const unsigned*)(zr + c); pp[i] = *(const unsigned*)(zp + c); m2[i] = *(const float2*)(mu + c); } }
#pragma unroll
        for (int i = 0; i < 10; ++i) qk[i] = *(const unsigned*)(zr + 3584 + i * 128 + lane * 2);
#pragma unroll
        for (int i = 0; i < 28; ++i) { const int c = i * 128 + lane * 2;
            if (i < 27 || lane < 32) { const unsigned pv = hp ? pp[i] : 0u;
                const float z0 = bflo(zz[i]), z1 = bfhi(zz[i]); const float a0 = z0 + (bflo(pv) - z0) * m2[i].x, a1 = z1 + (bfhi(pv) - z1) * m2[i].y;
                if (i < 24) *(unsigned*)(rkv + (size_t)t * 3072 + c) = cvt_pk_bf16(a0, a1);
                else if (c < 3168) *(unsigned*)(Ap + (size_t)t * 512 + (c - 3072)) = cvt_pk_bf16(tanhf(a0), tanhf(a1));
                else if (c < 3264) *(unsigned*)(Ap + (size_t)t * 512 + 96 + (c - 3168)) = cvt_pk_bf16(a0, a1);
                else *(unsigned*)(Ap + (size_t)t * 512 + 256 + (c - 3264)) = cvt_pk_bf16(sigmoidf_(a0), sigmoidf_(a1)); } }
        if (lane < 32) *(unsigned*)(Ap + (size_t)t * 512 + 192 + lane * 2) = 0u;
#pragma unroll
        for (int i = 0; i < 10; ++i) { const float v0 = bflo(qk[i]), v1 = bfhi(qk[i]); float ss = row16_sum(v0 * v0 + v1 * v1); ss += __shfl_xor(ss, 16);
            const float rs = rsqrtf(ss * (1.0f / 64.0f) + 1e-6f);
            if (i < 8) *(unsigned*)(Qn + (size_t)t * 1024 + i * 128 + lane * 2) = cvt_pk_bf16(v0 * rs * qg0, v1 * rs * qg1);
            else *(unsigned*)(Kn + (size_t)t * 256 + (i - 8) * 128 + lane * 2) = cvt_pk_bf16(v0 * rs * kg0, v1 * rs * kg1); }
    }
    for (int tl = bid; tl < MT / 64; tl += G) { const int t0 = tl * 64;
        __syncthreads();
        for (int i = 0; i < 16; ++i) { const int idx = tid + 512 * i, r = idx >> 7, cp = idx & 127; const unsigned vv = *(const unsigned*)(zmain + (size_t)(t0 + r) * ZM + 4864 + 2 * cp);
            tile[(2 * cp) * 66 + r] = (u16)(vv & 0xffffu); tile[(2 * cp + 1) * 66 + r] = (u16)(vv >> 16); }
        __syncthreads();
        const int b = t0 >> 12, s0 = t0 & (SEQ - 1);
        for (int i = 0; i < 16; ++i) { const int idx = tid + 512 * i, c = idx >> 5, sp = idx & 31;
            const unsigned w = (unsigned)tile[c * 66 + 2 * sp] | ((unsigned)tile[c * 66 + 2 * sp + 1] << 16);
            *(unsigned*)(Vt + ((size_t)(b * 4 + (c >> 6)) * 64 + (c & 63)) * SEQ + s0 + 2 * sp) = w; }
    }
}

constexpr int NSCAN = 32;
#define LDS_BARRIER() do { asm volatile("s_waitcnt lgkmcnt(0)" ::: "memory"); __builtin_amdgcn_s_barrier(); asm volatile("" ::: "memory"); } while (0)
__device__ __forceinline__ float row8_sum(float x) { x += dppf<0xB1>(x); x += dppf<0x4E>(x); x += dppf<0x141>(x); return x; }
__device__ void rwkv_prep(const Params& P, unsigned char* lds_raw) {
    unsigned char* ws = P.ws; const int tid = threadIdx.x, q4 = tid >> 7, lt = tid & 127, lane = tid & 63, qw = (tid >> 6) & 1, fr = lane & 15, fq = lane >> 4;
    unsigned char* lwb = ws + WS_Z + Z_LW; unsigned char* ab = ws + WS_Z + Z_A; u16* rkv = (u16*)((unsigned char*)P.out + O_RKV);
    float* gbuf = (float*)(ws + WS_G); float* rkb = (float*)(ws + WS_RK);
    const u16* Apx = (const u16*)(ws + WS_X + X_AP); const u16* w2t = (const u16*)(ws + WS_WLORA); const u16* a2t = w2t + 1024 * 96; const u16* g2t = a2t + 1024 * 96; u16* gout = (u16*)(ws + WS_Z + Z_G);
    unsigned char* L0 = lds_raw + q4 * 32768;
    u16* sAt = (u16*)L0; u16* sBt = sAt + 16 * 72; u16* sKt = sBt + 16 * 72; u16* sRt = sKt + 16 * 72;
    u16* sVt = (u16*)(L0 + 9216); u16* sAak = (u16*)(L0 + 12288); float* sN = (float*)(L0 + 13312); float* sRHS = (float*)(L0 + 14400); float* sL = (float*)(L0 + 22848); float* sAf = (float*)(L0 + 26944);
    const int tl = lt >> 3, c8 = (lt & 7) * 8;
    uint4 n_r, n_k, n_v; float4 n_kkw[2], n_kaw[2], n_rkw[2]; bf16x8 n_At[3], n_Aa[3], n_Ag[8];
    auto unit_of = [&](int it_) { if ((int)gridDim.x == 256) { const int s_ = (it_ & 255) * 4 + q4; return (s_ >> 5) * 256 + (s_ & 31) + 32 * (it_ >> 8); } return it_ * 4 + q4; };
    auto fetch = [&](int it_) { const int unit_ = unit_of(it_), b_ = unit_ >> 12, h_ = (unit_ >> 8) & 15, c_ = unit_ & 255; const size_t t_ = (size_t)b_ * SEQ + c_ * CH_ + tl; const int hc_ = h_ * 64 + c8;
        n_r = *(const uint4*)(rkv + t_ * 3072 + hc_); n_k = *(const uint4*)(rkv + t_ * 3072 + 1024 + hc_); n_v = *(const uint4*)(rkv + t_ * 3072 + 2048 + hc_);
#pragma unroll
        for (int i = 0; i < 2; ++i) {
            n_kkw[i] = *(const float4*)(P.in[9] + hc_ + 4 * i); n_kaw[i] = *(const float4*)(P.in[10] + hc_ + 4 * i); n_rkw[i] = *(const float4*)(P.in[11] + hc_ + 4 * i); }
        const u16* ar_ = Apx + ((size_t)b_ * SEQ + c_ * CH_ + fr) * 512 + 8 * fq;
#pragma unroll
        for (int ks = 0; ks < 3; ++ks) { n_At[ks] = *(const bf16x8*)(ar_ + 32 * ks); n_Aa[ks] = *(const bf16x8*)(ar_ + 96 + 32 * ks); }
#pragma unroll
        for (int ks = 0; ks < 8; ++ks) n_Ag[ks] = *(const bf16x8*)(ar_ + 256 + 32 * ks); };
    if ((int)blockIdx.x < 2048) fetch(blockIdx.x);
    for (int it = blockIdx.x; it < 2048; it += gridDim.x) {
        const int unit = unit_of(it), b = unit >> 12, h = (unit >> 8) & 15, c = unit & 255; const size_t t0 = (size_t)b * SEQ + c * CH_, t = t0 + tl;
#pragma unroll
        for (int n2 = 0; n2 < 2; ++n2) { const int cn = (qw * 2 + n2) * 16 + fr, nrow = h * 64 + cn;
            f32x4 accw = {0.f, 0.f, 0.f, 0.f}, acca = {0.f, 0.f, 0.f, 0.f}, accg = {0.f, 0.f, 0.f, 0.f};
#pragma unroll
            for (int ks = 0; ks < 3; ++ks) { const bf16x8 bw = *(const bf16x8*)(w2t + nrow * 96 + 32 * ks + 8 * fq), ba = *(const bf16x8*)(a2t + nrow * 96 + 32 * ks + 8 * fq);
                accw = __builtin_amdgcn_mfma_f32_16x16x32_bf16(n_At[ks], bw, accw, 0, 0, 0); acca = __builtin_amdgcn_mfma_f32_16x16x32_bf16(n_Aa[ks], ba, acca, 0, 0, 0); }
#pragma unroll
            for (int ks = 0; ks < 8; ++ks) { const bf16x8 bg = *(const bf16x8*)(g2t + nrow * 256 + 32 * ks + 8 * fq); accg = __builtin_amdgcn_mfma_f32_16x16x32_bf16(n_Ag[ks], bg, accg, 0, 0, 0); }
            const float w0v = P.in[4][nrow], a0v = P.in[6][nrow];
#pragma unroll
            for (int j = 0; j < 4; ++j) { const int tt = 4 * fq + j; const float y = -(w0v + accw[j]); const float sp = fmaxf(y, 0.f) + __logf(1.0f + __expf(-fabsf(y)));
                sL[tt * 64 + cn] = -__expf(-sp - 0.5f); sAf[tt * 64 + cn] = sigmoidf_(a0v + acca[j]); gout[(t0 + tt) * RWD + nrow] = f2bf(accg[j]); } }
        LDS_BARRIER();
        const unsigned ru[4] = {n_r.x, n_r.y, n_r.z, n_r.w}, ku[4] = {n_k.x, n_k.y, n_k.z, n_k.w}, vu[4] = {n_v.x, n_v.y, n_v.z, n_v.w};
        float rr[8], kr[8], aa[8], lw[8], kkw_[8], kaw_[8], rkw_[8];
        { const float4 l0 = *(const float4*)(sL + tl * 64 + c8), l1 = *(const float4*)(sL + tl * 64 + c8 + 4), q0 = *(const float4*)(sAf + tl * 64 + c8), q1 = *(const float4*)(sAf + tl * 64 + c8 + 4);
          lw[0] = l0.x; lw[1] = l0.y; lw[2] = l0.z; lw[3] = l0.w; lw[4] = l1.x; lw[5] = l1.y; lw[6] = l1.z; lw[7] = l1.w; aa[0] = q0.x; aa[1] = q0.y; aa[2] = q0.z; aa[3] = q0.w; aa[4] = q1.x; aa[5] = q1.y; aa[6] = q1.z; aa[7] = q1.w; }
#pragma unroll
        for (int i = 0; i < 4; ++i) { rr[2 * i] = bflo(ru[i]); rr[2 * i + 1] = bfhi(ru[i]); kr[2 * i] = bflo(ku[i]); kr[2 * i + 1] = bfhi(ku[i]); }
#pragma unroll
        for (int i = 0; i < 2; ++i) {
            kkw_[4 * i] = n_kkw[i].x; kkw_[4 * i + 1] = n_kkw[i].y; kkw_[4 * i + 2] = n_kkw[i].z; kkw_[4 * i + 3] = n_kkw[i].w; kaw_[4 * i] = n_kaw[i].x; kaw_[4 * i + 1] = n_kaw[i].y; kaw_[4 * i + 2] = n_kaw[i].z; kaw_[4 * i + 3] = n_kaw[i].w;
            rkw_[4 * i] = n_rkw[i].x; rkw_[4 * i + 1] = n_rkw[i].y; rkw_[4 * i + 2] = n_rkw[i].z; rkw_[4 * i + 3] = n_rkw[i].w; }
        float qq[8], kk[8], bb[8], kp[8]; float ss = 0.f, rks = 0.f;
#pragma unroll
        for (int j = 0; j < 8; ++j) { qq[j] = kr[j] * kkw_[j]; ss += qq[j] * qq[j]; }
        ss = row8_sum(ss); const float inv = 1.0f / fmaxf(sqrtf(ss), 1e-12f);
#pragma unroll
        for (int j = 0; j < 8; ++j) { kk[j] = qq[j] * inv; bb[j] = kk[j] * aa[j]; kp[j] = kr[j] * (1.0f + (aa[j] - 1.0f) * kaw_[j]); rks += rr[j] * kp[j] * rkw_[j]; }
        rks = row8_sum(rks); if ((lt & 7) == 0) rkb[t * 16 + h] = rks;
#pragma unroll
        for (int i = 0; i < 4; ++i) { sVt[(c8 + 2 * i) * 24 + tl] = (u16)(vu[i] & 0xffffu); sVt[(c8 + 2 * i + 1) * 24 + tl] = (u16)(vu[i] >> 16); }
        LDS_BARRIER();
        if (lt < 64) { float lv[16];
#pragma unroll
            for (int i = 0; i < 16; ++i) lv[i] = sL[i * 64 + lt];
#pragma unroll
            for (int i = 1; i < 16; ++i) lv[i] += lv[i - 1];
#pragma unroll
            for (int i = 0; i < 16; ++i) sL[i * 64 + lt] = lv[i]; }
        LDS_BARRIER();
        { const float4 La = *(const float4*)(sL + tl * 64 + c8), Lb = *(const float4*)(sL + tl * 64 + c8 + 4), Ta = *(const float4*)(sL + 15 * 64 + c8), Tb = *(const float4*)(sL + 15 * 64 + c8 + 4);
          const float Lc[8] = {La.x, La.y, La.z, La.w, Lb.x, Lb.y, Lb.z, Lb.w}, Lt[8] = {Ta.x, Ta.y, Ta.z, Ta.w, Tb.x, Tb.y, Tb.z, Tb.w};
          float at[8], bt[8], kt[8], rt[8], bh[8], kh[8];
#pragma unroll
          for (int j = 0; j < 8; ++j) { const float eL = __expf(Lc[j]), eLp = __expf(Lc[j] - lw[j]), eNL = __expf(-Lc[j]), eH = __expf(Lt[j] - Lc[j]);
              at[j] = -kk[j] * eLp; bt[j] = bb[j] * eNL; kt[j] = kp[j] * eNL; rt[j] = rr[j] * eL; bh[j] = bb[j] * eH; kh[j] = kp[j] * eH; }
          uint4 w; w.x = cvt_pk_bf16(at[0], at[1]); w.y = cvt_pk_bf16(at[2], at[3]); w.z = cvt_pk_bf16(at[4], at[5]); w.w = cvt_pk_bf16(at[6], at[7]); *(uint4*)(sAt + tl * 72 + c8) = w;
          w.x = cvt_pk_bf16(bt[0], bt[1]); w.y = cvt_pk_bf16(bt[2], bt[3]); w.z = cvt_pk_bf16(bt[4], bt[5]); w.w = cvt_pk_bf16(bt[6], bt[7]); *(uint4*)(sBt + tl * 72 + c8) = w;
          w.x = cvt_pk_bf16(kt[0], kt[1]); w.y = cvt_pk_bf16(kt[2], kt[3]); w.z = cvt_pk_bf16(kt[4], kt[5]); w.w = cvt_pk_bf16(kt[6], kt[7]); *(uint4*)(sKt + tl * 72 + c8) = w;
          w.x = cvt_pk_bf16(rt[0], rt[1]); w.y = cvt_pk_bf16(rt[2], rt[3]); w.z = cvt_pk_bf16(rt[4], rt[5]); w.w = cvt_pk_bf16(rt[6], rt[7]); *(uint4*)(sRt + tl * 72 + c8) = w;
          *(uint4*)(lwb + (t * 1024 + h * 64) * 4 + 128 + c8 * 2) = w;
          *(float4*)(sRHS + tl * 132 + c8) = make_float4(at[0], at[1], at[2], at[3]); *(float4*)(sRHS + tl * 132 + c8 + 4) = make_float4(at[4], at[5], at[6], at[7]);
#pragma unroll
          for (int j = 0; j < 8; ++j) { unsigned char* dst = ab + ((t0 + (c8 >> 2) + (j >> 2)) * 1024 + h * 64) * 4 + (j & 3) * 64;
              *(u16*)(dst + tl * 2) = f2bf(bh[j]); *(u16*)(dst + (16 + tl) * 2) = f2bf(kh[j]); }
          if (tl == 0) { *(float4*)(gbuf + (size_t)unit * 64 + c8) = make_float4(__expf(Lt[0]), __expf(Lt[1]), __expf(Lt[2]), __expf(Lt[3]));
              *(float4*)(gbuf + (size_t)unit * 64 + c8 + 4) = make_float4(__expf(Lt[4]), __expf(Lt[5]), __expf(Lt[6]), __expf(Lt[7])); } }
        LDS_BARRIER();
        if (it + (int)gridDim.x < 2048) fetch(it + (int)gridDim.x);
        { const u16* X = qw == 0 ? sAt : sRt;
          const bf16x8 a0 = *(const bf16x8*)(X + fr * 72 + 8 * fq), a1 = *(const bf16x8*)(X + fr * 72 + 32 + 8 * fq);
#pragma unroll
          for (int pi = 0; pi < 2; ++pi) { const u16* Y = pi ? sKt : sBt; const int hw = qw * 2 + pi;
              const bf16x8 b0 = *(const bf16x8*)(Y + fr * 72 + 8 * fq), b1 = *(const bf16x8*)(Y + fr * 72 + 32 + 8 * fq);
              f32x4 acc = {0.f, 0.f, 0.f, 0.f};
              acc = __builtin_amdgcn_mfma_f32_16x16x32_bf16(a0, b0, acc, 0, 0, 0); acc = __builtin_amdgcn_mfma_f32_16x16x32_bf16(a1, b1, acc, 0, 0, 0);
#pragma unroll
              for (int j = 0; j < 4; ++j) { const int tt = 4 * fq + j, i = fr; const bool keep = hw < 2 ? (i < tt) : (i <= tt); const float val = keep ? acc[j] : 0.f;
                  if (hw == 0) sN[tt * 17 + i] = val;
                  else if (hw == 1) sAak[tt * 24 + i] = f2bf(val);
                  else rkv[(t0 + tt) * 3072 + h * 64 + (hw == 3 ? 16 : 0) + i] = f2bf(val); } } }
        LDS_BARRIER();
#pragma unroll
        for (int vi = 0; vi < 2; ++vi) { const int vt = qw * 2 + vi; bf16x8 af = {0, 0, 0, 0, 0, 0, 0, 0}, bf = {0, 0, 0, 0, 0, 0, 0, 0};
          if (fq < 2) { af = *(const bf16x8*)(sAak + fr * 24 + 8 * fq); bf = *(const bf16x8*)(sVt + (vt * 16 + fr) * 24 + 8 * fq); }
          f32x4 acc = {0.f, 0.f, 0.f, 0.f}; acc = __builtin_amdgcn_mfma_f32_16x16x32_bf16(af, bf, acc, 0, 0, 0);
#pragma unroll
          for (int j = 0; j < 4; ++j) sRHS[(4 * fq + j) * 132 + 64 + vt * 16 + fr] = acc[j]; }
        LDS_BARRIER();
        { const int col = qw * 64 + lane; float x[16];
#pragma unroll
            for (int i = 0; i < 16; ++i) { float v = sRHS[i * 132 + col];
#pragma unroll
                for (int j = 0; j < i; ++j) v += sN[i * 17 + j] * x[j];
                x[i] = v; }
            if (qw == 0) {
#pragma unroll
                for (int i = 0; i < 16; ++i) *(u16*)(lwb + ((t0 + i) * 1024 + h * 64) * 4 + lane * 2) = f2bf(x[i]); }
            else { uint4 w0, w1; w0.x = cvt_pk_bf16(x[0], x[1]); w0.y = cvt_pk_bf16(x[2], x[3]); w0.z = cvt_pk_bf16(x[4], x[5]); w0.w = cvt_pk_bf16(x[6], x[7]);
                w1.x = cvt_pk_bf16(x[8], x[9]); w1.y = cvt_pk_bf16(x[10], x[11]); w1.z = cvt_pk_bf16(x[12], x[13]); w1.w = cvt_pk_bf16(x[14], x[15]);
                u16* wp = rkv + (t0 + (lane >> 2)) * 3072 + 1024 + h * 64 + (lane & 3) * 16;
                *(uint4*)wp = w0; *(uint4*)(wp + 8) = w1; } }
    }
}
__device__ void rwkv_serial(const Params& P, unsigned char* lds_raw) {
    unsigned char* ws = P.ws; const int tid = threadIdx.x, lane = tid & 63, w = __builtin_amdgcn_readfirstlane(tid >> 6), fr = lane & 15, fq = lane >> 4;
    const int hb = blockIdx.x, b = hb >> 4, h = hb & 15;
    const unsigned char* lwb = ws + WS_Z + Z_LW; const unsigned char* ab = ws + WS_Z + Z_A; const u16* rkv = (const u16*)((unsigned char*)P.out + O_RKV);
    const float* gbuf = (const float*)(ws + WS_G); u16* yb = (u16*)(ws + WS_Y);
    u16* Sb = (u16*)lds_raw; u16* UVt = (u16*)(lds_raw + 18432);
    for (int i = tid; i < 64 * 72; i += 512) Sb[i] = 0;
    const int kt = w >> 1, vt0 = (w & 1) * 2, ut = w & 3, kr = kt * 16 + fr, uv = ut * 16 + fr;
    f32x4 st0 = {0.f, 0.f, 0.f, 0.f}, st1 = {0.f, 0.f, 0.f, 0.f};
    typedef unsigned u32x2_t __attribute__((ext_vector_type(2)));
    struct Pre { bf16x8 f0, f1, x, bk; f32x4 g; unsigned vv; };
#define PRE_LOAD(c_, p) do { const size_t t0_ = (size_t)b * SEQ + (size_t)(c_) * CH_; \
        const unsigned char* ls_ = lwb + ((t0_ + fr) * 1024 + h * 64) * 4 + (w < 4 ? 0 : 128) + fq * 16; \
        const void* a0_ = ls_; const void* a1_ = ls_ + 64; \
        const void* a2_ = (w < 4) ? (const void*)(rkv + (t0_ + (uv >> 2)) * 3072 + 1024 + h * 64 + (uv & 3) * 16 + fq * 4) : (const void*)(rkv + (t0_ + fr) * 3072 + h * 64 + fq * 8); \
        const void* a4_ = ab + ((t0_ + (kr >> 2)) * 1024 + h * 64) * 4 + (kr & 3) * 64 + fq * 16; \
        const void* a5_ = gbuf + ((size_t)hb * 256 + (c_)) * 64 + kt * 16 + 4 * fq; \
        const void* a6_ = rkv + (t0_ + (tid >> 5)) * 3072 + 2048 + h * 64 + (tid & 31) * 2; \
        asm volatile("global_load_dwordx4 %0, %1, off" : "=v"(p.f0) : "v"(a0_) : "memory"); \
        asm volatile("global_load_dwordx4 %0, %1, off" : "=v"(p.f1) : "v"(a1_) : "memory"); \
        asm volatile("global_load_dwordx4 %0, %1, off" : "=v"(p.x) : "v"(a2_) : "memory"); \
        asm volatile("global_load_dwordx4 %0, %1, off" : "=v"(p.bk) : "v"(a4_) : "memory"); \
        asm volatile("global_load_dwordx4 %0, %1, off" : "=v"(p.g) : "v"(a5_) : "memory"); \
        asm volatile("global_load_dword %0, %1, off" : "=v"(p.vv) : "v"(a6_) : "memory"); } while (0)
#define PRE_WAIT(p, N) asm volatile("s_waitcnt vmcnt(" #N ")" : "+v"(p.f0), "+v"(p.f1), "+v"(p.x), "+v"(p.bk), "+v"(p.g), "+v"(p.vv) :: "memory")
    auto step = [&](int c, const Pre& cur) {
        const u16* S = Sb + (c & 1) * (64 * 72); u16* Sn = Sb + ((c & 1) ^ 1) * (64 * 72); const size_t t0 = (size_t)b * SEQ + c * CH_;
        { const int tv = tid >> 5, v2 = (tid & 31) * 2; UVt[v2 * 40 + 16 + tv] = (u16)(cur.vv & 0xffffu); UVt[(v2 + 1) * 40 + 16 + tv] = (u16)(cur.vv >> 16); }
        const bf16x8 s0 = *(const bf16x8*)(S + uv * 72 + 8 * fq), s1 = *(const bf16x8*)(S + uv * 72 + 32 + 8 * fq);
        f32x4 acc = {0.f, 0.f, 0.f, 0.f};
        if (w < 4) { const unsigned wx = (unsigned)(unsigned short)cur.x[0] | ((unsigned)(unsigned short)cur.x[1] << 16), wy = (unsigned)(unsigned short)cur.x[2] | ((unsigned)(unsigned short)cur.x[3] << 16);
            acc[0] = bflo(wx); acc[1] = bfhi(wx); acc[2] = bflo(wy); acc[3] = bfhi(wy); }
        acc = __builtin_amdgcn_mfma_f32_16x16x32_bf16(cur.f0, s0, acc, 0, 0, 0); acc = __builtin_amdgcn_mfma_f32_16x16x32_bf16(cur.f1, s1, acc, 0, 0, 0);
        if (w < 4) { uint2 o; o.x = cvt_pk_bf16(acc[0], acc[1]); o.y = cvt_pk_bf16(acc[2], acc[3]); *(uint2*)(UVt + uv * 40 + 4 * fq) = o; }
        LDS_BARRIER();
        if (w >= 4) { const bf16x8 uf = *(const bf16x8*)(UVt + uv * 40 + 8 * fq); acc = __builtin_amdgcn_mfma_f32_16x16x32_bf16(cur.x, uf, acc, 0, 0, 0);
#pragma unroll
            for (int j = 0; j < 4; ++j) yb[(t0 + 4 * fq + j) * RWD + h * 64 + uv] = f2bf(acc[j]); }
        { const bf16x8 u0 = *(const bf16x8*)(UVt + ((vt0 + 0) * 16 + fr) * 40 + 8 * fq), u1 = *(const bf16x8*)(UVt + ((vt0 + 1) * 16 + fr) * 40 + 8 * fq);
          st0 = __builtin_amdgcn_mfma_f32_16x16x32_bf16(cur.bk, u0, st0 * cur.g, 0, 0, 0); st1 = __builtin_amdgcn_mfma_f32_16x16x32_bf16(cur.bk, u1, st1 * cur.g, 0, 0, 0);
          uint2 o; o.x = cvt_pk_bf16(st0[0], st0[1]); o.y = cvt_pk_bf16(st0[2], st0[3]); *(uint2*)(Sn + ((vt0 + 0) * 16 + fr) * 72 + kt * 16 + 4 * fq) = o;
          o.x = cvt_pk_bf16(st1[0], st1[1]); o.y = cvt_pk_bf16(st1[2], st1[3]); *(uint2*)(Sn + ((vt0 + 1) * 16 + fr) * 72 + kt * 16 + 4 * fq) = o; }
        LDS_BARRIER(); };
    Pre q0, q1, q2, q3, q4, q5; PRE_LOAD(0, q0); PRE_LOAD(1, q1); PRE_LOAD(2, q2); PRE_LOAD(3, q3); PRE_LOAD(4, q4); PRE_LOAD(5, q5);
    __syncthreads();
    constexpr int NCH = SEQ / CH_;
    for (int c = 0; c < 252; c += 6) {
        PRE_WAIT(q0, 30); step(c, q0);     PRE_LOAD(min(c + 6, NCH - 1), q0);
        PRE_WAIT(q1, 30); step(c + 1, q1); PRE_LOAD(min(c + 7, NCH - 1), q1);
        PRE_WAIT(q2, 30); step(c + 2, q2); PRE_LOAD(min(c + 8, NCH - 1), q2);
        PRE_WAIT(q3, 30); step(c + 3, q3); PRE_LOAD(min(c + 9, NCH - 1), q3);
        PRE_WAIT(q4, 30); step(c + 4, q4); PRE_LOAD(min(c + 10, NCH - 1), q4);
        PRE_WAIT(q5, 30); step(c + 5, q5); PRE_LOAD(min(c + 11, NCH - 1), q5);
    }
    PRE_WAIT(q0, 0); PRE_WAIT(q1, 0); PRE_WAIT(q2, 0); PRE_WAIT(q3, 0); PRE_WAIT(q4, 0); PRE_WAIT(q5, 0);
    step(252, q0); step(253, q1); step(254, q2); step(255, q3);
#undef PRE_LOAD
#undef PRE_WAIT
}

__device__ void attn_phase(const Params& P) {
    unsigned char* ws = P.ws; const int tid = threadIdx.x, lane = tid & 63, fr = lane & 15, fq = lane >> 4;
    const u16* Qn = (const u16*)((unsigned char*)P.out + O_QN); const u16* Kn = (const u16*)(ws + WS_X + X_KN); const u16* Vt = (const u16*)(ws + WS_X + X_VT);
    u16* oatt = (u16*)(ws + WS_X + X_OATT);
    const int NA = (int)gridDim.x - NSCAN; const int gw = ((int)blockIdx.x - NSCAN) * 8 + (tid >> 6);
    for (int unit = gw; unit < 8192; unit += NA * 8) {
        const int h = unit & 15, st = (unit >> 4) & 255, b = unit >> 12, kh = h >> 2;
        const int s0 = st * 16; const size_t t0 = (size_t)b * SEQ + s0;
        const float slope = exp2f(-0.5f * (float)(h + 1)), sink = P.in[16][h];
        bf16x8 qf[2];
        qf[0] = *(const bf16x8*)(Qn + (t0 + fr) * 1024 + h * 64 + 8 * fq); qf[1] = *(const bf16x8*)(Qn + (t0 + fr) * 1024 + h * 64 + 32 + 8 * fq);
        f32x4 sc[10]; float mx = sink;
#pragma unroll
        for (int kt = 0; kt < 10; ++kt) { const int ks0 = s0 - 144 + 16 * kt; int kp = ks0 + fr; kp = kp < 0 ? 0 : kp;
            const u16* kr = Kn + ((size_t)b * SEQ + kp) * 256 + kh * 64 + 8 * fq;
            const bf16x8 k0 = *(const bf16x8*)kr, k1 = *(const bf16x8*)(kr + 32);
            f32x4 a = {0.f, 0.f, 0.f, 0.f};
            a = __builtin_amdgcn_mfma_f32_16x16x32_bf16(k0, qf[0], a, 0, 0, 0); a = __builtin_amdgcn_mfma_f32_16x16x32_bf16(k1, qf[1], a, 0, 0, 0);
#pragma unroll
            for (int j = 0; j < 4; ++j) { const int kpos = ks0 + 4 * fq + j; const int dist = s0 + fr - kpos; const bool valid = (dist >= 0) && (dist < 128) && (kpos >= 0);
                const float v = valid ? a[j] - slope * (float)dist : -1e30f; a[j] = v; mx = fmaxf(mx, v); }
            sc[kt] = a; }
        mx = fmaxf(mx, __shfl_xor(mx, 16)); mx = fmaxf(mx, __shfl_xor(mx, 32));
        float sum = 0.f;
#pragma unroll
        for (int kt = 0; kt < 10; ++kt)
#pragma unroll
            for (int j = 0; j < 4; ++j) { const float e = __expf(sc[kt][j] - mx); sc[kt][j] = e; sum += e; }
        sum += __shfl_xor(sum, 16); sum += __shfl_xor(sum, 32);
        const float inv = 1.0f / (sum + __expf(sink - mx));
        f32x4 o[4];
#pragma unroll
        for (int dt = 0; dt < 4; ++dt) o[dt] = (f32x4){0.f, 0.f, 0.f, 0.f};
#pragma unroll
        for (int u = 0; u < 5; ++u) {
            union { bf16x8 v; unsigned w[4]; } pf;
            pf.w[0] = cvt_pk_bf16(sc[2 * u][0] * inv, sc[2 * u][1] * inv); pf.w[1] = cvt_pk_bf16(sc[2 * u][2] * inv, sc[2 * u][3] * inv);
            pf.w[2] = cvt_pk_bf16(sc[2 * u + 1][0] * inv, sc[2 * u + 1][1] * inv); pf.w[3] = cvt_pk_bf16(sc[2 * u + 1][2] * inv, sc[2 * u + 1][3] * inv);
            int ka = s0 - 144 + 32 * u + 4 * fq, kb = ka + 16; ka = ka < 0 ? 0 : ka; kb = kb < 0 ? 0 : kb;
#pragma unroll
            for (int dt = 0; dt < 4; ++dt) { const u16* vr = Vt + ((size_t)(b * 4 + kh) * 64 + dt * 16 + fr) * SEQ;
                union { bf16x8 v; uint2 w[2]; } vf; vf.w[0] = *(const uint2*)(vr + ka); vf.w[1] = *(const uint2*)(vr + kb);
                o[dt] = __builtin_amdgcn_mfma_f32_16x16x32_bf16(pf.v, vf.v, o[dt], 0, 0, 0); } }
#pragma unroll
        for (int dt = 0; dt < 4; ++dt)
#pragma unroll
            for (int j = 0; j < 4; ++j) oatt[(t0 + 4 * fq + j) * 1024 + h * 64 + dt * 16 + fr] = f2bf(o[dt][j]);
    }
}

__device__ void phase5(const Params& P) {
    unsigned char* ws = P.ws; const int G = gridDim.x, bid = blockIdx.x, tid = threadIdx.x, lane = tid & 63;
    const u16* rkv = (const u16*)((unsigned char*)P.out + O_RKV); u16* orw = (u16*)((unsigned char*)P.out + O_QN);
    const u16* yraw = (const u16*)(ws + WS_Y); const u16* gp = (const u16*)(ws + WS_Z + Z_G); const float* rkb = (const float*)(ws + WS_RK);
    for (int t = bid * 8 + (tid >> 6); t < MT; t += G * 8) {
        uint2 y2[4], v2[4], g2[4]; float rk[4];
#pragma unroll
        for (int it = 0; it < 4; ++it) { const int hh = it * 4 + (lane >> 4), hc = hh * 64 + (lane & 15) * 4; const size_t o = (size_t)t * RWD + hc;
            y2[it] = *(const uint2*)(yraw + o); g2[it] = *(const uint2*)(gp + o); v2[it] = *(const uint2*)(rkv + (size_t)t * 3072 + 2048 + hc); rk[it] = rkb[(size_t)t * 16 + hh]; }
#pragma unroll
        for (int it = 0; it < 4; ++it) { const int hc = (it * 4 + (lane >> 4)) * 64 + (lane & 15) * 4; const size_t o = (size_t)t * RWD + hc;
            const float4 gw = *(const float4*)(P.in[12] + hc), gb = *(const float4*)(P.in[13] + hc);
            const float yx = bflo(y2[it].x), yy = bfhi(y2[it].x), yz = bflo(y2[it].y), yw = bfhi(y2[it].y);
            const float mu = row16_sum((yx + yy) + (yz + yw)) * (1.0f / 64.0f);
            const float dx = yx - mu, dy = yy - mu, dz = yz - mu, dw = yw - mu;
            const float var = row16_sum((dx * dx + dy * dy) + (dz * dz + dw * dw)) * (1.0f / 64.0f); const float rs = rsqrtf(var + 64e-5f);
            const float o0 = (dx * rs * gw.x + gb.x + rk[it] * bflo(v2[it].x)) * bflo(g2[it].x), o1 = (dy * rs * gw.y + gb.y + rk[it] * bfhi(v2[it].x)) * bfhi(g2[it].x);
            const float o2 = (dz * rs * gw.z + gb.z + rk[it] * bflo(v2[it].y)) * bflo(g2[it].y), o3 = (dw * rs * gw.w + gb.w + rk[it] * bfhi(v2[it].y)) * bfhi(g2[it].y);
            uint2 w; w.x = cvt_pk_bf16(o0, o1); w.y = cvt_pk_bf16(o2, o3); *(uint2*)(orw + o) = w; }
    }
}

__device__ void phase9(const Params& P) {
    unsigned char* ws = P.ws; const u16* uu = (const u16*)(ws + WS_Z); u16* act = (u16*)(ws + WS_ACT);
    const float* cw = P.in[21]; const float* cb = P.in[22];
    const int nth = gridDim.x * 512;
    for (int task = blockIdx.x * 512 + threadIdx.x; task < 1024 * 1408; task += nth) {
        const int j0 = (task % 1408) * 4, t0 = (task / 1408) * 8; const bool first = (t0 & (SEQ - 1)) == 0;
        uint2 ra[10], rg[10];
#pragma unroll
        for (int r = 0; r < 10; ++r) { const int t = (first && r < 2) ? t0 : t0 - 2 + r; ra[r] = *(const uint2*)(uu + (size_t)t * NUP + j0); rg[r] = *(const uint2*)(uu + (size_t)t * NUP + DFF + j0); }
        if (first) { ra[0] = make_uint2(0u, 0u); ra[1] = ra[0]; rg[0] = ra[0]; rg[1] = ra[0]; }
        const float4 wa0 = *(const float4*)(cw + j0), wa1 = *(const float4*)(cw + NUP + j0), wa2 = *(const float4*)(cw + 2 * NUP + j0), ba = *(const float4*)(cb + j0);
        const float4 wg0 = *(const float4*)(cw + DFF + j0), wg1 = *(const float4*)(cw + NUP + DFF + j0), wg2 = *(const float4*)(cw + 2 * NUP + DFF + j0), bg = *(const float4*)(cb + DFF + j0);
#pragma unroll
        for (int i = 0; i < 8; ++i) {
            const float cv0 = bflo(ra[i].x) * wa0.x + bflo(ra[i + 1].x) * wa1.x + bflo(ra[i + 2].x) * wa2.x + ba.x, cv1 = bfhi(ra[i].x) * wa0.y + bfhi(ra[i + 1].x) * wa1.y + bfhi(ra[i + 2].x) * wa2.y + ba.y;
            const float cv2 = bflo(ra[i].y) * wa0.z + bflo(ra[i + 1].y) * wa1.z + bflo(ra[i + 2].y) * wa2.z + ba.z, cv3 = bfhi(ra[i].y) * wa0.w + bfhi(ra[i + 1].y) * wa1.w + bfhi(ra[i + 2].y) * wa2.w + ba.w;
            const float cg0 = bflo(rg[i].x) * wg0.x + bflo(rg[i + 1].x) * wg1.x + bflo(rg[i + 2].x) * wg2.x + bg.x, cg1 = bfhi(rg[i].x) * wg0.y + bfhi(rg[i + 1].x) * wg1.y + bfhi(rg[i + 2].x) * wg2.y + bg.y;
            const float cg2 = bflo(rg[i].y) * wg0.z + bflo(rg[i + 1].y) * wg1.z + bflo(rg[i + 2].y) * wg2.z + bg.z, cg3 = bfhi(rg[i].y) * wg0.w + bfhi(rg[i + 1].y) * wg1.w + bfhi(rg[i + 2].y) * wg2.w + bg.w;
            uint2 w; w.x = cvt_pk_bf16(cg0 * sigmoidf_(cg0) * cv0, cg1 * sigmoidf_(cg1) * cv1); w.y = cvt_pk_bf16(cg2 * sigmoidf_(cg2) * cv2, cg3 * sigmoidf_(cg3) * cv3);
            *(uint2*)(act + (size_t)(t0 + i) * DFF + j0) = w; }
    }
}

#define XB_TMO      128
#define XB_XCNT(j)  (256  + 64 * (j))
#define XB_XSUB(j)  (1280 + 64 * (j))
#define XB_XGEN(j)  (2304 + 64 * (j))
#define XB_TOP      3328
#define XB_TOPGEN   3392
#define XCD_BAR_WORDS 3456
#define XB_SPIN_CAP (1u << 18)

__device__ __forceinline__ unsigned xb_ld(unsigned* p)              { return __hip_atomic_load(p, __ATOMIC_RELAXED, __HIP_MEMORY_SCOPE_AGENT); }
__device__ __forceinline__ unsigned xb_add(unsigned* p, unsigned v) { return __hip_atomic_fetch_add(p, v, __ATOMIC_RELAXED, __HIP_MEMORY_SCOPE_AGENT); }
__device__ __forceinline__ unsigned xb_xcc_id() { return (unsigned)__builtin_amdgcn_s_getreg((3 << 11) | 20) & 0xFu; }
#define XB_SPIN(cond, bar) do { unsigned _sp = 0; while (cond) { __builtin_amdgcn_s_sleep(1); \
    if ((++_sp & 255u) == 0u) { if (xb_ld(&(bar)[XB_TMO])) break; if (_sp > XB_SPIN_CAP) { atomicAdd(&(bar)[XB_TMO], 1u); break; } } } } while (0)

struct XcdBarrier {
    unsigned* bar; unsigned x;
    volatile LAS unsigned* st;
};

__device__ __forceinline__ XcdBarrier xcd_barrier_post(unsigned* bar, volatile LAS unsigned* st) {
    XcdBarrier b; b.bar = bar; b.x = xb_xcc_id(); b.st = st;
    if (threadIdx.x == 0) (void)xb_add(&bar[XB_XCNT(b.x)], 1u);
    return b;
}
__device__ __forceinline__ void xcd_barrier_complete(unsigned* bar, unsigned x, unsigned& nloc, unsigned& nx) {
    const unsigned G = gridDim.x * gridDim.y * gridDim.z;
    unsigned sum, cnt, mine, sp = 0u;
    for (;;) {
        sum = 0u; cnt = 0u; mine = 0u;
#pragma unroll
        for (unsigned j = 0; j < 16; ++j) { const unsigned c = xb_ld(&bar[XB_XCNT(j)]); sum += c; cnt += (c > 0u) ? 1u : 0u; mine = (j == x) ? c : mine; }
        if (sum == G) break;
        __builtin_amdgcn_s_sleep(1);
        if ((++sp & 255u) == 0u) { if (xb_ld(&bar[XB_TMO])) break; if (sp > XB_SPIN_CAP) { atomicAdd(&bar[XB_TMO], 1u); break; } }
    }
    nloc = mine > 0u ? mine : 1u; nx = cnt > 0u ? cnt : 1u;
}

__device__ __forceinline__ void xcd_barrier(const XcdBarrier& b) {
    asm volatile("s_waitcnt vmcnt(0)" ::: "memory");
    __syncthreads();
    if (threadIdx.x == 0) {
        unsigned* bar = b.bar;
        __builtin_amdgcn_s_waitcnt(0);
        unsigned nloc = b.st[0], nx = b.st[1];
        if (nloc == 0u) { xcd_barrier_complete(bar, b.x, nloc, nx); b.st[0] = nloc; b.st[1] = nx; }
        const unsigned old = xb_add(&bar[XB_XSUB(b.x)], 1u);
        const unsigned gen = old / nloc;
        if (old + 1u == (gen + 1u) * nloc) {
            __builtin_amdgcn_fence(__ATOMIC_RELEASE, "agent");
            asm volatile("s_waitcnt vmcnt(0)" ::: "memory");
            const unsigned og = xb_add(&bar[XB_TOP], 1u);
            const unsigned tg = og / nx;
            if (og + 1u == (tg + 1u) * nx) xb_add(&bar[XB_TOPGEN], 1u);
            else XB_SPIN(xb_ld(&bar[XB_TOPGEN]) == tg, bar);
            __builtin_amdgcn_fence(__ATOMIC_ACQUIRE, "agent");
            xb_add(&bar[XB_XGEN(b.x)], 1u);
            asm volatile("s_waitcnt vmcnt(0)" ::: "memory");
        } else {
            XB_SPIN(xb_ld(&bar[XB_XGEN(b.x)]) == gen, bar);
            __builtin_amdgcn_fence(__ATOMIC_ACQUIRE, "agent");
            asm volatile("s_waitcnt vmcnt(0)" ::: "memory");
        }
    }
    __syncthreads();
}

constexpr int NPH = 12;
__global__ void __launch_bounds__(512, 2) mega(Params P) {
    extern __shared__ __attribute__((aligned(16))) unsigned char lds_raw[];
    LAS unsigned char* lds = (LAS unsigned char*)lds_raw;
    unsigned char* ws = P.ws;
    volatile LAS unsigned* xst = (volatile LAS unsigned*)(lds + 131072);
    if (threadIdx.x < 4) xst[threadIdx.x] = 0u;
    __syncthreads();
    XcdBarrier xb = xcd_barrier_post((unsigned*)(ws + WS_BAR), xst);
#define RUN(i) ((i) >= P.ph_lo && (i) < P.ph_hi)
#define SEAM(i) do { if ((i) >= P.ph_lo && (i) + 1 < P.ph_hi) { xcd_barrier(xb); } } while (0)
    if (RUN(0)) phase0(P, (float*)lds_raw);
    SEAM(0);
    if (RUN(1)) { EpiZ E; E.zmain = (u16*)(ws + WS_Z + Z_MAIN); E.zgate = (u16*)(ws + WS_Z + Z_GATE); E.rstd = (const float*)(ws + WS_SMALL);
        run_gemm(lds, (const u16*)(ws + WS_Z + Z_TAIL), (const u16*)(ws + WS_WIN), 6144, 2048, E); }
    SEAM(1);
    if (RUN(2)) phase2(P, (u16*)lds_raw);
    SEAM(2);
    if (RUN(4)) rwkv_prep(P, lds_raw);
    SEAM(4);
    if (RUN(5)) {
        if ((int)blockIdx.x < NSCAN) rwkv_serial(P, lds_raw);
        else { attn_phase(P); __syncthreads();
            { EpiZG E; E.zgate = (u16*)(ws + WS_Z + Z_GATE); E.rstd = (const float*)(ws + WS_SMALL);
              run_gemm_sub(lds, (const u16*)(ws + WS_Z + Z_TAIL), (const u16*)(ws + WS_WIN) + (size_t)6144 * 2048, 3072, 2048, E, (int)gridDim.x - NSCAN, (int)blockIdx.x - NSCAN); } }
        { volatile int* qid = (volatile int*)(lds_raw + 98304); unsigned* head = (unsigned*)(ws + WS_CNT);
          for (;;) { __syncthreads(); if (threadIdx.x == 0) qid[0] = (int)atomicAdd(head, 1u); __syncthreads();
              const int q = qid[0]; if (q >= 1920) break;
              weight_tile(P, q < 1408 ? 1152 + q : 3264 + (q - 1408), (float*)lds_raw); } }
    }
    SEAM(5);
    if (RUN(6)) phase5(P);
    SEAM(6);
    if (RUN(7)) {
        { EpiBranch<0> E; E.mixed = (u16*)(ws + WS_Z); E.zgate = (const u16*)(ws + WS_Z + Z_GATE);
          run_gemm(lds, (const u16*)((unsigned char*)P.out + O_QN), (const u16*)(ws + WS_WBR1), 2048, 1024, E); }
        { EpiBranch<1> E; E.mixed = (u16*)(ws + WS_Z); E.zgate = (const u16*)(ws + WS_Z + Z_GATE);
          run_gemm(lds, (const u16*)(ws + WS_X + X_OATT), (const u16*)(ws + WS_WBR2), 2048, 1024, E); } }
    SEAM(7);
    if (RUN(8)) { EpiOut1 E; E.x = P.in[0]; E.x1 = P.out; E.x1b = (u16*)(ws + WS_X); E.rowss = (float*)(ws + WS_SMALL + 32768);
        run_gemm(lds, (const u16*)(ws + WS_Z), (const u16*)(ws + WS_WOUT), 2048, 2048, E); }
    SEAM(8);
    if (RUN(9)) { EpiUp E; E.uo = (u16*)(ws + WS_Z); E.rowss = (const float*)(ws + WS_SMALL + 32768);
        run_gemm(lds, (const u16*)(ws + WS_X), (const u16*)(ws + WS_WUP), NUP, 2048, E);
        { const int G_ = (int)gridDim.x, nfull = 1408 % G_, bid_ = (int)blockIdx.x;
          if (bid_ >= nfull) { __syncthreads(); for (int id = 2560 + (bid_ - nfull); id < 3264; id += G_ - nfull) weight_tile(P, id, (float*)lds_raw); } } }
    SEAM(9);
    if (RUN(10)) phase9(P);
    SEAM(10);
    if (RUN(11)) { EpiFinal E; E.out = P.out;
        run_gemm(lds, (const u16*)(ws + WS_ACT), (const u16*)(ws + WS_WDOWN), 2048, DFF, E); }
}

constexpr int LDS_BYTES = 131072 + 16;
extern "C" void kernel_launch(void* const* d_in, const int* in_sizes, int n_in, void* d_out, int out_size, void* d_ws, size_t ws_size, hipStream_t stream) {
    static int grid = 0;
    if (grid == 0) {
        if (n_in != 24 || out_size != MT * DM || ws_size < WS_END) { fprintf(stderr, "kernel_launch: unexpected shapes (n_in %d out %d ws %zu need %zu)\n", n_in, out_size, ws_size, (size_t)WS_END); grid = -1; return; }
        int dev = 0, cus = 0, per_cu = 0;
        hipGetDevice(&dev); hipDeviceGetAttribute(&cus, hipDeviceAttributeMultiprocessorCount, dev);
        if (hipFuncSetAttribute((const void*)mega, hipFuncAttributeMaxDynamicSharedMemorySize, LDS_BYTES) != hipSuccess) { fprintf(stderr, "kernel_launch: hipFuncSetAttribute failed\n"); grid = -1; return; }
        if (hipOccupancyMaxActiveBlocksPerMultiprocessor(&per_cu, (const void*)mega, 512, LDS_BYTES) != hipSuccess || per_cu < 1) { fprintf(stderr, "kernel_launch: occupancy query failed (%d)\n", per_cu); grid = -1; return; }
        grid = cus * per_cu; if (grid > 256) grid = 256;
        if (grid < 2 * NSCAN) { fprintf(stderr, "kernel_launch: grid %d too small\n", grid); grid = -1; return; }
    }
    if (grid < 0) return;
    Params p{};
    for (int i = 0; i < 24; ++i) p.in[i] = (const float*)d_in[i];
    p.out = (float*)d_out; p.ws = (unsigned char*)d_ws;
    if (hipMemsetAsync((unsigned char*)d_ws + WS_BAR, 0, 16384, stream) != hipSuccess) { fprintf(stderr, "kernel_launch: hipMemsetAsync of the barrier words failed\n"); return; }
    p.ph_lo = 0; p.ph_hi = NPH;
    { void* args[] = {&p}; hipError_t e = hipLaunchCooperativeKernel((const void*)mega, dim3(grid), dim3(512), args, LDS_BYTES, stream);
      if (e != hipSuccess) fprintf(stderr, "cooperative launch failed: %s (grid %d)\n", hipGetErrorString(e), grid); }

}
```

```cpp
#include <hip/hip_runtime.h>
#include <hip/hip_cooperative_groups.h>
#include <cstdio>
#include <cstdint>
namespace cg = cooperative_groups;
namespace pg8 {
#define PG8_LAS __attribute__((address_space(3)))
typedef unsigned short bf16_t;
typedef short bf16x8 __attribute__((ext_vector_type(8)));
typedef float f32x4 __attribute__((ext_vector_type(4)));
typedef unsigned u32x4 __attribute__((ext_vector_type(4)));
constexpr int BM = 256, BK = 64, HALF = 128, HTB = HALF * BK * 2  , STAGE_BYTES = 8 * HTB, NXCD = 8, WGM = 8;

__host__ __device__ __forceinline__ int lds_byte(int r, int c) { const int st = (r >> 4) * 2 + (c >> 5), rr = r & 15, cc = c & 31, ob = rr * 64 + cc * 2; return st * 1024 + (ob ^ (((ob >> 9) & 1) << 5)); }
__host__ __device__ __forceinline__ void stage_rc(int b, int& R, int& C) { const int st = b / 1024, sb = b % 1024, swz = sb ^ (((sb >> 9) & 1) << 5); R = (st >> 1) * 16 + swz / 64; C = (st & 1) * 32 + (swz % 64) / 2; }
__host__ __device__ __forceinline__ int perm32(int rho) { const int n = rho >> 4, i = rho & 15; return 8 * (i >> 2) + 4 * n + (i & 3); }

struct Unit { int pm, pn; };
struct Gemm { const bf16_t* A; const bf16_t* Bt; int M, N, K; };

struct StaticOrder {
    int nM, nN, nwg, G, c;
    __host__ __device__ void init(int M, int N, int G_, int c_) { nM = M / BM; nN = N / BM; nwg = nM * nN; G = G_; c = c_; }
    __host__ __device__ bool next(int i, Unit& u) const {
        const long L = (long)i * G + c; if (L >= nwg) return false;
        int wgid = (int)L; { const int q = nwg / NXCD, r = nwg % NXCD, xcd = wgid % NXCD, off = wgid / NXCD; wgid = (xcd < r ? xcd * (q + 1) : r * (q + 1) + (xcd - r) * q) + off; }
        const int nig = WGM * nN, gid = wgid / nig, fm = gid * WGM, gsz = (nM - fm) < WGM ? (nM - fm) : WGM;
        u.pm = fm + ((wgid % nig) % gsz); u.pn = (wgid % nig) / gsz; return true;
    }
    __device__ __forceinline__ void a_ready(const Unit&) const {}
    __device__ __forceinline__ void done(const Unit&) const {}
};
typedef __bf16 bf16v2_t __attribute__((ext_vector_type(2))); typedef float f32v2_t __attribute__((ext_vector_type(2)));
__device__ __forceinline__ unsigned cvt_pk_bf16(float lo, float hi) { const f32v2_t x = {lo, hi}; const bf16v2_t r = __builtin_convertvector(x, bf16v2_t); return __builtin_bit_cast(unsigned, r); }
template <class Epi, class Sched, bool ALIGN_EPI = false, bool SP2 = false>
__device__ __forceinline__ void gemm_phase(PG8_LAS unsigned char* lds, const Gemm g, const Sched& S, const Epi& E) {
    const int tid = threadIdx.x, wid = __builtin_amdgcn_readfirstlane(tid >> 6), lane = tid & 63, wr = wid >> 2, wc = wid & 3, fr = lane & 15, fq = lane >> 4;
    const int K = g.K, nt = K / BK;
    unsigned voffA[2], voffB[2];
#pragma unroll
    for (int i = 0; i < 2; ++i) { int R, C; stage_rc(tid * 16 + i * 8192, R, C); const int Rb = Epi::PERM ? ((R & ~31) + perm32(R & 31)) : R;
        voffA[i] = (unsigned)(R * K + C) * 2u; voffB[i] = (unsigned)(Rb * K + C) * 2u; }
    const size_t kstep = (size_t)(BK * 2);
    const size_t hstep = (size_t)HALF * K * 2;
    const size_t tstep = 2 * hstep;
    const unsigned ldsw = (unsigned)wid * 1024u;
    const int aoff = lds_byte(wr * 64 + fr, fq * 8), boff = lds_byte(wc * 32 + fr, fq * 8);
#define PG8_SA(b, h) (((b) * 2 + (h)) * HTB)
#define PG8_SB(b, h) ((4 + (b) * 2 + (h)) * HTB)
#define PG8_STAGE(bufoff, gbase, voff) do { _Pragma("unroll") for (int _i = 0; _i < 2; ++_i) \
        __builtin_amdgcn_global_load_lds((const unsigned*)((const char*)(gbase) + (voff)[_i]), (PG8_LAS unsigned*)(lds + (bufoff) + ldsw + _i * 8192), 16, 0, 0); } while (0)
#define PG8_LDA(dst, b, h) do { _Pragma("unroll") for (int m = 0; m < 4; ++m) _Pragma("unroll") for (int k = 0; k < 2; ++k) dst[m][k] = *(const PG8_LAS bf16x8*)(lds + PG8_SA(b, h) + aoff + m * 2048 + k * 1024); } while (0)
#define PG8_LDB(dst, b, h) do { _Pragma("unroll") for (int n = 0; n < 2; ++n) _Pragma("unroll") for (int k = 0; k < 2; ++k) dst[n][k] = *(const PG8_LAS bf16x8*)(lds + PG8_SB(b, h) + boff + n * 2048 + k * 1024); } while (0)
#define PG8_MMA(ai, bj, At, Bt) do { __builtin_amdgcn_s_setprio(1); _Pragma("unroll") for (int m = 0; m < 4; ++m) _Pragma("unroll") for (int n = 0; n < 2; ++n) _Pragma("unroll") for (int k = 0; k < 2; ++k) \
        acc[ai][bj][m][n] = __builtin_amdgcn_mfma_f32_16x16x32_bf16(Bt[n][k], At[m][k], acc[ai][bj][m][n], 0, 0, 0); __builtin_amdgcn_s_setprio(0); } while (0)
#define PG8_WAIT_V(n) asm volatile("s_waitcnt vmcnt(" #n ")" ::: "memory")
#define PG8_WAIT_L(n) asm volatile("s_waitcnt lgkmcnt(" #n ")" ::: "memory")
#define PG8_BAR __builtin_amdgcn_s_barrier()
#define PG8_SCHED __builtin_amdgcn_sched_barrier(0)
    Unit cur, nxt; int ui = 0;
    if (!S.next(0, cur)) return;
    f32x4 acc[2][2][4][2];
#pragma unroll
    for (int a = 0; a < 2; ++a)
#pragma unroll
        for (int b = 0; b < 2; ++b)
#pragma unroll
            for (int m = 0; m < 4; ++m)
#pragma unroll
                for (int n = 0; n < 2; ++n) acc[a][b][m][n] = (f32x4){0.f, 0.f, 0.f, 0.f};
    bf16x8 At[4][2], B0[2][2], B1[2][2];
    const char* cA = (const char*)g.A + (size_t)cur.pm * tstep; const char* cB = (const char*)g.Bt + (size_t)cur.pn * tstep;
    S.a_ready(cur);
    if constexpr (SP2) {
        PG8_STAGE(PG8_SB(0, 0), cB, voffB); PG8_STAGE(PG8_SB(0, 1), cB + hstep, voffB); PG8_STAGE(PG8_SA(0, 0), cA, voffA); PG8_STAGE(PG8_SA(0, 1), cA + hstep, voffA);
        if (wr == 1) PG8_BAR;
        PG8_WAIT_V(2); PG8_BAR;
        PG8_STAGE(PG8_SB(1, 0), cB + kstep, voffB); PG8_STAGE(PG8_SA(1, 0), cA + kstep, voffA); PG8_STAGE(PG8_SB(1, 1), cB + hstep + kstep, voffB);
        PG8_WAIT_V(6); PG8_BAR;
    } else {
        PG8_STAGE(PG8_SB(0, 0), cB, voffB); PG8_STAGE(PG8_SA(0, 0), cA, voffA); PG8_STAGE(PG8_SB(0, 1), cB + hstep, voffB); PG8_STAGE(PG8_SA(0, 1), cA + hstep, voffA);
        if (wr == 1) PG8_BAR;
        PG8_WAIT_V(4); PG8_BAR;
        PG8_STAGE(PG8_SB(1, 0), cB + kstep, voffB); PG8_STAGE(PG8_SA(1, 0), cA + kstep, voffA); PG8_STAGE(PG8_SB(1, 1), cB + hstep + kstep, voffB);
        PG8_WAIT_V(6); PG8_BAR;
    }
    for (;;) {
        const bool has_next = S.next(ui + 1, nxt);
        const char* nA = has_next ? (const char*)g.A + (size_t)nxt.pm * tstep : cA; const char* nB = has_next ? (const char*)g.Bt + (size_t)nxt.pn * tstep : cB;
        for (int t = 0; t < nt; t += 2) {
            const bool last = (t == nt - 2);
            const char* a1 = cA + (size_t)(t + 1) * kstep;
            const char* a2 = last ? nA : cA + (size_t)(t + 2) * kstep; const char* b2 = last ? nB : cB + (size_t)(t + 2) * kstep;
            const char* a3 = a2 + kstep; const char* b3 = b2 + kstep;
            if (last && has_next) S.a_ready(nxt);
            if constexpr (SP2) {
            PG8_LDB(B0, 0, 0); PG8_LDB(B1, 0, 1); PG8_SCHED; PG8_LDA(At, 0, 0); PG8_STAGE(PG8_SA(1, 1), a1 + hstep, voffA);
            PG8_WAIT_V(8); PG8_WAIT_L(0); PG8_BAR; PG8_MMA(0, 0, At, B0); PG8_MMA(0, 1, At, B1); PG8_BAR; PG8_SCHED;
            PG8_LDA(At, 0, 1); PG8_STAGE(PG8_SB(0, 0), b2, voffB); PG8_STAGE(PG8_SB(0, 1), b2 + hstep, voffB); PG8_STAGE(PG8_SA(0, 0), a2, voffA);
            PG8_WAIT_V(8); PG8_WAIT_L(0); PG8_BAR; PG8_MMA(1, 0, At, B0); PG8_MMA(1, 1, At, B1); PG8_BAR; PG8_SCHED;
            PG8_LDB(B0, 1, 0); PG8_LDB(B1, 1, 1); PG8_SCHED; PG8_LDA(At, 1, 0); PG8_STAGE(PG8_SA(0, 1), a2 + hstep, voffA);
            PG8_WAIT_V(8); PG8_WAIT_L(0); PG8_BAR; PG8_MMA(0, 0, At, B0); PG8_MMA(0, 1, At, B1); PG8_BAR; PG8_SCHED;
            PG8_LDA(At, 1, 1); PG8_STAGE(PG8_SB(1, 0), b3, voffB); PG8_STAGE(PG8_SB(1, 1), b3 + hstep, voffB); PG8_STAGE(PG8_SA(1, 0), a3, voffA);
            PG8_WAIT_V(8); PG8_WAIT_L(0); PG8_BAR; PG8_MMA(1, 0, At, B0); PG8_MMA(1, 1, At, B1); PG8_BAR; PG8_SCHED;
            } else {
            PG8_LDB(B0, 0, 0); PG8_SCHED; PG8_LDA(At, 0, 0); PG8_STAGE(PG8_SA(1, 1), a1 + hstep, voffA);
            PG8_WAIT_L(8); PG8_BAR; PG8_WAIT_L(0); PG8_MMA(0, 0, At, B0); PG8_BAR; PG8_SCHED;
            PG8_LDB(B1, 0, 1); PG8_STAGE(PG8_SB(0, 0), b2, voffB);
            PG8_BAR; PG8_WAIT_L(0); PG8_MMA(0, 1, At, B1); PG8_BAR;
            PG8_LDA(At, 0, 1); PG8_STAGE(PG8_SA(0, 0), a2, voffA);
            PG8_BAR; PG8_WAIT_L(0); PG8_MMA(1, 0, At, B0); PG8_BAR; PG8_SCHED;
            PG8_STAGE(PG8_SB(0, 1), b2 + hstep, voffB);
            PG8_WAIT_V(6); PG8_BAR; PG8_MMA(1, 1, At, B1); PG8_BAR;
            PG8_LDB(B0, 1, 0); PG8_SCHED; PG8_LDA(At, 1, 0); PG8_STAGE(PG8_SA(0, 1), a2 + hstep, voffA);
            PG8_WAIT_L(8); PG8_BAR; PG8_WAIT_L(0); PG8_MMA(0, 0, At, B0); PG8_BAR; PG8_SCHED;
            PG8_LDB(B1, 1, 1); PG8_STAGE(PG8_SB(1, 0), b3, voffB);
            PG8_BAR; PG8_WAIT_L(0); PG8_MMA(0, 1, At, B1); PG8_BAR;
            PG8_LDA(At, 1, 1); PG8_STAGE(PG8_SA(1, 0), a3, voffA);
            PG8_BAR; PG8_WAIT_L(0); PG8_MMA(1, 0, At, B0); PG8_BAR; PG8_SCHED;
            PG8_STAGE(PG8_SB(1, 1), b3 + hstep, voffB);
            PG8_WAIT_V(6); PG8_BAR; PG8_MMA(1, 1, At, B1); PG8_BAR;
            }
        }
        if constexpr (ALIGN_EPI) { if (wr == 0) PG8_BAR; }
        if constexpr (!Epi::AFTER_DRAIN) { E(acc, cur, wr, wc, fr, fq); S.done(cur); }
        if (!has_next) break;
#pragma unroll
        for (int a = 0; a < 2; ++a)
#pragma unroll
            for (int b = 0; b < 2; ++b)
#pragma unroll
                for (int m = 0; m < 4; ++m)
#pragma unroll
                    for (int n = 0; n < 2; ++n) acc[a][b][m][n] = (f32x4){0.f, 0.f, 0.f, 0.f};
        cur = nxt; cA = nA; cB = nB; ++ui;
        if constexpr (ALIGN_EPI) { if (wr == 1) PG8_BAR; }
    }
    PG8_WAIT_V(0);
    if constexpr (!ALIGN_EPI) { if (wr == 0) PG8_BAR; }
    PG8_BAR;
    if constexpr (Epi::AFTER_DRAIN) { E.fused(acc, cur, wr, wc, fr, fq, lds, wid, lane); S.done(cur); }
#undef PG8_SA
#undef PG8_SB
#undef PG8_STAGE
#undef PG8_LDA
#undef PG8_LDB
#undef PG8_MMA
#undef PG8_WAIT_V
#undef PG8_WAIT_L
#undef PG8_BAR
#undef PG8_SCHED
}
}

using pg8::f32x4; using pg8::bf16x8; using pg8::Unit; using pg8::cvt_pk_bf16;
typedef unsigned short u16;
#define LAS __attribute__((address_space(3)))

constexpr int MT = 8192, DM = 2048, SEQ = 4096, CH_ = 16;
constexpr int NZ = 9216, ZM = 5120, ZG = 4096, DFF = 5632, NUP = 11264, RWD = 1024;
constexpr size_t WS_WDOWN = 0;
constexpr size_t WS_WIN   = WS_WDOWN + (size_t)2048 * 5632 * 2;
constexpr size_t WS_WUP   = WS_WIN + (size_t)9216 * 2048 * 2;
constexpr size_t WS_WBR1  = WS_WUP + (size_t)11264 * 2048 * 2;
constexpr size_t WS_WBR2  = WS_WBR1 + (size_t)2048 * 1024 * 2;
constexpr size_t WS_WOUT  = WS_WBR2 + (size_t)2048 * 1024 * 2;
constexpr size_t WS_WLORA = WS_WOUT + (size_t)2048 * 2048 * 2;
constexpr size_t WS_Z     = WS_WLORA + (size_t)3072 * 512 * 2;
constexpr size_t Z_BYTES  = (size_t)MT * NUP * 2;
constexpr size_t WS_X     = WS_Z + Z_BYTES;
constexpr size_t WS_SMALL = WS_X + (size_t)MT * DM * 2;
constexpr size_t WS_Y     = WS_SMALL + 32768 + (size_t)MT * 32 * 4;
constexpr size_t WS_G     = WS_Y + (size_t)MT * 1024 * 2;
constexpr size_t WS_RK    = WS_G + (size_t)8192 * 64 * 4;
constexpr size_t WS_CNT   = WS_RK + (size_t)MT * 16 * 4;
constexpr size_t WS_BAR   = WS_CNT + 256;
constexpr size_t WS_END   = WS_BAR + 16384;
constexpr size_t WS_ACT   = WS_WIN;
static_assert(WS_Z - WS_WIN >= (size_t)MT * DFF * 2, "act overlay");
constexpr size_t Z_MAIN = 0, Z_GATE = (size_t)MT * ZM * 2, Z_TAIL = (size_t)MT * (ZM + ZG) * 2;
constexpr size_t Z_LW = 0, Z_A = (size_t)MT * RWD * 4, Z_G = 2 * (size_t)MT * RWD * 4;
constexpr size_t X_AP = 0, X_KN = (size_t)MT * 512 * 2, X_VT = X_KN + (size_t)MT * 256 * 2, X_OATT = X_VT + (size_t)MT * 256 * 2;
constexpr size_t O_RKV = 0, O_QN = (size_t)MT * 3072 * 2;

struct Params { const float* in[24]; float* out; unsigned char* ws; int ph_lo, ph_hi; };

__device__ __forceinline__ float bf2f(unsigned short b) { return __uint_as_float(((unsigned)b) << 16); }
__device__ __forceinline__ float bflo(unsigned u) { return __uint_as_float(u << 16); }
__device__ __forceinline__ float bfhi(unsigned u) { return __uint_as_float(u & 0xffff0000u); }
__device__ __forceinline__ u16 f2bf(float f) { return (u16)(cvt_pk_bf16(f, f) & 0xffffu); }
__device__ __forceinline__ float wave_sum(float v) {
#pragma unroll
    for (int o = 32; o; o >>= 1) v += __shfl_xor(v, o);
    return v; }
__device__ __forceinline__ float sigmoidf_(float x) { return 1.0f / (1.0f + __expf(-x)); }
template <int CTRL> __device__ __forceinline__ float dppf(float x) { return __int_as_float(__builtin_amdgcn_update_dpp(0, __float_as_int(x), CTRL, 0xF, 0xF, true)); }
__device__ __forceinline__ float row16_sum(float x) { x += dppf<0xB1>(x); x += dppf<0x4E>(x); x += dppf<0x141>(x); x += dppf<0x140>(x); return x; }

#define EPI_ROWS _Pragma("unroll") for (int ai = 0; ai < 2; ++ai) _Pragma("unroll") for (int m = 0; m < 4; ++m)
#define EPI_COLS _Pragma("unroll") for (int bj = 0; bj < 2; ++bj) _Pragma("unroll") for (int n = 0; n < 2; ++n)
struct EpiZ {
    static constexpr bool PERM = true, AFTER_DRAIN = false;
    u16* zmain; u16* zgate; const float* rstd;
    __device__ __forceinline__ void operator()(const f32x4 (&acc)[2][2][4][2], const Unit& u, int wr, int wc, int fr, int fq) const {
        u16* base; int ld, c0;
        if (u.pn < 20) { base = zmain; ld = ZM; c0 = u.pn * 256; } else { base = zgate; ld = ZG; c0 = (u.pn - 20) * 256; }
        const int row0 = u.pm * 256 + wr * 64 + fr; c0 += wc * 32 + 8 * fq;
        float rsv[2][4];
        EPI_ROWS rsv[ai][m] = rstd[row0 + ai * 128 + m * 16];
        EPI_ROWS { const int row = row0 + ai * 128 + m * 16; const float rs = rsv[ai][m]; u16* rp = base + (size_t)row * ld + c0;
#pragma unroll
            for (int bj = 0; bj < 2; ++bj) { const f32x4 v0 = acc[ai][bj][m][0] * rs, v1 = acc[ai][bj][m][1] * rs;
                uint4 w; w.x = cvt_pk_bf16(v0[0], v0[1]); w.y = cvt_pk_bf16(v0[2], v0[3]); w.z = cvt_pk_bf16(v1[0], v1[1]); w.w = cvt_pk_bf16(v1[2], v1[3]); *(uint4*)(rp + bj * 128) = w; } }
    }
};
struct EpiLora {
    static constexpr bool PERM = true, AFTER_DRAIN = false;
    float* lw; float* av; u16* g; const float* w0; const float* a0;
    __device__ __forceinline__ void operator()(const f32x4 (&acc)[2][2][4][2], const Unit& u, int wr, int wc, int fr, int fq) const {
        const int row0 = u.pm * 256 + wr * 64 + fr; const int kind = u.pn >> 2; const int c0 = (u.pn & 3) * 256 + wc * 32 + 8 * fq;
        if (kind == 0) {
            EPI_ROWS { const int row = row0 + ai * 128 + m * 16;
                EPI_COLS { const int col = c0 + bj * 128 + n * 4; const f32x4 v = acc[ai][bj][m][n]; const f32x4 b = *(const f32x4*)(w0 + col); f32x4 o;
#pragma unroll
                    for (int j = 0; j < 4; ++j) { const float y = -(b[j] + v[j]); const float sp = fmaxf(y, 0.f) + __logf(1.0f + __expf(-fabsf(y))); o[j] = -__expf(-sp - 0.5f); }
                    *(f32x4*)(lw + (size_t)row * RWD + col) = o; } }
        } else if (kind == 1) {
            EPI_ROWS { const int row = row0 + ai * 128 + m * 16;
                EPI_COLS { const int col = c0 + bj * 128 + n * 4; const f32x4 v = acc[ai][bj][m][n]; const f32x4 b = *(const f32x4*)(a0 + col); f32x4 o;
#pragma unroll
                    for (int j = 0; j < 4; ++j) o[j] = sigmoidf_(b[j] + v[j]);
                    *(f32x4*)(av + (size_t)row * RWD + col) = o; } }
        } else {
            EPI_ROWS { const int row = row0 + ai * 128 + m * 16;
#pragma unroll
                for (int bj = 0; bj < 2; ++bj) { const f32x4 v0 = acc[ai][bj][m][0], v1 = acc[ai][bj][m][1];
                    uint4 w; w.x = cvt_pk_bf16(v0[0], v0[1]); w.y = cvt_pk_bf16(v0[2], v0[3]); w.z = cvt_pk_bf16(v1[0], v1[1]); w.w = cvt_pk_bf16(v1[2], v1[3]); *(uint4*)(g + (size_t)row * RWD + c0 + bj * 128) = w; } }
        }
    }
};
template <int PASS> struct EpiBranch {
    static constexpr bool PERM = true, AFTER_DRAIN = false;
    u16* mixed; const u16* zgate;
    __device__ __forceinline__ void operator()(const f32x4 (&acc)[2][2][4][2], const Unit& u, int wr, int wc, int fr, int fq) const {
        const int row0 = u.pm * 256 + wr * 64 + fr; const int c0 = u.pn * 256 + wc * 32 + 8 * fq;
        uint4 ga[2], gn[2], ma[2], mn[2];
#pragma unroll
        for (int bj = 0; bj < 2; ++bj) { ga[bj] = *(const uint4*)(zgate + (size_t)row0 * ZG + PASS * 2048 + c0 + bj * 128); ma[bj] = make_uint4(0u, 0u, 0u, 0u); if (PASS == 1) ma[bj] = *(const uint4*)(mixed + (size_t)row0 * DM + c0 + bj * 128); gn[bj] = ga[bj]; mn[bj] = ma[bj]; }
#pragma unroll
        for (int r = 0; r < 8; ++r) { const int ai = r >> 2, m = r & 3; const int row = row0 + ai * 128 + m * 16;
            if (r < 7) { const int rown = row0 + ((r + 1) >> 2) * 128 + ((r + 1) & 3) * 16;
#pragma unroll
                for (int bj = 0; bj < 2; ++bj) { gn[bj] = *(const uint4*)(zgate + (size_t)rown * ZG + PASS * 2048 + c0 + bj * 128); if (PASS == 1) mn[bj] = *(const uint4*)(mixed + (size_t)rown * DM + c0 + bj * 128); } }
#pragma unroll
            for (int bj = 0; bj < 2; ++bj) { const int col = c0 + bj * 128; const f32x4 v0 = acc[ai][bj][m][0], v1 = acc[ai][bj][m][1]; const uint4 gz = ga[bj];
                float o[8]; o[0] = sigmoidf_(bflo(gz.x)) * v0[0]; o[1] = sigmoidf_(bfhi(gz.x)) * v0[1]; o[2] = sigmoidf_(bflo(gz.y)) * v0[2]; o[3] = sigmoidf_(bfhi(gz.y)) * v0[3];
                o[4] = sigmoidf_(bflo(gz.z)) * v1[0]; o[5] = sigmoidf_(bfhi(gz.z)) * v1[1]; o[6] = sigmoidf_(bflo(gz.w)) * v1[2]; o[7] = sigmoidf_(bfhi(gz.w)) * v1[3];
                if (PASS == 1) { const uint4 pm = ma[bj]; o[0] += bflo(pm.x); o[1] += bfhi(pm.x); o[2] += bflo(pm.y); o[3] += bfhi(pm.y); o[4] += bflo(pm.z); o[5] += bfhi(pm.z); o[6] += bflo(pm.w); o[7] += bfhi(pm.w); }
                uint4 w; w.x = cvt_pk_bf16(o[0], o[1]); w.y = cvt_pk_bf16(o[2], o[3]); w.z = cvt_pk_bf16(o[4], o[5]); w.w = cvt_pk_bf16(o[6], o[7]); *(uint4*)(mixed + (size_t)row * DM + col) = w; }
#pragma unroll
            for (int bj = 0; bj < 2; ++bj) { ga[bj] = gn[bj]; ma[bj] = mn[bj]; } }
    }
};
struct EpiOut1 {
    static constexpr bool PERM = true, AFTER_DRAIN = false;
    const float* x; float* x1; u16* x1b; float* rowss;
    __device__ __forceinline__ void operator()(const f32x4 (&acc)[2][2][4][2], const Unit& u, int wr, int wc, int fr, int fq) const {
        const int row0 = u.pm * 256 + wr * 64 + fr; const int c0 = u.pn * 256 + wc * 32 + 8 * fq;
        f32x4 xa[2][2], xn[2][2];
#pragma unroll
        for (int bj = 0; bj < 2; ++bj) { const size_t o = (size_t)row0 * DM + c0 + bj * 128; xa[bj][0] = *(const f32x4*)(x + o); xa[bj][1] = *(const f32x4*)(x + o + 4); }
#pragma unroll
        for (int r = 0; r < 8; ++r) { const int ai = r >> 2, m = r & 3; const int row = row0 + ai * 128 + m * 16; float ss = 0.f;
            if (r < 7) { const int rown = row0 + ((r + 1) >> 2) * 128 + ((r + 1) & 3) * 16;
#pragma unroll
                for (int bj = 0; bj < 2; ++bj) { const size_t o = (size_t)rown * DM + c0 + bj * 128; xn[bj][0] = *(const f32x4*)(x + o); xn[bj][1] = *(const f32x4*)(x + o + 4); } }
#pragma unroll
            for (int bj = 0; bj < 2; ++bj) { const size_t o = (size_t)row * DM + c0 + bj * 128;
                const f32x4 v0 = acc[ai][bj][m][0] + xa[bj][0], v1 = acc[ai][bj][m][1] + xa[bj][1];
                ss += (v0[0] * v0[0] + v0[1] * v0[1] + v0[2] * v0[2] + v0[3] * v0[3]) + (v1[0] * v1[0] + v1[1] * v1[1] + v1[2] * v1[2] + v1[3] * v1[3]);
                uint4 w; w.x = cvt_pk_bf16(v0[0], v0[1]); w.y = cvt_pk_bf16(v0[2], v0[3]); w.z = cvt_pk_bf16(v1[0], v1[1]); w.w = cvt_pk_bf16(v1[2], v1[3]); *(uint4*)(x1b + o) = w; }
            ss += __shfl_xor(ss, 16); ss += __shfl_xor(ss, 32);
            if (fq == 0) rowss[(size_t)row * 32 + u.pn * 4 + wc] = ss;
#pragma unroll
            for (int bj = 0; bj < 2; ++bj) { xa[bj][0] = xn[bj][0]; xa[bj][1] = xn[bj][1]; } }
    }
};
struct EpiUp {
    static constexpr bool PERM = true, AFTER_DRAIN = false;
    u16* uo; const float* rowss;
    __device__ __forceinline__ void operator()(const f32x4 (&acc)[2][2][4][2], const Unit& u, int wr, int wc, int fr, int fq) const {
        const int row0 = u.pm * 256 + wr * 64 + fr; const int c0 = u.pn * 256 + wc * 32 + 8 * fq;
        float rsv[2][4];
        EPI_ROWS { const int row = row0 + ai * 128 + m * 16;
            const f32x4 p0 = *(const f32x4*)(rowss + (size_t)row * 32 + fq * 8), p1 = *(const f32x4*)(rowss + (size_t)row * 32 + fq * 8 + 4);
            float ss = ((p0[0] + p0[1]) + (p0[2] + p0[3])) + ((p1[0] + p1[1]) + (p1[2] + p1[3]));
            ss += __shfl_xor(ss, 16); ss += __shfl_xor(ss, 32);
            rsv[ai][m] = rsqrtf(ss * (1.0f / 2048.0f) + 1e-6f); }
        EPI_ROWS { const int row = row0 + ai * 128 + m * 16; const float rs = rsv[ai][m]; u16* rp = uo + (size_t)row * NUP + c0;
#pragma unroll
            for (int bj = 0; bj < 2; ++bj) { const f32x4 v0 = acc[ai][bj][m][0] * rs, v1 = acc[ai][bj][m][1] * rs;
                uint4 w; w.x = cvt_pk_bf16(v0[0], v0[1]); w.y = cvt_pk_bf16(v0[2], v0[3]); w.z = cvt_pk_bf16(v1[0], v1[1]); w.w = cvt_pk_bf16(v1[2], v1[3]); *(uint4*)(rp + bj * 128) = w; } }
    }
};
struct EpiFinal {
    static constexpr bool PERM = true, AFTER_DRAIN = false;
    float* out; const u16* x1b;
    __device__ __forceinline__ void operator()(const f32x4 (&acc)[2][2][4][2], const Unit& u, int wr, int wc, int fr, int fq) const {
        const int row0 = u.pm * 256 + wr * 64 + fr; const int c0 = u.pn * 256 + wc * 32 + 8 * fq;
        uint4 xa[2], xn[2];
#pragma unroll
        for (int bj = 0; bj < 2; ++bj) { xa[bj] = *(const uint4*)(x1b + (size_t)row0 * DM + c0 + bj * 128); xn[bj] = xa[bj]; }
#pragma unroll
        for (int r = 0; r < 8; ++r) { const int ai = r >> 2, m = r & 3; const int row = row0 + ai * 128 + m * 16;
            if (r < 7) { const int rown = row0 + ((r + 1) >> 2) * 128 + ((r + 1) & 3) * 16;
#pragma unroll
                for (int bj = 0; bj < 2; ++bj) xn[bj] = *(const uint4*)(x1b + (size_t)rown * DM + c0 + bj * 128); }
#pragma unroll
            for (int bj = 0; bj < 2; ++bj) { float* op = out + (size_t)row * DM + c0 + bj * 128; const uint4 xb = xa[bj];
                f32x4 a0 = acc[ai][bj][m][0], a1 = acc[ai][bj][m][1];
                a0[0] += bflo(xb.x); a0[1] += bfhi(xb.x); a0[2] += bflo(xb.y); a0[3] += bfhi(xb.y); a1[0] += bflo(xb.z); a1[1] += bfhi(xb.z); a1[2] += bflo(xb.w); a1[3] += bfhi(xb.w);
                *(f32x4*)op = a0; *(f32x4*)(op + 4) = a1; }
#pragma unroll
            for (int bj = 0; bj < 2; ++bj) xa[bj] = xn[bj]; }
    }
};

template <class Epi> __device__ __forceinline__ void run_gemm(LAS unsigned char* lds, const u16* A, const u16* Bt, int N, int K, const Epi& E) {
    pg8::Gemm g; g.A = A; g.Bt = Bt; g.M = MT; g.N = N; g.K = K;
    pg8::StaticOrder S; S.init(MT, N, (int)gridDim.x, (int)blockIdx.x);
    pg8::gemm_phase<Epi, pg8::StaticOrder, true, true>(lds, g, S, E);
}

template <class Epi> __device__ __forceinline__ void run_gemm_sub(LAS unsigned char* lds, const u16* A, const u16* Bt, int N, int K, const Epi& E, int G, int c) {
    pg8::Gemm g; g.A = A; g.Bt = Bt; g.M = MT; g.N = N; g.K = K;
    pg8::StaticOrder S; S.init(MT, N, G, c);
    pg8::gemm_phase<Epi, pg8::StaticOrder, true, true>(lds, g, S, E);
}
struct EpiZG {
    static constexpr bool PERM = true, AFTER_DRAIN = false;
    u16* zgate; const float* rstd;
    __device__ __forceinline__ void operator()(const f32x4 (&acc)[2][2][4][2], const Unit& u, int wr, int wc, int fr, int fq) const {
        const int row0 = u.pm * 256 + wr * 64 + fr; const int c0 = 1024 + u.pn * 256 + wc * 32 + 8 * fq;
        float rsv[2][4];
        EPI_ROWS rsv[ai][m] = rstd[row0 + ai * 128 + m * 16];
        EPI_ROWS { const int row = row0 + ai * 128 + m * 16; const float rs = rsv[ai][m]; u16* rp = zgate + (size_t)row * ZG + c0;
#pragma unroll
            for (int bj = 0; bj < 2; ++bj) { const f32x4 v0 = acc[ai][bj][m][0] * rs, v1 = acc[ai][bj][m][1] * rs;
                uint4 w; w.x = cvt_pk_bf16(v0[0], v0[1]); w.y = cvt_pk_bf16(v0[2], v0[3]); w.z = cvt_pk_bf16(v1[0], v1[1]); w.w = cvt_pk_bf16(v1[2], v1[3]); *(uint4*)(rp + bj * 128) = w; } }
    }
};

__device__ __forceinline__ void tr_tile(const float* __restrict__ src, int ldn, int nsrc0, u16* __restrict__ dst, int K, int k0, int ndst0, const float* __restrict__ scale, float* tile) {
    const int tid = threadIdx.x, nc4 = (tid & 15) * 4, kr0 = tid >> 4;
    float4 v[8];
#pragma unroll
    for (int i = 0; i < 8; ++i) { const int kr = kr0 + 32 * i; v[i] = make_float4(0.f, 0.f, 0.f, 0.f);
        if (nsrc0 >= 0) v[i] = *(const float4*)(src + (size_t)(k0 + kr) * ldn + nsrc0 + nc4); }
#pragma unroll
    for (int i = 0; i < 8; ++i) { const int kr = kr0 + 32 * i; const float sc = scale ? scale[k0 + kr] : 1.0f; float* tp = tile + kr * 65 + nc4;
        tp[0] = v[i].x * sc; tp[1] = v[i].y * sc; tp[2] = v[i].z * sc; tp[3] = v[i].w * sc; }
    __syncthreads();
    const int nr = tid >> 3, kb = (tid & 7) * 8;
#pragma unroll
    for (int q = 0; q < 4; ++q) { const int kc = kb + 64 * q; uint4 w;
        w.x = cvt_pk_bf16(tile[(kc + 0) * 65 + nr], tile[(kc + 1) * 65 + nr]); w.y = cvt_pk_bf16(tile[(kc + 2) * 65 + nr], tile[(kc + 3) * 65 + nr]);
        w.z = cvt_pk_bf16(tile[(kc + 4) * 65 + nr], tile[(kc + 5) * 65 + nr]); w.w = cvt_pk_bf16(tile[(kc + 6) * 65 + nr], tile[(kc + 7) * 65 + nr]);
        *(uint4*)(dst + (size_t)(ndst0 + nr) * K + k0 + kc) = w; }
    __syncthreads();
}
constexpr int WT_IN = 1152, WT_ALL = 3776;
__device__ __forceinline__ void weight_tile(const Params& P, int id, float* tile) {
    unsigned char* ws = P.ws;
    if (id < 1152) { const int nt = id % 144, kt = id / 144; const int ns = nt < 55 ? nt * 64 : (nt == 55 ? -1 : nt * 64 - 64);
        tr_tile(P.in[2], 9152, ns, (u16*)(ws + WS_WIN), 2048, kt * 256, nt * 64, P.in[1], tile); }
    else if (id < 1152 + 1408) { const int j = id - 1152, nt = j % 176, kt = j / 176;
        tr_tile(P.in[20], NUP, nt * 64, (u16*)(ws + WS_WUP), 2048, kt * 256, nt * 64, P.in[19], tile); }
    else if (id < 2560 + 704) { const int j = id - 2560, nt = j % 32, kt = j / 32;
        tr_tile(P.in[23], 2048, nt * 64, (u16*)(ws + WS_WDOWN), 5632, kt * 256, nt * 64, nullptr, tile); }
    else if (id < 3264 + 128) { const int j = id - 3264, nt = j % 32, kt = j / 32;
        tr_tile(P.in[17], 2048, nt * 64, (u16*)(ws + WS_WBR1), 1024, kt * 256, nt * 64, nullptr, tile); }
    else if (id < 3392 + 128) { const int j = id - 3392, nt = j % 32, kt = j / 32;
        tr_tile(P.in[17] + (size_t)1024 * 2048, 2048, nt * 64, (u16*)(ws + WS_WBR2), 1024, kt * 256, nt * 64, nullptr, tile); }
    else { const int j = id - 3520, nt = j % 32, kt = j / 32;
        tr_tile(P.in[18], 2048, nt * 64, (u16*)(ws + WS_WOUT), 2048, kt * 256, nt * 64, nullptr, tile); }
}
__device__ __forceinline__ void win_tile(const Params& P, int kt, int nt, float* tile) {
    const int ns = nt < 55 ? nt * 64 : (nt == 55 ? -1 : nt * 64 - 64);
    tr_tile(P.in[2], 9152, ns, (u16*)(P.ws + WS_WIN), 2048, kt * 256, nt * 64, P.in[1], tile);
}
__device__ void phase0(const Params& P, float* tile) {
    unsigned char* ws = P.ws; const int G = gridDim.x, bid = blockIdx.x, tid = threadIdx.x;
    if (bid == 0 && tid == 0) *(unsigned*)(ws + WS_CNT) = 0u;
    for (int id = bid; id < 1152; id += G) win_tile(P, id / 144, id % 144, tile);
    { u16* w2t = (u16*)(ws + WS_WLORA); u16* a2t = w2t + 1024 * 96; u16* g2t = a2t + 1024 * 96;
      for (int idx = bid * 512 + tid; idx < 448 * 1024; idx += G * 512) { const int kk = idx >> 10, n = idx & 1023;
          if (kk < 96) w2t[n * 96 + kk] = f2bf(P.in[5][(size_t)kk * 1024 + n]);
          else if (kk < 192) a2t[n * 96 + (kk - 96)] = f2bf(P.in[7][(size_t)(kk - 96) * 1024 + n]);
          else g2t[n * 256 + (kk - 192)] = f2bf(P.in[8][(size_t)(kk - 192) * 1024 + n]); } }
    { const int lane = tid & 63, gw = bid * 8 + (tid >> 6), nw = G * 8; u16* xb = (u16*)(ws + WS_Z + Z_TAIL); float* rstd1 = (float*)(ws + WS_SMALL);
      for (int t = gw; t < MT; t += nw) { const float4* xr = (const float4*)(P.in[0] + (size_t)t * DM); float ss = 0.f;
#pragma unroll
          for (int i = 0; i < 8; ++i) { const float4 v = xr[lane + 64 * i]; ss += v.x * v.x + v.y * v.y + v.z * v.z + v.w * v.w;
              uint2 w; w.x = cvt_pk_bf16(v.x, v.y); w.y = cvt_pk_bf16(v.z, v.w); *(uint2*)(xb + (size_t)t * DM + (lane + 64 * i) * 4) = w; }
          ss = wave_sum(ss); if (lane == 0) rstd1[t] = rsqrtf(ss * (1.0f / 2048.0f) + 1e-6f); } }
}

__device__ void phase2(const Params& P, u16* tile) {
    unsigned char* ws = P.ws; const int G = gridDim.x, bid = blockIdx.x, tid = threadIdx.x, lane = tid & 63;
    const u16* zmain = (const u16*)(ws + WS_Z + Z_MAIN);
    u16* rkv = (u16*)((unsigned char*)P.out + O_RKV); u16* Qn = (u16*)((unsigned char*)P.out + O_QN);
    u16* Ap = (u16*)(ws + WS_X + X_AP); u16* Kn = (u16*)(ws + WS_X + X_KN); u16* Vt = (u16*)(ws + WS_X + X_VT);
    const float* mu = P.in[3];
    const int d0 = (lane * 2) & 63; const float qg0 = P.in[14][d0] * 0.125f, qg1 = P.in[14][d0 + 1] * 0.125f, kg0 = P.in[15][d0], kg1 = P.in[15][d0 + 1];
    for (int t = bid * 8 + (tid >> 6); t < MT; t += G * 8) {
        const u16* zr = zmain + (size_t)t * ZM; const bool hp = (t & (SEQ - 1)) != 0; const u16* zp = hp ? zr - ZM : zr;
        unsigned zz[28], pp[28], qk[10]; float2 m2[28];
#pragma unroll
        for (int i = 0; i < 28; ++i) { const int c = i * 128 + lane * 2; zz[i] = 0u; pp[i] = 0u; m2[i] = make_float2(0.f, 0.f);
            if (i < 27 || lane < 32) { zz[i] = *(const unsigned*)(zr + c); pp[i] = *(const unsigned*)(zp + c); m2[i] = *(const float2*)(mu + c); } }
#pragma unroll
        for (int i = 0; i < 10; ++i) qk[i] = *(const unsigned*)(zr + 3584 + i * 128 + lane * 2);
#pragma unroll
        for (int i = 0; i < 28; ++i) { const int c = i * 128 + lane * 2;
            if (i < 27 || lane < 32) { const unsigned pv = hp ? pp[i] : 0u;
                const float z0 = bflo(zz[i]), z1 = bfhi(zz[i]); const float a0 = z0 + (bflo(pv) - z0) * m2[i].x, a1 = z1 + (bfhi(pv) - z1) * m2[i].y;
                if (i < 24) *(unsigned*)(rkv + (size_t)t * 3072 + c) = cvt_pk_bf16(a0, a1);
                else if (c < 3168) *(unsigned*)(Ap + (size_t)t * 512 + (c - 3072)) = cvt_pk_bf16(tanhf(a0), tanhf(a1));
                else if (c < 3264) *(unsigned*)(Ap + (size_t)t * 512 + 96 + (c - 3168)) = cvt_pk_bf16(a0, a1);
                else *(unsigned*)(Ap + (size_t)t * 512 + 256 + (c - 3264)) = cvt_pk_bf16(sigmoidf_(a0), sigmoidf_(a1)); } }
        if (lane < 32) *(unsigned*)(Ap + (size_t)t * 512 + 192 + lane * 2) = 0u;
#pragma unroll
        for (int i = 0; i < 10; ++i) { const float v0 = bflo(qk[i]), v1 = bfhi(qk[i]); float ss = row16_sum(v0 * v0 + v1 * v1); ss += __shfl_xor(ss, 16);
            const float rs = rsqrtf(ss * (1.0f / 64.0f) + 1e-6f);
            if (i < 8) *(unsigned*)(Qn + (size_t)t * 1024 + i * 128 + lane * 2) = cvt_pk_bf16(v0 * rs * qg0, v1 * rs * qg1);
            else *(unsigned*)(Kn + (size_t)t * 256 + (i - 8) * 128 + lane * 2) = cvt_pk_bf16(v0 * rs * kg0, v1 * rs * kg1); }
    }
    for (int tl = bid; tl < MT / 64; tl += G) { const int t0 = tl * 64;
        __syncthreads();
        for (int i = 0; i < 16; ++i) { const int idx = tid + 512 * i, r = idx >> 7, cp = idx & 127; const unsigned vv = *(const unsigned*)(zmain + (size_t)(t0 + r) * ZM + 4864 + 2 * cp);
            tile[(2 * cp) * 66 + r] = (u16)(vv & 0xffffu); tile[(2 * cp + 1) * 66 + r] = (u16)(vv >> 16); }
        __syncthreads();
        const int b = t0 >> 12, s0 = t0 & (SEQ - 1);
        for (int i = 0; i < 16; ++i) { const int idx = tid + 512 * i, c = idx >> 5, sp = idx & 31;
            const unsigned w = (unsigned)tile[c * 66 + 2 * sp] | ((unsigned)tile[c * 66 + 2 * sp + 1] << 16);
            *(unsigned*)(Vt + ((size_t)(b * 4 + (c >> 6)) * 64 + (c & 63)) * SEQ + s0 + 2 * sp) = w; }
    }
}

constexpr int NSCAN = 32;
#define LDS_BARRIER() do { asm volatile("s_waitcnt lgkmcnt(0)" ::: "memory"); __builtin_amdgcn_s_barrier(); asm volatile("" ::: "memory"); } while (0)
__device__ __forceinline__ float row8_sum(float x) { x += dppf<0xB1>(x); x += dppf<0x4E>(x); x += dppf<0x141>(x); return x; }
__device__ void rwkv_prep(const Params& P, unsigned char* lds_raw) {
    unsigned char* ws = P.ws; const int tid = threadIdx.x, q4 = tid >> 7, lt = tid & 127, lane = tid & 63, qw = (tid >> 6) & 1, fr = lane & 15, fq = lane >> 4;
    unsigned char* lwb = ws + WS_Z + Z_LW; unsigned char* ab = ws + WS_Z + Z_A; u16* rkv = (u16*)((unsigned char*)P.out + O_RKV);
    float* gbuf = (float*)(ws + WS_G); float* rkb = (float*)(ws + WS_RK);
    const u16* Apx = (const u16*)(ws + WS_X + X_AP); const u16* w2t = (const u16*)(ws + WS_WLORA); const u16* a2t = w2t + 1024 * 96; const u16* g2t = a2t + 1024 * 96; u16* gout = (u16*)(ws + WS_Z + Z_G);
    unsigned char* L0 = lds_raw + q4 * 32768;
    u16* sAt = (u16*)L0; u16* sBt = sAt + 16 * 72; u16* sKt = sBt + 16 * 72; u16* sRt = sKt + 16 * 72;
    u16* sVt = (u16*)(L0 + 9216); u16* sAak = (u16*)(L0 + 12288); float* sN = (float*)(L0 + 13312); float* sRHS = (float*)(L0 + 14400); float* sL = (float*)(L0 + 22848); float* sAf = (float*)(L0 + 26944);
    const int tl = lt >> 3, c8 = (lt & 7) * 8;
    uint4 n_r, n_k, n_v; float4 n_kkw[2], n_kaw[2], n_rkw[2]; bf16x8 n_At[3], n_Aa[3], n_Ag[8];
    auto unit_of = [&](int it_) { if ((int)gridDim.x == 256) { const int s_ = (it_ & 255) * 4 + q4; return (s_ >> 5) * 256 + (s_ & 31) + 32 * (it_ >> 8); } return it_ * 4 + q4; };
    auto fetch = [&](int it_) { const int unit_ = unit_of(it_), b_ = unit_ >> 12, h_ = (unit_ >> 8) & 15, c_ = unit_ & 255; const size_t t_ = (size_t)b_ * SEQ + c_ * CH_ + tl; const int hc_ = h_ * 64 + c8;
        n_r = *(const uint4*)(rkv + t_ * 3072 + hc_); n_k = *(const uint4*)(rkv + t_ * 3072 + 1024 + hc_); n_v = *(const uint4*)(rkv + t_ * 3072 + 2048 + hc_);
#pragma unroll
        for (int i = 0; i < 2; ++i) {
            n_kkw[i] = *(const float4*)(P.in[9] + hc_ + 4 * i); n_kaw[i] = *(const float4*)(P.in[10] + hc_ + 4 * i); n_rkw[i] = *(const float4*)(P.in[11] + hc_ + 4 * i); }
        const u16* ar_ = Apx + ((size_t)b_ * SEQ + c_ * CH_ + fr) * 512 + 8 * fq;
#pragma unroll
        for (int ks = 0; ks < 3; ++ks) { n_At[ks] = *(const bf16x8*)(ar_ + 32 * ks); n_Aa[ks] = *(const bf16x8*)(ar_ + 96 + 32 * ks); }
#pragma unroll
        for (int ks = 0; ks < 8; ++ks) n_Ag[ks] = *(const bf16x8*)(ar_ + 256 + 32 * ks); };
    if ((int)blockIdx.x < 2048) fetch(blockIdx.x);
    for (int it = blockIdx.x; it < 2048; it += gridDim.x) {
        const int unit = unit_of(it), b = unit >> 12, h = (unit >> 8) & 15, c = unit & 255; const size_t t0 = (size_t)b * SEQ + c * CH_, t = t0 + tl;
#pragma unroll
        for (int n2 = 0; n2 < 2; ++n2) { const int cn = (qw * 2 + n2) * 16 + fr, nrow = h * 64 + cn;
            f32x4 accw = {0.f, 0.f, 0.f, 0.f}, acca = {0.f, 0.f, 0.f, 0.f}, accg = {0.f, 0.f, 0.f, 0.f};
#pragma unroll
            for (int ks = 0; ks < 3; ++ks) { const bf16x8 bw = *(const bf16x8*)(w2t + nrow * 96 + 32 * ks + 8 * fq), ba = *(const bf16x8*)(a2t + nrow * 96 + 32 * ks + 8 * fq);
                accw = __builtin_amdgcn_mfma_f32_16x16x32_bf16(n_At[ks], bw, accw, 0, 0, 0); acca = __builtin_amdgcn_mfma_f32_16x16x32_bf16(n_Aa[ks], ba, acca, 0, 0, 0); }
#pragma unroll
            for (int ks = 0; ks < 8; ++ks) { const bf16x8 bg = *(const bf16x8*)(g2t + nrow * 256 + 32 * ks + 8 * fq); accg = __builtin_amdgcn_mfma_f32_16x16x32_bf16(n_Ag[ks], bg, accg, 0, 0, 0); }
            const float w0v = P.in[4][nrow], a0v = P.in[6][nrow];
#pragma unroll
            for (int j = 0; j < 4; ++j) { const int tt = 4 * fq + j; const float y = -(w0v + accw[j]); const float sp = fmaxf(y, 0.f) + __logf(1.0f + __expf(-fabsf(y)));
                sL[tt * 64 + cn] = -__expf(-sp - 0.5f); sAf[tt * 64 + cn] = sigmoidf_(a0v + acca[j]); gout[(t0 + tt) * RWD + nrow] = f2bf(accg[j]); } }
        LDS_BARRIER();
        const unsigned ru[4] = {n_r.x, n_r.y, n_r.z, n_r.w}, ku[4] = {n_k.x, n_k.y, n_k.z, n_k.w}, vu[4] = {n_v.x, n_v.y, n_v.z, n_v.w};
        float rr[8], kr[8], aa[8], lw[8], kkw_[8], kaw_[8], rkw_[8];
        { const float4 l0 = *(const float4*)(sL + tl * 64 + c8), l1 = *(const float4*)(sL + tl * 64 + c8 + 4), q0 = *(const float4*)(sAf + tl * 64 + c8), q1 = *(const float4*)(sAf + tl * 64 + c8 + 4);
          lw[0] = l0.x; lw[1] = l0.y; lw[2] = l0.z; lw[3] = l0.w; lw[4] = l1.x; lw[5] = l1.y; lw[6] = l1.z; lw[7] = l1.w; aa[0] = q0.x; aa[1] = q0.y; aa[2] = q0.z; aa[3] = q0.w; aa[4] = q1.x; aa[5] = q1.y; aa[6] = q1.z; aa[7] = q1.w; }
#pragma unroll
        for (int i = 0; i < 4; ++i) { rr[2 * i] = bflo(ru[i]); rr[2 * i + 1] = bfhi(ru[i]); kr[2 * i] = bflo(ku[i]); kr[2 * i + 1] = bfhi(ku[i]); }
#pragma unroll
        for (int i = 0; i < 2; ++i) {
            kkw_[4 * i] = n_kkw[i].x; kkw_[4 * i + 1] = n_kkw[i].y; kkw_[4 * i + 2] = n_kkw[i].z; kkw_[4 * i + 3] = n_kkw[i].w; kaw_[4 * i] = n_kaw[i].x; kaw_[4 * i + 1] = n_kaw[i].y; kaw_[4 * i + 2] = n_kaw[i].z; kaw_[4 * i + 3] = n_kaw[i].w;
            rkw_[4 * i] = n_rkw[i].x; rkw_[4 * i + 1] = n_rkw[i].y; rkw_[4 * i + 2] = n_rkw[i].z; rkw_[4 * i + 3] = n_rkw[i].w; }
        float qq[8], kk[8], bb[8], kp[8]; float ss = 0.f, rks = 0.f;
#pragma unroll
        for (int j = 0; j < 8; ++j) { qq[j] = kr[j] * kkw_[j]; ss += qq[j] * qq[j]; }
        ss = row8_sum(ss); const float inv = 1.0f / fmaxf(sqrtf(ss), 1e-12f);
#pragma unroll
        for (int j = 0; j < 8; ++j) { kk[j] = qq[j] * inv; bb[j] = kk[j] * aa[j]; kp[j] = kr[j] * (1.0f + (aa[j] - 1.0f) * kaw_[j]); rks += rr[j] * kp[j] * rkw_[j]; }
        rks = row8_sum(rks); if ((lt & 7) == 0) rkb[t * 16 + h] = rks;
#pragma unroll
        for (int i = 0; i < 4; ++i) { sVt[(c8 + 2 * i) * 24 + tl] = (u16)(vu[i] & 0xffffu); sVt[(c8 + 2 * i + 1) * 24 + tl] = (u16)(vu[i] >> 16); }
        LDS_BARRIER();
        if (lt < 64) { float lv[16];
#pragma unroll
            for (int i = 0; i < 16; ++i) lv[i] = sL[i * 64 + lt];
#pragma unroll
            for (int i = 1; i < 16; ++i) lv[i] += lv[i - 1];
#pragma unroll
            for (int i = 0; i < 16; ++i) sL[i * 64 + lt] = lv[i]; }
        LDS_BARRIER();
        { const float4 La = *(const float4*)(sL + tl * 64 + c8), Lb = *(const float4*)(sL + tl * 64 + c8 + 4), Ta = *(const float4*)(sL + 15 * 64 + c8), Tb = *(const float4*)(sL + 15 * 64 + c8 + 4);
          const float Lc[8] = {La.x, La.y, La.z, La.w, Lb.x, Lb.y, Lb.z, Lb.w}, Lt[8] = {Ta.x, Ta.y, Ta.z, Ta.w, Tb.x, Tb.y, Tb.z, Tb.w};
          float at[8], bt[8], kt[8], rt[8], bh[8], kh[8];
#pragma unroll
          for (int j = 0; j < 8; ++j) { const float eL = __expf(Lc[j]), eLp = __expf(Lc[j] - lw[j]), eNL = __expf(-Lc[j]), eH = __expf(Lt[j] - Lc[j]);
              at[j] = -kk[j] * eLp; bt[j] = bb[j] * eNL; kt[j] = kp[j] * eNL; rt[j] = rr[j] * eL; bh[j] = bb[j] * eH; kh[j] = kp[j] * eH; }
          uint4 w; w.x = cvt_pk_bf16(at[0], at[1]); w.y = cvt_pk_bf16(at[2], at[3]); w.z = cvt_pk_bf16(at[4], at[5]); w.w = cvt_pk_bf16(at[6], at[7]); *(uint4*)(sAt + tl * 72 + c8) = w;
          w.x = cvt_pk_bf16(bt[0], bt[1]); w.y = cvt_pk_bf16(bt[2], bt[3]); w.z = cvt_pk_bf16(bt[4], bt[5]); w.w = cvt_pk_bf16(bt[6], bt[7]); *(uint4*)(sBt + tl * 72 + c8) = w;
          w.x = cvt_pk_bf16(kt[0], kt[1]); w.y = cvt_pk_bf16(kt[2], kt[3]); w.z = cvt_pk_bf16(kt[4], kt[5]); w.w = cvt_pk_bf16(kt[6], kt[7]); *(uint4*)(sKt + tl * 72 + c8) = w;
          w.x = cvt_pk_bf16(rt[0], rt[1]); w.y = cvt_pk_bf16(rt[2], rt[3]); w.z = cvt_pk_bf16(rt[4], rt[5]); w.w = cvt_pk_bf16(rt[6], rt[7]); *(uint4*)(sRt + tl * 72 + c8) = w;
          *(uint4*)(lwb + (t * 1024 + h * 64) * 4 + 128 + c8 * 2) = w;
          *(float4*)(sRHS + tl * 132 + c8) = make_float4(at[0], at[1], at[2], at[3]); *(float4*)(sRHS + tl * 132 + c8 + 4) = make_float4(at[4], at[5], at[6], at[7]);
#pragma unroll
          for (int j = 0; j < 8; ++j) { unsigned char* dst = ab + ((t0 + (c8 >> 2) + (j >> 2)) * 1024 + h * 64) * 4 + (j & 3) * 64;
              *(u16*)(dst + tl * 2) = f2bf(bh[j]); *(u16*)(dst + (16 + tl) * 2) = f2bf(kh[j]); }
          if (tl == 0) { *(float4*)(gbuf + (size_t)unit * 64 + c8) = make_float4(__expf(Lt[0]), __expf(Lt[1]), __expf(Lt[2]), __expf(Lt[3]));
              *(float4*)(gbuf + (size_t)unit * 64 + c8 + 4) = make_float4(__expf(Lt[4]), __expf(Lt[5]), __expf(Lt[6]), __expf(Lt[7])); } }
        LDS_BARRIER();
        if (it + (int)gridDim.x < 2048) fetch(it + (int)gridDim.x);
        { const u16* X = qw == 0 ? sAt : sRt;
          const bf16x8 a0 = *(const bf16x8*)(X + fr * 72 + 8 * fq), a1 = *(const bf16x8*)(X + fr * 72 + 32 + 8 * fq);
#pragma unroll
          for (int pi = 0; pi < 2; ++pi) { const u16* Y = pi ? sKt : sBt; const int hw = qw * 2 + pi;
              const bf16x8 b0 = *(const bf16x8*)(Y + fr * 72 + 8 * fq), b1 = *(const bf16x8*)(Y + fr * 72 + 32 + 8 * fq);
              f32x4 acc = {0.f, 0.f, 0.f, 0.f};
              acc = __builtin_amdgcn_mfma_f32_16x16x32_bf16(a0, b0, acc, 0, 0, 0); acc = __builtin_amdgcn_mfma_f32_16x16x32_bf16(a1, b1, acc, 0, 0, 0);
#pragma unroll
              for (int j = 0; j < 4; ++j) { const int tt = 4 * fq + j, i = fr; const bool keep = hw < 2 ? (i < tt) : (i <= tt); const float val = keep ? acc[j] : 0.f;
                  if (hw == 0) sN[tt * 17 + i] = val;
                  else if (hw == 1) sAak[tt * 24 + i] = f2bf(val);
                  else rkv[(t0 + tt) * 3072 + h * 64 + (hw == 3 ? 16 : 0) + i] = f2bf(val); } } }
        LDS_BARRIER();
#pragma unroll
        for (int vi = 0; vi < 2; ++vi) { const int vt = qw * 2 + vi; bf16x8 af = {0, 0, 0, 0, 0, 0, 0, 0}, bf = {0, 0, 0, 0, 0, 0, 0, 0};
          if (fq < 2) { af = *(const bf16x8*)(sAak + fr * 24 + 8 * fq); bf = *(const bf16x8*)(sVt + (vt * 16 + fr) * 24 + 8 * fq); }
          f32x4 acc = {0.f, 0.f, 0.f, 0.f}; acc = __builtin_amdgcn_mfma_f32_16x16x32_bf16(af, bf, acc, 0, 0, 0);
#pragma unroll
          for (int j = 0; j < 4; ++j) sRHS[(4 * fq + j) * 132 + 64 + vt * 16 + fr] = acc[j]; }
        LDS_BARRIER();
        { const int col = qw * 64 + lane; float x[16];
#pragma unroll
            for (int i = 0; i < 16; ++i) { float v = sRHS[i * 132 + col];
#pragma unroll
                for (int j = 0; j < i; ++j) v += sN[i * 17 + j] * x[j];
                x[i] = v; }
            if (qw == 0) {
#pragma unroll
                for (int i = 0; i < 16; ++i) *(u16*)(lwb + ((t0 + i) * 1024 + h * 64) * 4 + lane * 2) = f2bf(x[i]); }
            else { uint4 w0, w1; w0.x = cvt_pk_bf16(x[0], x[1]); w0.y = cvt_pk_bf16(x[2], x[3]); w0.z = cvt_pk_bf16(x[4], x[5]); w0.w = cvt_pk_bf16(x[6], x[7]);
                w1.x = cvt_pk_bf16(x[8], x[9]); w1.y = cvt_pk_bf16(x[10], x[11]); w1.z = cvt_pk_bf16(x[12], x[13]); w1.w = cvt_pk_bf16(x[14], x[15]);
                u16* wp = rkv + (t0 + (lane >> 2)) * 3072 + 1024 + h * 64 + (lane & 3) * 16;
                *(uint4*)wp = w0; *(uint4*)(wp + 8) = w1; } }
    }
}
__device__ void rwkv_serial(const Params& P, unsigned char* lds_raw) {
    unsigned char* ws = P.ws; const int tid = threadIdx.x, lane = tid & 63, w = __builtin_amdgcn_readfirstlane(tid >> 6), fr = lane & 15, fq = lane >> 4;
    const int hb = blockIdx.x, b = hb >> 4, h = hb & 15;
    const unsigned char* lwb = ws + WS_Z + Z_LW; const unsigned char* ab = ws + WS_Z + Z_A; const u16* rkv = (const u16*)((unsigned char*)P.out + O_RKV);
    const float* gbuf = (const float*)(ws + WS_G); u16* yb = (u16*)(ws + WS_Y);
    u16* Sb = (u16*)lds_raw; u16* UVt = (u16*)(lds_raw + 18432);
    for (int i = tid; i < 64 * 72; i += 512) Sb[i] = 0;
    const int kt = w >> 1, vt0 = (w & 1) * 2, ut = w & 3, kr = kt * 16 + fr, uv = ut * 16 + fr;
    f32x4 st0 = {0.f, 0.f, 0.f, 0.f}, st1 = {0.f, 0.f, 0.f, 0.f};
    typedef unsigned u32x2_t __attribute__((ext_vector_type(2)));
    struct Pre { bf16x8 f0, f1, x, bk; f32x4 g; unsigned vv; };
#define PRE_LOAD(c_, p) do { const size_t t0_ = (size_t)b * SEQ + (size_t)(c_) * CH_; \
        const unsigned char* ls_ = lwb + ((t0_ + fr) * 1024 + h * 64) * 4 + (w < 4 ? 0 : 128) + fq * 16; \
        const void* a0_ = ls_; const void* a1_ = ls_ + 64; \
        const void* a2_ = (w < 4) ? (const void*)(rkv + (t0_ + (uv >> 2)) * 3072 + 1024 + h * 64 + (uv & 3) * 16 + fq * 4) : (const void*)(rkv + (t0_ + fr) * 3072 + h * 64 + fq * 8); \
        const void* a4_ = ab + ((t0_ + (kr >> 2)) * 1024 + h * 64) * 4 + (kr & 3) * 64 + fq * 16; \
        const void* a5_ = gbuf + ((size_t)hb * 256 + (c_)) * 64 + kt * 16 + 4 * fq; \
        const void* a6_ = rkv + (t0_ + (tid >> 5)) * 3072 + 2048 + h * 64 + (tid & 31) * 2; \
        asm volatile("global_load_dwordx4 %0, %1, off" : "=v"(p.f0) : "v"(a0_) : "memory"); \
        asm volatile("global_load_dwordx4 %0, %1, off" : "=v"(p.f1) : "v"(a1_) : "memory"); \
        asm volatile("global_load_dwordx4 %0, %1, off" : "=v"(p.x) : "v"(a2_) : "memory"); \
        asm volatile("global_load_dwordx4 %0, %1, off" : "=v"(p.bk) : "v"(a4_) : "memory"); \
        asm volatile("global_load_dwordx4 %0, %1, off" : "=v"(p.g) : "v"(a5_) : "memory"); \
        asm volatile("global_load_dword %0, %1, off" : "=v"(p.vv) : "v"(a6_) : "memory"); } while (0)
#define PRE_WAIT(p, N) asm volatile("s_waitcnt vmcnt(" #N ")" : "+v"(p.f0), "+v"(p.f1), "+v"(p.x), "+v"(p.bk), "+v"(p.g), "+v"(p.vv) :: "memory")
    auto step = [&](int c, const Pre& cur) {
        const u16* S = Sb + (c & 1) * (64 * 72); u16* Sn = Sb + ((c & 1) ^ 1) * (64 * 72); const size_t t0 = (size_t)b * SEQ + c * CH_;
        { const int tv = tid >> 5, v2 = (tid & 31) * 2; UVt[v2 * 40 + 16 + tv] = (u16)(cur.vv & 0xffffu); UVt[(v2 + 1) * 40 + 16 + tv] = (u16)(cur.vv >> 16); }
        const bf16x8 s0 = *(const bf16x8*)(S + uv * 72 + 8 * fq), s1 = *(const bf16x8*)(S + uv * 72 + 32 + 8 * fq);
        f32x4 acc = {0.f, 0.f, 0.f, 0.f};
        if (w < 4) { const unsigned wx = (unsigned)(unsigned short)cur.x[0] | ((unsigned)(unsigned short)cur.x[1] << 16), wy = (unsigned)(unsigned short)cur.x[2] | ((unsigned)(unsigned short)cur.x[3] << 16);
            acc[0] = bflo(wx); acc[1] = bfhi(wx); acc[2] = bflo(wy); acc[3] = bfhi(wy); }
        acc = __builtin_amdgcn_mfma_f32_16x16x32_bf16(cur.f0, s0, acc, 0, 0, 0); acc = __builtin_amdgcn_mfma_f32_16x16x32_bf16(cur.f1, s1, acc, 0, 0, 0);
        if (w < 4) { uint2 o; o.x = cvt_pk_bf16(acc[0], acc[1]); o.y = cvt_pk_bf16(acc[2], acc[3]); *(uint2*)(UVt + uv * 40 + 4 * fq) = o; }
        LDS_BARRIER();
        if (w >= 4) { const bf16x8 uf = *(const bf16x8*)(UVt + uv * 40 + 8 * fq); acc = __builtin_amdgcn_mfma_f32_16x16x32_bf16(cur.x, uf, acc, 0, 0, 0);
#pragma unroll
            for (int j = 0; j < 4; ++j) yb[(t0 + 4 * fq + j) * RWD + h * 64 + uv] = f2bf(acc[j]); }
        { const bf16x8 u0 = *(const bf16x8*)(UVt + ((vt0 + 0) * 16 + fr) * 40 + 8 * fq), u1 = *(const bf16x8*)(UVt + ((vt0 + 1) * 16 + fr) * 40 + 8 * fq);
          st0 = __builtin_amdgcn_mfma_f32_16x16x32_bf16(cur.bk, u0, st0 * cur.g, 0, 0, 0); st1 = __builtin_amdgcn_mfma_f32_16x16x32_bf16(cur.bk, u1, st1 * cur.g, 0, 0, 0);
          uint2 o; o.x = cvt_pk_bf16(st0[0], st0[1]); o.y = cvt_pk_bf16(st0[2], st0[3]); *(uint2*)(Sn + ((vt0 + 0) * 16 + fr) * 72 + kt * 16 + 4 * fq) = o;
          o.x = cvt_pk_bf16(st1[0], st1[1]); o.y = cvt_pk_bf16(st1[2], st1[3]); *(uint2*)(Sn + ((vt0 + 1) * 16 + fr) * 72 + kt * 16 + 4 * fq) = o; }
        LDS_BARRIER(); };
    Pre q0, q1, q2, q3, q4, q5; PRE_LOAD(0, q0); PRE_LOAD(1, q1); PRE_LOAD(2, q2); PRE_LOAD(3, q3); PRE_LOAD(4, q4); PRE_LOAD(5, q5);
    __syncthreads();
    constexpr int NCH = SEQ / CH_;
    for (int c = 0; c < 252; c += 6) {
        PRE_WAIT(q0, 30); step(c, q0);     PRE_LOAD(min(c + 6, NCH - 1), q0);
        PRE_WAIT(q1, 30); step(c + 1, q1); PRE_LOAD(min(c + 7, NCH - 1), q1);
        PRE_WAIT(q2, 30); step(c + 2, q2); PRE_LOAD(min(c + 8, NCH - 1), q2);
        PRE_WAIT(q3, 30); step(c + 3, q3); PRE_LOAD(min(c + 9, NCH - 1), q3);
        PRE_WAIT(q4, 30); step(c + 4, q4); PRE_LOAD(min(c + 10, NCH - 1), q4);
        PRE_WAIT(q5, 30); step(c + 5, q5); PRE_LOAD(min(c + 11, NCH - 1), q5);
    }
    PRE_WAIT(q0, 0); PRE_WAIT(q1, 0); PRE_WAIT(q2, 0); PRE_WAIT(q3, 0); PRE_WAIT(q4, 0); PRE_WAIT(q5, 0);
    step(252, q0); step(253, q1); step(254, q2); step(255, q3);
#undef PRE_LOAD
#undef PRE_WAIT
}

__device__ void attn_phase(const Params& P) {
    unsigned char* ws = P.ws; const int tid = threadIdx.x, lane = tid & 63, fr = lane & 15, fq = lane >> 4;
    const u16* Qn = (const u16*)((unsigned char*)P.out + O_QN); const u16* Kn = (const u16*)(ws + WS_X + X_KN); const u16* Vt = (const u16*)(ws + WS_X + X_VT);
    u16* oatt = (u16*)(ws + WS_X + X_OATT);
    const int NA = (int)gridDim.x - NSCAN; const int gw = ((int)blockIdx.x - NSCAN) * 8 + (tid >> 6);
    for (int unit = gw; unit < 8192; unit += NA * 8) {
        const int h = unit & 15, st = (unit >> 4) & 255, b = unit >> 12, kh = h >> 2;
        const int s0 = st * 16; const size_t t0 = (size_t)b * SEQ + s0;
        const float slope = exp2f(-0.5f * (float)(h + 1)), sink = P.in[16][h];
        bf16x8 qf[2];
        qf[0] = *(const bf16x8*)(Qn + (t0 + fr) * 1024 + h * 64 + 8 * fq); qf[1] = *(const bf16x8*)(Qn + (t0 + fr) * 1024 + h * 64 + 32 + 8 * fq);
        f32x4 sc[10]; float mx = sink;
#pragma unroll
        for (int kt = 0; kt < 10; ++kt) { const int ks0 = s0 - 144 + 16 * kt; int kp = ks0 + fr; kp = kp < 0 ? 0 : kp;
            const u16* kr = Kn + ((size_t)b * SEQ + kp) * 256 + kh * 64 + 8 * fq;
            const bf16x8 k0 = *(const bf16x8*)kr, k1 = *(const bf16x8*)(kr + 32);
            f32x4 a = {0.f, 0.f, 0.f, 0.f};
            a = __builtin_amdgcn_mfma_f32_16x16x32_bf16(k0, qf[0], a, 0, 0, 0); a = __builtin_amdgcn_mfma_f32_16x16x32_bf16(k1, qf[1], a, 0, 0, 0);
#pragma unroll
            for (int j = 0; j < 4; ++j) { const int kpos = ks0 + 4 * fq + j; const int dist = s0 + fr - kpos; const bool valid = (dist >= 0) && (dist < 128) && (kpos >= 0);
                const float v = valid ? a[j] - slope * (float)dist : -1e30f; a[j] = v; mx = fmaxf(mx, v); }
            sc[kt] = a; }
        mx = fmaxf(mx, __shfl_xor(mx, 16)); mx = fmaxf(mx, __shfl_xor(mx, 32));
        float sum = 0.f;
#pragma unroll
        for (int kt = 0; kt < 10; ++kt)
#pragma unroll
            for (int j = 0; j < 4; ++j) { const float e = __expf(sc[kt][j] - mx); sc[kt][j] = e; sum += e; }
        sum += __shfl_xor(sum, 16); sum += __shfl_xor(sum, 32);
        const float inv = 1.0f / (sum + __expf(sink - mx));
        f32x4 o[4];
#pragma unroll
        for (int dt = 0; dt < 4; ++dt) o[dt] = (f32x4){0.f, 0.f, 0.f, 0.f};
#pragma unroll
        for (int u = 0; u < 5; ++u) {
            union { bf16x8 v; unsigned w[4]; } pf;
            pf.w[0] = cvt_pk_bf16(sc[2 * u][0] * inv, sc[2 * u][1] * inv); pf.w[1] = cvt_pk_bf16(sc[2 * u][2] * inv, sc[2 * u][3] * inv);
            pf.w[2] = cvt_pk_bf16(sc[2 * u + 1][0] * inv, sc[2 * u + 1][1] * inv); pf.w[3] = cvt_pk_bf16(sc[2 * u + 1][2] * inv, sc[2 * u + 1][3] * inv);
            int ka = s0 - 144 + 32 * u + 4 * fq, kb = ka + 16; ka = ka < 0 ? 0 : ka; kb = kb < 0 ? 0 : kb;
#pragma unroll
            for (int dt = 0; dt < 4; ++dt) { const u16* vr = Vt + ((size_t)(b * 4 + kh) * 64 + dt * 16 + fr) * SEQ;
                union { bf16x8 v; uint2 w[2]; } vf; vf.w[0] = *(const uint2*)(vr + ka); vf.w[1] = *(const uint2*)(vr + kb);
                o[dt] = __builtin_amdgcn_mfma_f32_16x16x32_bf16(pf.v, vf.v, o[dt], 0, 0, 0); } }
#pragma unroll
        for (int dt = 0; dt < 4; ++dt)
#pragma unroll
            for (int j = 0; j < 4; ++j) oatt[(t0 + 4 * fq + j) * 1024 + h * 64 + dt * 16 + fr] = f2bf(o[dt][j]);
    }
}

__device__ void phase5(const Params& P) {
    unsigned char* ws = P.ws; const int G = gridDim.x, bid = blockIdx.x, tid = threadIdx.x, lane = tid & 63;
    const u16* rkv = (const u16*)((unsigned char*)P.out + O_RKV); u16* orw = (u16*)((unsigned char*)P.out + O_QN);
    const u16* yraw = (const u16*)(ws + WS_Y); const u16* gp = (const u16*)(ws + WS_Z + Z_G); const float* rkb = (const float*)(ws + WS_RK);
    for (int t = bid * 8 + (tid >> 6); t < MT; t += G * 8) {
        uint2 y2[4], v2[4], g2[4]; float rk[4];
#pragma unroll
        for (int it = 0; it < 4; ++it) { const int hh = it * 4 + (lane >> 4), hc = hh * 64 + (lane & 15) * 4; const size_t o = (size_t)t * RWD + hc;
            y2[it] = *(const uint2*)(yraw + o); g2[it] = *(const uint2*)(gp + o); v2[it] = *(const uint2*)(rkv + (size_t)t * 3072 + 2048 + hc); rk[it] = rkb[(size_t)t * 16 + hh]; }
#pragma unroll
        for (int it = 0; it < 4; ++it) { const int hc = (it * 4 + (lane >> 4)) * 64 + (lane & 15) * 4; const size_t o = (size_t)t * RWD + hc;
            const float4 gw = *(const float4*)(P.in[12] + hc), gb = *(const float4*)(P.in[13] + hc);
            const float yx = bflo(y2[it].x), yy = bfhi(y2[it].x), yz = bflo(y2[it].y), yw = bfhi(y2[it].y);
            const float mu = row16_sum((yx + yy) + (yz + yw)) * (1.0f / 64.0f);
            const float dx = yx - mu, dy = yy - mu, dz = yz - mu, dw = yw - mu;
            const float var = row16_sum((dx * dx + dy * dy) + (dz * dz + dw * dw)) * (1.0f / 64.0f); const float rs = rsqrtf(var + 64e-5f);
            const float o0 = (dx * rs * gw.x + gb.x + rk[it] * bflo(v2[it].x)) * bflo(g2[it].x), o1 = (dy * rs * gw.y + gb.y + rk[it] * bfhi(v2[it].x)) * bfhi(g2[it].x);
            const float o2 = (dz * rs * gw.z + gb.z + rk[it] * bflo(v2[it].y)) * bflo(g2[it].y), o3 = (dw * rs * gw.w + gb.w + rk[it] * bfhi(v2[it].y)) * bfhi(g2[it].y);
            uint2 w; w.x = cvt_pk_bf16(o0, o1); w.y = cvt_pk_bf16(o2, o3); *(uint2*)(orw + o) = w; }
    }
}

__device__ void phase9(const Params& P) {
    unsigned char* ws = P.ws; const u16* uu = (const u16*)(ws + WS_Z); u16* act = (u16*)(ws + WS_ACT);
    const float* cw = P.in[21]; const float* cb = P.in[22];
    const int nth = gridDim.x * 512;
    for (int task = blockIdx.x * 512 + threadIdx.x; task < 1024 * 1408; task += nth) {
        const int j0 = (task % 1408) * 4, t0 = (task / 1408) * 8; const bool first = (t0 & (SEQ - 1)) == 0;
        uint2 ra[10], rg[10];
#pragma unroll
        for (int r = 0; r < 10; ++r) { const int t = (first && r < 2) ? t0 : t0 - 2 + r; ra[r] = *(const uint2*)(uu + (size_t)t * NUP + j0); rg[r] = *(const uint2*)(uu + (size_t)t * NUP + DFF + j0); }
        if (first) { ra[0] = make_uint2(0u, 0u); ra[1] = ra[0]; rg[0] = ra[0]; rg[1] = ra[0]; }
        const float4 wa0 = *(const float4*)(cw + j0), wa1 = *(const float4*)(cw + NUP + j0), wa2 = *(const float4*)(cw + 2 * NUP + j0), ba = *(const float4*)(cb + j0);
        const float4 wg0 = *(const float4*)(cw + DFF + j0), wg1 = *(const float4*)(cw + NUP + DFF + j0), wg2 = *(const float4*)(cw + 2 * NUP + DFF + j0), bg = *(const float4*)(cb + DFF + j0);
#pragma unroll
        for (int i = 0; i < 8; ++i) {
            const float cv0 = bflo(ra[i].x) * wa0.x + bflo(ra[i + 1].x) * wa1.x + bflo(ra[i + 2].x) * wa2.x + ba.x, cv1 = bfhi(ra[i].x) * wa0.y + bfhi(ra[i + 1].x) * wa1.y + bfhi(ra[i + 2].x) * wa2.y + ba.y;
            const float cv2 = bflo(ra[i].y) * wa0.z + bflo(ra[i + 1].y) * wa1.z + bflo(ra[i + 2].y) * wa2.z + ba.z, cv3 = bfhi(ra[i].y) * wa0.w + bfhi(ra[i + 1].y) * wa1.w + bfhi(ra[i + 2].y) * wa2.w + ba.w;
            const float cg0 = bflo(rg[i].x) * wg0.x + bflo(rg[i + 1].x) * wg1.x + bflo(rg[i + 2].x) * wg2.x + bg.x, cg1 = bfhi(rg[i].x) * wg0.y + bfhi(rg[i + 1].x) * wg1.y + bfhi(rg[i + 2].x) * wg2.y + bg.y;
            const float cg2 = bflo(rg[i].y) * wg0.z + bflo(rg[i + 1].y) * wg1.z + bflo(rg[i + 2].y) * wg2.z + bg.z, cg3 = bfhi(rg[i].y) * wg0.w + bfhi(rg[i + 1].y) * wg1.w + bfhi(rg[i + 2].y) * wg2.w + bg.w;
            uint2 w; w.x = cvt_pk_bf16(cg0 * sigmoidf_(cg0) * cv0, cg1 * sigmoidf_(cg1) * cv1); w.y = cvt_pk_bf16(cg2 * sigmoidf_(cg2) * cv2, cg3 * sigmoidf_(cg3) * cv3);
            *(uint2*)(act + (size_t)(t0 + i) * DFF + j0) = w; }
    }
}

#define XB_TMO      128
#define XB_XCNT(j)  (256  + 64 * (j))
#define XB_XSUB(j)  (1280 + 64 * (j))
#define XB_XGEN(j)  (2304 + 64 * (j))
#define XB_TOP      3328
#define XB_TOPGEN   3392
#define XCD_BAR_WORDS 3456
#define XB_SPIN_CAP (1u << 18)

__device__ __forceinline__ unsigned xb_ld(unsigned* p)              { return __hip_atomic_load(p, __ATOMIC_RELAXED, __HIP_MEMORY_SCOPE_AGENT); }
__device__ __forceinline__ unsigned xb_add(unsigned* p, unsigned v) { return __hip_atomic_fetch_add(p, v, __ATOMIC_RELAXED, __HIP_MEMORY_SCOPE_AGENT); }
__device__ __forceinline__ unsigned xb_xcc_id() { return (unsigned)__builtin_amdgcn_s_getreg((3 << 11) | 20) & 0xFu; }
#define XB_SPIN(cond, bar) do { unsigned _sp = 0; while (cond) { __builtin_amdgcn_s_sleep(1); \
    if ((++_sp & 255u) == 0u) { if (xb_ld(&(bar)[XB_TMO])) break; if (_sp > XB_SPIN_CAP) { atomicAdd(&(bar)[XB_TMO], 1u); break; } } } } while (0)

struct XcdBarrier {
    unsigned* bar; unsigned x;
    volatile LAS unsigned* st;
};

__device__ __forceinline__ XcdBarrier xcd_barrier_post(unsigned* bar, volatile LAS unsigned* st) {
    XcdBarrier b; b.bar = bar; b.x = xb_xcc_id(); b.st = st;
    if (threadIdx.x == 0) (void)xb_add(&bar[XB_XCNT(b.x)], 1u);
    return b;
}
__device__ __forceinline__ void xcd_barrier_complete(unsigned* bar, unsigned x, unsigned& nloc, unsigned& nx) {
    const unsigned G = gridDim.x * gridDim.y * gridDim.z;
    unsigned sum, cnt, mine, sp = 0u;
    for (;;) {
        sum = 0u; cnt = 0u; mine = 0u;
#pragma unroll
        for (unsigned j = 0; j < 16; ++j) { const unsigned c = xb_ld(&bar[XB_XCNT(j)]); sum += c; cnt += (c > 0u) ? 1u : 0u; mine = (j == x) ? c : mine; }
        if (sum == G) break;
        __builtin_amdgcn_s_sleep(1);
        if ((++sp & 255u) == 0u) { if (xb_ld(&bar[XB_TMO])) break; if (sp > XB_SPIN_CAP) { atomicAdd(&bar[XB_TMO], 1u); break; } }
    }
    nloc = mine > 0u ? mine : 1u; nx = cnt > 0u ? cnt : 1u;
}

__device__ __forceinline__ void xcd_barrier(const XcdBarrier& b) {
    asm volatile("s_waitcnt vmcnt(0)" ::: "memory");
    __syncthreads();
    if (threadIdx.x == 0) {
        unsigned* bar = b.bar;
        __builtin_amdgcn_s_waitcnt(0);
        unsigned nloc = b.st[0], nx = b.st[1];
        if (nloc == 0u) { xcd_barrier_complete(bar, b.x, nloc, nx); b.st[0] = nloc; b.st[1] = nx; }
        const unsigned old = xb_add(&bar[XB_XSUB(b.x)], 1u);
        const unsigned gen = old / nloc;
        if (old + 1u == (gen + 1u) * nloc) {
            __builtin_amdgcn_fence(__ATOMIC_RELEASE, "agent");
            asm volatile("s_waitcnt vmcnt(0)" ::: "memory");
            const unsigned og = xb_add(&bar[XB_TOP], 1u);
            const unsigned tg = og / nx;
            if (og + 1u == (tg + 1u) * nx) xb_add(&bar[XB_TOPGEN], 1u);
            else XB_SPIN(xb_ld(&bar[XB_TOPGEN]) == tg, bar);
            __builtin_amdgcn_fence(__ATOMIC_ACQUIRE, "agent");
            xb_add(&bar[XB_XGEN(b.x)], 1u);
            asm volatile("s_waitcnt vmcnt(0)" ::: "memory");
        } else {
            XB_SPIN(xb_ld(&bar[XB_XGEN(b.x)]) == gen, bar);
            __builtin_amdgcn_fence(__ATOMIC_ACQUIRE, "agent");
            asm volatile("s_waitcnt vmcnt(0)" ::: "memory");
        }
    }
    __syncthreads();
}

constexpr int NPH = 12;
__global__ void __launch_bounds__(512, 2) mega(Params P) {
    extern __shared__ __attribute__((aligned(16))) unsigned char lds_raw[];
    LAS unsigned char* lds = (LAS unsigned char*)lds_raw;
    unsigned char* ws = P.ws;
    volatile LAS unsigned* xst = (volatile LAS unsigned*)(lds + 131072);
    if (threadIdx.x < 4) xst[threadIdx.x] = 0u;
    __syncthreads();
    XcdBarrier xb = xcd_barrier_post((unsigned*)(ws + WS_BAR), xst);
#define RUN(i) ((i) >= P.ph_lo && (i) < P.ph_hi)
#define SEAM(i) do { if ((i) >= P.ph_lo && (i) + 1 < P.ph_hi) { xcd_barrier(xb); } } while (0)
    if (RUN(0)) phase0(P, (float*)lds_raw);
    SEAM(0);
    if (RUN(1)) { EpiZ E; E.zmain = (u16*)(ws + WS_Z + Z_MAIN); E.zgate = (u16*)(ws + WS_Z + Z_GATE); E.rstd = (const float*)(ws + WS_SMALL);
        run_gemm(lds, (const u16*)(ws + WS_Z + Z_TAIL), (const u16*)(ws + WS_WIN), 6144, 2048, E); }
    SEAM(1);
    if (RUN(2)) phase2(P, (u16*)lds_raw);
    SEAM(2);
    if (RUN(4)) rwkv_prep(P, lds_raw);
    SEAM(4);
    if (RUN(5)) {
        if ((int)blockIdx.x < NSCAN) rwkv_serial(P, lds_raw);
        else { attn_phase(P); __syncthreads();
            { EpiZG E; E.zgate = (u16*)(ws + WS_Z + Z_GATE); E.rstd = (const float*)(ws + WS_SMALL);
              run_gemm_sub(lds, (const u16*)(ws + WS_Z + Z_TAIL), (const u16*)(ws + WS_WIN) + (size_t)6144 * 2048, 3072, 2048, E, (int)gridDim.x - NSCAN, (int)blockIdx.x - NSCAN); } }
        { volatile int* qid = (volatile int*)(lds_raw + 98304); unsigned* head = (unsigned*)(ws + WS_CNT);
          for (;;) { __syncthreads(); if (threadIdx.x == 0) qid[0] = (int)atomicAdd(head, 1u); __syncthreads();
              const int q = qid[0]; if (q >= 1920) break;
              weight_tile(P, q < 1408 ? 1152 + q : 3264 + (q - 1408), (float*)lds_raw); } }
    }
    SEAM(5);
    if (RUN(6)) phase5(P);
    SEAM(6);
    if (RUN(7)) {
        { EpiBranch<0> E; E.mixed = (u16*)(ws + WS_Z); E.zgate = (const u16*)(ws + WS_Z + Z_GATE);
          run_gemm(lds, (const u16*)((unsigned char*)P.out + O_QN), (const u16*)(ws + WS_WBR1), 2048, 1024, E); }
        { EpiBranch<1> E; E.mixed = (u16*)(ws + WS_Z); E.zgate = (const u16*)(ws + WS_Z + Z_GATE);
          run_gemm(lds, (const u16*)(ws + WS_X + X_OATT), (const u16*)(ws + WS_WBR2), 2048, 1024, E); } }
    SEAM(7);
    if (RUN(8)) { EpiOut1 E; E.x = P.in[0]; E.x1 = P.out; E.x1b = (u16*)(ws + WS_X); E.rowss = (float*)(ws + WS_SMALL + 32768);
        run_gemm(lds, (const u16*)(ws + WS_Z), (const u16*)(ws + WS_WOUT), 2048, 2048, E); }
    SEAM(8);
    if (RUN(9)) { EpiUp E; E.uo = (u16*)(ws + WS_Z); E.rowss = (const float*)(ws + WS_SMALL + 32768);
        run_gemm(lds, (const u16*)(ws + WS_X), (const u16*)(ws + WS_WUP), NUP, 2048, E);
        { const int G_ = (int)gridDim.x, nfull = 1408 % G_, bid_ = (int)blockIdx.x;
          if (bid_ >= nfull) { __syncthreads(); for (int id = 2560 + (bid_ - nfull); id < 3264; id += G_ - nfull) weight_tile(P, id, (float*)lds_raw); } } }
    SEAM(9);
    if (RUN(10)) phase9(P);
    SEAM(10);
    if (RUN(11)) { EpiFinal E; E.out = P.out; E.x1b = (const u16*)(ws + WS_X);
        run_gemm(lds, (const u16*)(ws + WS_ACT), (const u16*)(ws + WS_WDOWN), 2048, DFF, E); }
}

constexpr int LDS_BYTES = 131072 + 16;
extern "C" void kernel_launch(void* const* d_in, const int* in_sizes, int n_in, void* d_out, int out_size, void* d_ws, size_t ws_size, hipStream_t stream) {
    static int grid = 0;
    if (grid == 0) {
        if (n_in != 24 || out_size != MT * DM || ws_size < WS_END) { fprintf(stderr, "kernel_launch: unexpected shapes (n_in %d out %d ws %zu need %zu)\n", n_in, out_size, ws_size, (size_t)WS_END); grid = -1; return; }
        int dev = 0, cus = 0, per_cu = 0;
        hipGetDevice(&dev); hipDeviceGetAttribute(&cus, hipDeviceAttributeMultiprocessorCount, dev);
        if (hipFuncSetAttribute((const void*)mega, hipFuncAttributeMaxDynamicSharedMemorySize, LDS_BYTES) != hipSuccess) { fprintf(stderr, "kernel_launch: hipFuncSetAttribute failed\n"); grid = -1; return; }
        if (hipOccupancyMaxActiveBlocksPerMultiprocessor(&per_cu, (const void*)mega, 512, LDS_BYTES) != hipSuccess || per_cu < 1) { fprintf(stderr, "kernel_launch: occupancy query failed (%d)\n", per_cu); grid = -1; return; }
        grid = cus * per_cu; if (grid > 256) grid = 256;
        if (grid < 2 * NSCAN) { fprintf(stderr, "kernel_launch: grid %d too small\n", grid); grid = -1; return; }
    }
    if (grid < 0) return;
    Params p{};
    for (int i = 0; i < 24; ++i) p.in[i] = (const float*)d_in[i];
    p.out = (float*)d_out; p.ws = (unsigned char*)d_ws;
    if (hipMemsetAsync((unsigned char*)d_ws + WS_BAR, 0, 16384, stream) != hipSuccess) { fprintf(stderr, "kernel_launch: hipMemsetAsync of the barrier words failed\n"); return; }
    p.ph_lo = 0; p.ph_hi = NPH;
    { void* args[] = {&p}; hipError_t e = hipLaunchCooperativeKernel((const void*)mega, dim3(grid), dim3(512), args, LDS_BYTES, stream);
      if (e != hipSuccess) fprintf(stderr, "cooperative launch failed: %s (grid %d)\n", hipGetErrorString(e), grid); }

}
```
